# Optimizing an MI355X kernel written in HIP

```python
import jax
import jax.numpy as jnp
from jax import lax
import numpy as np

D_MODEL = 2048
BATCH = 4
SEQ = 2048
DEPTH = 1

EPS = 1e-6
D_MIX = D_MODEL

HG_HEADS = 8
HG_DK = 128
HG_DV = 128
HG_WIDTH = HG_HEADS * HG_DV
HG_CHUNK = 64

MLA_HEADS = 8
MLA_Q_RANK = 512
MLA_KV_RANK = 256
MLA_NOPE = 128
MLA_ROPE = 64
MLA_QK = MLA_NOPE + MLA_ROPE
MLA_V = 128
MLA_WIDTH = MLA_HEADS * MLA_V
ATTN_BLOCK = 128
ROPE_THETA = 10000.0

IN_SIZES = (HG_HEADS * HG_DK, HG_HEADS * HG_DK, HG_HEADS * HG_DV, HG_HEADS * HG_DV,
            MLA_Q_RANK, MLA_KV_RANK, MLA_ROPE)
IN_COLS = sum(IN_SIZES)

N_EXPERTS = 64
TOP_K = 8
N_GROUPS = 8
TOPK_GROUPS = 4
EXPERTS_PER_GROUP = N_EXPERTS // N_GROUPS
D_EXPERT = 512
ROUTED_SCALE = 2.5
MOE_BLOCK = 128

kernel_name = 'hymba_hgrn2_mla_moe_adaln'


def rms_norm(x, g):
    xf = x.astype(jnp.float32)
    y = xf * lax.rsqrt(jnp.mean(xf * xf, axis=-1, keepdims=True) + EPS)
    return (y * g.astype(jnp.float32)).astype(x.dtype)


def apply_rope(x, pos):
    half = MLA_ROPE // 2
    inv_freq = ROPE_THETA ** (-jnp.arange(half, dtype=jnp.float32) / half)
    ang = pos.astype(jnp.float32)[:, :, None, None] * inv_freq
    cos, sin = jnp.cos(ang), jnp.sin(ang)
    xf = x.astype(jnp.float32)
    x1, x2 = xf[..., :half], xf[..., half:]
    return jnp.concatenate([x1 * cos - x2 * sin, x2 * cos + x1 * sin], axis=-1).astype(x.dtype)


def hgrn2_group(q, f_logit, i_in, g, lb, out_g):
    B, S, _ = q.shape
    n_chunks = S // HG_CHUNK
    f32 = jnp.float32
    f = lb + (1.0 - lb) * jax.nn.sigmoid(f_logit.astype(f32))
    log_f = jnp.log(f)
    k = 1.0 - f

    def to_chunks(t, d):
        return t.astype(f32).reshape(B, n_chunks, HG_CHUNK, HG_HEADS, d).transpose(1, 0, 3, 2, 4)

    qc, lfc, kc, vc = to_chunks(q, HG_DK), to_chunks(log_f, HG_DK), to_chunks(k, HG_DK), to_chunks(i_in, HG_DV)
    causal = jnp.tril(jnp.ones((HG_CHUNK, HG_CHUNK), dtype=bool))[:, :, None]

    def chunk_step(state, inp):
        q_c, lf_c, k_c, v_c = inp
        b = jnp.cumsum(lf_c, axis=2)
        o_inter = jnp.einsum('bhtk,bhkv->bhtv', q_c * jnp.exp(b), state)
        rel = b[:, :, :, None, :] - b[:, :, None, :, :]
        decay = jnp.exp(jnp.where(causal, rel, -jnp.inf))
        attn = jnp.einsum('bhtk,bhtsk,bhsk->bhts', q_c, decay, k_c)
        o_intra = jnp.einsum('bhts,bhsv->bhtv', attn, v_c)
        b_last = b[:, :, -1, :]
        state = (jnp.exp(b_last)[..., None] * state
                 + jnp.einsum('bhsk,bhsv->bhkv', k_c * jnp.exp(b_last[:, :, None, :] - b), v_c))
        return state, o_inter + o_intra

    s0 = jnp.zeros((B, HG_HEADS, HG_DK, HG_DV), f32)
    _, o = lax.scan(chunk_step, s0, (qc, lfc, kc, vc))
    o = o.transpose(1, 0, 3, 2, 4).reshape(B, S, HG_HEADS, HG_DV)
    gate = jax.nn.silu(g.astype(f32)).reshape(B, S, HG_HEADS, HG_DV)
    o = rms_norm(o, out_g) * gate
    return o.reshape(B, S, HG_WIDTH).astype(q.dtype)


def mla_group(c_q, c_kv, k_rope, pos, q_a_g, w_uq, kv_a_g, w_ukv, q_norm_g, k_norm_g):
    B, S, _ = c_q.shape
    q = (rms_norm(c_q, q_a_g) @ w_uq).reshape(B, S, MLA_HEADS, MLA_QK)
    kv = (rms_norm(c_kv, kv_a_g) @ w_ukv).reshape(B, S, MLA_HEADS, MLA_NOPE + MLA_V)
    k_nope, v = kv[..., :MLA_NOPE], kv[..., MLA_NOPE:]
    k = jnp.concatenate([k_nope, jnp.broadcast_to(k_rope[:, :, None, :], (B, S, MLA_HEADS, MLA_ROPE))], axis=-1)
    q = rms_norm(q, q_norm_g)
    k = rms_norm(k, k_norm_g)
    q = jnp.concatenate([q[..., :MLA_NOPE], apply_rope(q[..., MLA_NOPE:], pos)], axis=-1)
    k = jnp.concatenate([k[..., :MLA_NOPE], apply_rope(k[..., MLA_NOPE:], pos)], axis=-1)

    n_blocks = S // ATTN_BLOCK
    q_blocks = q.reshape(B, n_blocks, ATTN_BLOCK, MLA_HEADS, MLA_QK).transpose(1, 0, 2, 3, 4)
    key_idx = jnp.arange(S)
    scale = MLA_QK ** -0.5

    def attend(args):
        q_blk, blk = args
        q_idx = blk * ATTN_BLOCK + jnp.arange(ATTN_BLOCK)
        s = jnp.einsum('bqhd,bkhd->bhqk', q_blk, k, preferred_element_type=jnp.float32) * scale
        s = jnp.where(key_idx[None, :] <= q_idx[:, None], s, -jnp.inf)
        p = jax.nn.softmax(s, axis=-1).astype(v.dtype)
        return jnp.einsum('bhqk,bkhd->bqhd', p, v)

    o = lax.map(attend, (q_blocks, jnp.arange(n_blocks)))
    return o.transpose(1, 0, 2, 3, 4).reshape(B, S, MLA_WIDTH)


def moe(h, w_router, router_bias, w_gate, w_up, w_down, ws_gate, ws_up, ws_down):
    B, S, D = h.shape
    T = B * S
    xt = h.reshape(T, D)
    scores = jax.nn.sigmoid(jnp.einsum('td,de->te', xt, w_router, preferred_element_type=jnp.float32))
    sel = scores + router_bias.astype(jnp.float32)
    grp_score = lax.top_k(sel.reshape(T, N_GROUPS, EXPERTS_PER_GROUP), 2)[0].sum(-1)
    _, grp_idx = lax.top_k(grp_score, TOPK_GROUPS)
    grp_mask = jnp.any(grp_idx[:, :, None] == jnp.arange(N_GROUPS)[None, None, :], axis=1)
    sel = jnp.where(jnp.repeat(grp_mask, EXPERTS_PER_GROUP, axis=1), sel, -jnp.inf)
    _, top_idx = lax.top_k(sel, TOP_K)
    top_w = jnp.take_along_axis(scores, top_idx, axis=1)
    top_w = top_w / jnp.sum(top_w, axis=-1, keepdims=True) * ROUTED_SCALE

    A = T * TOP_K
    e_flat = top_idx.reshape(A)
    tok_flat = jnp.repeat(jnp.arange(T, dtype=jnp.int32), TOP_K)
    w_flat = top_w.reshape(A)
    order = jnp.argsort(e_flat)
    e_sorted, tok_sorted, w_sorted = e_flat[order], tok_flat[order], w_flat[order]
    counts = jnp.bincount(e_flat, length=N_EXPERTS)
    padded = (counts + MOE_BLOCK - 1) // MOE_BLOCK * MOE_BLOCK
    start = jnp.cumsum(counts) - counts
    pad_end = jnp.cumsum(padded)
    pad_start = pad_end - padded
    dest = pad_start[e_sorted] + (jnp.arange(A, dtype=jnp.int32) - start[e_sorted])
    P = A + N_EXPERTS * MOE_BLOCK
    n_blk = P // MOE_BLOCK
    row_tok = jnp.full((P,), T, dtype=jnp.int32).at[dest].set(tok_sorted)
    row_w = jnp.zeros((P,), jnp.float32).at[dest].set(w_sorted)
    blk_expert = jnp.minimum(jnp.searchsorted(pad_end, jnp.arange(n_blk) * MOE_BLOCK, side='right'), N_EXPERTS - 1)
    x_pad = jnp.concatenate([xt, jnp.zeros((1, D), xt.dtype)], axis=0)

    def block_step(acc, args):
        rows, wts, e = args
        xb = x_pad[rows]
        hid = jax.nn.silu(xb @ w_gate[e]) * (xb @ w_up[e])
        yb = (hid @ w_down[e]) * wts[:, None].astype(xb.dtype)
        return acc.at[rows].add(yb), None

    acc0 = jnp.zeros((T + 1, D), xt.dtype)
    acc, _ = lax.scan(block_step, acc0,
                      (row_tok.reshape(n_blk, MOE_BLOCK), row_w.reshape(n_blk, MOE_BLOCK), blk_expert))
    routed = acc[:T]
    shared = (jax.nn.silu(xt @ ws_gate) * (xt @ ws_up)) @ ws_down
    return (routed + shared).reshape(B, S, D)


def setup_inputs(seed: int = 0) -> dict:
    key = jax.random.key(seed)
    ks = jax.random.split(key, 27)
    f32 = jnp.float32
    nrm = lambda k, shape, s: jax.random.normal(k, shape, f32) * s
    gain = lambda k, shape: 1.0 + 0.02 * jax.random.normal(k, shape, f32)
    L = DEPTH
    return {
        'x': nrm(ks[0], (BATCH, SEQ, D_MODEL), 1.0),
        'c': nrm(ks[1], (BATCH, D_MODEL), 1.0),
        'positions': (jnp.arange(SEQ, dtype=jnp.int32)[None, :]
                      + jax.random.randint(ks[2], (BATCH, 1), 0, 4096, dtype=jnp.int32)),
        'w_ada': nrm(ks[3], (L, D_MODEL, 6 * D_MODEL), 0.5 * D_MODEL ** -0.5),
        'b_ada': nrm(ks[4], (L, 6 * D_MODEL), 0.02),
        'norm_mix_g': gain(ks[5], (L, D_MODEL)),
        'norm_ffn_g': gain(ks[6], (L, D_MODEL)),
        'w_in': nrm(ks[7], (L, D_MODEL, IN_COLS), D_MODEL ** -0.5),
        'hg_lb_logits': nrm(ks[8], (DEPTH + 1, HG_HEADS * HG_DK), 0.1),
        'hg_out_g': gain(ks[9], (L, HG_DV)),
        'mla_q_a_g': gain(ks[10], (L, MLA_Q_RANK)),
        'mla_w_uq': nrm(ks[11], (L, MLA_Q_RANK, MLA_HEADS * MLA_QK), MLA_Q_RANK ** -0.5),
        'mla_kv_a_g': gain(ks[12], (L, MLA_KV_RANK)),
        'mla_w_ukv': nrm(ks[13], (L, MLA_KV_RANK, MLA_HEADS * (MLA_NOPE + MLA_V)), MLA_KV_RANK ** -0.5),
        'mla_q_norm_g': gain(ks[14], (L, MLA_QK)),
        'mla_k_norm_g': gain(ks[15], (L, MLA_QK)),
        'mla_out_g': gain(ks[16], (L, MLA_WIDTH)),
        'w_out': nrm(ks[17], (L, D_MIX, D_MODEL), D_MIX ** -0.5),
        'w_router': nrm(ks[18], (L, D_MODEL, N_EXPERTS), D_MODEL ** -0.5),
        'router_bias': nrm(ks[19], (L, N_EXPERTS), 0.01),
        'w_gate': nrm(ks[20], (L, N_EXPERTS, D_MODEL, D_EXPERT), D_MODEL ** -0.5),
        'w_up': nrm(ks[21], (L, N_EXPERTS, D_MODEL, D_EXPERT), D_MODEL ** -0.5),
        'w_down': nrm(ks[22], (L, N_EXPERTS, D_EXPERT, D_MODEL), D_EXPERT ** -0.5),
        'ws_gate': nrm(ks[23], (L, D_MODEL, D_EXPERT), D_MODEL ** -0.5),
        'ws_up': nrm(ks[24], (L, D_MODEL, D_EXPERT), D_MODEL ** -0.5),
        'ws_down': nrm(ks[25], (L, D_EXPERT, D_MODEL), D_EXPERT ** -0.5),
    }


def reference(x, c, positions, w_ada, b_ada, norm_mix_g, norm_ffn_g, w_in, hg_lb_logits, hg_out_g,
              mla_q_a_g, mla_w_uq, mla_kv_a_g, mla_w_ukv, mla_q_norm_g, mla_k_norm_g, mla_out_g,
              w_out, w_router, router_bias, w_gate, w_up, w_down, ws_gate, ws_up, ws_down):
    lb_all = jnp.cumsum(jax.nn.softmax(hg_lb_logits.astype(jnp.float32), axis=0), axis=0)
    cond = jax.nn.silu(c)
    offs = [int(o) for o in np.cumsum(IN_SIZES)[:-1]]
    h = x
    for l in range(DEPTH):
        mod = cond @ w_ada[l] + b_ada[l]
        sh_m, sc_m, gt_m, sh_f, sc_f, gt_f = jnp.split(mod, 6, axis=-1)

        u = rms_norm(h, norm_mix_g[l]) * (1.0 + sc_m[:, None, :]) + sh_m[:, None, :]
        proj = u @ w_in[l]
        hq, hf, hi, hgate, cq, ckv, krope = jnp.split(proj, offs, axis=-1)
        o_hg = hgrn2_group(hq, hf, hi, hgate, lb_all[l], hg_out_g[l])
        o_mla = mla_group(cq, ckv, krope, positions, mla_q_a_g[l], mla_w_uq[l], mla_kv_a_g[l],
                          mla_w_ukv[l], mla_q_norm_g[l], mla_k_norm_g[l])
        merged = jnp.concatenate([o_hg, rms_norm(o_mla, mla_out_g[l])], axis=-1)
        h = h + gt_m[:, None, :] * (merged @ w_out[l])

        u = rms_norm(h, norm_ffn_g[l]) * (1.0 + sc_f[:, None, :]) + sh_f[:, None, :]
        h = h + gt_f[:, None, :] * moe(u, w_router[l], router_bias[l], w_gate[l], w_up[l], w_down[l],
                                       ws_gate[l], ws_up[l], ws_down[l])
    return h
```

```cpp
#include <hip/hip_runtime.h>
#include <stdint.h>

constexpr int NB = 4, SEQ = 2048, DM = 2048, NT = NB * SEQ;
constexpr int INC = 4928;
constexpr int HGH = 8, HDK = 128, HDV = 128;
constexpr int MH = 8, QR = 512, KVR = 256, NOPE = 128, ROPE = 64, QKD = 192, VD = 128;
constexpr int NE = 64, TOPK = 8, DE = 512;
constexpr float EPS = 1e-6f;
constexpr int MODW = 6 * DM;

__device__ __forceinline__ float sigmoidf_(float x) { return 1.f / (1.f + expf(-x)); }
__device__ __forceinline__ float siluf_(float x) { return x / (1.f + expf(-x)); }

__global__ __launch_bounds__(256) void k_ada(const float* __restrict__ c, const float* __restrict__ w, const float* __restrict__ bias, float* __restrict__ mod) {
    __shared__ float cs[NB][DM];
    for (int i = threadIdx.x; i < NB * DM; i += 256) cs[i / DM][i % DM] = siluf_(c[i]);
    __syncthreads();
    const int j = blockIdx.x * 256 + threadIdx.x;
    float a0 = 0, a1 = 0, a2 = 0, a3 = 0;
    for (int k = 0; k < DM; ++k) { const float wv = w[(size_t)k * MODW + j]; a0 += cs[0][k] * wv; a1 += cs[1][k] * wv; a2 += cs[2][k] * wv; a3 += cs[3][k] * wv; }
    const float bv = bias[j];
    mod[0 * MODW + j] = a0 + bv; mod[1 * MODW + j] = a1 + bv; mod[2 * MODW + j] = a2 + bv; mod[3 * MODW + j] = a3 + bv;
}

__global__ __launch_bounds__(256) void k_norm_mod(const float* __restrict__ h, const float* __restrict__ g, const float* __restrict__ mod, int sh_off, int sc_off, float* __restrict__ u) {
    const int t = blockIdx.x, b = t / SEQ, tid = threadIdx.x;
    const float* hp = h + (size_t)t * DM;
    float v[8]; float ss = 0;
#pragma unroll
    for (int i = 0; i < 8; ++i) { v[i] = hp[tid + i * 256]; ss += v[i] * v[i]; }
    __shared__ float red[4];
    for (int o = 32; o; o >>= 1) ss += __shfl_xor(ss, o);
    if ((tid & 63) == 0) red[tid >> 6] = ss;
    __syncthreads();
    ss = red[0] + red[1] + red[2] + red[3];
    const float r = rsqrtf(ss / DM + EPS);
#pragma unroll
    for (int i = 0; i < 8; ++i) { const int col = tid + i * 256; u[(size_t)t * DM + col] = v[i] * r * g[col] * (1.f + mod[b * MODW + sc_off + col]) + mod[b * MODW + sh_off + col]; }
}

__global__ __launch_bounds__(256) void k_rmsnorm_rows(const float* __restrict__ src, int ldsrc, int off, int width, const float* __restrict__ g, float* __restrict__ dst, int lddst, int doff) {
    const int t = blockIdx.x, tid = threadIdx.x;
    const float* sp = src + (size_t)t * ldsrc + off;
    float ss = 0;
    for (int j = tid; j < width; j += 256) { const float x = sp[j]; ss += x * x; }
    __shared__ float red[4];
    for (int o = 32; o; o >>= 1) ss += __shfl_xor(ss, o);
    if ((tid & 63) == 0) red[tid >> 6] = ss;
    __syncthreads();
    ss = red[0] + red[1] + red[2] + red[3];
    const float r = rsqrtf(ss / width + EPS);
    for (int j = tid; j < width; j += 256) dst[(size_t)t * lddst + doff + j] = sp[j] * r * g[j];
}

template <class Epi>
__global__ __launch_bounds__(256) void k_gemm(const float* __restrict__ A, int lda, const int* __restrict__ rowmap, const float* __restrict__ Bm, int ldb, size_t strideB,
                                              int M, int N, int K, const int* __restrict__ gcnt, const int* __restrict__ goff, Epi epi) {
    __shared__ float As[16][68];
    __shared__ float Bs[16][64];
    const int e = blockIdx.z; int rbase = 0, Mloc = M;
    if (gcnt) { Mloc = gcnt[e]; rbase = goff[e]; Bm += (size_t)e * strideB; }
    const int m0 = blockIdx.y * 64, n0 = blockIdx.x * 64;
    if (m0 >= Mloc) return;
    const int tid = threadIdx.x, tx = tid & 15, ty = tid >> 4;
    const int ar = tid >> 2, ak = (tid & 3) * 4;
    const int arow = m0 + ar; const bool avalid = arow < Mloc;
    const long asrc = avalid ? (rowmap ? (long)rowmap[rbase + arow] : (long)(rbase + arow)) : 0;
    const float* Ap = A + asrc * lda + ak;
    const int bk = tid >> 4, bc = (tid & 15) * 4;
    const float* Bp = Bm + (size_t)bk * ldb + n0 + bc;
    float acc[4][4];
#pragma unroll
    for (int i = 0; i < 4; ++i)
#pragma unroll
        for (int j = 0; j < 4; ++j) acc[i][j] = 0.f;
    for (int k0 = 0; k0 < K; k0 += 16) {
        const float4 av = avalid ? *(const float4*)(Ap + k0) : make_float4(0.f, 0.f, 0.f, 0.f);
        const float4 bv = *(const float4*)(Bp + (size_t)k0 * ldb);
        As[ak + 0][ar] = av.x; As[ak + 1][ar] = av.y; As[ak + 2][ar] = av.z; As[ak + 3][ar] = av.w;
        *(float4*)&Bs[bk][bc] = bv;
        __syncthreads();
#pragma unroll
        for (int kk = 0; kk < 16; ++kk) {
            const float4 a4 = *(const float4*)&As[kk][ty * 4];
            const float4 b4 = *(const float4*)&Bs[kk][tx * 4];
            const float a[4] = {a4.x, a4.y, a4.z, a4.w}; const float bb[4] = {b4.x, b4.y, b4.z, b4.w};
#pragma unroll
            for (int i = 0; i < 4; ++i)
#pragma unroll
                for (int j = 0; j < 4; ++j) acc[i][j] += a[i] * bb[j];
        }
        __syncthreads();
    }
#pragma unroll
    for (int i = 0; i < 4; ++i) { const int row = m0 + ty * 4 + i; if (row < Mloc) epi(rbase + row, n0 + tx * 4, acc[i][0], acc[i][1], acc[i][2], acc[i][3]); }
}

struct EpiStore { float* C; int ldc; int pad;
    __device__ void operator()(int row, int col, float a, float b, float c, float d) const { *(float4*)(C + (size_t)row * ldc + col) = make_float4(a, b, c, d); } };
struct EpiResid { const float* x; const float* mod; float* out; int goff; int pad;
    __device__ void operator()(int row, int col, float a, float b, float c, float d) const {
        const int bi = row / SEQ; const float* gp = mod + bi * MODW + goff + col; const float4 xv = *(const float4*)(x + (size_t)row * DM + col);
        *(float4*)(out + (size_t)row * DM + col) = make_float4(xv.x + gp[0] * a, xv.y + gp[1] * b, xv.z + gp[2] * c, xv.w + gp[3] * d); } };
struct EpiSiluMul { float* H; int ldc; int pad;
    __device__ void operator()(int row, int col, float a, float b, float c, float d) const {
        float4* p = (float4*)(H + (size_t)row * ldc + col); const float4 g = *p; *p = make_float4(siluf_(g.x) * a, siluf_(g.y) * b, siluf_(g.z) * c, siluf_(g.w) * d); } };
struct EpiScatterAdd { float* acc; const int* tok; const float* wt;
    __device__ void operator()(int row, int col, float a, float b, float c, float d) const {
        const int t = tok ? tok[row] : row; const float w = wt ? wt[row] : 1.f; float* p = acc + (size_t)t * DM + col;
        atomicAdd(p + 0, w * a); atomicAdd(p + 1, w * b); atomicAdd(p + 2, w * c); atomicAdd(p + 3, w * d); } };

__global__ __launch_bounds__(256) void k_hgrn_naive(const float* __restrict__ proj, const float* __restrict__ lbl, float* __restrict__ oraw) {
    const int blk = blockIdx.x, vs = blk & 7, h = (blk >> 3) & 7, b = blk >> 6;
    const int tid = threadIdx.x, kk = tid & 127, vh = tid >> 7;
    const float l0 = lbl[h * 128 + kk], l1 = lbl[1024 + h * 128 + kk];
    const float lb = 1.f / (1.f + expf(l1 - l0));
    float S[8];
#pragma unroll
    for (int j = 0; j < 8; ++j) S[j] = 0.f;
    __shared__ float red[4][8];
    for (int t = 0; t < SEQ; ++t) {
        const float* p = proj + (size_t)(b * SEQ + t) * INC;
        const float q = p[h * 128 + kk], fl = p[1024 + h * 128 + kk];
        const float f = lb + (1.f - lb) * sigmoidf_(fl), kv = 1.f - f;
        const float* vp = p + 2048 + h * 128 + vs * 16 + vh * 8;
        float o[8];
#pragma unroll
        for (int j = 0; j < 8; ++j) { S[j] = f * S[j] + kv * vp[j]; o[j] = q * S[j]; }
#pragma unroll
        for (int j = 0; j < 8; ++j)
            for (int off = 32; off; off >>= 1) o[j] += __shfl_xor(o[j], off);
        if ((tid & 63) == 0) {
#pragma unroll
            for (int j = 0; j < 8; ++j) red[tid >> 6][j] = o[j];
        }
        __syncthreads();
        if (tid < 16) { const int v2 = tid >> 3, j = tid & 7; oraw[(size_t)(b * SEQ + t) * 1024 + h * 128 + vs * 16 + v2 * 8 + j] = red[v2 * 2][j] + red[v2 * 2 + 1][j]; }
        __syncthreads();
    }
}
__global__ __launch_bounds__(256) void k_hgrn_out(const float* __restrict__ oraw, const float* __restrict__ proj, const float* __restrict__ og, float* __restrict__ merged) {
    const int gw = blockIdx.x * 4 + (threadIdx.x >> 6), lane = threadIdx.x & 63;
    const int t = gw >> 3, h = gw & 7;
    const float* op = oraw + (size_t)t * 1024 + h * 128;
    const float a = op[lane], b = op[lane + 64];
    float ss = a * a + b * b;
    for (int o = 32; o; o >>= 1) ss += __shfl_xor(ss, o);
    const float r = rsqrtf(ss / 128.f + EPS);
    const float* gp = proj + (size_t)t * INC + 3072 + h * 128;
    float* mp = merged + (size_t)t * DM + h * 128;
    mp[lane] = a * r * og[lane] * siluf_(gp[lane]); mp[lane + 64] = b * r * og[lane + 64] * siluf_(gp[lane + 64]);
}

__global__ __launch_bounds__(256) void k_qk_final(const float* __restrict__ qraw, const float* __restrict__ kvraw, const float* __restrict__ proj, const int* __restrict__ pos,
                                                  const float* __restrict__ qg, const float* __restrict__ kg, float* __restrict__ Q, float* __restrict__ K, float* __restrict__ V) {
    const int gw = blockIdx.x * 4 + (threadIdx.x >> 6), lane = threadIdx.x & 63;
    const int t = gw >> 3, h = gw & 7, b = t / SEQ, s = t % SEQ;
    const float p = (float)pos[t];
    float q0 = qraw[(size_t)t * 1536 + h * 192 + lane], q1 = qraw[(size_t)t * 1536 + h * 192 + 64 + lane], q2 = qraw[(size_t)t * 1536 + h * 192 + 128 + lane];
    float k0 = kvraw[(size_t)t * 2048 + h * 256 + lane], k1 = kvraw[(size_t)t * 2048 + h * 256 + 64 + lane], k2 = proj[(size_t)t * INC + 4864 + lane];
    float sq = q0 * q0 + q1 * q1 + q2 * q2, sk = k0 * k0 + k1 * k1 + k2 * k2;
    for (int o = 32; o; o >>= 1) { sq += __shfl_xor(sq, o); sk += __shfl_xor(sk, o); }
    const float rq = rsqrtf(sq / 192.f + EPS), rk = rsqrtf(sk / 192.f + EPS);
    q0 *= rq * qg[lane]; q1 *= rq * qg[64 + lane]; q2 *= rq * qg[128 + lane];
    k0 *= rk * kg[lane]; k1 *= rk * kg[64 + lane]; k2 *= rk * kg[128 + lane];
    const int i = lane & 31;
    const float inv = powf(10000.f, -(float)i / 32.f);
    const float ang = p * inv; const float cs = cosf(ang), sn = sinf(ang);
    const float q2o = __shfl_xor(q2, 32), k2o = __shfl_xor(k2, 32);
    const float q2r = lane < 32 ? q2 * cs - q2o * sn : q2 * cs + q2o * sn;
    const float k2r = lane < 32 ? k2 * cs - k2o * sn : k2 * cs + k2o * sn;
    const size_t base = ((size_t)(b * MH + h) * SEQ + s);
    float* Qp = Q + base * QKD; float* Kp = K + base * QKD; float* Vp = V + base * VD;
    Qp[lane] = q0; Qp[64 + lane] = q1; Qp[128 + lane] = q2r;
    Kp[lane] = k0; Kp[64 + lane] = k1; Kp[128 + lane] = k2r;
    Vp[lane] = kvraw[(size_t)t * 2048 + h * 256 + 128 + lane]; Vp[64 + lane] = kvraw[(size_t)t * 2048 + h * 256 + 192 + lane];
}

__global__ __launch_bounds__(256) void k_attn_naive(const float* __restrict__ Q, const float* __restrict__ K, const float* __restrict__ V, float* __restrict__ O) {
    __shared__ float Qs[32][193];
    __shared__ float KVs[32 * 193];
    __shared__ float Ps[32][33];
    const int qb = blockIdx.x, bh = blockIdx.y, tid = threadIdx.x, qi = tid >> 3, sub = tid & 7;
    const float* Qg = Q + ((size_t)bh * SEQ + qb * 32) * QKD;
    for (int i = tid; i < 32 * 192; i += 256) Qs[i / 192][i % 192] = Qg[i];
    float m = -1e30f, l = 0.f, o[16];
#pragma unroll
    for (int j = 0; j < 16; ++j) o[j] = 0.f;
    const float scale = 0.07216878364870323f;
    for (int kt = 0; kt <= qb; ++kt) {
        const float* Kg = K + ((size_t)bh * SEQ + kt * 32) * QKD;
        __syncthreads();
        for (int i = tid; i < 32 * 192; i += 256) KVs[(i / 192) * 193 + (i % 192)] = Kg[i];
        __syncthreads();
        float sc[4]; float tmax = -1e30f;
#pragma unroll
        for (int c = 0; c < 4; ++c) {
            const int kj = sub * 4 + c; float d = 0.f;
            for (int dd = 0; dd < 192; ++dd) d += Qs[qi][dd] * KVs[kj * 193 + dd];
            d *= scale;
            if (kt == qb && kj > qi) d = -INFINITY;
            sc[c] = d; tmax = fmaxf(tmax, d);
        }
        for (int off = 1; off < 8; off <<= 1) tmax = fmaxf(tmax, __shfl_xor(tmax, off));
        const float mn = fmaxf(m, tmax), alpha = expf(m - mn);
        float ps = 0.f;
#pragma unroll
        for (int c = 0; c < 4; ++c) { const float pv = expf(sc[c] - mn); ps += pv; Ps[qi][sub * 4 + c] = pv; }
        for (int off = 1; off < 8; off <<= 1) ps += __shfl_xor(ps, off);
        l = l * alpha + ps; m = mn;
        const float* Vg = V + ((size_t)bh * SEQ + kt * 32) * VD;
        __syncthreads();
        for (int i = tid; i < 32 * 128; i += 256) KVs[i] = Vg[i];
        __syncthreads();
#pragma unroll
        for (int j = 0; j < 16; ++j) o[j] *= alpha;
        for (int k = 0; k < 32; ++k) { const float pv = Ps[qi][k];
#pragma unroll
            for (int j = 0; j < 16; ++j) o[j] += pv * KVs[k * 128 + sub * 16 + j]; }
    }
    const int b = bh >> 3, h = bh & 7;
    float* Op = O + ((size_t)(b * SEQ + qb * 32 + qi)) * 1024 + h * 128 + sub * 16;
    const float inv = 1.f / l;
#pragma unroll
    for (int j = 0; j < 16; ++j) Op[j] = o[j] * inv;
}

__global__ __launch_bounds__(256) void k_route(const float* __restrict__ logits, const float* __restrict__ rbias, int* __restrict__ top_idx, float* __restrict__ top_w, int* __restrict__ cnt) {
    const int t = blockIdx.x * 256 + threadIdx.x; if (t >= NT) return;
    const float* lp = logits + (size_t)t * NE;
    float gs[8];
    for (int g = 0; g < 8; ++g) { float m1 = -INFINITY, m2 = -INFINITY;
        for (int j = 0; j < 8; ++j) { const float v = sigmoidf_(lp[g * 8 + j]) + rbias[g * 8 + j]; if (v > m1) { m2 = m1; m1 = v; } else if (v > m2) m2 = v; }
        gs[g] = m1 + m2; }
    unsigned gmask = 0;
    for (int r = 0; r < 4; ++r) { int best = -1; float bv = -INFINITY; for (int g = 0; g < 8; ++g) if (!((gmask >> g) & 1) && gs[g] > bv) { bv = gs[g]; best = g; } gmask |= 1u << best; }
    unsigned long long used = 0; float wsum = 0.f; int idx[8]; float wv[8];
    for (int r = 0; r < 8; ++r) { int best = -1; float bv = -INFINITY;
        for (int e = 0; e < NE; ++e) { if (!((gmask >> (e >> 3)) & 1) || ((used >> e) & 1ull)) continue; const float v = sigmoidf_(lp[e]) + rbias[e]; if (v > bv) { bv = v; best = e; } }
        used |= 1ull << best; idx[r] = best; wv[r] = sigmoidf_(lp[best]); wsum += wv[r]; }
    for (int r = 0; r < 8; ++r) { top_idx[t * 8 + r] = idx[r]; top_w[t * 8 + r] = wv[r] / wsum * 2.5f; atomicAdd(&cnt[idx[r]], 1); }
}
__global__ void k_scan(const int* __restrict__ cnt, int* __restrict__ off) { if (threadIdx.x == 0) { int a = 0; for (int e = 0; e < NE; ++e) { off[e] = a; a += cnt[e]; } } }
__global__ __launch_bounds__(256) void k_fill(const int* __restrict__ top_idx, const float* __restrict__ top_w, const int* __restrict__ off, int* __restrict__ fill, int* __restrict__ ent_tok, float* __restrict__ ent_w) {
    const int i = blockIdx.x * 256 + threadIdx.x; if (i >= NT * 8) return;
    const int e = top_idx[i]; const int p = off[e] + atomicAdd(&fill[e], 1); ent_tok[p] = i >> 3; ent_w[p] = top_w[i];
}
__global__ __launch_bounds__(256) void k_final(const float* __restrict__ h1, const float* __restrict__ mod, const float* __restrict__ acc, float* __restrict__ out) {
    const size_t i = (size_t)blockIdx.x * 256 + threadIdx.x; const int t = (int)(i / DM), col = (int)(i % DM), b = t / SEQ;
    out[i] = h1[i] + mod[b * MODW + 5 * DM + col] * acc[i];
}

template <class Epi>
static void gemm(hipStream_t st, const float* A, int lda, const int* rowmap, const float* Bm, int ldb, size_t strideB, int M, int N, int K, const int* gcnt, const int* goff, int nz, int mmax, Epi epi) {
    dim3 grid(N / 64, (mmax + 63) / 64, nz);
    hipLaunchKernelGGL(k_gemm<Epi>, grid, dim3(256), 0, st, A, lda, rowmap, Bm, ldb, strideB, M, N, K, gcnt, goff, epi);
}

extern "C" void kernel_launch(void* const* d_in, const int* in_sizes, int n_in, void* d_out, int out_size, void* d_ws, size_t ws_size, hipStream_t stream) {
    const float* x = (const float*)d_in[0]; const float* c = (const float*)d_in[1]; const int* pos = (const int*)d_in[2];
    const float* w_ada = (const float*)d_in[3]; const float* b_ada = (const float*)d_in[4];
    const float* g_mix = (const float*)d_in[5]; const float* g_ffn = (const float*)d_in[6];
    const float* w_in = (const float*)d_in[7]; const float* lbl = (const float*)d_in[8]; const float* hg_og = (const float*)d_in[9];
    const float* q_a_g = (const float*)d_in[10]; const float* w_uq = (const float*)d_in[11]; const float* kv_a_g = (const float*)d_in[12]; const float* w_ukv = (const float*)d_in[13];
    const float* qng = (const float*)d_in[14]; const float* kng = (const float*)d_in[15]; const float* mla_og = (const float*)d_in[16];
    const float* w_out = (const float*)d_in[17]; const float* w_router = (const float*)d_in[18]; const float* rbias = (const float*)d_in[19];
    const float* w_gate = (const float*)d_in[20]; const float* w_up = (const float*)d_in[21]; const float* w_down = (const float*)d_in[22];
    const float* ws_gate = (const float*)d_in[23]; const float* ws_up = (const float*)d_in[24]; const float* ws_down = (const float*)d_in[25];
    float* out = (float*)d_out;

    char* wp = (char*)d_ws; size_t off = 0;
    auto alloc = [&](size_t bytes) { void* p = wp + off; off += (bytes + 255) & ~(size_t)255; return p; };
    float* mod = (float*)alloc((size_t)NB * MODW * 4);
    int* cnt = (int*)alloc(256 * 4);
    int* fill = cnt + 64; int* offs = cnt + 128;
    float* h1 = (float*)alloc((size_t)NT * DM * 4);
    float* u = (float*)alloc((size_t)NT * DM * 4);
    float* merged = (float*)alloc((size_t)NT * DM * 4);
    const size_t mark = off;
    float* proj = (float*)alloc((size_t)NT * INC * 4);
    float* oraw = (float*)alloc((size_t)NT * 1024 * 4);
    float* cqn = (float*)alloc((size_t)NT * QR * 4);
    float* ckvn = (float*)alloc((size_t)NT * KVR * 4);
    float* qraw = (float*)alloc((size_t)NT * 1536 * 4);
    float* kvraw = (float*)alloc((size_t)NT * 2048 * 4);
    float* Qb = (float*)alloc((size_t)NT * MH * QKD * 4);
    float* Kb = (float*)alloc((size_t)NT * MH * QKD * 4);
    float* Vb = (float*)alloc((size_t)NT * MH * VD * 4);
    float* omla = (float*)alloc((size_t)NT * 1024 * 4);
    off = mark;
    float* logits = (float*)alloc((size_t)NT * NE * 4);
    int* top_idx = (int*)alloc((size_t)NT * 8 * 4);
    float* top_w = (float*)alloc((size_t)NT * 8 * 4);
    int* ent_tok = (int*)alloc((size_t)NT * 8 * 4);
    float* ent_w = (float*)alloc((size_t)NT * 8 * 4);
    float* hid = (float*)alloc((size_t)NT * 8 * DE * 4);
    float* hids = (float*)alloc((size_t)NT * DE * 4);
    float* acc = (float*)alloc((size_t)NT * DM * 4);

    (void)hipMemsetAsync(cnt, 0, 256 * 4, stream);
    hipLaunchKernelGGL(k_ada, dim3(MODW / 256), dim3(256), 0, stream, c, w_ada, b_ada, mod);
    hipLaunchKernelGGL(k_norm_mod, dim3(NT), dim3(256), 0, stream, x, g_mix, mod, 0, DM, u);
    gemm(stream, u, DM, nullptr, w_in, INC, 0, NT, INC, DM, nullptr, nullptr, 1, NT, EpiStore{proj, INC});
    hipLaunchKernelGGL(k_hgrn_naive, dim3(NB * HGH * 8), dim3(256), 0, stream, proj, lbl, oraw);
    hipLaunchKernelGGL(k_hgrn_out, dim3(NT * 8 / 4), dim3(256), 0, stream, oraw, proj, hg_og, merged);
    hipLaunchKernelGGL(k_rmsnorm_rows, dim3(NT), dim3(256), 0, stream, proj, INC, 4096, QR, q_a_g, cqn, QR, 0);
    hipLaunchKernelGGL(k_rmsnorm_rows, dim3(NT), dim3(256), 0, stream, proj, INC, 4608, KVR, kv_a_g, ckvn, KVR, 0);
    gemm(stream, cqn, QR, nullptr, w_uq, 1536, 0, NT, 1536, QR, nullptr, nullptr, 1, NT, EpiStore{qraw, 1536});
    gemm(stream, ckvn, KVR, nullptr, w_ukv, 2048, 0, NT, 2048, KVR, nullptr, nullptr, 1, NT, EpiStore{kvraw, 2048});
    hipLaunchKernelGGL(k_qk_final, dim3(NT * 8 / 4), dim3(256), 0, stream, qraw, kvraw, proj, pos, qng, kng, Qb, Kb, Vb);
    hipLaunchKernelGGL(k_attn_naive, dim3(SEQ / 32, NB * MH), dim3(256), 0, stream, Qb, Kb, Vb, omla);
    hipLaunchKernelGGL(k_rmsnorm_rows, dim3(NT), dim3(256), 0, stream, omla, 1024, 0, 1024, mla_og, merged, DM, 1024);
    gemm(stream, merged, DM, nullptr, w_out, DM, 0, NT, DM, DM, nullptr, nullptr, 1, NT, EpiResid{x, mod, h1, 2 * DM, 0});
    hipLaunchKernelGGL(k_norm_mod, dim3(NT), dim3(256), 0, stream, h1, g_ffn, mod, 3 * DM, 4 * DM, u);
    gemm(stream, u, DM, nullptr, w_router, NE, 0, NT, NE, DM, nullptr, nullptr, 1, NT, EpiStore{logits, NE});
    hipLaunchKernelGGL(k_route, dim3(NT / 256), dim3(256), 0, stream, logits, rbias, top_idx, top_w, cnt);
    hipLaunchKernelGGL(k_scan, dim3(1), dim3(64), 0, stream, cnt, offs);
    hipLaunchKernelGGL(k_fill, dim3(NT * 8 / 256), dim3(256), 0, stream, top_idx, top_w, offs, fill, ent_tok, ent_w);
    (void)hipMemsetAsync(acc, 0, (size_t)NT * DM * 4, stream);
    gemm(stream, u, DM, ent_tok, w_gate, DE, (size_t)DM * DE, 0, DE, DM, cnt, offs, NE, NT, EpiStore{hid, DE});
    gemm(stream, u, DM, ent_tok, w_up, DE, (size_t)DM * DE, 0, DE, DM, cnt, offs, NE, NT, EpiSiluMul{hid, DE});
    gemm(stream, hid, DE, nullptr, w_down, DM, (size_t)DE * DM, 0, DM, DE, cnt, offs, NE, NT, EpiScatterAdd{acc, ent_tok, ent_w});
    gemm(stream, u, DM, nullptr, ws_gate, DE, 0, NT, DE, DM, nullptr, nullptr, 1, NT, EpiStore{hids, DE});
    gemm(stream, u, DM, nullptr, ws_up, DE, 0, NT, DE, DM, nullptr, nullptr, 1, NT, EpiSiluMul{hids, DE});
    gemm(stream, hids, DE, nullptr, ws_down, DM, 0, NT, DM, DE, nullptr, nullptr, 1, NT, EpiScatterAdd{acc, nullptr, nullptr});
    hipLaunchKernelGGL(k_final, dim3(NT * DM / 256), dim3(256), 0, stream, h1, mod, acc, out);
}
```

```cpp
#include <hip/hip_runtime.h>
#include <cstdio>
#include <cstdint>
constexpr int NB = 4, SEQ = 2048, DM = 2048, NT = NB * SEQ;
constexpr int INC = 4928, INCP = 5120;
constexpr int MH = 8, QR = 512, KVR = 256, QKD = 192, VD = 128;
constexpr int NE = 64, DE = 512;
constexpr float EPS = 1e-6f;
constexpr int MODW = 6 * DM;
constexpr int NWAVES = 8, NTHR = 512;
constexpr int PROWS = 90112;
constexpr int ROUTED_ROWS_MAX = 81920;

constexpr size_t MiB = 1u << 20;
constexpr size_t WS_CTL = 0, CTL_ZERO_BYTES = 1 * MiB;
constexpr int CW_BAR = 1024;
constexpr size_t CTL_MOD = 64 * 1024;
constexpr size_t WS_MODP = 4 * MiB;
constexpr size_t TAB_SSQ_Q8 = 7 * MiB, TAB_SSQ_KV4 = 7 * MiB + 256 * 1024, TAB_SSQ_O8 = 7 * MiB + 512 * 1024;
constexpr size_t CTL_HIST = 416 * 1024;
constexpr size_t WS_TAB = 1 * MiB;
constexpr size_t TAB_HGD = WS_TAB;
constexpr size_t TAB_TOPI = WS_TAB + 1 * MiB;
constexpr size_t TAB_TOPW = TAB_TOPI + 256 * 1024;
constexpr size_t TAB_SLOT = TAB_TOPW + 256 * 1024;
constexpr size_t TAB_ROWTOK = TAB_SLOT + 256 * 1024;
constexpr size_t TAB_TILEEXP = TAB_ROWTOK + 512 * 1024;
constexpr size_t WS_BT_IN = 8 * MiB, WS_BT_UQ = 28 * MiB, WS_BT_KV = 30 * MiB, WS_BT_OUT = 32 * MiB, WS_BT_GU = 40 * MiB, WS_BT_DN = 300 * MiB;
constexpr size_t WS_U16 = 430 * MiB, WS_H1 = 462 * MiB, WS_HID = 526 * MiB, WS_X = 614 * MiB;
constexpr size_t WS_PROJ = WS_X, WS_QRAW = WS_X + 80 * MiB, WS_KRAW = WS_X + 104 * MiB, WS_VT = WS_X + 120 * MiB, WS_Q16 = WS_X + 136 * MiB, WS_K16 = WS_X + 160 * MiB,
                 WS_HGU = WS_X + 184 * MiB, WS_MERGED = WS_X + 216 * MiB, WS_Y = WS_X, WS_END = 966 * MiB;

constexpr int RING_BYTES = 131072, LDS_BYTES = 163840, MISC_OFF = LDS_BYTES - 256;

#define GAS __attribute__((address_space(1)))
#define LAS __attribute__((address_space(3)))
typedef unsigned short bf16_t;
typedef unsigned v4u __attribute__((ext_vector_type(4)));
typedef unsigned v2u __attribute__((ext_vector_type(2)));
typedef float f32x4 __attribute__((ext_vector_type(4)));
typedef GAS unsigned gu32;
#define RLX_AGENT __ATOMIC_RELAXED, __HIP_MEMORY_SCOPE_AGENT
__device__ __forceinline__ unsigned f2bf(float f) { unsigned u = __builtin_bit_cast(unsigned, f); return (u + 0x7fffu + ((u >> 16) & 1u)) >> 16; }
__device__ __forceinline__ unsigned pk2(float lo, float hi) { unsigned r; asm volatile("v_cvt_pk_bf16_f32 %0, %1, %2" : "=v"(r) : "v"(lo), "v"(hi)); return r; }
__device__ __forceinline__ float bf2f(unsigned short b) { return __builtin_bit_cast(float, ((unsigned)b) << 16); }
__device__ __forceinline__ float bflo(unsigned w) { return __builtin_bit_cast(float, w << 16); }
__device__ __forceinline__ float bfhi(unsigned w) { return __builtin_bit_cast(float, w & 0xffff0000u); }
__device__ __forceinline__ float sigmoidf_(float x) { return 1.f / (1.f + __expf(-x)); }
__device__ __forceinline__ float siluf_(float x) { return x / (1.f + __expf(-x)); }
__device__ __forceinline__ float wave_sum(float v) {
#pragma unroll
    for (int o = 1; o < 64; o <<= 1) v += __shfl_xor(v, o);
    return v;
}

#define XB_TMO      128
#define XB_XCNT(j)  (256  + 64 * (j))
#define XB_XSUB(j)  (1280 + 64 * (j))
#define XB_XGEN(j)  (2304 + 64 * (j))
#define XB_TOP      3328
#define XB_TOPGEN   3392
#define XCD_BAR_WORDS 3456
#define XB_SPIN_CAP (1u << 18)
__device__ __forceinline__ unsigned xb_ld(unsigned* p)              { return __hip_atomic_load(p, __ATOMIC_RELAXED, __HIP_MEMORY_SCOPE_AGENT); }
__device__ __forceinline__ unsigned xb_add(unsigned* p, unsigned v) { return __hip_atomic_fetch_add(p, v, __ATOMIC_RELAXED, __HIP_MEMORY_SCOPE_AGENT); }
__device__ __forceinline__ unsigned xb_xcc_id() { return (unsigned)__builtin_amdgcn_s_getreg((3 << 11) | 20) & 0xFu; }
#define XB_SPIN(cond, bar) do { unsigned _sp = 0; while (cond) { __builtin_amdgcn_s_sleep(1); \
    if ((++_sp & 255u) == 0u) { if (xb_ld(&(bar)[XB_TMO])) break; if (_sp > XB_SPIN_CAP) { atomicAdd(&(bar)[XB_TMO], 1u); break; } } } } while (0)
struct XcdBarrier { unsigned* bar; unsigned x; volatile LAS unsigned* st; };
__device__ __forceinline__ XcdBarrier xcd_barrier_post(unsigned* bar, volatile LAS unsigned* st) {
    XcdBarrier b; b.bar = bar; b.x = xb_xcc_id(); b.st = st;
    if (threadIdx.x == 0) (void)xb_add(&bar[XB_XCNT(b.x)], 1u);
    return b;
}
__device__ __forceinline__ void xcd_barrier_complete(unsigned* bar, unsigned x, unsigned& nloc, unsigned& nx) {
    const unsigned G = gridDim.x * gridDim.y * gridDim.z;
    unsigned sum, cnt, mine, sp = 0u;
    for (;;) {
        sum = 0u; cnt = 0u; mine = 0u;
#pragma unroll
        for (unsigned j = 0; j < 16; ++j) { const unsigned c = xb_ld(&bar[XB_XCNT(j)]); sum += c; cnt += (c > 0u) ? 1u : 0u; mine = (j == x) ? c : mine; }
        if (sum == G) break;
        __builtin_amdgcn_s_sleep(1);
        if ((++sp & 255u) == 0u) { if (xb_ld(&bar[XB_TMO])) break; if (sp > XB_SPIN_CAP) { atomicAdd(&bar[XB_TMO], 1u); break; } }
    }
    nloc = mine > 0u ? mine : 1u; nx = cnt > 0u ? cnt : 1u;
}
__device__ __forceinline__ void xcd_barrier(const XcdBarrier& b) {
    asm volatile("s_waitcnt vmcnt(0)" ::: "memory");
    __syncthreads();
    if (threadIdx.x == 0) {
        unsigned* bar = b.bar;
        __builtin_amdgcn_s_waitcnt(0);
        unsigned nloc = b.st[0], nx = b.st[1];
        if (nloc == 0u) { xcd_barrier_complete(bar, b.x, nloc, nx); b.st[0] = nloc; b.st[1] = nx; }
        const unsigned old = xb_add(&bar[XB_XSUB(b.x)], 1u);
        const unsigned gen = old / nloc;
        if (old + 1u == (gen + 1u) * nloc) {
            __builtin_amdgcn_fence(__ATOMIC_RELEASE, "agent");
            asm volatile("s_waitcnt vmcnt(0)" ::: "memory");
            const unsigned og = xb_add(&bar[XB_TOP], 1u);
            const unsigned tg = og / nx;
            if (og + 1u == (tg + 1u) * nx) xb_add(&bar[XB_TOPGEN], 1u);
            else XB_SPIN(xb_ld(&bar[XB_TOPGEN]) == tg, bar);
            __builtin_amdgcn_fence(__ATOMIC_ACQUIRE, "agent");
            xb_add(&bar[XB_XGEN(b.x)], 1u);
            asm volatile("s_waitcnt vmcnt(0)" ::: "memory");
        } else {
            XB_SPIN(xb_ld(&bar[XB_XGEN(b.x)]) == gen, bar);
            __builtin_amdgcn_fence(__ATOMIC_ACQUIRE, "agent");
            asm volatile("s_waitcnt vmcnt(0)" ::: "memory");
        }
    }
    __syncthreads();
}

struct Params { const float* in[26]; float* out; unsigned char* ws; int ph_lo, ph_hi; };
namespace pg8 {
#define PG8_LAS __attribute__((address_space(3)))
typedef unsigned short bf16_t;
typedef short bf16x8 __attribute__((ext_vector_type(8)));
typedef float f32x4 __attribute__((ext_vector_type(4)));
typedef unsigned u32x4 __attribute__((ext_vector_type(4)));
typedef unsigned u32x2 __attribute__((ext_vector_type(2)));
constexpr int BM = 256, BK = 64, HALF = 128, HTB = HALF * BK * 2, STAGE_BYTES = 8 * HTB, NXCD = 8, WGM = 8;

__host__ __device__ __forceinline__ int lds_byte(int r, int c) { const int st = (r >> 4) * 2 + (c >> 5), rr = r & 15, cc = c & 31, ob = rr * 64 + cc * 2; return st * 1024 + (ob ^ (((ob >> 9) & 1) << 5)); }
__host__ __device__ __forceinline__ void stage_rc(int b, int& R, int& C) { const int st = b / 1024, sb = b % 1024, swz = sb ^ (((sb >> 9) & 1) << 5); R = (st >> 1) * 16 + swz / 64; C = (st & 1) * 32 + (swz % 64) / 2; }
__host__ __device__ __forceinline__ int perm32(int rho) { const int n = rho >> 4, i = rho & 15; return 8 * (i >> 2) + 4 * n + (i & 3); }

struct Unit { int pm, pn; long boff; };
struct Gemm { const bf16_t* A; const bf16_t* Bt; const int* rowtab; int lda, ldb, K, pad; };

__device__ __forceinline__ unsigned cvt_pk_bf16(float lo, float hi) { unsigned r; asm volatile("v_cvt_pk_bf16_f32 %0, %1, %2" : "=v"(r) : "v"(lo), "v"(hi)); return r; }

struct StaticOrder {
    int nM, nN, nwg, G, c; long bstep;
    __device__ void init(int nM_, int nN_, int G_, int c_, int ldb) { nM = nM_; nN = nN_; nwg = nM * nN; G = G_; c = c_; bstep = (long)BM * ldb * 2; }
    __device__ bool next(int i, Unit& u) const {
        const long L = (long)i * G + c; if (L >= nwg) return false;
        int wgid = (int)L; { const int q = nwg / NXCD, r = nwg % NXCD, xcd = wgid % NXCD, off = wgid / NXCD; wgid = (xcd < r ? xcd * (q + 1) : r * (q + 1) + (xcd - r) * q) + off; }
        const int nig = WGM * nN, gid = wgid / nig, fm = gid * WGM, gsz = (nM - fm) < WGM ? (nM - fm) : WGM;
        u.pm = fm + ((wgid % nig) % gsz); u.pn = (wgid % nig) / gsz; u.boff = (long)u.pn * bstep; return true;
    }
};

template <class Epi, class Sched>
__device__ __forceinline__ void gemm_phase(PG8_LAS unsigned char* lds, const Gemm g, const Sched& S, const Epi& E) {
    const int tid = threadIdx.x, wid = __builtin_amdgcn_readfirstlane(tid >> 6), lane = tid & 63, wr = wid >> 2, wc = wid & 3, fr = lane & 15, fq = lane >> 4;
    const int K = g.K, nt = K / BK;
    int Rr[2]; unsigned Cb[2], voffB[2];
#pragma unroll
    for (int i = 0; i < 2; ++i) { int R, C; stage_rc(tid * 16 + i * 8192, R, C); const int Rb = Epi::PERM ? ((R & ~31) + perm32(R & 31)) : R;
        Rr[i] = R; Cb[i] = (unsigned)C * 2u; voffB[i] = (unsigned)(Rb * g.ldb + C) * 2u; }
    const size_t kstep = (size_t)(BK * 2);
    const size_t hstepB = (size_t)HALF * g.ldb * 2;
    const unsigned lda2 = (unsigned)g.lda * 2u;
    const unsigned ldsw = (unsigned)wid * 1024u;
    const int aoff = lds_byte(wr * 64 + fr, fq * 8), boff = lds_byte(wc * 32 + fr, fq * 8);
    const char* const Abase = (const char*)g.A; const char* const Bbase = (const char*)g.Bt;
#define PG8_SA(b, h) (((b) * 2 + (h)) * HTB)
#define PG8_SB(b, h) ((4 + (b) * 2 + (h)) * HTB)
#define PG8_STAGE(bufoff, gbase, voff) do { _Pragma("unroll") for (int _i = 0; _i < 2; ++_i) \
        __builtin_amdgcn_global_load_lds((const unsigned*)((const char*)(gbase) + (voff)[_i]), (PG8_LAS unsigned*)(lds + (bufoff) + ldsw + _i * 8192), 16, 0, 0); } while (0)
#define PG8_VOFFA(u, v) do { _Pragma("unroll") for (int _h = 0; _h < 2; ++_h) _Pragma("unroll") for (int _i = 0; _i < 2; ++_i) { const int _gr = (u).pm * BM + _h * HALF + Rr[_i]; \
        const int _src = g.rowtab ? g.rowtab[_gr] : _gr; (v)[_h][_i] = (unsigned)_src * lda2 + Cb[_i]; } } while (0)
#define PG8_LDA(dst, b, h) do { _Pragma("unroll") for (int m = 0; m < 4; ++m) _Pragma("unroll") for (int k = 0; k < 2; ++k) dst[m][k] = *(const PG8_LAS bf16x8*)(lds + PG8_SA(b, h) + aoff + m * 2048 + k * 1024); } while (0)
#define PG8_LDB(dst, b, h) do { _Pragma("unroll") for (int n = 0; n < 2; ++n) _Pragma("unroll") for (int k = 0; k < 2; ++k) dst[n][k] = *(const PG8_LAS bf16x8*)(lds + PG8_SB(b, h) + boff + n * 2048 + k * 1024); } while (0)
#define PG8_MMA(ai, bj, At, Bt) do { __builtin_amdgcn_s_setprio(1); _Pragma("unroll") for (int m = 0; m < 4; ++m) _Pragma("unroll") for (int n = 0; n < 2; ++n) _Pragma("unroll") for (int k = 0; k < 2; ++k) \
        acc[ai][bj][m][n] = __builtin_amdgcn_mfma_f32_16x16x32_bf16(Bt[n][k], At[m][k], acc[ai][bj][m][n], 0, 0, 0); __builtin_amdgcn_s_setprio(0); } while (0)
#define PG8_WAIT_V(n) asm volatile("s_waitcnt vmcnt(" #n ")" ::: "memory")
#define PG8_WAIT_L(n) asm volatile("s_waitcnt lgkmcnt(" #n ")" ::: "memory")
#define PG8_BAR __builtin_amdgcn_s_barrier()
#define PG8_SCHED __builtin_amdgcn_sched_barrier(0)
    Unit cur, nxt; int ui = 0;
    if (!S.next(0, cur)) return;
    f32x4 acc[2][2][4][2];
#pragma unroll
    for (int a = 0; a < 2; ++a)
#pragma unroll
        for (int b = 0; b < 2; ++b)
#pragma unroll
            for (int m = 0; m < 4; ++m)
#pragma unroll
                for (int n = 0; n < 2; ++n) acc[a][b][m][n] = (f32x4){0.f, 0.f, 0.f, 0.f};
    bf16x8 At[4][2], B0[2][2], B1[2][2];
    unsigned cv[2][2], nv[2][2];
    PG8_VOFFA(cur, cv);
#pragma unroll
    for (int h = 0; h < 2; ++h) { nv[h][0] = cv[h][0]; nv[h][1] = cv[h][1]; }
    const char* cB = Bbase + cur.boff;
    PG8_STAGE(PG8_SB(0, 0), cB, voffB); PG8_STAGE(PG8_SB(0, 1), cB + hstepB, voffB); PG8_STAGE(PG8_SA(0, 0), Abase, cv[0]); PG8_STAGE(PG8_SA(0, 1), Abase, cv[1]);
    if (wr == 1) PG8_BAR;
    PG8_WAIT_V(2); PG8_BAR;
    PG8_STAGE(PG8_SB(1, 0), cB + kstep, voffB); PG8_STAGE(PG8_SA(1, 0), Abase + kstep, cv[0]); PG8_STAGE(PG8_SB(1, 1), cB + hstepB + kstep, voffB);
    PG8_WAIT_V(6); PG8_BAR;
    for (;;) {
        const bool has_next = S.next(ui + 1, nxt);
        const char* nB = has_next ? Bbase + nxt.boff : cB;
#pragma unroll 1
        for (int t = 0; t < nt; t += 2) {
            const bool last = (t == nt - 2);
            if (last && has_next) { PG8_VOFFA(nxt, nv); }
            const char* a1 = Abase + (size_t)(t + 1) * kstep;
            const char* a2 = Abase + (last ? (size_t)0 : (size_t)(t + 2) * kstep); const char* a3 = a2 + kstep;
            const char* b2 = last ? nB : cB + (size_t)(t + 2) * kstep; const char* b3 = b2 + kstep;
            unsigned x0[2], x1[2];
            x0[0] = last ? nv[0][0] : cv[0][0]; x0[1] = last ? nv[0][1] : cv[0][1]; x1[0] = last ? nv[1][0] : cv[1][0]; x1[1] = last ? nv[1][1] : cv[1][1];
            PG8_LDB(B0, 0, 0); PG8_LDB(B1, 0, 1); PG8_SCHED; PG8_LDA(At, 0, 0); PG8_STAGE(PG8_SA(1, 1), a1, cv[1]);
            PG8_WAIT_V(8); PG8_WAIT_L(0); PG8_BAR; PG8_MMA(0, 0, At, B0); PG8_MMA(0, 1, At, B1); PG8_BAR; PG8_SCHED;
            PG8_LDA(At, 0, 1); PG8_STAGE(PG8_SB(0, 0), b2, voffB); PG8_STAGE(PG8_SB(0, 1), b2 + hstepB, voffB); PG8_STAGE(PG8_SA(0, 0), a2, x0);
            PG8_WAIT_V(8); PG8_WAIT_L(0); PG8_BAR; PG8_MMA(1, 0, At, B0); PG8_MMA(1, 1, At, B1); PG8_BAR; PG8_SCHED;
            PG8_LDB(B0, 1, 0); PG8_LDB(B1, 1, 1); PG8_SCHED; PG8_LDA(At, 1, 0); PG8_STAGE(PG8_SA(0, 1), a2, x1);
            PG8_WAIT_V(8); PG8_WAIT_L(0); PG8_BAR; PG8_MMA(0, 0, At, B0); PG8_MMA(0, 1, At, B1); PG8_BAR; PG8_SCHED;
            PG8_LDA(At, 1, 1); PG8_STAGE(PG8_SB(1, 0), b3, voffB); PG8_STAGE(PG8_SB(1, 1), b3 + hstepB, voffB); PG8_STAGE(PG8_SA(1, 0), a3, x0);
            PG8_WAIT_V(8); PG8_WAIT_L(0); PG8_BAR; PG8_MMA(1, 0, At, B0); PG8_MMA(1, 1, At, B1); PG8_BAR; PG8_SCHED;
        }
        if (wr == 0) PG8_BAR;
        E(acc, cur, wr, wc, fr, fq);
        if (!has_next) break;
#pragma unroll
        for (int a = 0; a < 2; ++a)
#pragma unroll
            for (int b = 0; b < 2; ++b)
#pragma unroll
                for (int m = 0; m < 4; ++m)
#pragma unroll
                    for (int n = 0; n < 2; ++n) acc[a][b][m][n] = (f32x4){0.f, 0.f, 0.f, 0.f};
        cur = nxt; cB = nB; ++ui;
#pragma unroll
        for (int h = 0; h < 2; ++h) { cv[h][0] = nv[h][0]; cv[h][1] = nv[h][1]; }
        if (wr == 1) PG8_BAR;
    }
    PG8_WAIT_V(0);
    PG8_BAR;
#undef PG8_SA
#undef PG8_SB
#undef PG8_STAGE
#undef PG8_VOFFA
#undef PG8_LDA
#undef PG8_LDB
#undef PG8_MMA
#undef PG8_WAIT_V
#undef PG8_WAIT_L
#undef PG8_BAR
#undef PG8_SCHED
}
}
__device__ __forceinline__ void conv_tile(const float* __restrict__ src, int ldn, int k0, int n0, const float* __restrict__ kscale, int kfrom,
                                          bf16_t* __restrict__ dst, int dld, int drow0, LAS unsigned* T, int lane) {
    const int c4 = lane & 15, kq = lane >> 4;
    f32x4 v0[8], v1[8];
#pragma unroll
    for (int j = 0; j < 8; ++j) { const int kp = kq + 4 * j; const float* p = src + (size_t)(k0 + 2 * kp) * ldn + n0 + c4 * 4;
        v0[j] = *(const f32x4*)p; v1[j] = *(const f32x4*)(p + ldn); }
#pragma unroll
    for (int j = 0; j < 8; ++j) { const int kp = kq + 4 * j; const int k = k0 + 2 * kp;
        float s0 = 1.f, s1 = 1.f; if (kscale && k >= kfrom) { s0 = kscale[k - kfrom]; s1 = kscale[k + 1 - kfrom]; }
#pragma unroll
        for (int q = 0; q < 4; ++q) T[(c4 * 4 + q) * 33 + kp] = pk2(v0[j][q] * s0, v1[j][q] * s1); }
    asm volatile("s_waitcnt lgkmcnt(0)" ::: "memory"); __builtin_amdgcn_wave_barrier();
    const int ch = lane & 7, nr = lane >> 3;
#pragma unroll
    for (int ps = 0; ps < 8; ++ps) { const int n = ps * 8 + nr; const LAS unsigned* t = T + n * 33 + ch * 4;
        v4u o; o.x = t[0]; o.y = t[1]; o.z = t[2]; o.w = t[3];
        *(v4u*)(dst + (size_t)(drow0 + n) * dld + k0 + ch * 8) = o; }
    asm volatile("s_waitcnt lgkmcnt(0)" ::: "memory"); __builtin_amdgcn_wave_barrier();
}

__device__ __forceinline__ void ada_item(const float* __restrict__ c, const float* __restrict__ w, float* __restrict__ modp, int item, int lane) {
    const int cc = item % 48, ks = item / 48, col = cc * 256 + lane * 4;
    f32x4 acc[4];
#pragma unroll
    for (int b = 0; b < 4; ++b) acc[b] = (f32x4){0.f, 0.f, 0.f, 0.f};
#pragma unroll 1
    for (int half = 0; half < 2; ++half) {
        const int k0 = ks * 128 + half * 64;
        float cd[4];
#pragma unroll
        for (int b = 0; b < 4; ++b) cd[b] = siluf_(c[b * DM + k0 + lane]);
        const float* wp = w + (size_t)k0 * MODW + col;
#pragma unroll 8
        for (int kk = 0; kk < 64; ++kk) { const f32x4 wv = *(const f32x4*)(wp + (size_t)kk * MODW);
#pragma unroll
            for (int b = 0; b < 4; ++b) { const float s = __builtin_bit_cast(float, __builtin_amdgcn_readlane(__builtin_bit_cast(int, cd[b]), kk)); acc[b] += wv * s; } }
    }
#pragma unroll
    for (int b = 0; b < 4; ++b) *(f32x4*)(modp + ((size_t)ks * 4 + b) * MODW + col) = acc[b];
}

constexpr int CT_ADA = 48 * 16;
constexpr int CT_IN = 32 * 77, CT_UQ = 8 * 24, CT_KV = 4 * 32, CT_OUT = 32 * 32, CT_G1 = 32 * 8, CT_D1 = 8 * 32;
constexpr int CT_ZERO = 192 * 4;
constexpr int CT_TOTAL = CT_ADA + CT_IN + CT_UQ + CT_KV + CT_OUT + 65 * (2 * CT_G1 + CT_D1) + CT_ZERO;

__device__ __forceinline__ void phase0(const Params& p, LAS unsigned char* lds, int wave, int lane) {
    LAS unsigned* T = (LAS unsigned*)(lds + wave * 16384);
    unsigned char* ws = p.ws;
    float* modp = (float*)(ws + WS_MODP);
    const int gw = blockIdx.x * NWAVES + wave, NGW = gridDim.x * NWAVES;
    for (int it = gw; it < CT_TOTAL; it += NGW) {
        int r = it;
        if (r < CT_ADA) { ada_item(p.in[1], p.in[3], modp, r, lane); continue; } r -= CT_ADA;
        if (r < CT_IN) { const int kb = r / 77, nb = r % 77; conv_tile(p.in[7], INC, kb * 64, nb * 64, nullptr, 0, (bf16_t*)(ws + WS_BT_IN), DM, nb * 64, T, lane); continue; } r -= CT_IN;
        if (r < CT_UQ) { const int kb = r / 24, nb = r % 24; conv_tile(p.in[11], 1536, kb * 64, nb * 64, p.in[10], 0, (bf16_t*)(ws + WS_BT_UQ), QR, nb * 64, T, lane); continue; } r -= CT_UQ;
        if (r < CT_KV) { const int kb = r / 32, nb = r % 32, n0 = nb * 64, h = n0 >> 8, j0 = n0 & 255; const int dr = (j0 < 128) ? h * 128 + j0 : 1024 + h * 128 + (j0 - 128);
                         conv_tile(p.in[13], 2048, kb * 64, n0, p.in[12], 0, (bf16_t*)(ws + WS_BT_KV), KVR, dr, T, lane); continue; } r -= CT_KV;
        if (r < CT_OUT) { const int kb = r / 32, nb = r % 32; conv_tile(p.in[17], DM, kb * 64, nb * 64, p.in[16], 1024, (bf16_t*)(ws + WS_BT_OUT), DM, nb * 64, T, lane); continue; } r -= CT_OUT;
        if (r < 65 * (2 * CT_G1 + CT_D1)) {
            const int e = r / (2 * CT_G1 + CT_D1); int q = r % (2 * CT_G1 + CT_D1);
            bf16_t* gu = (bf16_t*)(ws + WS_BT_GU) + (size_t)e * 1024 * DM; bf16_t* dn = (bf16_t*)(ws + WS_BT_DN) + (size_t)e * DM * DE;
            if (q < 2 * CT_G1) { const int up = q >= CT_G1; q -= up * CT_G1; const int kb = q / 8, nb = q % 8, n0 = nb * 64;
                const float* src = (e < 64) ? p.in[up ? 21 : 20] + (size_t)e * DM * DE : p.in[up ? 24 : 23];
                conv_tile(src, DE, kb * 64, n0, nullptr, 0, gu, DM, (n0 >> 7) * 256 + up * 128 + (n0 & 127), T, lane); }
            else { q -= 2 * CT_G1; const int kb = q / 32, nb = q % 32; const float* src = (e < 64) ? p.in[22] + (size_t)e * DE * DM : p.in[25];
                conv_tile(src, DM, kb * 64, nb * 64, nullptr, 0, dn, DE, nb * 64, T, lane); }
            continue; }
        r -= 65 * (2 * CT_G1 + CT_D1);
        { const int row = INC + (r >> 2), pc = r & 3; v4u z = {0u, 0u, 0u, 0u}; *(v4u*)((bf16_t*)(ws + WS_BT_IN) + (size_t)row * DM + pc * 512 + lane * 8) = z; }
    }
}

__device__ __forceinline__ void norm_mod_row(const float* __restrict__ hrow, const float* __restrict__ g, const float* __restrict__ sc, const float* __restrict__ sh, bf16_t* __restrict__ urow, int lane) {
    f32x4 v[8]; float s = 0.f;
#pragma unroll
    for (int j = 0; j < 8; ++j) { v[j] = *(const f32x4*)(hrow + lane * 4 + 256 * j); s += (v[j].x * v[j].x + v[j].y * v[j].y) + (v[j].z * v[j].z + v[j].w * v[j].w); }
    const float r = rsqrtf(wave_sum(s) * (1.f / DM) + EPS);
#pragma unroll
    for (int j = 0; j < 8; ++j) { const int col = lane * 4 + 256 * j; const f32x4 gv = *(const f32x4*)(g + col), sv = *(const f32x4*)(sc + col), hv = *(const f32x4*)(sh + col);
        const f32x4 o = v[j] * r * gv * (sv + 1.f) + hv; v2u w; w.x = pk2(o.x, o.y); w.y = pk2(o.z, o.w); *(v2u*)(urow + col) = w; }
}
__device__ __forceinline__ float mod_reduce(const float* __restrict__ modp, const float* __restrict__ bias, int v) {
    float s = bias[v % MODW];
#pragma unroll
    for (int ks = 0; ks < 16; ++ks) s += modp[(size_t)ks * 4 * MODW + v];
    return s;
}
__device__ __forceinline__ void phase1(const Params& p, LAS unsigned char* lds, int wave, int lane) {
    const float* modp = (const float*)(p.ws + WS_MODP); float* mod = (float*)(p.ws + CTL_MOD); bf16_t* u16 = (bf16_t*)(p.ws + WS_U16);
    LAS float* sm = (LAS float*)lds;
    const int G = gridDim.x;
    for (int v = blockIdx.x * NTHR + threadIdx.x; v < NB * MODW; v += G * NTHR) mod[v] = mod_reduce(modp, p.in[4], v);
    for (int tb = blockIdx.x; tb < NT / 32; tb += G) {
        const int b = (tb * 32) / SEQ;
        __syncthreads();
        for (int i = threadIdx.x; i < 2 * DM; i += NTHR) sm[i] = mod_reduce(modp, p.in[4], b * MODW + i);
        __syncthreads();
#pragma unroll 1
        for (int rr = 0; rr < 4; ++rr) { const int t = tb * 32 + wave * 4 + rr;
            const float* hrow = p.in[0] + (size_t)t * DM; const float* g = p.in[5];
            f32x4 v[8]; float s = 0.f;
#pragma unroll
            for (int j = 0; j < 8; ++j) { v[j] = *(const f32x4*)(hrow + lane * 4 + 256 * j); s += (v[j].x * v[j].x + v[j].y * v[j].y) + (v[j].z * v[j].z + v[j].w * v[j].w); }
            const float r = rsqrtf(wave_sum(s) * (1.f / DM) + EPS);
#pragma unroll
            for (int j = 0; j < 8; ++j) { const int col = lane * 4 + 256 * j; const f32x4 gv = *(const f32x4*)(g + col);
                const f32x4 hv = *(const LAS f32x4*)(sm + col), sv = *(const LAS f32x4*)(sm + DM + col);
                const f32x4 o = v[j] * r * gv * (sv + 1.f) + hv; v2u w; w.x = pk2(o.x, o.y); w.y = pk2(o.z, o.w); *(v2u*)(u16 + (size_t)t * DM + col) = w; }
        }
    }
}

struct EpiInProj { static constexpr bool PERM = true; bf16_t* O; float* ssq_q8; float* ssq_kv4;
    __device__ __forceinline__ void operator()(const pg8::f32x4 (&acc)[2][2][4][2], const pg8::Unit& u, int wr, int wc, int fr, int fq) const {
        const int row0 = u.pm * 256 + wr * 64 + fr, col0 = u.pn * 256 + wc * 32 + 8 * fq;
        const bool sq = (u.pn >= 16 && u.pn <= 18);
#pragma unroll
        for (int ai = 0; ai < 2; ++ai)
#pragma unroll
            for (int m = 0; m < 4; ++m) { const int row = row0 + ai * 128 + m * 16; bf16_t* rowp = O + (size_t)row * INCP + col0; float ss = 0.f;
#pragma unroll
                for (int bj = 0; bj < 2; ++bj) { const pg8::f32x4 v0 = acc[ai][bj][m][0], v1 = acc[ai][bj][m][1];
                    v4u w; w.x = pk2(v0[0], v0[1]); w.y = pk2(v0[2], v0[3]); w.z = pk2(v1[0], v1[1]); w.w = pk2(v1[2], v1[3]);
                    *(v4u*)(rowp + bj * 128) = w;
                    ss += (v0[0] * v0[0] + v0[1] * v0[1]) + (v0[2] * v0[2] + v0[3] * v0[3]) + (v1[0] * v1[0] + v1[1] * v1[1]) + (v1[2] * v1[2] + v1[3] * v1[3]); }
                if (sq) { ss += __shfl_xor(ss, 16); ss += __shfl_xor(ss, 32);
                    if (fq == 0) { if (u.pn == 18) ssq_kv4[row * 4 + wc] = ss; else ssq_q8[row * 8 + (u.pn - 16) * 4 + wc] = ss; } } }
    }
};
__device__ __forceinline__ void phase2(const Params& p, LAS unsigned char* lds) {
    unsigned char* ws = p.ws;
    pg8::Gemm g{(const bf16_t*)(ws + WS_U16), (const bf16_t*)(ws + WS_BT_IN), nullptr, DM, DM, DM, 0};
    pg8::StaticOrder S; S.init(NT / 256, INCP / 256, gridDim.x, blockIdx.x, DM);
    EpiInProj E{(bf16_t*)(ws + WS_PROJ), (float*)(ws + TAB_SSQ_Q8), (float*)(ws + TAB_SSQ_KV4)};
    pg8::gemm_phase<EpiInProj, pg8::StaticOrder>((PG8_LAS unsigned char*)lds, g, S, E);
}
struct EpiBf16Store { static constexpr bool PERM = true; bf16_t* O; int ldc, pad;
    __device__ __forceinline__ void operator()(const pg8::f32x4 (&acc)[2][2][4][2], const pg8::Unit& u, int wr, int wc, int fr, int fq) const {
        const int row0 = u.pm * 256 + wr * 64 + fr, col0 = u.pn * 256 + wc * 32 + 8 * fq;
#pragma unroll
        for (int ai = 0; ai < 2; ++ai)
#pragma unroll
            for (int m = 0; m < 4; ++m) { bf16_t* rowp = O + (size_t)(row0 + ai * 128 + m * 16) * ldc + col0;
#pragma unroll
                for (int bj = 0; bj < 2; ++bj) { const pg8::f32x4 v0 = acc[ai][bj][m][0], v1 = acc[ai][bj][m][1];
                    v4u w; w.x = pk2(v0[0], v0[1]); w.y = pk2(v0[2], v0[3]); w.z = pk2(v1[0], v1[1]); w.w = pk2(v1[2], v1[3]); *(v4u*)(rowp + bj * 128) = w; } }
    }
};
struct EpiVt { static constexpr bool PERM = true; bf16_t* Vt; const float* ssq_kv4;
    __device__ __forceinline__ void operator()(const pg8::f32x4 (&acc)[2][2][4][2], const pg8::Unit& u, int wr, int wc, int fr, int fq) const {
        const int row0 = u.pm * 256 + wr * 64 + fr, col0 = u.pn * 256 + wc * 32 + 8 * fq;
        const int pb = (col0 & ~15) + 4 * (fq & 1);
#pragma unroll
        for (int bj = 0; bj < 2; ++bj) {
            float rs[8];
#pragma unroll
            for (int j = 0; j < 8; ++j) { const pg8::f32x4 s4 = *(const pg8::f32x4*)(ssq_kv4 + (size_t)(col0 + bj * 128 + j) * 4); rs[j] = rsqrtf(((s4[0] + s4[1]) + (s4[2] + s4[3])) * (1.f / KVR) + EPS); }
#pragma unroll
            for (int ai = 0; ai < 2; ++ai)
#pragma unroll
                for (int m = 0; m < 4; ++m) { bf16_t* rowp = Vt + (size_t)(row0 + ai * 128 + m * 16) * NT + pb + bj * 128;
                    const pg8::f32x4 v0 = acc[ai][bj][m][0], v1 = acc[ai][bj][m][1];
                    v2u a, b; a.x = pk2(v0[0] * rs[0], v0[1] * rs[1]); a.y = pk2(v0[2] * rs[2], v0[3] * rs[3]);
                    b.x = pk2(v1[0] * rs[4], v1[1] * rs[5]); b.y = pk2(v1[2] * rs[6], v1[3] * rs[7]);
                    *(v2u*)(rowp) = a; *(v2u*)(rowp + 8) = b; }
        }
    }
};
__device__ __forceinline__ void phase3_gemms(const Params& p, LAS unsigned char* lds) {
    unsigned char* ws = p.ws; const int G = gridDim.x, c = blockIdx.x;
    const bf16_t* proj = (const bf16_t*)(ws + WS_PROJ);
    { pg8::Gemm g{proj + 4096, (const bf16_t*)(ws + WS_BT_UQ), nullptr, INCP, QR, QR, 0};
      pg8::StaticOrder S; S.init(NT / 256, 6, G, c, QR); EpiBf16Store E{(bf16_t*)(ws + WS_QRAW), 1536, 0};
      pg8::gemm_phase<EpiBf16Store, pg8::StaticOrder>((PG8_LAS unsigned char*)lds, g, S, E); }
    { pg8::Gemm g{proj + 4608, (const bf16_t*)(ws + WS_BT_KV), nullptr, INCP, KVR, KVR, 0};
      pg8::StaticOrder S; S.init(NT / 256, 4, G, (c + 64) % G, KVR); EpiBf16Store E{(bf16_t*)(ws + WS_KRAW), 1024, 0};
      pg8::gemm_phase<EpiBf16Store, pg8::StaticOrder>((PG8_LAS unsigned char*)lds, g, S, E); }
    { pg8::Gemm g{(const bf16_t*)(ws + WS_BT_KV) + 1024 * KVR, proj + 4608, nullptr, KVR, INCP, KVR, 0};
      pg8::StaticOrder S; S.init(4, NT / 256, G, (c + 192) % G, INCP); EpiVt E{(bf16_t*)(ws + WS_VT), (const float*)(ws + TAB_SSQ_KV4)};
      pg8::gemm_phase<EpiVt, pg8::StaticOrder>((PG8_LAS unsigned char*)lds, g, S, E); }
}

constexpr float QSCALE = 0.07216878364870323f * 1.4426950408889634f;
__device__ __forceinline__ void phase4_qk(const Params& p, int wave, int lane) {
    unsigned char* ws = p.ws;
    const bf16_t* qraw = (const bf16_t*)(ws + WS_QRAW); const bf16_t* kraw = (const bf16_t*)(ws + WS_KRAW); const bf16_t* proj = (const bf16_t*)(ws + WS_PROJ);
    const float* ssq_q8 = (const float*)(ws + TAB_SSQ_Q8); const float* ssq_kv4 = (const float*)(ws + TAB_SSQ_KV4);
    const int* pos = (const int*)p.in[2]; const float* qg = p.in[14]; const float* kg = p.in[15];
    bf16_t* Q16 = (bf16_t*)(ws + WS_Q16); bf16_t* K16 = (bf16_t*)(ws + WS_K16);
    const float g0q = qg[lane], g1q = qg[64 + lane], g2q = qg[128 + lane], g0k = kg[lane], g1k = kg[64 + lane], g2k = kg[128 + lane];
    const int i = lane & 31; const float inv = exp2f(-(float)i * (13.287712379549449f / 32.f));
    const int gw = blockIdx.x * NWAVES + wave, NGW = gridDim.x * NWAVES;
    for (int it = gw; it < NT * MH; it += NGW) {
        const int t = it >> 3, h = it & 7, b = t / SEQ, s = t % SEQ;
        const pg8::f32x4 qa = *(const pg8::f32x4*)(ssq_q8 + (size_t)t * 8), qb = *(const pg8::f32x4*)(ssq_q8 + (size_t)t * 8 + 4), ka = *(const pg8::f32x4*)(ssq_kv4 + (size_t)t * 4);
        const float rq = rsqrtf((((qa[0] + qa[1]) + (qa[2] + qa[3])) + ((qb[0] + qb[1]) + (qb[2] + qb[3]))) * (1.f / QR) + EPS), rkv = rsqrtf(((ka[0] + ka[1]) + (ka[2] + ka[3])) * (1.f / KVR) + EPS);
        float q0 = bf2f(qraw[(size_t)t * 1536 + h * 192 + lane]) * rq, q1 = bf2f(qraw[(size_t)t * 1536 + h * 192 + 64 + lane]) * rq, q2 = bf2f(qraw[(size_t)t * 1536 + h * 192 + 128 + lane]) * rq;
        float k0 = bf2f(kraw[(size_t)t * 1024 + h * 128 + lane]) * rkv, k1 = bf2f(kraw[(size_t)t * 1024 + h * 128 + 64 + lane]) * rkv, k2 = bf2f(proj[(size_t)t * INCP + 4864 + lane]);
        const float sq = wave_sum(q0 * q0 + q1 * q1 + q2 * q2), sk = wave_sum(k0 * k0 + k1 * k1 + k2 * k2);
        const float nq = rsqrtf(sq * (1.f / 192.f) + EPS) * QSCALE, nk = rsqrtf(sk * (1.f / 192.f) + EPS);
        q0 *= nq * g0q; q1 *= nq * g1q; q2 *= nq * g2q; k0 *= nk * g0k; k1 *= nk * g1k; k2 *= nk * g2k;
        const float ang = (float)pos[t] * inv; float sn, cs; sincosf(ang, &sn, &cs);
        const float q2o = __shfl_xor(q2, 32), k2o = __shfl_xor(k2, 32);
        const float q2r = lane < 32 ? q2 * cs - q2o * sn : q2 * cs + q2o * sn;
        const float k2r = lane < 32 ? k2 * cs - k2o * sn : k2 * cs + k2o * sn;
        const size_t base = ((size_t)(b * MH + h) * SEQ + s) * QKD;
        Q16[base + lane] = (bf16_t)f2bf(q0); Q16[base + 64 + lane] = (bf16_t)f2bf(q1); Q16[base + 128 + lane] = (bf16_t)f2bf(q2r);
        K16[base + lane] = (bf16_t)f2bf(k0); K16[base + 64 + lane] = (bf16_t)f2bf(k1); K16[base + 128 + lane] = (bf16_t)f2bf(k2r);
    }
}

typedef short bf16x8 __attribute__((ext_vector_type(8)));
typedef float f32x16 __attribute__((ext_vector_type(16)));
constexpr int AT_KP = 400, AT_VP = 144, AT_KB = 64 * AT_KP, AT_VB = 128 * AT_VP, AT_BUF = AT_KB + AT_VB;
__device__ __forceinline__ void phase5_attn(const Params& p, LAS unsigned char* lds, int wave, int lane) {
    unsigned char* ws = p.ws;
    const bf16_t* Q16 = (const bf16_t*)(ws + WS_Q16); const bf16_t* K16 = (const bf16_t*)(ws + WS_K16); const bf16_t* Vt = (const bf16_t*)(ws + WS_VT);
    bf16_t* merged = (bf16_t*)(ws + WS_MERGED); float* ssq_o8 = (float*)(ws + TAB_SSQ_O8);
    const int tid = threadIdx.x, cl = lane & 31, hh = lane >> 5, qsub = wave & 3, kpar = wave >> 2;
    float mq = 0.f, mk = 0.f;
    for (int i = 0; i < 3; ++i) { mq = fmaxf(mq, fabsf(p.in[14][lane + 64 * i])); mk = fmaxf(mk, fabsf(p.in[15][lane + 64 * i])); }
#pragma unroll
    for (int o = 1; o < 64; o <<= 1) { mq = fmaxf(mq, __shfl_xor(mq, o)); mk = fmaxf(mk, __shfl_xor(mk, o)); }
    const float negc0 = -(13.856406460551018f * 1.4426950408889634f * 1.02f) * mq * mk;
    int kso[3], vso[2]; size_t vgo[2];
#pragma unroll
    for (int i = 0; i < 3; ++i) { const int c = tid + 512 * i; kso[i] = (c / 24) * AT_KP + (c % 24) * 16; }
#pragma unroll
    for (int i = 0; i < 2; ++i) { const int c = tid + 512 * i, dv = c >> 3, ch = c & 7; vso[i] = AT_KB + dv * AT_VP + ch * 16; vgo[i] = (size_t)dv * NT * 2 + ch * 16; }
    for (int item = blockIdx.x; item < 256; item += gridDim.x) {
        const int bh = item >> 3, x = item & 7, b = bh >> 3, h = bh & 7;
        const char* Qg = (const char*)(Q16 + (size_t)bh * SEQ * QKD); const char* Kg = (const char*)(K16 + (size_t)bh * SEQ * QKD);
        const char* Vg = (const char*)(Vt + (size_t)(h * 128) * NT + b * SEQ);
#pragma unroll 1
        for (int pass = 0; pass < 2; ++pass) {
            const int qi = pass == 0 ? 15 - x : x, nsteps = 2 * (qi + 1), qrow0 = qi * 128 + qsub * 32;
            bf16x8 Qf[12];
#pragma unroll
            for (int ks = 0; ks < 12; ++ks) Qf[ks] = *(const bf16x8*)(Qg + ((size_t)(qrow0 + cl) * QKD + ks * 16 + hh * 8) * 2);
            f32x16 O[4];
#pragma unroll
            for (int vb = 0; vb < 4; ++vb)
#pragma unroll
                for (int r = 0; r < 16; ++r) O[vb][r] = 0.f;
            float lsum = 0.f;
            v4u kr[3], vr[2];
#define AT_LOAD(j) do { _Pragma("unroll") for (int i_ = 0; i_ < 3; ++i_) kr[i_] = *(const v4u*)(Kg + (size_t)(j) * 24576 + (size_t)(tid + 512 * i_) * 16); \
                        _Pragma("unroll") for (int i_ = 0; i_ < 2; ++i_) vr[i_] = *(const v4u*)(Vg + vgo[i_] + (size_t)(j) * 128); } while (0)
#define AT_WRITE(bo) do { _Pragma("unroll") for (int i_ = 0; i_ < 3; ++i_) *(LAS v4u*)(lds + (bo) + kso[i_]) = kr[i_]; \
                          _Pragma("unroll") for (int i_ = 0; i_ < 2; ++i_) *(LAS v4u*)(lds + (bo) + vso[i_]) = vr[i_]; } while (0)
            AT_LOAD(0); AT_WRITE(0); __syncthreads();
#pragma unroll 1
            for (int j = 0; j < nsteps; ++j) {
                const int bo = (j & 1) * AT_BUF;
                if (j + 1 < nsteps) AT_LOAD(j + 1);
                const int key0 = 64 * j + 32 * kpar;
                if (key0 <= qrow0 + 31) {
                    f32x16 S;
#pragma unroll
                    for (int r = 0; r < 16; ++r) S[r] = negc0;
                    const LAS unsigned char* kb = lds + bo + (32 * kpar + cl) * AT_KP + hh * 16;
#pragma unroll
                    for (int ks = 0; ks < 12; ++ks) { const bf16x8 a = *(const LAS bf16x8*)(kb + ks * 32); S = __builtin_amdgcn_mfma_f32_32x32x16_bf16(a, Qf[ks], S, 0, 0, 0); }
                    const bool diag = key0 + 31 > qrow0;
                    float pr[16];
#pragma unroll
                    for (int r = 0; r < 16; ++r) { float e = __builtin_amdgcn_exp2f(S[r]);
                        if (diag) { const int key = key0 + (r & 3) + 8 * (r >> 2) + 4 * hh; if (key > qrow0 + cl) e = 0.f; }
                        pr[r] = e; lsum += e; }
                    bf16x8 Pf[2];
#pragma unroll
                    for (int s = 0; s < 2; ++s) { v4u w; w.x = pk2(pr[8 * s + 0], pr[8 * s + 1]); w.y = pk2(pr[8 * s + 2], pr[8 * s + 3]); w.z = pk2(pr[8 * s + 4], pr[8 * s + 5]); w.w = pk2(pr[8 * s + 6], pr[8 * s + 7]);
                        Pf[s] = __builtin_bit_cast(bf16x8, w); }
                    const LAS unsigned char* vbp = lds + bo + AT_KB + cl * AT_VP + (32 * kpar + 8 * hh) * 2;
#pragma unroll
                    for (int vb = 0; vb < 4; ++vb)
#pragma unroll
                        for (int s = 0; s < 2; ++s) { const bf16x8 a = *(const LAS bf16x8*)(vbp + vb * 32 * AT_VP + s * 32); O[vb] = __builtin_amdgcn_mfma_f32_32x32x16_bf16(a, Pf[s], O[vb], 0, 0, 0); }
                }
                if (j + 1 < nsteps) AT_WRITE(((j + 1) & 1) * AT_BUF);
                __syncthreads();
            }
            LAS float* X = (LAS float*)lds;
            if (kpar == 1) {
#pragma unroll
                for (int vb = 0; vb < 4; ++vb)
#pragma unroll
                    for (int r = 0; r < 16; ++r) X[(qsub * 65 + vb * 16 + r) * 64 + lane] = O[vb][r];
                X[(qsub * 65 + 64) * 64 + lane] = lsum;
            }
            __syncthreads();
            if (kpar == 0) {
                float l = lsum + X[(qsub * 65 + 64) * 64 + lane];
                l += __shfl_xor(l, 32);
                const float il = 1.f / l; float ss = 0.f;
                const int t = b * SEQ + qrow0 + cl;
                bf16_t* op = merged + (size_t)t * DM + 1024 + h * 128 + 4 * hh;
#pragma unroll
                for (int vb = 0; vb < 4; ++vb)
#pragma unroll
                    for (int rq = 0; rq < 4; ++rq) { float o[4];
#pragma unroll
                        for (int r3 = 0; r3 < 4; ++r3) { const int r = rq * 4 + r3; o[r3] = (O[vb][r] + X[(qsub * 65 + vb * 16 + r) * 64 + lane]) * il; ss += o[r3] * o[r3]; }
                        v2u w; w.x = pk2(o[0], o[1]); w.y = pk2(o[2], o[3]); *(v2u*)(op + vb * 32 + rq * 8) = w; }
                ss += __shfl_xor(ss, 32);
                if (hh == 0) ssq_o8[(size_t)t * 8 + h] = ss;
            }
            __syncthreads();
        }
    }
#undef AT_LOAD
#undef AT_WRITE
}

__device__ __forceinline__ void phase6_scale(const Params& p, int wave, int lane) {
    unsigned char* ws = p.ws; bf16_t* merged = (bf16_t*)(ws + WS_MERGED); const float* ssq_o8 = (const float*)(ws + TAB_SSQ_O8);
    const int gw = blockIdx.x * NWAVES + wave, NGW = gridDim.x * NWAVES;
    for (int t = gw; t < NT; t += NGW) { const pg8::f32x4 oa = *(const pg8::f32x4*)(ssq_o8 + (size_t)t * 8), ob = *(const pg8::f32x4*)(ssq_o8 + (size_t)t * 8 + 4);
        const float r = rsqrtf((((oa[0] + oa[1]) + (oa[2] + oa[3])) + ((ob[0] + ob[1]) + (ob[2] + ob[3]))) * (1.f / 1024.f) + EPS);
#pragma unroll
        for (int j = 0; j < 2; ++j) { v4u* q = (v4u*)(merged + (size_t)t * DM + 1024 + j * 512 + lane * 8); v4u y = *q;
            y.x = pk2(bflo(y.x) * r, bfhi(y.x) * r); y.y = pk2(bflo(y.y) * r, bfhi(y.y) * r); y.z = pk2(bflo(y.z) * r, bfhi(y.z) * r); y.w = pk2(bflo(y.w) * r, bfhi(y.w) * r); *q = y; } }
}

struct EpiResidF32 { static constexpr bool PERM = false; const float* x; const float* gate; float* out;
    __device__ __forceinline__ void operator()(const pg8::f32x4 (&acc)[2][2][4][2], const pg8::Unit& u, int wr, int wc, int fr, int fq) const {
        const int row0 = u.pm * 256 + wr * 64 + fr, col0 = u.pn * 256 + wc * 32 + 4 * fq;
        const float* gp = gate + (size_t)((u.pm * 256) / SEQ) * MODW + col0;
        pg8::f32x4 gv[2][2];
#pragma unroll
        for (int bj = 0; bj < 2; ++bj)
#pragma unroll
            for (int n = 0; n < 2; ++n) gv[bj][n] = *(const pg8::f32x4*)(gp + bj * 128 + n * 16);
#pragma unroll
        for (int ai = 0; ai < 2; ++ai)
#pragma unroll
            for (int m = 0; m < 4; ++m) { const size_t ro = (size_t)(row0 + ai * 128 + m * 16) * DM + col0;
#pragma unroll
                for (int bj = 0; bj < 2; ++bj)
#pragma unroll
                    for (int n = 0; n < 2; ++n) { const pg8::f32x4 xv = *(const pg8::f32x4*)(x + ro + bj * 128 + n * 16); *(pg8::f32x4*)(out + ro + bj * 128 + n * 16) = xv + gv[bj][n] * acc[ai][bj][m][n]; } }
    }
};
__device__ __forceinline__ void phase7(const Params& p, LAS unsigned char* lds) {
    unsigned char* ws = p.ws;
    pg8::Gemm g{(const bf16_t*)(ws + WS_MERGED), (const bf16_t*)(ws + WS_BT_OUT), nullptr, DM, DM, DM, 0};
    pg8::StaticOrder S; S.init(NT / 256, DM / 256, gridDim.x, blockIdx.x, DM);
    EpiResidF32 E{p.in[0], (const float*)(ws + CTL_MOD) + 2 * DM, (float*)(ws + WS_H1)};
    pg8::gemm_phase<EpiResidF32, pg8::StaticOrder>((PG8_LAS unsigned char*)lds, g, S, E);
}
constexpr int HG_P = 272, HG_VP = 144;
constexpr int HG_A2 = 0, HG_A1 = 17408, HG_QB = 34816, HG_VT = 52224, HG_KT = 70656, HG_SEG = 89088, HG_RS = 91136;
struct HgCol { float lf[16]; float b[16]; float blast, bmid; };
__device__ __forceinline__ void hg_column(const bf16_t* __restrict__ proj, const float* __restrict__ lbl, int t0, int h, LAS unsigned char* lds, HgCol& C) {
    const int tid = threadIdx.x, k = tid & 127, seg = tid >> 7;
    const float l0 = lbl[h * 128 + k], l1 = lbl[1024 + h * 128 + k];
    const float lb = 1.f / (1.f + __expf(l1 - l0));
    const bf16_t* fp = proj + (size_t)(t0 + seg * 16) * INCP + 1024 + h * 128 + k;
    float run = 0.f;
#pragma unroll
    for (int i = 0; i < 16; ++i) { const float fl = bf2f(fp[(size_t)i * INCP]); const float f = lb + (1.f - lb) / (1.f + __expf(-fl)); C.lf[i] = __logf(f); run += C.lf[i]; C.b[i] = run; }
    LAS float* SEG = (LAS float*)(lds + HG_SEG);
    __syncthreads();
    SEG[seg * 128 + k] = run;
    __syncthreads();
    const float s0 = SEG[k], s1 = SEG[128 + k], s2 = SEG[256 + k], s3 = SEG[384 + k];
    const float off = (seg > 0 ? s0 : 0.f) + (seg > 1 ? s1 : 0.f) + (seg > 2 ? s2 : 0.f);
#pragma unroll
    for (int i = 0; i < 16; ++i) C.b[i] += off;
    C.bmid = s0 + s1; C.blast = (s0 + s1) + (s2 + s3);
}
template <bool PERM>
__device__ __forceinline__ void hg_load_vt(const bf16_t* __restrict__ proj, int t0, int h, LAS unsigned char* lds) {
    const int tid = threadIdx.x;
#pragma unroll
    for (int i = 0; i < 2; ++i) { const int c = tid + 512 * i, t = c >> 4, c16 = c & 15;
        const v4u w = *(const v4u*)(proj + (size_t)(t0 + t) * INCP + 2048 + h * 128 + c16 * 8);
        const int o = t & 15, pos = PERM ? ((t & ~15) + 8 * ((o >> 2) & 1) + 4 * ((o >> 3) & 1) + (o & 3)) : t;
        LAS unsigned short* vp = (LAS unsigned short*)(lds + HG_VT + (c16 * 8) * HG_VP + pos * 2);
        vp[0 * (HG_VP / 2)] = (unsigned short)(w.x & 0xffff); vp[1 * (HG_VP / 2)] = (unsigned short)(w.x >> 16);
        vp[2 * (HG_VP / 2)] = (unsigned short)(w.y & 0xffff); vp[3 * (HG_VP / 2)] = (unsigned short)(w.y >> 16);
        vp[4 * (HG_VP / 2)] = (unsigned short)(w.z & 0xffff); vp[5 * (HG_VP / 2)] = (unsigned short)(w.z >> 16);
        vp[6 * (HG_VP / 2)] = (unsigned short)(w.w & 0xffff); vp[7 * (HG_VP / 2)] = (unsigned short)(w.w >> 16); }
}
__device__ __forceinline__ void hgrn_pass1(const Params& p, LAS unsigned char* lds, int wave, int lane) {
    unsigned char* ws = p.ws; const bf16_t* proj = (const bf16_t*)(ws + WS_PROJ);
    bf16_t* hgU = (bf16_t*)(ws + WS_HGU); float* hgd = (float*)(ws + TAB_HGD);
    const int tid = threadIdx.x, k = tid & 127, seg = tid >> 7, cl = lane & 31, hh = lane >> 5;
    for (int item = blockIdx.x; item < 1024; item += gridDim.x) {
        const int bh = item >> 5, c = item & 31, b = bh >> 3, h = bh & 7, t0 = b * SEQ + c * 64;
        HgCol C; hg_column(proj, p.in[8], t0, h, lds, C);
        { unsigned w[8];
#pragma unroll
          for (int i = 0; i < 8; ++i) { const float a0 = (1.f - __expf(C.lf[2 * i])) * __expf(C.blast - C.b[2 * i]), a1 = (1.f - __expf(C.lf[2 * i + 1])) * __expf(C.blast - C.b[2 * i + 1]); w[i] = pk2(a0, a1); }
          LAS v4u* kp = (LAS v4u*)(lds + HG_KT + k * HG_VP + seg * 32); kp[0] = (v4u){w[0], w[1], w[2], w[3]}; kp[1] = (v4u){w[4], w[5], w[6], w[7]}; }
        if (seg == 0) hgd[item * 128 + k] = __expf(C.blast);
        hg_load_vt<false>(proj, t0, h, lds);
        __syncthreads();
        const int vb = wave >> 1;
        bf16x8 af[4];
#pragma unroll
        for (int ks = 0; ks < 4; ++ks) af[ks] = *(const LAS bf16x8*)(lds + HG_VT + (32 * vb + cl) * HG_VP + (16 * ks + 8 * hh) * 2);
#pragma unroll
        for (int q = 0; q < 2; ++q) { const int kb = (wave & 1) * 2 + q; f32x16 acc;
#pragma unroll
            for (int r = 0; r < 16; ++r) acc[r] = 0.f;
#pragma unroll
            for (int ks = 0; ks < 4; ++ks) { const bf16x8 bfr = *(const LAS bf16x8*)(lds + HG_KT + (32 * kb + cl) * HG_VP + (16 * ks + 8 * hh) * 2); acc = __builtin_amdgcn_mfma_f32_32x32x16_bf16(af[ks], bfr, acc, 0, 0, 0); }
            bf16_t* up = hgU + (size_t)item * 16384 + 32 * kb + cl;
#pragma unroll
            for (int r = 0; r < 16; ++r) { const int v = 32 * vb + (r & 3) + 8 * (r >> 2) + 4 * hh; up[(size_t)v * 128] = (bf16_t)f2bf(acc[r]); } }
    }
}
__device__ __forceinline__ void hgrn_scan(const Params& p) {
    unsigned char* ws = p.ws; bf16_t* hgU = (bf16_t*)(ws + WS_HGU); const float* hgd = (const float*)(ws + TAB_HGD);
    for (int i = blockIdx.x * NTHR + threadIdx.x; i < 32 * 4096; i += gridDim.x * NTHR) {
        const int bh = i >> 12, e4 = i & 4095, k4 = (e4 & 31) * 4;
        float S[4] = {0.f, 0.f, 0.f, 0.f};
        v2u* up = (v2u*)(hgU + (size_t)bh * 32 * 16384 + (size_t)e4 * 4); const float* dp = hgd + (size_t)bh * 32 * 128 + k4;
#pragma unroll 8
        for (int c = 0; c < 32; ++c) { const v2u u = up[(size_t)c * 4096]; const f32x4 d = *(const f32x4*)(dp + c * 128);
            v2u o; o.x = pk2(S[0], S[1]); o.y = pk2(S[2], S[3]); up[(size_t)c * 4096] = o;
            S[0] = d[0] * S[0] + bflo(u.x); S[1] = d[1] * S[1] + bfhi(u.x); S[2] = d[2] * S[2] + bflo(u.y); S[3] = d[3] * S[3] + bfhi(u.y); }
    }
}
__device__ __forceinline__ void hgrn_pass3(const Params& p, LAS unsigned char* lds, int wave, int lane) {
    unsigned char* ws = p.ws; const bf16_t* proj = (const bf16_t*)(ws + WS_PROJ);
    const bf16_t* hgS = (const bf16_t*)(ws + WS_HGU); bf16_t* merged = (bf16_t*)(ws + WS_MERGED); const float* og = p.in[9];
    const int tid = threadIdx.x, k = tid & 127, seg = tid >> 7, cl = lane & 31, hh = lane >> 5, vb = wave & 3, tb = wave >> 2;
    for (int item = blockIdx.x; item < 1024; item += gridDim.x) {
        const int bh = item >> 5, c = item & 31, b = bh >> 3, h = bh & 7, t0 = b * SEQ + c * 64;
        HgCol C; hg_column(proj, p.in[8], t0, h, lds, C);
        { const bf16_t* qp = proj + (size_t)(t0 + seg * 16) * INCP + h * 128 + k;
          LAS unsigned short* a2 = (LAS unsigned short*)(lds + HG_A2 + (seg * 16) * HG_P + k * 2);
          LAS unsigned short* a1 = (LAS unsigned short*)(lds + HG_A1 + (seg * 16) * HG_P + k * 2);
          LAS unsigned short* qb = (LAS unsigned short*)(lds + HG_QB + (seg * 16) * HG_P + k * 2);
#pragma unroll
          for (int i = 0; i < 16; ++i) { const float q = bf2f(qp[(size_t)i * INCP]);
              a2[i * (HG_P / 2)] = (unsigned short)f2bf((1.f - __expf(C.lf[i])) * __expf(C.bmid - C.b[i]));
              a1[i * (HG_P / 2)] = (unsigned short)f2bf(q * __expf(C.b[i] - C.bmid));
              qb[i * (HG_P / 2)] = (unsigned short)f2bf(q * __expf(C.b[i])); } }
        hg_load_vt<true>(proj, t0, h, lds);
        __syncthreads();
        f32x16 O;
#pragma unroll
        for (int r = 0; r < 16; ++r) O[r] = 0.f;
        { const bf16_t* sp = hgS + (size_t)item * 16384 + (size_t)(32 * vb + cl) * 128 + 8 * hh;
#pragma unroll
          for (int ks = 0; ks < 8; ++ks) { const bf16x8 a = *(const bf16x8*)(sp + 16 * ks); const bf16x8 bq = *(const LAS bf16x8*)(lds + HG_QB + (32 * tb + cl) * HG_P + (16 * ks + 8 * hh) * 2);
              O = __builtin_amdgcn_mfma_f32_32x32x16_bf16(a, bq, O, 0, 0, 0); } }
#pragma unroll
        for (int sb = 0; sb < 2; ++sb) {
            if (sb <= tb) {
                f32x16 X;
#pragma unroll
                for (int r = 0; r < 16; ++r) X[r] = 0.f;
#pragma unroll
                for (int ks = 0; ks < 8; ++ks) { const bf16x8 a = *(const LAS bf16x8*)(lds + HG_A2 + (32 * sb + cl) * HG_P + (16 * ks + 8 * hh) * 2);
                    const bf16x8 bq = *(const LAS bf16x8*)(lds + HG_A1 + (32 * tb + cl) * HG_P + (16 * ks + 8 * hh) * 2); X = __builtin_amdgcn_mfma_f32_32x32x16_bf16(a, bq, X, 0, 0, 0); }
                if (sb == tb) {
#pragma unroll
                    for (int r = 0; r < 16; ++r) { const int s = (r & 3) + 8 * (r >> 2) + 4 * hh; if (s > cl) X[r] = 0.f; } }
#pragma unroll
                for (int s2 = 0; s2 < 2; ++s2) { v4u w; w.x = pk2(X[8 * s2 + 0], X[8 * s2 + 1]); w.y = pk2(X[8 * s2 + 2], X[8 * s2 + 3]); w.z = pk2(X[8 * s2 + 4], X[8 * s2 + 5]); w.w = pk2(X[8 * s2 + 6], X[8 * s2 + 7]);
                    const bf16x8 a = *(const LAS bf16x8*)(lds + HG_VT + (32 * vb + cl) * HG_VP + (32 * sb + 16 * s2 + 8 * hh) * 2);
                    O = __builtin_amdgcn_mfma_f32_32x32x16_bf16(a, __builtin_bit_cast(bf16x8, w), O, 0, 0, 0); }
            }
        }
        float ss = 0.f;
#pragma unroll
        for (int r = 0; r < 16; ++r) ss += O[r] * O[r];
        ss += __shfl_xor(ss, 32);
        LAS float* RS = (LAS float*)(lds + HG_RS);
        if (hh == 0) RS[(tb * 4 + vb) * 32 + cl] = ss;
        __syncthreads();
        const float tot = (RS[(tb * 4 + 0) * 32 + cl] + RS[(tb * 4 + 1) * 32 + cl]) + (RS[(tb * 4 + 2) * 32 + cl] + RS[(tb * 4 + 3) * 32 + cl]);
        const float rn = rsqrtf(tot * (1.f / 128.f) + EPS);
        const int t = t0 + 32 * tb + cl;
#pragma unroll
        for (int rq = 0; rq < 4; ++rq) { const int v = 32 * vb + 8 * rq + 4 * hh;
            const v2u gw = *(const v2u*)(proj + (size_t)t * INCP + 3072 + h * 128 + v); const f32x4 gg = *(const f32x4*)(og + v);
            const float g0 = bflo(gw.x), g1 = bfhi(gw.x), g2 = bflo(gw.y), g3 = bfhi(gw.y);
            const float o0 = O[rq * 4 + 0] * rn * gg[0] * (g0 / (1.f + __expf(-g0))), o1 = O[rq * 4 + 1] * rn * gg[1] * (g1 / (1.f + __expf(-g1)));
            const float o2 = O[rq * 4 + 2] * rn * gg[2] * (g2 / (1.f + __expf(-g2))), o3 = O[rq * 4 + 3] * rn * gg[3] * (g3 / (1.f + __expf(-g3)));
            v2u w; w.x = pk2(o0, o1); w.y = pk2(o2, o3); *(v2u*)(merged + (size_t)t * DM + h * 128 + v) = w; }
    }
}
typedef float f32x2v __attribute__((ext_vector_type(2)));
constexpr int UPITCH = 2050;
constexpr int LDS_HIST = RING_BYTES + 1024;
__device__ __forceinline__ void phase8(const Params& p, LAS unsigned char* lds, int wave, int lane) {
    unsigned char* ws = p.ws;
    const float* h1 = (const float*)(ws + WS_H1); const float* mod = (const float*)(ws + CTL_MOD);
    bf16_t* u16 = (bf16_t*)(ws + WS_U16);
    const float* wr_ = p.in[18]; const float* rbias = p.in[19];
    int* top_idx = (int*)(ws + TAB_TOPI); float* top_w = (float*)(ws + TAB_TOPW); int* slot = (int*)(ws + TAB_SLOT);
    LAS float* U = (LAS float*)lds;
    LAS int* hist = (LAS int*)(lds + LDS_HIST);
    if (threadIdx.x < 64) hist[threadIdx.x] = 0;
    __syncthreads();
    for (int task = blockIdx.x; task < NT / 16; task += gridDim.x) {
        const int t0 = task * 16;
#pragma unroll 1
        for (int rr = 0; rr < 2; ++rr) {
            const int tl = wave * 2 + rr, t = t0 + tl, b = t / SEQ;
            const float* hrow = h1 + (size_t)t * DM; const float* g = p.in[6]; const float* sc = mod + b * MODW + 4 * DM; const float* sh = mod + b * MODW + 3 * DM;
            f32x4 v[8]; float s = 0.f;
#pragma unroll
            for (int j = 0; j < 8; ++j) { v[j] = *(const f32x4*)(hrow + lane * 4 + 256 * j); s += (v[j].x * v[j].x + v[j].y * v[j].y) + (v[j].z * v[j].z + v[j].w * v[j].w); }
            const float r = rsqrtf(wave_sum(s) * (1.f / DM) + EPS);
#pragma unroll
            for (int j = 0; j < 8; ++j) { const int col = lane * 4 + 256 * j; const f32x4 gv = *(const f32x4*)(g + col), sv = *(const f32x4*)(sc + col), hv = *(const f32x4*)(sh + col);
                const f32x4 o = v[j] * r * gv * (sv + 1.f) + hv; v2u w; w.x = pk2(o.x, o.y); w.y = pk2(o.z, o.w); *(v2u*)(u16 + (size_t)t * DM + col) = w;
                LAS f32x2v* up = (LAS f32x2v*)(U + tl * UPITCH + col); up[0] = (f32x2v){o.x, o.y}; up[1] = (f32x2v){o.z, o.w}; }
        }
        __syncthreads();
        f32x4 acc[4];
#pragma unroll
        for (int c = 0; c < 4; ++c) acc[c] = (f32x4){0.f, 0.f, 0.f, 0.f};
        { const int kb = wave * 256 + (lane >> 4); const LAS float* ua = U + (lane & 15) * UPITCH + kb; const float* wb = wr_ + (size_t)kb * NE + 4 * (lane & 15);
#pragma unroll 8
          for (int ks = 0; ks < 64; ++ks) { const float a = ua[ks * 4]; const f32x4 bv = *(const f32x4*)(wb + (size_t)ks * 4 * NE);
#pragma unroll
              for (int c = 0; c < 4; ++c) acc[c] = __builtin_amdgcn_mfma_f32_16x16x4f32(a, bv[c], acc[c], 0, 0, 0); } }
        __syncthreads();
        LAS float* P = (LAS float*)lds;
#pragma unroll
        for (int c = 0; c < 4; ++c)
#pragma unroll
            for (int r = 0; r < 4; ++r) P[wave * 1024 + ((lane >> 4) * 4 + r) * 64 + 4 * (lane & 15) + c] = acc[c][r];
        __syncthreads();
        LAS float* LG = (LAS float*)(lds + 32768);
#pragma unroll
        for (int q = 0; q < 2; ++q) { const int i = threadIdx.x + q * NTHR; float s = 0.f;
#pragma unroll
            for (int w = 0; w < 8; ++w) s += P[w * 1024 + i]; LG[i] = s; }
        __syncthreads();
#pragma unroll 1
        for (int rr = 0; rr < 2; ++rr) {
            const int tl = wave * 2 + rr, t = t0 + tl;
            const float sc = 1.f / (1.f + expf(-LG[tl * 64 + lane])); const float sel = sc + rbias[lane];
            float m1 = sel; m1 = fmaxf(m1, __shfl_xor(m1, 1)); m1 = fmaxf(m1, __shfl_xor(m1, 2)); m1 = fmaxf(m1, __shfl_xor(m1, 4));
            const unsigned long long gm = 0xFFull << (lane & 56);
            const int first = __ffsll((long long)(__ballot(sel == m1) & gm)) - 1;
            float m2 = (lane == first) ? -INFINITY : sel; m2 = fmaxf(m2, __shfl_xor(m2, 1)); m2 = fmaxf(m2, __shfl_xor(m2, 2)); m2 = fmaxf(m2, __shfl_xor(m2, 4));
            const float gs = m1 + m2; const int g = lane >> 3; int grank = 0;
#pragma unroll
            for (int gg = 0; gg < 8; ++gg) { const float og = __builtin_bit_cast(float, __builtin_amdgcn_readlane(__builtin_bit_cast(int, gs), gg * 8)); grank += (og > gs || (og == gs && gg < g)) ? 1 : 0; }
            const bool gsel = grank < 4; const float msel = gsel ? sel : -INFINITY; int rk = 0;
#pragma unroll
            for (int e = 0; e < 64; ++e) { const float o = __builtin_bit_cast(float, __builtin_amdgcn_readlane(__builtin_bit_cast(int, msel), e)); rk += (o > msel || (o == msel && e < lane)) ? 1 : 0; }
            const bool chosen = gsel && rk < 8;
            const unsigned long long cb = __ballot(chosen);
            const float wsum = wave_sum(chosen ? sc : 0.f);
            const int ks = __popcll(cb & ((1ull << lane) - 1ull));
            if (chosen) { const int lr = __hip_atomic_fetch_add((int*)(hist + lane), 1, __ATOMIC_RELAXED, __HIP_MEMORY_SCOPE_WORKGROUP); top_idx[t * 8 + ks] = lane; top_w[t * 8 + ks] = sc / wsum * 2.5f; slot[t * 8 + ks] = lr; }
        }
        __syncthreads();
    }
    if (threadIdx.x < 64) ((int*)(ws + CTL_HIST))[blockIdx.x * 64 + threadIdx.x] = hist[threadIdx.x];
}

__device__ __forceinline__ void phase9(const Params& p, LAS unsigned char* lds, int wave, int lane) {
    unsigned char* ws = p.ws;
    const int* bh = (const int*)(ws + CTL_HIST);
    int* top_idx = (int*)(ws + TAB_TOPI); int* slot = (int*)(ws + TAB_SLOT); int* row_tok = (int*)(ws + TAB_ROWTOK); int* tile_exp = (int*)(ws + TAB_TILEEXP);
    LAS int* rb = (LAS int*)(lds + LDS_HIST + 256);
    const int G = gridDim.x;
    if (wave == 0) {
        int cnt = 0, base = 0;
        for (int b = 0; b < G; ++b) { const int v = bh[b * 64 + lane]; base += (b < (int)blockIdx.x) ? v : 0; cnt += v; }
        const int tiles = (cnt + 255) >> 8;
        int incl = tiles;
#pragma unroll
        for (int o = 1; o < 64; o <<= 1) { const int n = __shfl_up(incl, o); if (lane >= o) incl += n; }
        const int toff = incl - tiles;
        rb[lane] = toff * 256 + base;
        if (blockIdx.x == 0) { for (int i = 0; i < tiles; ++i) tile_exp[toff + i] = lane; if (lane == 63) tile_exp[512] = incl; if (lane < 32) tile_exp[320 + lane] = 64; }
        rb[64 + lane] = toff * 256 + cnt; rb[128 + lane] = (toff + tiles) * 256;
    }
    __syncthreads();
    for (int e = blockIdx.x; e < 64; e += G) { const int lo = rb[64 + e], hi = rb[128 + e]; for (int r = lo + (int)threadIdx.x; r < hi; r += NTHR) row_tok[r] = 0; }
    for (int i = blockIdx.x * NTHR + threadIdx.x; i < NT; i += G * NTHR) row_tok[ROUTED_ROWS_MAX + i] = i;
    for (int task = blockIdx.x; task < NT / 16; task += G) {
        const int t = task * 16 + wave * 2 + (lane >> 3), k = lane & 7;
        if (lane < 16) { const int e = top_idx[t * 8 + k]; const int pos = rb[e] + slot[t * 8 + k]; slot[t * 8 + k] = pos; row_tok[pos] = t; }
    }
}

struct MoeOrder {
    const int* tile_exp; int ntr, nN, nwg, G, c; long estride, bstep;
    __device__ void init(const int* te, int nN_, int G_, int c_, long estride_, int ldb) { tile_exp = te; ntr = te[512]; nN = nN_; nwg = (ntr + 32) * nN; G = G_; c = c_; estride = estride_; bstep = (long)256 * ldb * 2; }
    __device__ bool next(int i, pg8::Unit& u) const {
        const long L = (long)i * G + c; if (L >= nwg) return false;
        int wgid = (int)L; { const int q = nwg / 8, r = nwg % 8, xcd = wgid % 8, off = wgid / 8; wgid = (xcd < r ? xcd * (q + 1) : r * (q + 1) + (xcd - r) * q) + off; }
        const int ti = wgid / nN, pn = wgid % nN;
        int tile, e; if (ti < ntr) { tile = ti; e = tile_exp[ti]; } else { tile = 320 + (ti - ntr); e = 64; }
        u.pm = tile; u.pn = pn; u.boff = (long)e * estride + (long)pn * bstep; return true;
    }
};
struct EpiGateUp { static constexpr bool PERM = true; bf16_t* H;
    __device__ __forceinline__ void operator()(const pg8::f32x4 (&acc)[2][2][4][2], const pg8::Unit& u, int wr, int wc, int fr, int fq) const {
        const int row0 = u.pm * 256 + wr * 64 + fr, col0 = u.pn * 128 + wc * 32 + 8 * fq;
#pragma unroll
        for (int ai = 0; ai < 2; ++ai)
#pragma unroll
            for (int m = 0; m < 4; ++m) { const int row = row0 + ai * 128 + m * 16; float o[8];
#pragma unroll
                for (int n = 0; n < 2; ++n)
#pragma unroll
                    for (int j = 0; j < 4; ++j) { const float gt = acc[ai][0][m][n][j], up = acc[ai][1][m][n][j]; o[n * 4 + j] = gt / (1.f + __expf(-gt)) * up; }
                v4u w; w.x = pk2(o[0], o[1]); w.y = pk2(o[2], o[3]); w.z = pk2(o[4], o[5]); w.w = pk2(o[6], o[7]);
                *(v4u*)(H + (size_t)row * DE + col0) = w; }
    }
};
struct EpiDown { static constexpr bool PERM = true; bf16_t* Y;
    __device__ __forceinline__ void operator()(const pg8::f32x4 (&acc)[2][2][4][2], const pg8::Unit& u, int wr, int wc, int fr, int fq) const {
        const int row0 = u.pm * 256 + wr * 64 + fr, col0 = u.pn * 256 + wc * 32 + 8 * fq;
#pragma unroll
        for (int ai = 0; ai < 2; ++ai)
#pragma unroll
            for (int m = 0; m < 4; ++m) { const int row = row0 + ai * 128 + m * 16; bf16_t* rowp = Y + (size_t)row * DM + col0;
#pragma unroll
                for (int bj = 0; bj < 2; ++bj) { const pg8::f32x4 v0 = acc[ai][bj][m][0], v1 = acc[ai][bj][m][1];
                    v4u w; w.x = pk2(v0[0], v0[1]); w.y = pk2(v0[2], v0[3]); w.z = pk2(v1[0], v1[1]); w.w = pk2(v1[2], v1[3]); *(v4u*)(rowp + bj * 128) = w; } }
    }
};
__device__ __forceinline__ void phase10(const Params& p, LAS unsigned char* lds) {
    unsigned char* ws = p.ws;
    pg8::Gemm g{(const bf16_t*)(ws + WS_U16), (const bf16_t*)(ws + WS_BT_GU), (const int*)(ws + TAB_ROWTOK), DM, DM, DM, 0};
    MoeOrder S; S.init((const int*)(ws + TAB_TILEEXP), 4, gridDim.x, blockIdx.x, (long)1024 * DM * 2, DM);
    EpiGateUp E{(bf16_t*)(ws + WS_HID)};
    pg8::gemm_phase<EpiGateUp, MoeOrder>((PG8_LAS unsigned char*)lds, g, S, E);
}
__device__ __forceinline__ void phase11(const Params& p, LAS unsigned char* lds) {
    unsigned char* ws = p.ws;
    pg8::Gemm g{(const bf16_t*)(ws + WS_HID), (const bf16_t*)(ws + WS_BT_DN), nullptr, DE, DE, DE, 0};
    MoeOrder S; S.init((const int*)(ws + TAB_TILEEXP), 8, gridDim.x, blockIdx.x, (long)DM * DE * 2, DE);
    EpiDown E{(bf16_t*)(ws + WS_Y)};
    pg8::gemm_phase<EpiDown, MoeOrder>((PG8_LAS unsigned char*)lds, g, S, E);
}
__device__ __forceinline__ void phase12(const Params& p, int wave, int lane) {
    unsigned char* ws = p.ws;
    const float* h1 = (const float*)(ws + WS_H1); const float* mod = (const float*)(ws + CTL_MOD); const bf16_t* Y = (const bf16_t*)(ws + WS_Y);
    const int* slot = (const int*)(ws + TAB_SLOT); const float* top_w = (const float*)(ws + TAB_TOPW);
    const int gw = blockIdx.x * NWAVES + wave, NGW = gridDim.x * NWAVES;
    for (int t = gw; t < NT; t += NGW) {
        const int b = t / SEQ; const float* gt = mod + b * MODW + 5 * DM;
        int sl = 0; float wk = 0.f; if (lane < 8) { sl = slot[t * 8 + lane]; wk = top_w[t * 8 + lane]; }
#pragma unroll 1
        for (int j = 0; j < 4; ++j) {
            const int col = j * 512 + lane * 8; float a[8];
            { const v4u y = *(const v4u*)(Y + (size_t)(ROUTED_ROWS_MAX + t) * DM + col); a[0] = bflo(y.x); a[1] = bfhi(y.x); a[2] = bflo(y.y); a[3] = bfhi(y.y); a[4] = bflo(y.z); a[5] = bfhi(y.z); a[6] = bflo(y.w); a[7] = bfhi(y.w); }
#pragma unroll
            for (int k = 0; k < 8; ++k) { const int s = __builtin_amdgcn_readlane(sl, k); const float w = __builtin_bit_cast(float, __builtin_amdgcn_readlane(__builtin_bit_cast(int, wk), k));
                const v4u y = *(const v4u*)(Y + (size_t)s * DM + col);
                a[0] += w * bflo(y.x); a[1] += w * bfhi(y.x); a[2] += w * bflo(y.y); a[3] += w * bfhi(y.y); a[4] += w * bflo(y.z); a[5] += w * bfhi(y.z); a[6] += w * bflo(y.w); a[7] += w * bfhi(y.w); }
            const f32x4 h0 = *(const f32x4*)(h1 + (size_t)t * DM + col), h4 = *(const f32x4*)(h1 + (size_t)t * DM + col + 4);
            const f32x4 g0 = *(const f32x4*)(gt + col), g4 = *(const f32x4*)(gt + col + 4);
            f32x4 o0, o4; o0.x = h0.x + g0.x * a[0]; o0.y = h0.y + g0.y * a[1]; o0.z = h0.z + g0.z * a[2]; o0.w = h0.w + g0.w * a[3];
            o4.x = h4.x + g4.x * a[4]; o4.y = h4.y + g4.y * a[5]; o4.z = h4.z + g4.z * a[6]; o4.w = h4.w + g4.w * a[7];
            *(f32x4*)(p.out + (size_t)t * DM + col) = o0; *(f32x4*)(p.out + (size_t)t * DM + col + 4) = o4;
        }
    }
}

__global__ void __launch_bounds__(NTHR, 2) k_mega(Params p) {
    extern __shared__ __attribute__((aligned(16))) unsigned char lds_raw[];
    LAS unsigned char* lds = (LAS unsigned char*)lds_raw;
    const int tid = threadIdx.x, lane = tid & 63, wave = __builtin_amdgcn_readfirstlane(tid >> 6);
    volatile LAS unsigned* MISC = (volatile LAS unsigned*)(lds + MISC_OFF);
    for (int u = tid; u < (LDS_BYTES - RING_BYTES) / 4; u += NTHR) ((LAS unsigned*)(lds + RING_BYTES))[u] = 0u;
    __syncthreads();
    XcdBarrier bar = xcd_barrier_post((unsigned*)(p.ws + WS_CTL) + CW_BAR, MISC + 8);
    const int lo = p.ph_lo, hi = p.ph_hi;
#define IN(k) (lo <= (k) && (k) < hi)
#define SEAM(k) do { if (IN(k) && IN((k) + 1)) xcd_barrier(bar); } while (0)
    if (IN(0)) { phase0(p, lds, wave, lane); } SEAM(0);
    if (IN(1)) { phase1(p, lds, wave, lane); } SEAM(1);
    if (IN(2)) { phase2(p, lds); } SEAM(2);
    if (IN(3)) { phase3_gemms(p, lds); hgrn_pass1(p, lds, wave, lane); } SEAM(3);
    if (IN(4)) { hgrn_scan(p); phase4_qk(p, wave, lane); } SEAM(4);
    if (IN(5)) { phase5_attn(p, lds, wave, lane); hgrn_pass3(p, lds, wave, lane); } SEAM(5);
    if (IN(6)) { phase6_scale(p, wave, lane); } SEAM(6);
    if (IN(7)) { phase7(p, lds); } SEAM(7);
    if (IN(8)) { phase8(p, lds, wave, lane); } SEAM(8);
    if (IN(9)) { phase9(p, lds, wave, lane); } SEAM(9);
    if (IN(10)) { phase10(p, lds); } SEAM(10);
    if (IN(11)) { phase11(p, lds); } SEAM(11);
    if (IN(12)) { phase12(p, wave, lane); }
#undef IN
#undef SEAM
}
extern "C" void kernel_launch(void* const* d_in, const int* in_sizes, int n_in, void* d_out, int out_size, void* d_ws, size_t ws_size, hipStream_t stream) {
    static int grid = 0;
    if (grid == 0) {
        int dev = 0, cus = 0;
        if (hipGetDevice(&dev) != hipSuccess || hipDeviceGetAttribute(&cus, hipDeviceAttributeMultiprocessorCount, dev) != hipSuccess) { grid = -1; return; }
        if (hipFuncSetAttribute((const void*)k_mega, hipFuncAttributeMaxDynamicSharedMemorySize, LDS_BYTES) != hipSuccess) { fprintf(stderr, "kernel_launch: hipFuncSetAttribute failed\n"); grid = -1; return; }
        (void)hipGetLastError();
        grid = cus;
        if (n_in != 26 || ws_size < WS_END) { fprintf(stderr, "kernel_launch: unexpected inputs / workspace (%d, %zu)\n", n_in, ws_size); grid = -1; return; }
    }
    if (grid < 0) return;
    (void)hipMemsetAsync((char*)d_ws + WS_CTL, 0, CTL_ZERO_BYTES, stream);
    Params p{};
    for (int i = 0; i < 26; ++i) p.in[i] = (const float*)d_in[i];
    p.out = (float*)d_out; p.ws = (unsigned char*)d_ws; p.ph_lo = 0; p.ph_hi = 13;
    hipLaunchKernelGGL(k_mega, dim3(grid), dim3(NTHR), LDS_BYTES, stream, p);
}
```

```cpp
#define DUP_MASK 0x0
#include <hip/hip_runtime.h>
#include <cstdio>
#include <cstdint>
constexpr int NB = 4, SEQ = 2048, DM = 2048, NT = NB * SEQ;
constexpr int INC = 4928, INCP = 5120;
constexpr int MH = 8, QR = 512, KVR = 256, QKD = 192, VD = 128;
constexpr int NE = 64, DE = 512;
constexpr float EPS = 1e-6f;
constexpr int MODW = 6 * DM;
constexpr int NWAVES = 8, NTHR = 512;
constexpr int PROWS = 90112;
constexpr int ROUTED_ROWS_MAX = 81920;

constexpr size_t MiB = 1u << 20;
constexpr size_t WS_CTL = 0, CTL_ZERO_BYTES = 1 * MiB;
constexpr int CW_BAR = 1024;
constexpr size_t CTL_MOD = 64 * 1024;
constexpr size_t WS_MODP = 4 * MiB;
constexpr size_t TAB_SSQ_Q8 = 7 * MiB, TAB_SSQ_KV4 = 7 * MiB + 256 * 1024, TAB_SSQ_O8 = 7 * MiB + 512 * 1024;
constexpr size_t CTL_HIST = 416 * 1024;
constexpr size_t WS_TAB = 1 * MiB;
constexpr size_t TAB_HGD = WS_TAB;
constexpr size_t TAB_TOPI = WS_TAB + 1 * MiB;
constexpr size_t TAB_TOPW = TAB_TOPI + 256 * 1024;
constexpr size_t TAB_SLOT = TAB_TOPW + 256 * 1024;
constexpr size_t TAB_ROWTOK = TAB_SLOT + 256 * 1024;
constexpr size_t TAB_TILEEXP = TAB_ROWTOK + 512 * 1024;
constexpr size_t WS_BT_IN = 8 * MiB, WS_BT_UQ = 28 * MiB, WS_BT_KV = 30 * MiB, WS_BT_OUT = 32 * MiB, WS_BT_GU = 40 * MiB, WS_BT_DN = 300 * MiB;
constexpr size_t WS_U16 = 430 * MiB, WS_H1 = 462 * MiB, WS_HID = 526 * MiB, WS_X = 614 * MiB;
constexpr size_t WS_PROJ = WS_X, WS_QRAW = WS_X + 80 * MiB, WS_KRAW = WS_X + 104 * MiB, WS_VT = WS_X + 120 * MiB, WS_Q16 = WS_X + 136 * MiB, WS_K16 = WS_X + 160 * MiB,
                 WS_HGU = WS_X + 184 * MiB, WS_MERGED = WS_X + 216 * MiB, WS_Y = WS_X, WS_END = 966 * MiB;

constexpr int RING_BYTES = 131072, LDS_BYTES = 163840, MISC_OFF = LDS_BYTES - 256;

#define GAS __attribute__((address_space(1)))
#define LAS __attribute__((address_space(3)))
typedef unsigned short bf16_t;
typedef unsigned v4u __attribute__((ext_vector_type(4)));
typedef unsigned v2u __attribute__((ext_vector_type(2)));
typedef float f32x4 __attribute__((ext_vector_type(4)));
typedef GAS unsigned gu32;
#define RLX_AGENT __ATOMIC_RELAXED, __HIP_MEMORY_SCOPE_AGENT
__device__ __forceinline__ unsigned f2bf(float f) { unsigned u = __builtin_bit_cast(unsigned, f); return (u + 0x7fffu + ((u >> 16) & 1u)) >> 16; }
__device__ __forceinline__ unsigned pk2(float lo, float hi) { unsigned r; asm volatile("v_cvt_pk_bf16_f32 %0, %1, %2" : "=v"(r) : "v"(lo), "v"(hi)); return r; }
__device__ __forceinline__ float bf2f(unsigned short b) { return __builtin_bit_cast(float, ((unsigned)b) << 16); }
__device__ __forceinline__ float bflo(unsigned w) { return __builtin_bit_cast(float, w << 16); }
__device__ __forceinline__ float bfhi(unsigned w) { return __builtin_bit_cast(float, w & 0xffff0000u); }
__device__ __forceinline__ float sigmoidf_(float x) { return 1.f / (1.f + __expf(-x)); }
__device__ __forceinline__ float siluf_(float x) { return x / (1.f + __expf(-x)); }
__device__ __forceinline__ float wave_sum(float v) {
#pragma unroll
    for (int o = 1; o < 64; o <<= 1) v += __shfl_xor(v, o);
    return v;
}

#define XB_TMO      128
#define XB_XCNT(j)  (256  + 64 * (j))
#define XB_XSUB(j)  (1280 + 64 * (j))
#define XB_XGEN(j)  (2304 + 64 * (j))
#define XB_TOP      3328
#define XB_TOPGEN   3392
#define XCD_BAR_WORDS 3456
#define XB_SPIN_CAP (1u << 18)
__device__ __forceinline__ unsigned xb_ld(unsigned* p)              { return __hip_atomic_load(p, __ATOMIC_RELAXED, __HIP_MEMORY_SCOPE_AGENT); }
__device__ __forceinline__ unsigned xb_add(unsigned* p, unsigned v) { return __hip_atomic_fetch_add(p, v, __ATOMIC_RELAXED, __HIP_MEMORY_SCOPE_AGENT); }
__device__ __forceinline__ unsigned xb_xcc_id() { return (unsigned)__builtin_amdgcn_s_getreg((3 << 11) | 20) & 0xFu; }
#define XB_SPIN(cond, bar) do { unsigned _sp = 0; while (cond) { __builtin_amdgcn_s_sleep(1); \
    if ((++_sp & 255u) == 0u) { if (xb_ld(&(bar)[XB_TMO])) break; if (_sp > XB_SPIN_CAP) { atomicAdd(&(bar)[XB_TMO], 1u); break; } } } } while (0)
struct XcdBarrier { unsigned* bar; unsigned x; volatile LAS unsigned* st; };
__device__ __forceinline__ XcdBarrier xcd_barrier_post(unsigned* bar, volatile LAS unsigned* st) {
    XcdBarrier b; b.bar = bar; b.x = xb_xcc_id(); b.st = st;
    if (threadIdx.x == 0) (void)xb_add(&bar[XB_XCNT(b.x)], 1u);
    return b;
}
__device__ __forceinline__ void xcd_barrier_complete(unsigned* bar, unsigned x, unsigned& nloc, unsigned& nx) {
    const unsigned G = gridDim.x * gridDim.y * gridDim.z;
    unsigned sum, cnt, mine, sp = 0u;
    for (;;) {
        sum = 0u; cnt = 0u; mine = 0u;
#pragma unroll
        for (unsigned j = 0; j < 16; ++j) { const unsigned c = xb_ld(&bar[XB_XCNT(j)]); sum += c; cnt += (c > 0u) ? 1u : 0u; mine = (j == x) ? c : mine; }
        if (sum == G) break;
        __builtin_amdgcn_s_sleep(1);
        if ((++sp & 255u) == 0u) { if (xb_ld(&bar[XB_TMO])) break; if (sp > XB_SPIN_CAP) { atomicAdd(&bar[XB_TMO], 1u); break; } }
    }
    nloc = mine > 0u ? mine : 1u; nx = cnt > 0u ? cnt : 1u;
}
__device__ __forceinline__ void xcd_barrier(const XcdBarrier& b) {
    asm volatile("s_waitcnt vmcnt(0)" ::: "memory");
    __syncthreads();
    if (threadIdx.x == 0) {
        unsigned* bar = b.bar;
        __builtin_amdgcn_s_waitcnt(0);
        unsigned nloc = b.st[0], nx = b.st[1];
        if (nloc == 0u) { xcd_barrier_complete(bar, b.x, nloc, nx); b.st[0] = nloc; b.st[1] = nx; }
        const unsigned old = xb_add(&bar[XB_XSUB(b.x)], 1u);
        const unsigned gen = old / nloc;
        if (old + 1u == (gen + 1u) * nloc) {
            __builtin_amdgcn_fence(__ATOMIC_RELEASE, "agent");
            asm volatile("s_waitcnt vmcnt(0)" ::: "memory");
            const unsigned og = xb_add(&bar[XB_TOP], 1u);
            const unsigned tg = og / nx;
            if (og + 1u == (tg + 1u) * nx) xb_add(&bar[XB_TOPGEN], 1u);
            else XB_SPIN(xb_ld(&bar[XB_TOPGEN]) == tg, bar);
            __builtin_amdgcn_fence(__ATOMIC_ACQUIRE, "agent");
            xb_add(&bar[XB_XGEN(b.x)], 1u);
            asm volatile("s_waitcnt vmcnt(0)" ::: "memory");
        } else {
            XB_SPIN(xb_ld(&bar[XB_XGEN(b.x)]) == gen, bar);
            __builtin_amdgcn_fence(__ATOMIC_ACQUIRE, "agent");
            asm volatile("s_waitcnt vmcnt(0)" ::: "memory");
        }
    }
    __syncthreads();
}

struct Params { const float* in[26]; float* out; unsigned char* ws; int ph_lo, ph_hi; };
namespace pg8 {
#define PG8_LAS __attribute__((address_space(3)))
typedef unsigned short bf16_t;
typedef short bf16x8 __attribute__((ext_vector_type(8)));
typedef float f32x4 __attribute__((ext_vector_type(4)));
typedef unsigned u32x4 __attribute__((ext_vector_type(4)));
typedef unsigned u32x2 __attribute__((ext_vector_type(2)));
constexpr int BM = 256, BK = 64, HALF = 128, HTB = HALF * BK * 2, STAGE_BYTES = 8 * HTB, NXCD = 8, WGM = 8;

__host__ __device__ __forceinline__ int lds_byte(int r, int c) { const int st = (r >> 4) * 2 + (c >> 5), rr = r & 15, cc = c & 31, ob = rr * 64 + cc * 2; return st * 1024 + (ob ^ (((ob >> 9) & 1) << 5)); }
__host__ __device__ __forceinline__ void stage_rc(int b, int& R, int& C) { const int st = b / 1024, sb = b % 1024, swz = sb ^ (((sb >> 9) & 1) << 5); R = (st >> 1) * 16 + swz / 64; C = (st & 1) * 32 + (swz % 64) / 2; }
__host__ __device__ __forceinline__ int perm32(int rho) { const int n = rho >> 4, i = rho & 15; return 8 * (i >> 2) + 4 * n + (i & 3); }

struct Unit { int pm, pn; long boff; };
struct Gemm { const bf16_t* A; const bf16_t* Bt; const int* rowtab; int lda, ldb, K, pad; };

__device__ __forceinline__ unsigned cvt_pk_bf16(float lo, float hi) { unsigned r; asm volatile("v_cvt_pk_bf16_f32 %0, %1, %2" : "=v"(r) : "v"(lo), "v"(hi)); return r; }

struct StaticOrder {
    int nM, nN, nwg, G, c; long bstep;
    __device__ void init(int nM_, int nN_, int G_, int c_, int ldb) { nM = nM_; nN = nN_; nwg = nM * nN; G = G_; c = c_; bstep = (long)BM * ldb * 2; }
    __device__ bool next(int i, Unit& u) const {
        const long L = (long)i * G + c; if (L >= nwg) return false;
        int wgid = (int)L; { const int q = nwg / NXCD, r = nwg % NXCD, xcd = wgid % NXCD, off = wgid / NXCD; wgid = (xcd < r ? xcd * (q + 1) : r * (q + 1) + (xcd - r) * q) + off; }
        const int nig = WGM * nN, gid = wgid / nig, fm = gid * WGM, gsz = (nM - fm) < WGM ? (nM - fm) : WGM;
        u.pm = fm + ((wgid % nig) % gsz); u.pn = (wgid % nig) / gsz; u.boff = (long)u.pn * bstep; return true;
    }
};

template <class Epi, class Sched>
__device__ __forceinline__ void gemm_phase(PG8_LAS unsigned char* lds, const Gemm g, const Sched& S, const Epi& E) {
    const int tid = threadIdx.x, wid = __builtin_amdgcn_readfirstlane(tid >> 6), lane = tid & 63, wr = wid >> 2, wc = wid & 3, fr = lane & 15, fq = lane >> 4;
    const int K = g.K, nt = K / BK;
    int Rr[2]; unsigned Cb[2], voffB[2];
#pragma unroll
    for (int i = 0; i < 2; ++i) { int R, C; stage_rc(tid * 16 + i * 8192, R, C); const int Rb = Epi::PERM ? ((R & ~31) + perm32(R & 31)) : R;
        Rr[i] = R; Cb[i] = (unsigned)C * 2u; voffB[i] = (unsigned)(Rb * g.ldb + C) * 2u; }
    const size_t kstep = (size_t)(BK * 2);
    const size_t hstepB = (size_t)HALF * g.ldb * 2;
    const unsigned lda2 = (unsigned)g.lda * 2u;
    const unsigned ldsw = (unsigned)wid * 1024u;
    const int aoff = lds_byte(wr * 64 + fr, fq * 8), boff = lds_byte(wc * 32 + fr, fq * 8);
    const char* const Abase = (const char*)g.A; const char* const Bbase = (const char*)g.Bt;
#define PG8_SA(b, h) (((b) * 2 + (h)) * HTB)
#define PG8_SB(b, h) ((4 + (b) * 2 + (h)) * HTB)
#define PG8_STAGE(bufoff, gbase, voff) do { _Pragma("unroll") for (int _i = 0; _i < 2; ++_i) \
        __builtin_amdgcn_global_load_lds((const unsigned*)((const char*)(gbase) + (voff)[_i]), (PG8_LAS unsigned*)(lds + (bufoff) + ldsw + _i * 8192), 16, 0, 0); } while (0)
#define PG8_VOFFA(u, v) do { _Pragma("unroll") for (int _h = 0; _h < 2; ++_h) _Pragma("unroll") for (int _i = 0; _i < 2; ++_i) { const int _gr = (u).pm * BM + _h * HALF + Rr[_i]; \
        const int _src = g.rowtab ? g.rowtab[_gr] : _gr; (v)[_h][_i] = (unsigned)_src * lda2 + Cb[_i]; } } while (0)
#define PG8_LDA(dst, b, h) do { _Pragma("unroll") for (int m = 0; m < 4; ++m) _Pragma("unroll") for (int k = 0; k < 2; ++k) dst[m][k] = *(const PG8_LAS bf16x8*)(lds + PG8_SA(b, h) + aoff + m * 2048 + k * 1024); } while (0)
#define PG8_LDB(dst, b, h) do { _Pragma("unroll") for (int n = 0; n < 2; ++n) _Pragma("unroll") for (int k = 0; k < 2; ++k) dst[n][k] = *(const PG8_LAS bf16x8*)(lds + PG8_SB(b, h) + boff + n * 2048 + k * 1024); } while (0)
#define PG8_MMA(ai, bj, At, Bt) do { __builtin_amdgcn_s_setprio(1); _Pragma("unroll") for (int m = 0; m < 4; ++m) _Pragma("unroll") for (int n = 0; n < 2; ++n) _Pragma("unroll") for (int k = 0; k < 2; ++k) \
        acc[ai][bj][m][n] = __builtin_amdgcn_mfma_f32_16x16x32_bf16(Bt[n][k], At[m][k], acc[ai][bj][m][n], 0, 0, 0); __builtin_amdgcn_s_setprio(0); } while (0)
#define PG8_WAIT_V(n) asm volatile("s_waitcnt vmcnt(" #n ")" ::: "memory")
#define PG8_WAIT_L(n) asm volatile("s_waitcnt lgkmcnt(" #n ")" ::: "memory")
#define PG8_BAR __builtin_amdgcn_s_barrier()
#define PG8_SCHED __builtin_amdgcn_sched_barrier(0)
    Unit cur, nxt; int ui = 0;
    if (!S.next(0, cur)) return;
    f32x4 acc[2][2][4][2];
#pragma unroll
    for (int a = 0; a < 2; ++a)
#pragma unroll
        for (int b = 0; b < 2; ++b)
#pragma unroll
            for (int m = 0; m < 4; ++m)
#pragma unroll
                for (int n = 0; n < 2; ++n) acc[a][b][m][n] = (f32x4){0.f, 0.f, 0.f, 0.f};
    bf16x8 At[4][2], B0[2][2], B1[2][2];
    unsigned cv[2][2], nv[2][2];
    PG8_VOFFA(cur, cv);
#pragma unroll
    for (int h = 0; h < 2; ++h) { nv[h][0] = cv[h][0]; nv[h][1] = cv[h][1]; }
    const char* cB = Bbase + cur.boff;
    PG8_STAGE(PG8_SB(0, 0), cB, voffB); PG8_STAGE(PG8_SB(0, 1), cB + hstepB, voffB); PG8_STAGE(PG8_SA(0, 0), Abase, cv[0]); PG8_STAGE(PG8_SA(0, 1), Abase, cv[1]);
    if (wr == 1) PG8_BAR;
    PG8_WAIT_V(2); PG8_BAR;
    PG8_STAGE(PG8_SB(1, 0), cB + kstep, voffB); PG8_STAGE(PG8_SA(1, 0), Abase + kstep, cv[0]); PG8_STAGE(PG8_SB(1, 1), cB + hstepB + kstep, voffB);
    PG8_WAIT_V(6); PG8_BAR;
    for (;;) {
        const bool has_next = S.next(ui + 1, nxt);
        const char* nB = has_next ? Bbase + nxt.boff : cB;
#pragma unroll 1
        for (int t = 0; t < nt; t += 2) {
            const bool last = (t == nt - 2);
            if (last && has_next) { PG8_VOFFA(nxt, nv); }
            const char* a1 = Abase + (size_t)(t + 1) * kstep;
            const char* a2 = Abase + (last ? (size_t)0 : (size_t)(t + 2) * kstep); const char* a3 = a2 + kstep;
            const char* b2 = last ? nB : cB + (size_t)(t + 2) * kstep; const char* b3 = b2 + kstep;
            unsigned x0[2], x1[2];
            x0[0] = last ? nv[0][0] : cv[0][0]; x0[1] = last ? nv[0][1] : cv[0][1]; x1[0] = last ? nv[1][0] : cv[1][0]; x1[1] = last ? nv[1][1] : cv[1][1];
            PG8_LDB(B0, 0, 0); PG8_LDB(B1, 0, 1); PG8_SCHED; PG8_LDA(At, 0, 0); PG8_STAGE(PG8_SA(1, 1), a1, cv[1]);
            PG8_WAIT_V(8); PG8_WAIT_L(0); PG8_BAR; PG8_MMA(0, 0, At, B0); PG8_MMA(0, 1, At, B1); PG8_BAR; PG8_SCHED;
            PG8_LDA(At, 0, 1); PG8_STAGE(PG8_SB(0, 0), b2, voffB); PG8_STAGE(PG8_SB(0, 1), b2 + hstepB, voffB); PG8_STAGE(PG8_SA(0, 0), a2, x0);
            PG8_WAIT_V(8); PG8_WAIT_L(0); PG8_BAR; PG8_MMA(1, 0, At, B0); PG8_MMA(1, 1, At, B1); PG8_BAR; PG8_SCHED;
            PG8_LDB(B0, 1, 0); PG8_LDB(B1, 1, 1); PG8_SCHED; PG8_LDA(At, 1, 0); PG8_STAGE(PG8_SA(0, 1), a2, x1);
            PG8_WAIT_V(8); PG8_WAIT_L(0); PG8_BAR; PG8_MMA(0, 0, At, B0); PG8_MMA(0, 1, At, B1); PG8_BAR; PG8_SCHED;
            PG8_LDA(At, 1, 1); PG8_STAGE(PG8_SB(1, 0), b3, voffB); PG8_STAGE(PG8_SB(1, 1), b3 + hstepB, voffB); PG8_STAGE(PG8_SA(1, 0), a3, x0);
            PG8_WAIT_V(8); PG8_WAIT_L(0); PG8_BAR; PG8_MMA(1, 0, At, B0); PG8_MMA(1, 1, At, B1); PG8_BAR; PG8_SCHED;
        }
        if (wr == 0) PG8_BAR;
        E(acc, cur, wr, wc, fr, fq);
        if (!has_next) break;
#pragma unroll
        for (int a = 0; a < 2; ++a)
#pragma unroll
            for (int b = 0; b < 2; ++b)
#pragma unroll
                for (int m = 0; m < 4; ++m)
#pragma unroll
                    for (int n = 0; n < 2; ++n) acc[a][b][m][n] = (f32x4){0.f, 0.f, 0.f, 0.f};
        cur = nxt; cB = nB; ++ui;
#pragma unroll
        for (int h = 0; h < 2; ++h) { cv[h][0] = nv[h][0]; cv[h][1] = nv[h][1]; }
        if (wr == 1) PG8_BAR;
    }
    PG8_WAIT_V(0);
    PG8_BAR;
#undef PG8_SA
#undef PG8_SB
#undef PG8_STAGE
#undef PG8_VOFFA
#undef PG8_LDA
#undef PG8_LDB
#undef PG8_MMA
#undef PG8_WAIT_V
#undef PG8_WAIT_L
#undef PG8_BAR
#undef PG8_SCHED
}
}
__device__ __forceinline__ void conv_tile(const float* __restrict__ src, int ldn, int k0, int n0, const float* __restrict__ kscale, int kfrom,
                                          bf16_t* __restrict__ dst, int dld, int drow0, LAS unsigned* T, int lane) {
    const int c4 = lane & 15, kq = lane >> 4;
    f32x4 v0[8], v1[8];
#pragma unroll
    for (int j = 0; j < 8; ++j) { const int kp = kq + 4 * j; const float* p = src + (size_t)(k0 + 2 * kp) * ldn + n0 + c4 * 4;
        v0[j] = *(const f32x4*)p; v1[j] = *(const f32x4*)(p + ldn); }
#pragma unroll
    for (int j = 0; j < 8; ++j) { const int kp = kq + 4 * j; const int k = k0 + 2 * kp;
        float s0 = 1.f, s1 = 1.f; if (kscale && k >= kfrom) { s0 = kscale[k - kfrom]; s1 = kscale[k + 1 - kfrom]; }
#pragma unroll
        for (int q = 0; q < 4; ++q) T[(c4 * 4 + q) * 33 + kp] = pk2(v0[j][q] * s0, v1[j][q] * s1); }
    asm volatile("s_waitcnt lgkmcnt(0)" ::: "memory"); __builtin_amdgcn_wave_barrier();
    const int ch = lane & 7, nr = lane >> 3;
#pragma unroll
    for (int ps = 0; ps < 8; ++ps) { const int n = ps * 8 + nr; const LAS unsigned* t = T + n * 33 + ch * 4;
        v4u o; o.x = t[0]; o.y = t[1]; o.z = t[2]; o.w = t[3];
        *(v4u*)(dst + (size_t)(drow0 + n) * dld + k0 + ch * 8) = o; }
    asm volatile("s_waitcnt lgkmcnt(0)" ::: "memory"); __builtin_amdgcn_wave_barrier();
}

__device__ __forceinline__ void conv_tile128(const float* __restrict__ src, int ldn, int k0, int n0, bf16_t* __restrict__ dst, int dld, int drow0, LAS unsigned* T, int lane) {
    const int c4 = lane & 15, kq = lane >> 4;
    f32x4 v0[16], v1[16];
#pragma unroll
    for (int j = 0; j < 16; ++j) { const int kp = kq + 4 * j; const float* q = src + (size_t)(k0 + 2 * kp) * ldn + n0 + c4 * 4;
        v0[j] = __builtin_nontemporal_load((const f32x4*)q); v1[j] = __builtin_nontemporal_load((const f32x4*)(q + ldn)); }
#pragma unroll
    for (int j = 0; j < 16; ++j) { const int kp = kq + 4 * j;
#pragma unroll
        for (int q = 0; q < 4; ++q) T[(c4 * 4 + q) * 65 + kp] = pk2(v0[j][q], v1[j][q]); }
    asm volatile("s_waitcnt lgkmcnt(0)" ::: "memory"); __builtin_amdgcn_wave_barrier();
    const int ch = lane & 15, nr = lane >> 4;
#pragma unroll
    for (int ps = 0; ps < 16; ++ps) { const int n = ps * 4 + nr; const LAS unsigned* t = T + n * 65 + ch * 4;
        v4u o; o.x = t[0]; o.y = t[1]; o.z = t[2]; o.w = t[3];
        *(v4u*)(dst + (size_t)(drow0 + n) * dld + k0 + ch * 8) = o; }
    asm volatile("s_waitcnt lgkmcnt(0)" ::: "memory"); __builtin_amdgcn_wave_barrier();
}

__device__ __forceinline__ void ada_item(const float* __restrict__ c, const float* __restrict__ w, float* __restrict__ modp, int item, int lane) {
    const int cc = item % 48, ks = item / 48, col = cc * 256 + lane * 4;
    f32x4 acc[4];
#pragma unroll
    for (int b = 0; b < 4; ++b) acc[b] = (f32x4){0.f, 0.f, 0.f, 0.f};
#pragma unroll 1
    for (int half = 0; half < 2; ++half) {
        const int k0 = ks * 128 + half * 64;
        float cd[4];
#pragma unroll
        for (int b = 0; b < 4; ++b) cd[b] = siluf_(c[b * DM + k0 + lane]);
        const float* wp = w + (size_t)k0 * MODW + col;
#pragma unroll 8
        for (int kk = 0; kk < 64; ++kk) { const f32x4 wv = *(const f32x4*)(wp + (size_t)kk * MODW);
#pragma unroll
            for (int b = 0; b < 4; ++b) { const float s = __builtin_bit_cast(float, __builtin_amdgcn_readlane(__builtin_bit_cast(int, cd[b]), kk)); acc[b] += wv * s; } }
    }
#pragma unroll
    for (int b = 0; b < 4; ++b) *(f32x4*)(modp + ((size_t)ks * 4 + b) * MODW + col) = acc[b];
}

constexpr int CT_ADA = 48 * 16;
constexpr int CT_IN = 32 * 77, CT_UQ = 8 * 24, CT_KV = 4 * 32, CT_OUT = 32 * 32, CT_G1 = 16 * 8, CT_D1 = 4 * 32;
constexpr int CT_ZERO = 192 * 4;
constexpr int CT_GU = 65 * 2 * CT_G1, CT_DN = 65 * CT_D1;
constexpr int CT_GU_LATE = 0;
constexpr int CT_TOTAL0 = CT_ADA + CT_IN + CT_UQ + CT_KV + CT_OUT + CT_ZERO + (CT_GU - CT_GU_LATE) + CT_DN;
constexpr int CW_QGU = 8192, CW_QDN = 8192 + 512;

__device__ __forceinline__ void conv_gu_tile(const Params& p, int r, LAS unsigned* T, int lane) {
    const int e = r / (2 * CT_G1); int q = r % (2 * CT_G1);
    bf16_t* gu = (bf16_t*)(p.ws + WS_BT_GU) + (size_t)e * 1024 * DM;
    const int up = q >= CT_G1; q -= up * CT_G1; const int kb = q / 8, nb = q % 8, n0 = nb * 64;
    const float* src = (e < 64) ? p.in[up ? 21 : 20] + (size_t)e * DM * DE : p.in[up ? 24 : 23];
    conv_tile128(src, DE, kb * 128, n0, gu, DM, (n0 >> 7) * 256 + up * 128 + (n0 & 127), T, lane);
}
__device__ __forceinline__ void conv_dn_tile(const Params& p, int r, LAS unsigned* T, int lane) {
    const int e = r / CT_D1, q = r % CT_D1, kb = q / 32, nb = q % 32;
    bf16_t* dn = (bf16_t*)(p.ws + WS_BT_DN) + (size_t)e * DM * DE;
    const float* src = (e < 64) ? p.in[22] + (size_t)e * DE * DM : p.in[25];
    conv_tile128(src, DM, kb * 128, nb * 64, dn, DE, nb * 64, T, lane);
}
template <bool DN>
__device__ __forceinline__ void conv_queue(const Params& p, LAS unsigned char* lds, int wave, int lane, int first, int total) {
    LAS unsigned* T = (LAS unsigned*)(lds + wave * 18432);
    unsigned* heads = (unsigned*)(p.ws + WS_CTL) + (DN ? CW_QDN : CW_QGU);
    const int n = total - first, per = (n + 7) / 8, xcd = (int)xb_xcc_id() & 7;
    for (int s = 0; s < 8; ++s) {
        const int sh = (xcd + s) & 7, lo = first + sh * per, hi = (lo + per < total) ? lo + per : total;
        for (;;) {
            unsigned i = 0; if (lane == 0) i = __hip_atomic_fetch_add(heads + 64 * sh, 2u, __ATOMIC_RELAXED, __HIP_MEMORY_SCOPE_AGENT);
            const int r = lo + (int)__builtin_amdgcn_readfirstlane(i);
            if (r >= hi) break;
            if (DN) conv_dn_tile(p, r, T, lane); else conv_gu_tile(p, r, T, lane);
            if (r + 1 < hi) { if (DN) conv_dn_tile(p, r + 1, T, lane); else conv_gu_tile(p, r + 1, T, lane); }
        }
    }
}

__device__ __forceinline__ void phase0(const Params& p, LAS unsigned char* lds, int wave, int lane) {
    LAS unsigned* T = (LAS unsigned*)(lds + wave * 18432);
    unsigned char* ws = p.ws;
    float* modp = (float*)(ws + WS_MODP);
    const int gw = blockIdx.x * NWAVES + wave, NGW = gridDim.x * NWAVES;
    for (int it = gw; it < CT_TOTAL0; it += NGW) {
        int r = it;
        if (r < CT_ADA) { ada_item(p.in[1], p.in[3], modp, r, lane); continue; } r -= CT_ADA;
        if (r < CT_IN) { const int kb = r / 77, nb = r % 77; conv_tile(p.in[7], INC, kb * 64, nb * 64, nullptr, 0, (bf16_t*)(ws + WS_BT_IN), DM, nb * 64, T, lane); continue; } r -= CT_IN;
        if (r < CT_UQ) { const int kb = r / 24, nb = r % 24; conv_tile(p.in[11], 1536, kb * 64, nb * 64, p.in[10], 0, (bf16_t*)(ws + WS_BT_UQ), QR, nb * 64, T, lane); continue; } r -= CT_UQ;
        if (r < CT_KV) { const int kb = r / 32, nb = r % 32, n0 = nb * 64, h = n0 >> 8, j0 = n0 & 255; const int dr = (j0 < 128) ? h * 128 + j0 : 1024 + h * 128 + (j0 - 128);
                         conv_tile(p.in[13], 2048, kb * 64, n0, p.in[12], 0, (bf16_t*)(ws + WS_BT_KV), KVR, dr, T, lane); continue; } r -= CT_KV;
        if (r < CT_OUT) { const int kb = r / 32, nb = r % 32; conv_tile(p.in[17], DM, kb * 64, nb * 64, p.in[16], 1024, (bf16_t*)(ws + WS_BT_OUT), DM, nb * 64, T, lane); continue; } r -= CT_OUT;
        if (r < CT_ZERO) { const int row = INC + (r >> 2), pc = r & 3; v4u z = {0u, 0u, 0u, 0u}; *(v4u*)((bf16_t*)(ws + WS_BT_IN) + (size_t)row * DM + pc * 512 + lane * 8) = z; continue; } r -= CT_ZERO;
        if (r < CT_GU - CT_GU_LATE) { conv_gu_tile(p, r, T, lane); continue; } r -= CT_GU - CT_GU_LATE;
        conv_dn_tile(p, r, T, lane);
    }
}

__device__ __forceinline__ void norm_mod_row(const float* __restrict__ hrow, const float* __restrict__ g, const float* __restrict__ sc, const float* __restrict__ sh, bf16_t* __restrict__ urow, int lane) {
    f32x4 v[8]; float s = 0.f;
#pragma unroll
    for (int j = 0; j < 8; ++j) { v[j] = *(const f32x4*)(hrow + lane * 4 + 256 * j); s += (v[j].x * v[j].x + v[j].y * v[j].y) + (v[j].z * v[j].z + v[j].w * v[j].w); }
    const float r = rsqrtf(wave_sum(s) * (1.f / DM) + EPS);
#pragma unroll
    for (int j = 0; j < 8; ++j) { const int col = lane * 4 + 256 * j; const f32x4 gv = *(const f32x4*)(g + col), sv = *(const f32x4*)(sc + col), hv = *(const f32x4*)(sh + col);
        const f32x4 o = v[j] * r * gv * (sv + 1.f) + hv; v2u w; w.x = pk2(o.x, o.y); w.y = pk2(o.z, o.w); *(v2u*)(urow + col) = w; }
}
__device__ __forceinline__ float mod_reduce(const float* __restrict__ modp, const float* __restrict__ bias, int v) {
    float s = bias[v % MODW];
#pragma unroll
    for (int ks = 0; ks < 16; ++ks) s += modp[(size_t)ks * 4 * MODW + v];
    return s;
}
__device__ __forceinline__ void phase1(const Params& p, LAS unsigned char* lds, int wave, int lane) {
    const float* modp = (const float*)(p.ws + WS_MODP); float* mod = (float*)(p.ws + CTL_MOD); bf16_t* u16 = (bf16_t*)(p.ws + WS_U16);
    LAS float* sm = (LAS float*)lds;
    const int G = gridDim.x;
    for (int v = blockIdx.x * NTHR + threadIdx.x; v < NB * MODW; v += G * NTHR) mod[v] = mod_reduce(modp, p.in[4], v);
    for (int tb = blockIdx.x; tb < NT / 32; tb += G) {
        const int b = (tb * 32) / SEQ;
        __syncthreads();
        for (int i = threadIdx.x; i < 2 * DM; i += NTHR) sm[i] = mod_reduce(modp, p.in[4], b * MODW + i);
        __syncthreads();
#pragma unroll 1
        for (int rr = 0; rr < 4; ++rr) { const int t = tb * 32 + wave * 4 + rr;
            const float* hrow = p.in[0] + (size_t)t * DM; const float* g = p.in[5];
            f32x4 v[8]; float s = 0.f;
#pragma unroll
            for (int j = 0; j < 8; ++j) { v[j] = *(const f32x4*)(hrow + lane * 4 + 256 * j); s += (v[j].x * v[j].x + v[j].y * v[j].y) + (v[j].z * v[j].z + v[j].w * v[j].w); }
            const float r = rsqrtf(wave_sum(s) * (1.f / DM) + EPS);
#pragma unroll
            for (int j = 0; j < 8; ++j) { const int col = lane * 4 + 256 * j; const f32x4 gv = *(const f32x4*)(g + col);
                const f32x4 hv = *(const LAS f32x4*)(sm + col), sv = *(const LAS f32x4*)(sm + DM + col);
                const f32x4 o = v[j] * r * gv * (sv + 1.f) + hv; v2u w; w.x = pk2(o.x, o.y); w.y = pk2(o.z, o.w); *(v2u*)(u16 + (size_t)t * DM + col) = w; }
        }
    }
}

struct EpiInProj { static constexpr bool PERM = true; bf16_t* O; float* ssq_q8; float* ssq_kv4;
    __device__ __forceinline__ void operator()(const pg8::f32x4 (&acc)[2][2][4][2], const pg8::Unit& u, int wr, int wc, int fr, int fq) const {
        const int row0 = u.pm * 256 + wr * 64 + fr, col0 = u.pn * 256 + wc * 32 + 8 * fq;
        const bool sq = (u.pn >= 16 && u.pn <= 18);
#pragma unroll
        for (int ai = 0; ai < 2; ++ai)
#pragma unroll
            for (int m = 0; m < 4; ++m) { const int row = row0 + ai * 128 + m * 16; bf16_t* rowp = O + (size_t)row * INCP + col0; float ss = 0.f;
#pragma unroll
                for (int bj = 0; bj < 2; ++bj) { const pg8::f32x4 v0 = acc[ai][bj][m][0], v1 = acc[ai][bj][m][1];
                    v4u w; w.x = pk2(v0[0], v0[1]); w.y = pk2(v0[2], v0[3]); w.z = pk2(v1[0], v1[1]); w.w = pk2(v1[2], v1[3]);
                    *(v4u*)(rowp + bj * 128) = w;
                    ss += (v0[0] * v0[0] + v0[1] * v0[1]) + (v0[2] * v0[2] + v0[3] * v0[3]) + (v1[0] * v1[0] + v1[1] * v1[1]) + (v1[2] * v1[2] + v1[3] * v1[3]); }
                if (sq) { ss += __shfl_xor(ss, 16); ss += __shfl_xor(ss, 32);
                    if (fq == 0) { if (u.pn == 18) ssq_kv4[row * 4 + wc] = ss; else ssq_q8[row * 8 + (u.pn - 16) * 4 + wc] = ss; } } }
    }
};
__device__ __forceinline__ void phase2(const Params& p, LAS unsigned char* lds) {
    unsigned char* ws = p.ws;
    pg8::Gemm g{(const bf16_t*)(ws + WS_U16), (const bf16_t*)(ws + WS_BT_IN), nullptr, DM, DM, DM, 0};
    pg8::StaticOrder S; S.init(NT / 256, INCP / 256, gridDim.x, blockIdx.x, DM);
    EpiInProj E{(bf16_t*)(ws + WS_PROJ), (float*)(ws + TAB_SSQ_Q8), (float*)(ws + TAB_SSQ_KV4)};
    pg8::gemm_phase<EpiInProj, pg8::StaticOrder>((PG8_LAS unsigned char*)lds, g, S, E);
}
struct EpiBf16Store { static constexpr bool PERM = true; bf16_t* O; int ldc, pad;
    __device__ __forceinline__ void operator()(const pg8::f32x4 (&acc)[2][2][4][2], const pg8::Unit& u, int wr, int wc, int fr, int fq) const {
        const int row0 = u.pm * 256 + wr * 64 + fr, col0 = u.pn * 256 + wc * 32 + 8 * fq;
#pragma unroll
        for (int ai = 0; ai < 2; ++ai)
#pragma unroll
            for (int m = 0; m < 4; ++m) { bf16_t* rowp = O + (size_t)(row0 + ai * 128 + m * 16) * ldc + col0;
#pragma unroll
                for (int bj = 0; bj < 2; ++bj) { const pg8::f32x4 v0 = acc[ai][bj][m][0], v1 = acc[ai][bj][m][1];
                    v4u w; w.x = pk2(v0[0], v0[1]); w.y = pk2(v0[2], v0[3]); w.z = pk2(v1[0], v1[1]); w.w = pk2(v1[2], v1[3]); *(v4u*)(rowp + bj * 128) = w; } }
    }
};
struct EpiVt { static constexpr bool PERM = true; bf16_t* Vt; const float* ssq_kv4;
    __device__ __forceinline__ void operator()(const pg8::f32x4 (&acc)[2][2][4][2], const pg8::Unit& u, int wr, int wc, int fr, int fq) const {
        const int row0 = u.pm * 256 + wr * 64 + fr, col0 = u.pn * 256 + wc * 32 + 8 * fq;
        const int pb = (col0 & ~15) + 4 * (fq & 1);
#pragma unroll
        for (int bj = 0; bj < 2; ++bj) {
            float rs[8];
#pragma unroll
            for (int j = 0; j < 8; ++j) { const pg8::f32x4 s4 = *(const pg8::f32x4*)(ssq_kv4 + (size_t)(col0 + bj * 128 + j) * 4); rs[j] = rsqrtf(((s4[0] + s4[1]) + (s4[2] + s4[3])) * (1.f / KVR) + EPS); }
#pragma unroll
            for (int ai = 0; ai < 2; ++ai)
#pragma unroll
                for (int m = 0; m < 4; ++m) { bf16_t* rowp = Vt + (size_t)(row0 + ai * 128 + m * 16) * NT + pb + bj * 128;
                    const pg8::f32x4 v0 = acc[ai][bj][m][0], v1 = acc[ai][bj][m][1];
                    v2u a, b; a.x = pk2(v0[0] * rs[0], v0[1] * rs[1]); a.y = pk2(v0[2] * rs[2], v0[3] * rs[3]);
                    b.x = pk2(v1[0] * rs[4], v1[1] * rs[5]); b.y = pk2(v1[2] * rs[6], v1[3] * rs[7]);
                    *(v2u*)(rowp) = a; *(v2u*)(rowp + 8) = b; }
        }
    }
};
__device__ __forceinline__ void phase3_gemms(const Params& p, LAS unsigned char* lds) {
    unsigned char* ws = p.ws; const int G = gridDim.x, c = blockIdx.x;
    const bf16_t* proj = (const bf16_t*)(ws + WS_PROJ);
    { pg8::Gemm g{proj + 4096, (const bf16_t*)(ws + WS_BT_UQ), nullptr, INCP, QR, QR, 0};
      pg8::StaticOrder S; S.init(NT / 256, 6, G, c, QR); EpiBf16Store E{(bf16_t*)(ws + WS_QRAW), 1536, 0};
      pg8::gemm_phase<EpiBf16Store, pg8::StaticOrder>((PG8_LAS unsigned char*)lds, g, S, E); }
    { pg8::Gemm g{proj + 4608, (const bf16_t*)(ws + WS_BT_KV), nullptr, INCP, KVR, KVR, 0};
      pg8::StaticOrder S; S.init(NT / 256, 4, G, (c + 64) % G, KVR); EpiBf16Store E{(bf16_t*)(ws + WS_KRAW), 1024, 0};
      pg8::gemm_phase<EpiBf16Store, pg8::StaticOrder>((PG8_LAS unsigned char*)lds, g, S, E); }
    { pg8::Gemm g{(const bf16_t*)(ws + WS_BT_KV) + 1024 * KVR, proj + 4608, nullptr, KVR, INCP, KVR, 0};
      pg8::StaticOrder S; S.init(4, NT / 256, G, (c + 192) % G, INCP); EpiVt E{(bf16_t*)(ws + WS_VT), (const float*)(ws + TAB_SSQ_KV4)};
      pg8::gemm_phase<EpiVt, pg8::StaticOrder>((PG8_LAS unsigned char*)lds, g, S, E); }
}

constexpr float QSCALE = 0.07216878364870323f * 1.4426950408889634f;
__device__ __forceinline__ void phase4_qk(const Params& p, int wave, int lane) {
    unsigned char* ws = p.ws;
    const bf16_t* qraw = (const bf16_t*)(ws + WS_QRAW); const bf16_t* kraw = (const bf16_t*)(ws + WS_KRAW); const bf16_t* proj = (const bf16_t*)(ws + WS_PROJ);
    const float* ssq_q8 = (const float*)(ws + TAB_SSQ_Q8); const float* ssq_kv4 = (const float*)(ws + TAB_SSQ_KV4);
    const int* pos = (const int*)p.in[2]; const float* qg = p.in[14]; const float* kg = p.in[15];
    bf16_t* Q16 = (bf16_t*)(ws + WS_Q16); bf16_t* K16 = (bf16_t*)(ws + WS_K16);
    const float g0q = qg[lane], g1q = qg[64 + lane], g2q = qg[128 + lane], g0k = kg[lane], g1k = kg[64 + lane], g2k = kg[128 + lane];
    const int i = lane & 31; const float inv = exp2f(-(float)i * (13.287712379549449f / 32.f));
    const int gw = blockIdx.x * NWAVES + wave, NGW = gridDim.x * NWAVES;
    for (int it = gw; it < NT * MH; it += NGW) {
        const int t = it >> 3, h = it & 7, b = t / SEQ, s = t % SEQ;
        const pg8::f32x4 qa = *(const pg8::f32x4*)(ssq_q8 + (size_t)t * 8), qb = *(const pg8::f32x4*)(ssq_q8 + (size_t)t * 8 + 4), ka = *(const pg8::f32x4*)(ssq_kv4 + (size_t)t * 4);
        const float rq = rsqrtf((((qa[0] + qa[1]) + (qa[2] + qa[3])) + ((qb[0] + qb[1]) + (qb[2] + qb[3]))) * (1.f / QR) + EPS), rkv = rsqrtf(((ka[0] + ka[1]) + (ka[2] + ka[3])) * (1.f / KVR) + EPS);
        float q0 = bf2f(qraw[(size_t)t * 1536 + h * 192 + lane]) * rq, q1 = bf2f(qraw[(size_t)t * 1536 + h * 192 + 64 + lane]) * rq, q2 = bf2f(qraw[(size_t)t * 1536 + h * 192 + 128 + lane]) * rq;
        float k0 = bf2f(kraw[(size_t)t * 1024 + h * 128 + lane]) * rkv, k1 = bf2f(kraw[(size_t)t * 1024 + h * 128 + 64 + lane]) * rkv, k2 = bf2f(proj[(size_t)t * INCP + 4864 + lane]);
        const float sq = wave_sum(q0 * q0 + q1 * q1 + q2 * q2), sk = wave_sum(k0 * k0 + k1 * k1 + k2 * k2);
        const float nq = rsqrtf(sq * (1.f / 192.f) + EPS) * QSCALE, nk = rsqrtf(sk * (1.f / 192.f) + EPS);
        q0 *= nq * g0q; q1 *= nq * g1q; q2 *= nq * g2q; k0 *= nk * g0k; k1 *= nk * g1k; k2 *= nk * g2k;
        const float ang = (float)pos[t] * inv; const float rev = ang * 0.15915494309189535f; const float fr_ = rev - floorf(rev); const float sn = __builtin_amdgcn_sinf(fr_), cs = __builtin_amdgcn_cosf(fr_);
        const float q2o = __shfl_xor(q2, 32), k2o = __shfl_xor(k2, 32);
        const float q2r = lane < 32 ? q2 * cs - q2o * sn : q2 * cs + q2o * sn;
        const float k2r = lane < 32 ? k2 * cs - k2o * sn : k2 * cs + k2o * sn;
        const size_t base = ((size_t)(b * MH + h) * SEQ + s) * QKD;
        Q16[base + lane] = (bf16_t)f2bf(q0); Q16[base + 64 + lane] = (bf16_t)f2bf(q1); Q16[base + 128 + lane] = (bf16_t)f2bf(q2r);
        K16[base + lane] = (bf16_t)f2bf(k0); K16[base + 64 + lane] = (bf16_t)f2bf(k1); K16[base + 128 + lane] = (bf16_t)f2bf(k2r);
    }
}

typedef short bf16x8 __attribute__((ext_vector_type(8)));
typedef float f32x16 __attribute__((ext_vector_type(16)));
constexpr int AT_KP = 400, AT_VP = 144, AT_KB = 64 * AT_KP, AT_VB = 128 * AT_VP, AT_BUF = AT_KB + AT_VB;
__device__ __forceinline__ void phase5_attn(const Params& p, LAS unsigned char* lds, int wave, int lane) {
    unsigned char* ws = p.ws;
    const bf16_t* Q16 = (const bf16_t*)(ws + WS_Q16); const bf16_t* K16 = (const bf16_t*)(ws + WS_K16); const bf16_t* Vt = (const bf16_t*)(ws + WS_VT);
    bf16_t* merged = (bf16_t*)(ws + WS_MERGED); float* ssq_o8 = (float*)(ws + TAB_SSQ_O8);
    const int tid = threadIdx.x, cl = lane & 31, hh = lane >> 5, qsub = wave & 3, kpar = wave >> 2;
    float mq = 0.f, mk = 0.f;
    for (int i = 0; i < 3; ++i) { mq = fmaxf(mq, fabsf(p.in[14][lane + 64 * i])); mk = fmaxf(mk, fabsf(p.in[15][lane + 64 * i])); }
#pragma unroll
    for (int o = 1; o < 64; o <<= 1) { mq = fmaxf(mq, __shfl_xor(mq, o)); mk = fmaxf(mk, __shfl_xor(mk, o)); }
    const float negc0 = -(13.856406460551018f * 1.4426950408889634f * 1.02f) * mq * mk;
    int kso[3], vso[2]; size_t vgo[2];
#pragma unroll
    for (int i = 0; i < 3; ++i) { const int c = tid + 512 * i; kso[i] = (c / 24) * AT_KP + (c % 24) * 16; }
#pragma unroll
    for (int i = 0; i < 2; ++i) { const int c = tid + 512 * i, dv = c >> 3, ch = c & 7; vso[i] = AT_KB + dv * AT_VP + ch * 16; vgo[i] = (size_t)dv * NT * 2 + ch * 16; }
    for (int item = blockIdx.x; item < 256; item += gridDim.x) {
        const int bh = item >> 3, x = item & 7, b = bh >> 3, h = bh & 7;
        const char* Qg = (const char*)(Q16 + (size_t)bh * SEQ * QKD); const char* Kg = (const char*)(K16 + (size_t)bh * SEQ * QKD);
        const char* Vg = (const char*)(Vt + (size_t)(h * 128) * NT + b * SEQ);
#pragma unroll 1
        for (int pass = 0; pass < 2; ++pass) {
            const int qi = pass == 0 ? 15 - x : x, nsteps = 2 * (qi + 1), qrow0 = qi * 128 + qsub * 32;
            bf16x8 Qf[12];
#pragma unroll
            for (int ks = 0; ks < 12; ++ks) Qf[ks] = *(const bf16x8*)(Qg + ((size_t)(qrow0 + cl) * QKD + ks * 16 + hh * 8) * 2);
            f32x16 O[4];
#pragma unroll
            for (int vb = 0; vb < 4; ++vb)
#pragma unroll
                for (int r = 0; r < 16; ++r) O[vb][r] = 0.f;
            float lsum = 0.f;
            v4u kr[3], vr[2];
#define AT_LOAD(j) do { _Pragma("unroll") for (int i_ = 0; i_ < 3; ++i_) kr[i_] = *(const v4u*)(Kg + (size_t)(j) * 24576 + (size_t)(tid + 512 * i_) * 16); \
                        _Pragma("unroll") for (int i_ = 0; i_ < 2; ++i_) vr[i_] = *(const v4u*)(Vg + vgo[i_] + (size_t)(j) * 128); } while (0)
#define AT_WRITE(bo) do { _Pragma("unroll") for (int i_ = 0; i_ < 3; ++i_) *(LAS v4u*)(lds + (bo) + kso[i_]) = kr[i_]; \
                          _Pragma("unroll") for (int i_ = 0; i_ < 2; ++i_) *(LAS v4u*)(lds + (bo) + vso[i_]) = vr[i_]; } while (0)
            AT_LOAD(0); AT_WRITE(0); __syncthreads();
#pragma unroll 1
            for (int j = 0; j < nsteps; ++j) {
                const int bo = (j & 1) * AT_BUF;
                if (j + 1 < nsteps) AT_LOAD(j + 1);
                const int key0 = 64 * j + 32 * kpar;
                if (key0 <= qrow0 + 31) {
                    f32x16 S;
#pragma unroll
                    for (int r = 0; r < 16; ++r) S[r] = negc0;
                    const LAS unsigned char* kb = lds + bo + (32 * kpar + cl) * AT_KP + hh * 16;
#pragma unroll
                    for (int ks = 0; ks < 12; ++ks) { const bf16x8 a = *(const LAS bf16x8*)(kb + ks * 32); S = __builtin_amdgcn_mfma_f32_32x32x16_bf16(a, Qf[ks], S, 0, 0, 0); }
                    const bool diag = key0 + 31 > qrow0;
                    float pr[16];
#pragma unroll
                    for (int r = 0; r < 16; ++r) { float e = __builtin_amdgcn_exp2f(S[r]);
                        if (diag) { const int key = key0 + (r & 3) + 8 * (r >> 2) + 4 * hh; if (key > qrow0 + cl) e = 0.f; }
                        pr[r] = e; lsum += e; }
                    bf16x8 Pf[2];
#pragma unroll
                    for (int s = 0; s < 2; ++s) { v4u w; w.x = pk2(pr[8 * s + 0], pr[8 * s + 1]); w.y = pk2(pr[8 * s + 2], pr[8 * s + 3]); w.z = pk2(pr[8 * s + 4], pr[8 * s + 5]); w.w = pk2(pr[8 * s + 6], pr[8 * s + 7]);
                        Pf[s] = __builtin_bit_cast(bf16x8, w); }
                    const LAS unsigned char* vbp = lds + bo + AT_KB + cl * AT_VP + (32 * kpar + 8 * hh) * 2;
#pragma unroll
                    for (int vb = 0; vb < 4; ++vb)
#pragma unroll
                        for (int s = 0; s < 2; ++s) { const bf16x8 a = *(const LAS bf16x8*)(vbp + vb * 32 * AT_VP + s * 32); O[vb] = __builtin_amdgcn_mfma_f32_32x32x16_bf16(a, Pf[s], O[vb], 0, 0, 0); }
                }
                if (j + 1 < nsteps) AT_WRITE(((j + 1) & 1) * AT_BUF);
                __syncthreads();
            }
            LAS float* X = (LAS float*)lds;
            if (kpar == 1) {
#pragma unroll
                for (int vb = 0; vb < 4; ++vb)
#pragma unroll
                    for (int r = 0; r < 16; ++r) X[(qsub * 65 + vb * 16 + r) * 64 + lane] = O[vb][r];
                X[(qsub * 65 + 64) * 64 + lane] = lsum;
            }
            __syncthreads();
            if (kpar == 0) {
                float l = lsum + X[(qsub * 65 + 64) * 64 + lane];
                l += __shfl_xor(l, 32);
                const float il = 1.f / l; float ss = 0.f;
                const int t = b * SEQ + qrow0 + cl;
                bf16_t* op = merged + (size_t)t * DM + 1024 + h * 128 + 4 * hh;
#pragma unroll
                for (int vb = 0; vb < 4; ++vb)
#pragma unroll
                    for (int rq = 0; rq < 4; ++rq) { float o[4];
#pragma unroll
                        for (int r3 = 0; r3 < 4; ++r3) { const int r = rq * 4 + r3; o[r3] = (O[vb][r] + X[(qsub * 65 + vb * 16 + r) * 64 + lane]) * il; ss += o[r3] * o[r3]; }
                        v2u w; w.x = pk2(o[0], o[1]); w.y = pk2(o[2], o[3]); *(v2u*)(op + vb * 32 + rq * 8) = w; }
                ss += __shfl_xor(ss, 32);
                if (hh == 0) ssq_o8[(size_t)t * 8 + h] = ss;
            }
            __syncthreads();
        }
    }
#undef AT_LOAD
#undef AT_WRITE
}

__device__ __forceinline__ void phase6_scale(const Params& p, int wave, int lane) {
    unsigned char* ws = p.ws; bf16_t* merged = (bf16_t*)(ws + WS_MERGED); const float* ssq_o8 = (const float*)(ws + TAB_SSQ_O8);
    const int gw = blockIdx.x * NWAVES + wave, NGW = gridDim.x * NWAVES;
    for (int t = gw; t < NT; t += NGW) { const pg8::f32x4 oa = *(const pg8::f32x4*)(ssq_o8 + (size_t)t * 8), ob = *(const pg8::f32x4*)(ssq_o8 + (size_t)t * 8 + 4);
        const float r = rsqrtf((((oa[0] + oa[1]) + (oa[2] + oa[3])) + ((ob[0] + ob[1]) + (ob[2] + ob[3]))) * (1.f / 1024.f) + EPS);
#pragma unroll
        for (int j = 0; j < 2; ++j) { v4u* q = (v4u*)(merged + (size_t)t * DM + 1024 + j * 512 + lane * 8); v4u y = *q;
            y.x = pk2(bflo(y.x) * r, bfhi(y.x) * r); y.y = pk2(bflo(y.y) * r, bfhi(y.y) * r); y.z = pk2(bflo(y.z) * r, bfhi(y.z) * r); y.w = pk2(bflo(y.w) * r, bfhi(y.w) * r); *q = y; } }
}

struct EpiResidF32 { static constexpr bool PERM = false; const float* x; const float* gate; float* out;
    __device__ __forceinline__ void operator()(const pg8::f32x4 (&acc)[2][2][4][2], const pg8::Unit& u, int wr, int wc, int fr, int fq) const {
        const int row0 = u.pm * 256 + wr * 64 + fr, col0 = u.pn * 256 + wc * 32 + 4 * fq;
        const float* gp = gate + (size_t)((u.pm * 256) / SEQ) * MODW + col0;
        pg8::f32x4 gv[2][2];
#pragma unroll
        for (int bj = 0; bj < 2; ++bj)
#pragma unroll
            for (int n = 0; n < 2; ++n) gv[bj][n] = *(const pg8::f32x4*)(gp + bj * 128 + n * 16);
#pragma unroll
        for (int ai = 0; ai < 2; ++ai)
#pragma unroll
            for (int m = 0; m < 4; ++m) { const size_t ro = (size_t)(row0 + ai * 128 + m * 16) * DM + col0;
#pragma unroll
                for (int bj = 0; bj < 2; ++bj)
#pragma unroll
                    for (int n = 0; n < 2; ++n) { const pg8::f32x4 xv = *(const pg8::f32x4*)(x + ro + bj * 128 + n * 16); *(pg8::f32x4*)(out + ro + bj * 128 + n * 16) = xv + gv[bj][n] * acc[ai][bj][m][n]; } }
    }
};
__device__ __forceinline__ void phase7(const Params& p, LAS unsigned char* lds) {
    unsigned char* ws = p.ws;
    pg8::Gemm g{(const bf16_t*)(ws + WS_MERGED), (const bf16_t*)(ws + WS_BT_OUT), nullptr, DM, DM, DM, 0};
    pg8::StaticOrder S; S.init(NT / 256, DM / 256, gridDim.x, blockIdx.x, DM);
    EpiResidF32 E{p.in[0], (const float*)(ws + CTL_MOD) + 2 * DM, (float*)(ws + WS_H1)};
    pg8::gemm_phase<EpiResidF32, pg8::StaticOrder>((PG8_LAS unsigned char*)lds, g, S, E);
}
constexpr int HG_P = 272, HG_VP = 144;
constexpr int HG_A2 = 0, HG_A1 = 17408, HG_QB = 34816, HG_VT = 52224, HG_KT = 70656, HG_SEG = 89088, HG_RS = 91136, HG_FL = 92160, HG_QT = 109568;
struct HgPre { v4u fl[2], q[2], v[2]; };
template <bool NEEDQ>
__device__ __forceinline__ void hg_issue(const bf16_t* __restrict__ proj, int item, HgPre& P) {
    const int bh = item >> 5, c = item & 31, b = bh >> 3, h = bh & 7, t0 = b * SEQ + c * 64, tid = threadIdx.x;
#pragma unroll
    for (int i = 0; i < 2; ++i) { const int ch = tid + 512 * i, t = ch >> 4, c16 = ch & 15; const bf16_t* rp = proj + (size_t)(t0 + t) * INCP + h * 128 + c16 * 8;
        P.fl[i] = *(const v4u*)(rp + 1024); P.v[i] = *(const v4u*)(rp + 2048); if (NEEDQ) P.q[i] = *(const v4u*)rp; }
}
struct HgCol { float lf[16]; float b[16]; float blast, bmid; };
template <bool NEEDQ, bool PERM>
__device__ __forceinline__ void hg_stage(const HgPre& P, const float* __restrict__ lbl, int h, LAS unsigned char* lds, HgCol& C) {
    const int tid = threadIdx.x, k = tid & 127, seg = tid >> 7;
    __syncthreads();
#pragma unroll
    for (int i = 0; i < 2; ++i) { const int ch = tid + 512 * i, t = ch >> 4, c16 = ch & 15;
        *(LAS v4u*)(lds + HG_FL + t * HG_P + c16 * 16) = P.fl[i]; if (NEEDQ) *(LAS v4u*)(lds + HG_QT + t * HG_P + c16 * 16) = P.q[i];
        const v4u w = P.v[i]; const int o = t & 15, pos = PERM ? ((t & ~15) + 8 * ((o >> 2) & 1) + 4 * ((o >> 3) & 1) + (o & 3)) : t;
        LAS unsigned short* vp = (LAS unsigned short*)(lds + HG_VT + (c16 * 8) * HG_VP + pos * 2);
        vp[0 * (HG_VP / 2)] = (unsigned short)(w.x & 0xffff); vp[1 * (HG_VP / 2)] = (unsigned short)(w.x >> 16);
        vp[2 * (HG_VP / 2)] = (unsigned short)(w.y & 0xffff); vp[3 * (HG_VP / 2)] = (unsigned short)(w.y >> 16);
        vp[4 * (HG_VP / 2)] = (unsigned short)(w.z & 0xffff); vp[5 * (HG_VP / 2)] = (unsigned short)(w.z >> 16);
        vp[6 * (HG_VP / 2)] = (unsigned short)(w.w & 0xffff); vp[7 * (HG_VP / 2)] = (unsigned short)(w.w >> 16); }
    const float l0 = lbl[h * 128 + k], l1 = lbl[1024 + h * 128 + k];
    const float lb = 1.f / (1.f + __expf(l1 - l0));
    __syncthreads();
    const LAS unsigned short* fp = (const LAS unsigned short*)(lds + HG_FL + (seg * 16) * HG_P + k * 2);
    float run = 0.f;
#pragma unroll
    for (int i = 0; i < 16; ++i) { const float fl = bf2f(fp[i * (HG_P / 2)]); const float f = lb + (1.f - lb) / (1.f + __expf(-fl)); C.lf[i] = __logf(f); run += C.lf[i]; C.b[i] = run; }
    LAS float* SEG = (LAS float*)(lds + HG_SEG);
    SEG[seg * 128 + k] = run;
    __syncthreads();
    const float s0 = SEG[k], s1 = SEG[128 + k], s2 = SEG[256 + k], s3 = SEG[384 + k];
    const float off = (seg > 0 ? s0 : 0.f) + (seg > 1 ? s1 : 0.f) + (seg > 2 ? s2 : 0.f);
#pragma unroll
    for (int i = 0; i < 16; ++i) C.b[i] += off;
    C.bmid = s0 + s1; C.blast = (s0 + s1) + (s2 + s3);
}
__device__ __forceinline__ void hgrn_pass1(const Params& p, LAS unsigned char* lds, int wave, int lane) {
    unsigned char* ws = p.ws; const bf16_t* proj = (const bf16_t*)(ws + WS_PROJ);
    bf16_t* hgU = (bf16_t*)(ws + WS_HGU); float* hgd = (float*)(ws + TAB_HGD);
    const int tid = threadIdx.x, k = tid & 127, seg = tid >> 7, cl = lane & 31, hh = lane >> 5, G = gridDim.x;
    HgPre P; if ((int)blockIdx.x < 1024) hg_issue<false>(proj, blockIdx.x, P);
    for (int item = blockIdx.x; item < 1024; item += G) {
        const int h = (item >> 5) & 7;
        HgCol C; hg_stage<false, false>(P, p.in[8], h, lds, C);
        if (item + G < 1024) hg_issue<false>(proj, item + G, P);
        { unsigned w[8];
#pragma unroll
          for (int i = 0; i < 8; ++i) { const float a0 = (1.f - __expf(C.lf[2 * i])) * __expf(C.blast - C.b[2 * i]), a1 = (1.f - __expf(C.lf[2 * i + 1])) * __expf(C.blast - C.b[2 * i + 1]); w[i] = pk2(a0, a1); }
          LAS v4u* kp = (LAS v4u*)(lds + HG_KT + k * HG_VP + seg * 32); kp[0] = (v4u){w[0], w[1], w[2], w[3]}; kp[1] = (v4u){w[4], w[5], w[6], w[7]}; }
        if (seg == 0) hgd[item * 128 + k] = __expf(C.blast);
        __syncthreads();
        const int vb = wave >> 1;
        bf16x8 af[4];
#pragma unroll
        for (int ks = 0; ks < 4; ++ks) af[ks] = *(const LAS bf16x8*)(lds + HG_VT + (32 * vb + cl) * HG_VP + (16 * ks + 8 * hh) * 2);
#pragma unroll
        for (int q = 0; q < 2; ++q) { const int kb = (wave & 1) * 2 + q; f32x16 acc;
#pragma unroll
            for (int r = 0; r < 16; ++r) acc[r] = 0.f;
#pragma unroll
            for (int ks = 0; ks < 4; ++ks) { const bf16x8 bfr = *(const LAS bf16x8*)(lds + HG_KT + (32 * kb + cl) * HG_VP + (16 * ks + 8 * hh) * 2); acc = __builtin_amdgcn_mfma_f32_32x32x16_bf16(af[ks], bfr, acc, 0, 0, 0); }
            bf16_t* up = hgU + (size_t)item * 16384 + 32 * kb + cl;
#pragma unroll
            for (int r = 0; r < 16; ++r) { const int v = 32 * vb + (r & 3) + 8 * (r >> 2) + 4 * hh; up[(size_t)v * 128] = (bf16_t)f2bf(acc[r]); } }
    }
}
__device__ __forceinline__ void hgrn_scan(const Params& p) {
    unsigned char* ws = p.ws; bf16_t* hgU = (bf16_t*)(ws + WS_HGU); const float* hgd = (const float*)(ws + TAB_HGD);
    for (int i = blockIdx.x * NTHR + threadIdx.x; i < 32 * 4096; i += gridDim.x * NTHR) {
        const int bh = i >> 12, e4 = i & 4095, k4 = (e4 & 31) * 4;
        float S[4] = {0.f, 0.f, 0.f, 0.f};
        v2u* up = (v2u*)(hgU + (size_t)bh * 32 * 16384 + (size_t)e4 * 4); const float* dp = hgd + (size_t)bh * 32 * 128 + k4;
#pragma unroll 1
        for (int c0 = 0; c0 < 32; c0 += 8) { v2u u[8]; f32x4 d[8];
#pragma unroll
            for (int j = 0; j < 8; ++j) { u[j] = up[(size_t)(c0 + j) * 4096]; d[j] = *(const f32x4*)(dp + (c0 + j) * 128); }
#pragma unroll
            for (int j = 0; j < 8; ++j) { v2u o; o.x = pk2(S[0], S[1]); o.y = pk2(S[2], S[3]); up[(size_t)(c0 + j) * 4096] = o;
                S[0] = d[j][0] * S[0] + bflo(u[j].x); S[1] = d[j][1] * S[1] + bfhi(u[j].x); S[2] = d[j][2] * S[2] + bflo(u[j].y); S[3] = d[j][3] * S[3] + bfhi(u[j].y); } }
    }
}
__device__ __forceinline__ void hgrn_pass3(const Params& p, LAS unsigned char* lds, int wave, int lane) {
    unsigned char* ws = p.ws; const bf16_t* proj = (const bf16_t*)(ws + WS_PROJ);
    const bf16_t* hgS = (const bf16_t*)(ws + WS_HGU); bf16_t* merged = (bf16_t*)(ws + WS_MERGED); const float* og = p.in[9];
    const int tid = threadIdx.x, k = tid & 127, seg = tid >> 7, cl = lane & 31, hh = lane >> 5, vb = wave & 3, tb = wave >> 2, G = gridDim.x;
    HgPre P; if ((int)blockIdx.x < 1024) hg_issue<true>(proj, blockIdx.x, P);
    for (int item = blockIdx.x; item < 1024; item += G) {
        const int bh = item >> 5, c = item & 31, b = bh >> 3, h = bh & 7, t0 = b * SEQ + c * 64;
        bf16x8 sf[8]; v2u gw[4];
        { const bf16_t* sp = hgS + (size_t)item * 16384 + (size_t)(32 * vb + cl) * 128 + 8 * hh;
#pragma unroll
          for (int ks = 0; ks < 8; ++ks) sf[ks] = *(const bf16x8*)(sp + 16 * ks);
          const int t = t0 + 32 * tb + cl;
#pragma unroll
          for (int rq = 0; rq < 4; ++rq) gw[rq] = *(const v2u*)(proj + (size_t)t * INCP + 3072 + h * 128 + 32 * vb + 8 * rq + 4 * hh); }
        HgCol C; hg_stage<true, true>(P, p.in[8], h, lds, C);
        { const LAS unsigned short* qp = (const LAS unsigned short*)(lds + HG_QT + (seg * 16) * HG_P + k * 2);
          LAS unsigned short* a2 = (LAS unsigned short*)(lds + HG_A2 + (seg * 16) * HG_P + k * 2);
          LAS unsigned short* a1 = (LAS unsigned short*)(lds + HG_A1 + (seg * 16) * HG_P + k * 2);
          LAS unsigned short* qb = (LAS unsigned short*)(lds + HG_QB + (seg * 16) * HG_P + k * 2);
#pragma unroll
          for (int i = 0; i < 16; ++i) { const float q = bf2f(qp[i * (HG_P / 2)]);
              a2[i * (HG_P / 2)] = (unsigned short)f2bf((1.f - __expf(C.lf[i])) * __expf(C.bmid - C.b[i]));
              a1[i * (HG_P / 2)] = (unsigned short)f2bf(q * __expf(C.b[i] - C.bmid));
              qb[i * (HG_P / 2)] = (unsigned short)f2bf(q * __expf(C.b[i])); } }
        __syncthreads();
        if (item + G < 1024) hg_issue<true>(proj, item + G, P);
        f32x16 O;
#pragma unroll
        for (int r = 0; r < 16; ++r) O[r] = 0.f;
#pragma unroll
        for (int ks = 0; ks < 8; ++ks) { const bf16x8 bq = *(const LAS bf16x8*)(lds + HG_QB + (32 * tb + cl) * HG_P + (16 * ks + 8 * hh) * 2); O = __builtin_amdgcn_mfma_f32_32x32x16_bf16(sf[ks], bq, O, 0, 0, 0); }
#pragma unroll
        for (int sb = 0; sb < 2; ++sb) {
            if (sb <= tb) {
                f32x16 X;
#pragma unroll
                for (int r = 0; r < 16; ++r) X[r] = 0.f;
#pragma unroll
                for (int ks = 0; ks < 8; ++ks) { const bf16x8 a = *(const LAS bf16x8*)(lds + HG_A2 + (32 * sb + cl) * HG_P + (16 * ks + 8 * hh) * 2);
                    const bf16x8 bq = *(const LAS bf16x8*)(lds + HG_A1 + (32 * tb + cl) * HG_P + (16 * ks + 8 * hh) * 2); X = __builtin_amdgcn_mfma_f32_32x32x16_bf16(a, bq, X, 0, 0, 0); }
                if (sb == tb) {
#pragma unroll
                    for (int r = 0; r < 16; ++r) { const int s = (r & 3) + 8 * (r >> 2) + 4 * hh; if (s > cl) X[r] = 0.f; } }
#pragma unroll
                for (int s2 = 0; s2 < 2; ++s2) { v4u w; w.x = pk2(X[8 * s2 + 0], X[8 * s2 + 1]); w.y = pk2(X[8 * s2 + 2], X[8 * s2 + 3]); w.z = pk2(X[8 * s2 + 4], X[8 * s2 + 5]); w.w = pk2(X[8 * s2 + 6], X[8 * s2 + 7]);
                    const bf16x8 a = *(const LAS bf16x8*)(lds + HG_VT + (32 * vb + cl) * HG_VP + (32 * sb + 16 * s2 + 8 * hh) * 2);
                    O = __builtin_amdgcn_mfma_f32_32x32x16_bf16(a, __builtin_bit_cast(bf16x8, w), O, 0, 0, 0); }
            }
        }
        float ss = 0.f;
#pragma unroll
        for (int r = 0; r < 16; ++r) ss += O[r] * O[r];
        ss += __shfl_xor(ss, 32);
        LAS float* RS = (LAS float*)(lds + HG_RS);
        if (hh == 0) RS[(tb * 4 + vb) * 32 + cl] = ss;
        __syncthreads();
        const float tot = (RS[(tb * 4 + 0) * 32 + cl] + RS[(tb * 4 + 1) * 32 + cl]) + (RS[(tb * 4 + 2) * 32 + cl] + RS[(tb * 4 + 3) * 32 + cl]);
        const float rn = rsqrtf(tot * (1.f / 128.f) + EPS);
        const int t = t0 + 32 * tb + cl;
#pragma unroll
        for (int rq = 0; rq < 4; ++rq) { const int v = 32 * vb + 8 * rq + 4 * hh; const f32x4 gg = *(const f32x4*)(og + v);
            const float g0 = bflo(gw[rq].x), g1 = bfhi(gw[rq].x), g2 = bflo(gw[rq].y), g3 = bfhi(gw[rq].y);
            const float o0 = O[rq * 4 + 0] * rn * gg[0] * (g0 / (1.f + __expf(-g0))), o1 = O[rq * 4 + 1] * rn * gg[1] * (g1 / (1.f + __expf(-g1)));
            const float o2 = O[rq * 4 + 2] * rn * gg[2] * (g2 / (1.f + __expf(-g2))), o3 = O[rq * 4 + 3] * rn * gg[3] * (g3 / (1.f + __expf(-g3)));
            v2u w; w.x = pk2(o0, o1); w.y = pk2(o2, o3); *(v2u*)(merged + (size_t)t * DM + h * 128 + v) = w; }
    }
}
typedef float f32x2v __attribute__((ext_vector_type(2)));
constexpr int UPITCH = 2050;
constexpr int LDS_HIST = RING_BYTES + 1024;
__device__ __forceinline__ void phase8(const Params& p, LAS unsigned char* lds, int wave, int lane) {
    unsigned char* ws = p.ws;
    const float* h1 = (const float*)(ws + WS_H1); const float* mod = (const float*)(ws + CTL_MOD);
    bf16_t* u16 = (bf16_t*)(ws + WS_U16);
    const float* wr_ = p.in[18]; const float* rbias = p.in[19];
    int* top_idx = (int*)(ws + TAB_TOPI); float* top_w = (float*)(ws + TAB_TOPW); int* slot = (int*)(ws + TAB_SLOT);
    LAS float* U = (LAS float*)lds;
    LAS int* hist = (LAS int*)(lds + LDS_HIST);
    if (threadIdx.x < 64) hist[threadIdx.x] = 0;
    __syncthreads();
    for (int task = blockIdx.x; task < NT / 16; task += gridDim.x) {
        const int t0 = task * 16;
#pragma unroll 1
        for (int rr = 0; rr < 2; ++rr) {
            const int tl = wave * 2 + rr, t = t0 + tl, b = t / SEQ;
            const float* hrow = h1 + (size_t)t * DM; const float* g = p.in[6]; const float* sc = mod + b * MODW + 4 * DM; const float* sh = mod + b * MODW + 3 * DM;
            f32x4 v[8]; float s = 0.f;
#pragma unroll
            for (int j = 0; j < 8; ++j) { v[j] = *(const f32x4*)(hrow + lane * 4 + 256 * j); s += (v[j].x * v[j].x + v[j].y * v[j].y) + (v[j].z * v[j].z + v[j].w * v[j].w); }
            const float r = rsqrtf(wave_sum(s) * (1.f / DM) + EPS);
#pragma unroll
            for (int j = 0; j < 8; ++j) { const int col = lane * 4 + 256 * j; const f32x4 gv = *(const f32x4*)(g + col), sv = *(const f32x4*)(sc + col), hv = *(const f32x4*)(sh + col);
                const f32x4 o = v[j] * r * gv * (sv + 1.f) + hv; v2u w; w.x = pk2(o.x, o.y); w.y = pk2(o.z, o.w); *(v2u*)(u16 + (size_t)t * DM + col) = w;
                LAS f32x2v* up = (LAS f32x2v*)(U + tl * UPITCH + col); up[0] = (f32x2v){o.x, o.y}; up[1] = (f32x2v){o.z, o.w}; }
        }
        __syncthreads();
        f32x4 acc[4];
#pragma unroll
        for (int c = 0; c < 4; ++c) acc[c] = (f32x4){0.f, 0.f, 0.f, 0.f};
        { const int kb = wave * 256 + (lane >> 4); const LAS float* ua = U + (lane & 15) * UPITCH + kb; const float* wb = wr_ + (size_t)kb * NE + 4 * (lane & 15);
#pragma unroll 1
          for (int k16 = 0; k16 < 64; k16 += 16) { f32x4 bv[16];
#pragma unroll
              for (int q = 0; q < 16; ++q) bv[q] = *(const f32x4*)(wb + (size_t)(k16 + q) * 4 * NE);
#pragma unroll
              for (int q = 0; q < 16; ++q) { const float a = ua[(k16 + q) * 4];
#pragma unroll
                  for (int c = 0; c < 4; ++c) acc[c] = __builtin_amdgcn_mfma_f32_16x16x4f32(a, bv[q][c], acc[c], 0, 0, 0); } } }
        __syncthreads();
        LAS float* P = (LAS float*)lds;
#pragma unroll
        for (int c = 0; c < 4; ++c)
#pragma unroll
            for (int r = 0; r < 4; ++r) P[wave * 1024 + ((lane >> 4) * 4 + r) * 64 + 4 * (lane & 15) + c] = acc[c][r];
        __syncthreads();
        LAS float* LG = (LAS float*)(lds + 32768);
#pragma unroll
        for (int q = 0; q < 2; ++q) { const int i = threadIdx.x + q * NTHR; float s = 0.f;
#pragma unroll
            for (int w = 0; w < 8; ++w) s += P[w * 1024 + i]; LG[i] = s; }
        __syncthreads();
#pragma unroll 1
        for (int rr = 0; rr < 2; ++rr) {
            const int tl = wave * 2 + rr, t = t0 + tl;
            const float sc = 1.f / (1.f + expf(-LG[tl * 64 + lane])); const float sel = sc + rbias[lane];
            float m1 = sel; m1 = fmaxf(m1, __shfl_xor(m1, 1)); m1 = fmaxf(m1, __shfl_xor(m1, 2)); m1 = fmaxf(m1, __shfl_xor(m1, 4));
            const unsigned long long gm = 0xFFull << (lane & 56);
            const int first = __ffsll((long long)(__ballot(sel == m1) & gm)) - 1;
            float m2 = (lane == first) ? -INFINITY : sel; m2 = fmaxf(m2, __shfl_xor(m2, 1)); m2 = fmaxf(m2, __shfl_xor(m2, 2)); m2 = fmaxf(m2, __shfl_xor(m2, 4));
            const float gs = m1 + m2; const int g = lane >> 3; int grank = 0;
#pragma unroll
            for (int gg = 0; gg < 8; ++gg) { const float og = __builtin_bit_cast(float, __builtin_amdgcn_readlane(__builtin_bit_cast(int, gs), gg * 8)); grank += (og > gs || (og == gs && gg < g)) ? 1 : 0; }
            const bool gsel = grank < 4; const float msel = gsel ? sel : -INFINITY; int rk = 0;
#pragma unroll
            for (int e = 0; e < 64; ++e) { const float o = __builtin_bit_cast(float, __builtin_amdgcn_readlane(__builtin_bit_cast(int, msel), e)); rk += (o > msel || (o == msel && e < lane)) ? 1 : 0; }
            const bool chosen = gsel && rk < 8;
            const unsigned long long cb = __ballot(chosen);
            const float wsum = wave_sum(chosen ? sc : 0.f);
            const int ks = __popcll(cb & ((1ull << lane) - 1ull));
            if (chosen) { const int lr = __hip_atomic_fetch_add((int*)(hist + lane), 1, __ATOMIC_RELAXED, __HIP_MEMORY_SCOPE_WORKGROUP); top_idx[t * 8 + ks] = lane; top_w[t * 8 + ks] = sc / wsum * 2.5f; slot[t * 8 + ks] = lr; }
        }
        __syncthreads();
    }
    if (threadIdx.x < 64) ((int*)(ws + CTL_HIST))[blockIdx.x * 64 + threadIdx.x] = hist[threadIdx.x];
}

__device__ __forceinline__ void phase9(const Params& p, LAS unsigned char* lds, int wave, int lane) {
    unsigned char* ws = p.ws;
    const int* bh = (const int*)(ws + CTL_HIST);
    int* top_idx = (int*)(ws + TAB_TOPI); int* slot = (int*)(ws + TAB_SLOT); int* row_tok = (int*)(ws + TAB_ROWTOK); int* tile_exp = (int*)(ws + TAB_TILEEXP);
    LAS int* rb = (LAS int*)(lds + LDS_HIST + 256);
    const int G = gridDim.x;
    {
        LAS int* part = (LAS int*)(lds + LDS_HIST + 2048);
        const int e = threadIdx.x & 63, pt = threadIdx.x >> 6, per = (G + 7) / 8, b0 = pt * per, b1 = (b0 + per < G) ? b0 + per : G;
        int cnt = 0, base = 0;
#pragma unroll 8
        for (int b = b0; b < b1; ++b) { const int v = bh[b * 64 + e]; base += (b < (int)blockIdx.x) ? v : 0; cnt += v; }
        part[pt * 64 + e] = cnt; part[512 + pt * 64 + e] = base;
    }
    __syncthreads();
    if (wave == 0) {
        LAS int* part = (LAS int*)(lds + LDS_HIST + 2048);
        int cnt = 0, base = 0;
#pragma unroll
        for (int q = 0; q < 8; ++q) { cnt += part[q * 64 + lane]; base += part[512 + q * 64 + lane]; }
        const int tiles = (cnt + 255) >> 8;
        int incl = tiles;
#pragma unroll
        for (int o = 1; o < 64; o <<= 1) { const int n = __shfl_up(incl, o); if (lane >= o) incl += n; }
        const int toff = incl - tiles;
        rb[lane] = toff * 256 + base;
        if (blockIdx.x == 0) { for (int i = 0; i < tiles; ++i) tile_exp[toff + i] = lane; if (lane == 63) tile_exp[512] = incl; if (lane < 32) tile_exp[320 + lane] = 64; }
        rb[64 + lane] = toff * 256 + cnt; rb[128 + lane] = (toff + tiles) * 256;
    }
    __syncthreads();
    for (int e = blockIdx.x; e < 64; e += G) { const int lo = rb[64 + e], hi = rb[128 + e]; for (int r = lo + (int)threadIdx.x; r < hi; r += NTHR) row_tok[r] = 0; }
    for (int i = blockIdx.x * NTHR + threadIdx.x; i < NT; i += G * NTHR) row_tok[ROUTED_ROWS_MAX + i] = i;
    for (int task = blockIdx.x; task < NT / 16; task += G) {
        const int t = task * 16 + wave * 2 + (lane >> 3), k = lane & 7;
        if (lane < 16) { const int e = top_idx[t * 8 + k]; const int pos = rb[e] + slot[t * 8 + k]; slot[t * 8 + k] = pos; row_tok[pos] = t; }
    }
}

constexpr int LDS_UNITS = RING_BYTES + 8192;
struct MoeOrder {
    LAS int* tab; int n;
    __device__ void init(LAS unsigned char* lds, const int* tile_exp, int nN, int G, int c, long estride, int ldb) {
        tab = (LAS int*)(lds + LDS_UNITS);
        const int ntr = tile_exp[512], nwg = (ntr + 32) * nN; const long bstep = (long)256 * ldb * 2;
        const int i = threadIdx.x; n = 0;
        { const long L0 = c; if (L0 < nwg) n = (int)((nwg - 1 - L0) / G) + 1; }
        if (i < 32 && i < n) {
            int wgid = i * G + c; { const int q = nwg / 8, r = nwg % 8, xcd = wgid % 8, off = wgid / 8; wgid = (xcd < r ? xcd * (q + 1) : r * (q + 1) + (xcd - r) * q) + off; }
            const int ti = wgid / nN, pn = wgid % nN; int tile, e; if (ti < ntr) { tile = ti; e = tile_exp[ti]; } else { tile = 320 + (ti - ntr); e = 64; }
            const long boff = (long)e * estride + (long)pn * bstep;
            tab[i * 4 + 0] = tile; tab[i * 4 + 1] = pn; tab[i * 4 + 2] = (int)(boff & 0xffffffffl); tab[i * 4 + 3] = (int)(boff >> 32);
        }
        __syncthreads();
    }
    __device__ bool next(int i, pg8::Unit& u) const {
        if (i >= n) return false;
        u.pm = tab[i * 4 + 0]; u.pn = tab[i * 4 + 1]; u.boff = (long)(((unsigned long long)(unsigned)tab[i * 4 + 3] << 32) | (unsigned)tab[i * 4 + 2]); return true;
    }
};
struct EpiGateUp { static constexpr bool PERM = true; bf16_t* H;
    __device__ __forceinline__ void operator()(const pg8::f32x4 (&acc)[2][2][4][2], const pg8::Unit& u, int wr, int wc, int fr, int fq) const {
        const int row0 = u.pm * 256 + wr * 64 + fr, col0 = u.pn * 128 + wc * 32 + 8 * fq;
#pragma unroll
        for (int ai = 0; ai < 2; ++ai)
#pragma unroll
            for (int m = 0; m < 4; ++m) { const int row = row0 + ai * 128 + m * 16; float o[8];
#pragma unroll
                for (int n = 0; n < 2; ++n)
#pragma unroll
                    for (int j = 0; j < 4; ++j) { const float gt = acc[ai][0][m][n][j], up = acc[ai][1][m][n][j]; o[n * 4 + j] = gt / (1.f + __expf(-gt)) * up; }
                v4u w; w.x = pk2(o[0], o[1]); w.y = pk2(o[2], o[3]); w.z = pk2(o[4], o[5]); w.w = pk2(o[6], o[7]);
                *(v4u*)(H + (size_t)row * DE + col0) = w; }
    }
};
struct EpiDown { static constexpr bool PERM = true; bf16_t* Y;
    __device__ __forceinline__ void operator()(const pg8::f32x4 (&acc)[2][2][4][2], const pg8::Unit& u, int wr, int wc, int fr, int fq) const {
        const int row0 = u.pm * 256 + wr * 64 + fr, col0 = u.pn * 256 + wc * 32 + 8 * fq;
#pragma unroll
        for (int ai = 0; ai < 2; ++ai)
#pragma unroll
            for (int m = 0; m < 4; ++m) { const int row = row0 + ai * 128 + m * 16; bf16_t* rowp = Y + (size_t)row * DM + col0;
#pragma unroll
                for (int bj = 0; bj < 2; ++bj) { const pg8::f32x4 v0 = acc[ai][bj][m][0], v1 = acc[ai][bj][m][1];
                    v4u w; w.x = pk2(v0[0], v0[1]); w.y = pk2(v0[2], v0[3]); w.z = pk2(v1[0], v1[1]); w.w = pk2(v1[2], v1[3]); *(v4u*)(rowp + bj * 128) = w; } }
    }
};
__device__ __forceinline__ void phase10(const Params& p, LAS unsigned char* lds) {
    unsigned char* ws = p.ws;
    pg8::Gemm g{(const bf16_t*)(ws + WS_U16), (const bf16_t*)(ws + WS_BT_GU), (const int*)(ws + TAB_ROWTOK), DM, DM, DM, 0};
    MoeOrder S; S.init(lds, (const int*)(ws + TAB_TILEEXP), 4, gridDim.x, blockIdx.x, (long)1024 * DM * 2, DM);
    EpiGateUp E{(bf16_t*)(ws + WS_HID)};
    pg8::gemm_phase<EpiGateUp, MoeOrder>((PG8_LAS unsigned char*)lds, g, S, E);
}
__device__ __forceinline__ void phase11(const Params& p, LAS unsigned char* lds) {
    unsigned char* ws = p.ws;
    pg8::Gemm g{(const bf16_t*)(ws + WS_HID), (const bf16_t*)(ws + WS_BT_DN), nullptr, DE, DE, DE, 0};
    MoeOrder S; S.init(lds, (const int*)(ws + TAB_TILEEXP), 8, gridDim.x, blockIdx.x, (long)DM * DE * 2, DE);
    EpiDown E{(bf16_t*)(ws + WS_Y)};
    pg8::gemm_phase<EpiDown, MoeOrder>((PG8_LAS unsigned char*)lds, g, S, E);
}
__device__ __forceinline__ void phase12(const Params& p, int wave, int lane) {
    unsigned char* ws = p.ws;
    const float* h1 = (const float*)(ws + WS_H1); const float* mod = (const float*)(ws + CTL_MOD); const bf16_t* Y = (const bf16_t*)(ws + WS_Y);
    const int* slot = (const int*)(ws + TAB_SLOT); const float* top_w = (const float*)(ws + TAB_TOPW);
    const int gw = blockIdx.x * NWAVES + wave, NGW = gridDim.x * NWAVES;
    for (int t = gw; t < NT; t += NGW) {
        const int b = t / SEQ; const float* gt = mod + b * MODW + 5 * DM;
        int sl = 0; float wk = 0.f; if (lane < 8) { sl = slot[t * 8 + lane]; wk = top_w[t * 8 + lane]; }
#pragma unroll 1
        for (int j = 0; j < 4; ++j) {
            const int col = j * 512 + lane * 8; float a[8];
            { const v4u y = *(const v4u*)(Y + (size_t)(ROUTED_ROWS_MAX + t) * DM + col); a[0] = bflo(y.x); a[1] = bfhi(y.x); a[2] = bflo(y.y); a[3] = bfhi(y.y); a[4] = bflo(y.z); a[5] = bfhi(y.z); a[6] = bflo(y.w); a[7] = bfhi(y.w); }
#pragma unroll
            for (int k = 0; k < 8; ++k) { const int s = __builtin_amdgcn_readlane(sl, k); const float w = __builtin_bit_cast(float, __builtin_amdgcn_readlane(__builtin_bit_cast(int, wk), k));
                const v4u y = *(const v4u*)(Y + (size_t)s * DM + col);
                a[0] += w * bflo(y.x); a[1] += w * bfhi(y.x); a[2] += w * bflo(y.y); a[3] += w * bfhi(y.y); a[4] += w * bflo(y.z); a[5] += w * bfhi(y.z); a[6] += w * bflo(y.w); a[7] += w * bfhi(y.w); }
            const f32x4 h0 = *(const f32x4*)(h1 + (size_t)t * DM + col), h4 = *(const f32x4*)(h1 + (size_t)t * DM + col + 4);
            const f32x4 g0 = *(const f32x4*)(gt + col), g4 = *(const f32x4*)(gt + col + 4);
            f32x4 o0, o4; o0.x = h0.x + g0.x * a[0]; o0.y = h0.y + g0.y * a[1]; o0.z = h0.z + g0.z * a[2]; o0.w = h0.w + g0.w * a[3];
            o4.x = h4.x + g4.x * a[4]; o4.y = h4.y + g4.y * a[5]; o4.z = h4.z + g4.z * a[6]; o4.w = h4.w + g4.w * a[7];
            *(f32x4*)(p.out + (size_t)t * DM + col) = o0; *(f32x4*)(p.out + (size_t)t * DM + col + 4) = o4;
        }
    }
}

__global__ void __launch_bounds__(NTHR, 2) k_mega(Params p) {
    extern __shared__ __attribute__((aligned(16))) unsigned char lds_raw[];
    LAS unsigned char* lds = (LAS unsigned char*)lds_raw;
    const int tid = threadIdx.x, lane = tid & 63, wave = __builtin_amdgcn_readfirstlane(tid >> 6);
    volatile LAS unsigned* MISC = (volatile LAS unsigned*)(lds + MISC_OFF);
    for (int u = tid; u < (LDS_BYTES - RING_BYTES) / 4; u += NTHR) ((LAS unsigned*)(lds + RING_BYTES))[u] = 0u;
    __syncthreads();
    XcdBarrier bar = xcd_barrier_post((unsigned*)(p.ws + WS_CTL) + CW_BAR, MISC + 8);
    const int lo = p.ph_lo, hi = p.ph_hi;
#ifndef DUP_MASK
#define DUP_MASK 0
#endif
#define IN(k) (lo <= (k) && (k) < hi)
#define DUPK(k, body) do { if (IN(k)) { body; if ((DUP_MASK >> (k)) & 1) { xcd_barrier(bar); body; } } } while (0)
#define SEAM(k) do { if (IN(k) && IN((k) + 1)) xcd_barrier(bar); } while (0)
    DUPK(0, phase0(p, lds, wave, lane)); SEAM(0);
    DUPK(1, phase1(p, lds, wave, lane)); SEAM(1);
    DUPK(2, phase2(p, lds)); SEAM(2);
    DUPK(3, phase3_gemms(p, lds); hgrn_pass1(p, lds, wave, lane)); SEAM(3);
    DUPK(4, hgrn_scan(p); phase4_qk(p, wave, lane); if ((DUP_MASK >> 17) & 1) { xcd_barrier(bar); phase4_qk(p, wave, lane); }); SEAM(4);
    DUPK(5, phase5_attn(p, lds, wave, lane); hgrn_pass3(p, lds, wave, lane); if ((DUP_MASK >> 16) & 1) { xcd_barrier(bar); hgrn_pass3(p, lds, wave, lane); }); SEAM(5);
    DUPK(6, phase6_scale(p, wave, lane)); SEAM(6);
    DUPK(7, phase7(p, lds)); SEAM(7);
    DUPK(8, phase8(p, lds, wave, lane)); SEAM(8);
    DUPK(9, phase9(p, lds, wave, lane)); SEAM(9);
    DUPK(10, phase10(p, lds)); SEAM(10);
    DUPK(11, phase11(p, lds)); SEAM(11);
    DUPK(12, phase12(p, wave, lane));
#undef IN
#undef SEAM
}
extern "C" void kernel_launch(void* const* d_in, const int* in_sizes, int n_in, void* d_out, int out_size, void* d_ws, size_t ws_size, hipStream_t stream) {
    static int grid = 0;
    if (grid == 0) {
        int dev = 0, cus = 0;
        if (hipGetDevice(&dev) != hipSuccess || hipDeviceGetAttribute(&cus, hipDeviceAttributeMultiprocessorCount, dev) != hipSuccess) { grid = -1; return; }
        if (hipFuncSetAttribute((const void*)k_mega, hipFuncAttributeMaxDynamicSharedMemorySize, LDS_BYTES) != hipSuccess) { fprintf(stderr, "kernel_launch: hipFuncSetAttribute failed\n"); grid = -1; return; }
        (void)hipGetLastError();
        grid = cus;
        if (n_in != 26 || ws_size < WS_END) { fprintf(stderr, "kernel_launch: unexpected inputs / workspace (%d, %zu)\n", n_in, ws_size); grid = -1; return; }
    }
    if (grid < 0) return;
    (void)hipMemsetAsync((char*)d_ws + WS_CTL, 0, CTL_ZERO_BYTES, stream);
    Params p{};
    for (int i = 0; i < 26; ++i) p.in[i] = (const float*)d_in[i];
    p.out = (float*)d_out; p.ws = (unsigned char*)d_ws; p.ph_lo = 0; p.ph_hi = 13;
    hipLaunchKernelGGL(k_mega, dim3(grid), dim3(NTHR), LDS_BYTES, stream, p);
}
```

```cpp
#define DUP_MASK 0x0
#include <hip/hip_runtime.h>
#include <cstdio>
#include <cstdint>
constexpr int NB = 4, SEQ = 2048, DM = 2048, NT = NB * SEQ;
constexpr int INC = 4928, INCP = 5120;
constexpr int MH = 8, QR = 512, KVR = 256, QKD = 192, VD = 128;
constexpr int NE = 64, DE = 512;
constexpr float EPS = 1e-6f;
constexpr int MODW = 6 * DM;
constexpr int NWAVES = 8, NTHR = 512;
constexpr int PROWS = 90112;
constexpr int ROUTED_ROWS_MAX = 81920;

constexpr size_t MiB = 1u << 20;
constexpr size_t WS_CTL = 0, CTL_ZERO_BYTES = 1 * MiB;
constexpr int CW_BAR = 1024;
constexpr size_t CTL_MOD = 64 * 1024;
constexpr size_t WS_MODP = 4 * MiB;
constexpr size_t TAB_SSQ_Q8 = 7 * MiB, TAB_SSQ_KV4 = 7 * MiB + 256 * 1024, TAB_SSQ_O8 = 7 * MiB + 512 * 1024;
constexpr size_t CTL_HIST = 416 * 1024;
constexpr size_t WS_TAB = 1 * MiB;
constexpr size_t TAB_HGD = WS_TAB;
constexpr size_t TAB_TOPI = WS_TAB + 1 * MiB;
constexpr size_t TAB_TOPW = TAB_TOPI + 256 * 1024;
constexpr size_t TAB_SLOT = TAB_TOPW + 256 * 1024;
constexpr size_t TAB_ROWTOK = TAB_SLOT + 256 * 1024;
constexpr size_t TAB_TILEEXP = TAB_ROWTOK + 512 * 1024;
constexpr size_t WS_BT_IN = 8 * MiB, WS_BT_UQ = 28 * MiB, WS_BT_KV = 30 * MiB, WS_BT_OUT = 32 * MiB, WS_BT_GU = 40 * MiB, WS_BT_DN = 300 * MiB;
constexpr size_t WS_U16 = 430 * MiB, WS_H1 = 462 * MiB, WS_HID = 526 * MiB, WS_X = 614 * MiB;
constexpr size_t WS_PROJ = WS_X, WS_QRAW = WS_X + 80 * MiB, WS_KRAW = WS_X + 104 * MiB, WS_VT = WS_X + 120 * MiB, WS_Q16 = WS_X + 136 * MiB, WS_K16 = WS_X + 160 * MiB,
                 WS_HGU = WS_X + 184 * MiB, WS_MERGED = WS_X + 216 * MiB, WS_Y = WS_X, WS_END = 966 * MiB;

constexpr int RING_BYTES = 131072, LDS_BYTES = 163840, MISC_OFF = LDS_BYTES - 256;

#define GAS __attribute__((address_space(1)))
#define LAS __attribute__((address_space(3)))
typedef unsigned short bf16_t;
typedef unsigned v4u __attribute__((ext_vector_type(4)));
typedef unsigned v2u __attribute__((ext_vector_type(2)));
typedef float f32x4 __attribute__((ext_vector_type(4)));
typedef GAS unsigned gu32;
#define RLX_AGENT __ATOMIC_RELAXED, __HIP_MEMORY_SCOPE_AGENT
__device__ __forceinline__ unsigned f2bf(float f) { unsigned u = __builtin_bit_cast(unsigned, f); return (u + 0x7fffu + ((u >> 16) & 1u)) >> 16; }
__device__ __forceinline__ unsigned pk2(float lo, float hi) { unsigned r; asm volatile("v_cvt_pk_bf16_f32 %0, %1, %2" : "=v"(r) : "v"(lo), "v"(hi)); return r; }
__device__ __forceinline__ float bf2f(unsigned short b) { return __builtin_bit_cast(float, ((unsigned)b) << 16); }
__device__ __forceinline__ float bflo(unsigned w) { return __builtin_bit_cast(float, w << 16); }
__device__ __forceinline__ float bfhi(unsigned w) { return __builtin_bit_cast(float, w & 0xffff0000u); }
__device__ __forceinline__ float sigmoidf_(float x) { return 1.f / (1.f + __expf(-x)); }
__device__ __forceinline__ float siluf_(float x) { return x / (1.f + __expf(-x)); }
__device__ __forceinline__ float wave_sum(float v) {
#pragma unroll
    for (int o = 1; o < 64; o <<= 1) v += __shfl_xor(v, o);
    return v;
}

#define XB_TMO      128
#define XB_XCNT(j)  (256  + 64 * (j))
#define XB_XSUB(j)  (1280 + 64 * (j))
#define XB_XGEN(j)  (2304 + 64 * (j))
#define XB_TOP      3328
#define XB_TOPGEN   3392
#define XCD_BAR_WORDS 3456
#define XB_SPIN_CAP (1u << 18)
__device__ __forceinline__ unsigned xb_ld(unsigned* p)              { return __hip_atomic_load(p, __ATOMIC_RELAXED, __HIP_MEMORY_SCOPE_AGENT); }
__device__ __forceinline__ unsigned xb_add(unsigned* p, unsigned v) { return __hip_atomic_fetch_add(p, v, __ATOMIC_RELAXED, __HIP_MEMORY_SCOPE_AGENT); }
__device__ __forceinline__ unsigned xb_xcc_id() { return (unsigned)__builtin_amdgcn_s_getreg((3 << 11) | 20) & 0xFu; }
#define XB_SPIN(cond, bar) do { unsigned _sp = 0; while (cond) { __builtin_amdgcn_s_sleep(1); \
    if ((++_sp & 255u) == 0u) { if (xb_ld(&(bar)[XB_TMO])) break; if (_sp > XB_SPIN_CAP) { atomicAdd(&(bar)[XB_TMO], 1u); break; } } } } while (0)
struct XcdBarrier { unsigned* bar; unsigned x; volatile LAS unsigned* st; };
__device__ __forceinline__ XcdBarrier xcd_barrier_post(unsigned* bar, volatile LAS unsigned* st) {
    XcdBarrier b; b.bar = bar; b.x = xb_xcc_id(); b.st = st;
    if (threadIdx.x == 0) (void)xb_add(&bar[XB_XCNT(b.x)], 1u);
    return b;
}
__device__ __forceinline__ void xcd_barrier_complete(unsigned* bar, unsigned x, unsigned& nloc, unsigned& nx) {
    const unsigned G = gridDim.x * gridDim.y * gridDim.z;
    unsigned sum, cnt, mine, sp = 0u;
    for (;;) {
        sum = 0u; cnt = 0u; mine = 0u;
#pragma unroll
        for (unsigned j = 0; j < 16; ++j) { const unsigned c = xb_ld(&bar[XB_XCNT(j)]); sum += c; cnt += (c > 0u) ? 1u : 0u; mine = (j == x) ? c : mine; }
        if (sum == G) break;
        __builtin_amdgcn_s_sleep(1);
        if ((++sp & 255u) == 0u) { if (xb_ld(&bar[XB_TMO])) break; if (sp > XB_SPIN_CAP) { atomicAdd(&bar[XB_TMO], 1u); break; } }
    }
    nloc = mine > 0u ? mine : 1u; nx = cnt > 0u ? cnt : 1u;
}
__device__ __forceinline__ void xcd_barrier(const XcdBarrier& b) {
    asm volatile("s_waitcnt vmcnt(0)" ::: "memory");
    __syncthreads();
    if (threadIdx.x == 0) {
        unsigned* bar = b.bar;
        __builtin_amdgcn_s_waitcnt(0);
        unsigned nloc = b.st[0], nx = b.st[1];
        if (nloc == 0u) { xcd_barrier_complete(bar, b.x, nloc, nx); b.st[0] = nloc; b.st[1] = nx; }
        const unsigned old = xb_add(&bar[XB_XSUB(b.x)], 1u);
        const unsigned gen = old / nloc;
        if (old + 1u == (gen + 1u) * nloc) {
            __builtin_amdgcn_fence(__ATOMIC_RELEASE, "agent");
            asm volatile("s_waitcnt vmcnt(0)" ::: "memory");
            const unsigned og = xb_add(&bar[XB_TOP], 1u);
            const unsigned tg = og / nx;
            if (og + 1u == (tg + 1u) * nx) xb_add(&bar[XB_TOPGEN], 1u);
            else XB_SPIN(xb_ld(&bar[XB_TOPGEN]) == tg, bar);
            __builtin_amdgcn_fence(__ATOMIC_ACQUIRE, "agent");
            xb_add(&bar[XB_XGEN(b.x)], 1u);
            asm volatile("s_waitcnt vmcnt(0)" ::: "memory");
        } else {
            XB_SPIN(xb_ld(&bar[XB_XGEN(b.x)]) == gen, bar);
            __builtin_amdgcn_fence(__ATOMIC_ACQUIRE, "agent");
            asm volatile("s_waitcnt vmcnt(0)" ::: "memory");
        }
    }
    __syncthreads();
}

struct Params { const float* in[26]; float* out; unsigned char* ws; int ph_lo, ph_hi; };
namespace pg8 {
#define PG8_LAS __attribute__((address_space(3)))
typedef unsigned short bf16_t;
typedef short bf16x8 __attribute__((ext_vector_type(8)));
typedef float f32x4 __attribute__((ext_vector_type(4)));
typedef unsigned u32x4 __attribute__((ext_vector_type(4)));
typedef unsigned u32x2 __attribute__((ext_vector_type(2)));
constexpr int BM = 256, BK = 64, HALF = 128, HTB = HALF * BK * 2, STAGE_BYTES = 8 * HTB, NXCD = 8, WGM = 8;

__host__ __device__ __forceinline__ int lds_byte(int r, int c) { const int st = (r >> 4) * 2 + (c >> 5), rr = r & 15, cc = c & 31, ob = rr * 64 + cc * 2; return st * 1024 + (ob ^ (((ob >> 9) & 1) << 5)); }
__host__ __device__ __forceinline__ void stage_rc(int b, int& R, int& C) { const int st = b / 1024, sb = b % 1024, swz = sb ^ (((sb >> 9) & 1) << 5); R = (st >> 1) * 16 + swz / 64; C = (st & 1) * 32 + (swz % 64) / 2; }
__host__ __device__ __forceinline__ int perm32(int rho) { const int n = rho >> 4, i = rho & 15; return 8 * (i >> 2) + 4 * n + (i & 3); }

struct Unit { int pm, pn; long boff; int mask, pad; };
struct Gemm { const bf16_t* A; const bf16_t* Bt; const int* rowtab; int lda, ldb, K, pad; };

__device__ __forceinline__ unsigned cvt_pk_bf16(float lo, float hi) { unsigned r; asm volatile("v_cvt_pk_bf16_f32 %0, %1, %2" : "=v"(r) : "v"(lo), "v"(hi)); return r; }

struct StaticOrder {
    int nM, nN, nwg, G, c, nfull, T; long bstep;
    __device__ void init(int nM_, int nN_, int G_, int c_, int ldb) { nM = nM_; nN = nN_; nwg = nM * nN; G = G_; c = c_; bstep = (long)BM * ldb * 2;
        T = 0; nfull = nwg; }
    __device__ bool next(int i, Unit& u) const {
        const long L = (long)i * G + c; int wgid, mask = 15;
        if (L < nfull) wgid = (int)L;
        else { const long j = L - nfull; if (j >= 2 * T) return false; wgid = nfull + (int)(j % T); mask = (j / T) ? 12 : 3; }
        { const int q = nwg / NXCD, r = nwg % NXCD, xcd = wgid % NXCD, off = wgid / NXCD; wgid = (xcd < r ? xcd * (q + 1) : r * (q + 1) + (xcd - r) * q) + off; }
        const int nig = WGM * nN, gid = wgid / nig, fm = gid * WGM, gsz = (nM - fm) < WGM ? (nM - fm) : WGM;
        u.pm = fm + ((wgid % nig) % gsz); u.pn = (wgid % nig) / gsz; u.boff = (long)u.pn * bstep; u.mask = mask; u.pad = i; return true;
    }
};

template <class Epi, class Sched>
__device__ __forceinline__ void gemm_phase(PG8_LAS unsigned char* lds, const Gemm g, const Sched& S, const Epi& E) {
    const int tid = threadIdx.x, wid = __builtin_amdgcn_readfirstlane(tid >> 6), lane = tid & 63, wr = wid >> 2, wc = wid & 3, fr = lane & 15, fq = lane >> 4;
    const int K = g.K, nt = K / BK;
    int Rr[2]; unsigned Cb[2], voffB[2];
#pragma unroll
    for (int i = 0; i < 2; ++i) { int R, C; stage_rc(tid * 16 + i * 8192, R, C); const int Rb = Epi::PERM ? ((R & ~31) + perm32(R & 31)) : R;
        Rr[i] = R; Cb[i] = (unsigned)C * 2u; voffB[i] = (unsigned)(Rb * g.ldb + C) * 2u; }
    const size_t kstep = (size_t)(BK * 2);
    const size_t hstepB = (size_t)HALF * g.ldb * 2;
    const unsigned lda2 = (unsigned)g.lda * 2u;
    const unsigned ldsw = (unsigned)wid * 1024u;
    const int aoff = lds_byte(wr * 64 + fr, fq * 8), boff = lds_byte(wc * 32 + fr, fq * 8);
    const char* const Abase = (const char*)g.A; const char* const Bbase = (const char*)g.Bt;
#define PG8_SA(b, h) (((b) * 2 + (h)) * HTB)
#define PG8_SB(b, h) ((4 + (b) * 2 + (h)) * HTB)
#define PG8_STAGE(bufoff, gbase, voff) do { _Pragma("unroll") for (int _i = 0; _i < 2; ++_i) \
        __builtin_amdgcn_global_load_lds((const unsigned*)((const char*)(gbase) + (voff)[_i]), (PG8_LAS unsigned*)(lds + (bufoff) + ldsw + _i * 8192), 16, 0, 0); } while (0)
#define PG8_VOFFA(u, v) do { _Pragma("unroll") for (int _h = 0; _h < 2; ++_h) _Pragma("unroll") for (int _i = 0; _i < 2; ++_i) { const int _gr = (u).pm * BM + _h * HALF + Rr[_i]; \
        const int _src = g.rowtab ? g.rowtab[_gr] : _gr; (v)[_h][_i] = (unsigned)_src * lda2 + Cb[_i]; } } while (0)
#define PG8_LDA(dst, b, h) do { _Pragma("unroll") for (int m = 0; m < 4; ++m) _Pragma("unroll") for (int k = 0; k < 2; ++k) dst[m][k] = *(const PG8_LAS bf16x8*)(lds + PG8_SA(b, h) + aoff + m * 2048 + k * 1024); } while (0)
#define PG8_LDB(dst, b, h) do { _Pragma("unroll") for (int n = 0; n < 2; ++n) _Pragma("unroll") for (int k = 0; k < 2; ++k) dst[n][k] = *(const PG8_LAS bf16x8*)(lds + PG8_SB(b, h) + boff + n * 2048 + k * 1024); } while (0)
#define PG8_MMA(ai, bj, At, Bt) do { { __builtin_amdgcn_s_setprio(1); _Pragma("unroll") for (int m = 0; m < 4; ++m) _Pragma("unroll") for (int n = 0; n < 2; ++n) _Pragma("unroll") for (int k = 0; k < 2; ++k) \
        acc[ai][bj][m][n] = __builtin_amdgcn_mfma_f32_16x16x32_bf16(Bt[n][k], At[m][k], acc[ai][bj][m][n], 0, 0, 0); __builtin_amdgcn_s_setprio(0); } } while (0)
#define PG8_WAIT_V(n) asm volatile("s_waitcnt vmcnt(" #n ")" ::: "memory")
#define PG8_WAIT_L(n) asm volatile("s_waitcnt lgkmcnt(" #n ")" ::: "memory")
#define PG8_BAR __builtin_amdgcn_s_barrier()
#define PG8_SCHED __builtin_amdgcn_sched_barrier(0)
    Unit cur, nxt; int ui = 0;
    if (!S.next(0, cur)) return;
    f32x4 acc[2][2][4][2];
#pragma unroll
    for (int a = 0; a < 2; ++a)
#pragma unroll
        for (int b = 0; b < 2; ++b)
#pragma unroll
            for (int m = 0; m < 4; ++m)
#pragma unroll
                for (int n = 0; n < 2; ++n) acc[a][b][m][n] = (f32x4){0.f, 0.f, 0.f, 0.f};
    bf16x8 At[4][2], B0[2][2], B1[2][2];
    unsigned cv[2][2], nv[2][2];
    PG8_VOFFA(cur, cv);
#pragma unroll
    for (int h = 0; h < 2; ++h) { nv[h][0] = cv[h][0]; nv[h][1] = cv[h][1]; }
    const char* cB = Bbase + cur.boff;
    PG8_STAGE(PG8_SB(0, 0), cB, voffB); PG8_STAGE(PG8_SB(0, 1), cB + hstepB, voffB); PG8_STAGE(PG8_SA(0, 0), Abase, cv[0]); PG8_STAGE(PG8_SA(0, 1), Abase, cv[1]);
    if (wr == 1) PG8_BAR;
    PG8_WAIT_V(2); PG8_BAR;
    PG8_STAGE(PG8_SB(1, 0), cB + kstep, voffB); PG8_STAGE(PG8_SA(1, 0), Abase + kstep, cv[0]); PG8_STAGE(PG8_SB(1, 1), cB + hstepB + kstep, voffB);
    PG8_WAIT_V(6); PG8_BAR;
    for (;;) {
        const bool has_next = S.next(ui + 1, nxt);
        const char* nB = has_next ? Bbase + nxt.boff : cB;
#pragma unroll 1
        for (int t = 0; t < nt; t += 2) {
            const bool last = (t == nt - 2);
            if constexpr (Epi::MIDK) { if (t == nt / 2) E.mid(acc, cur, wr, wc, fr, fq); }
            if (last && has_next) { PG8_VOFFA(nxt, nv); }
            const char* a1 = Abase + (size_t)(t + 1) * kstep;
            const char* a2 = Abase + (last ? (size_t)0 : (size_t)(t + 2) * kstep); const char* a3 = a2 + kstep;
            const char* b2 = last ? nB : cB + (size_t)(t + 2) * kstep; const char* b3 = b2 + kstep;
            unsigned x0[2], x1[2];
            x0[0] = last ? nv[0][0] : cv[0][0]; x0[1] = last ? nv[0][1] : cv[0][1]; x1[0] = last ? nv[1][0] : cv[1][0]; x1[1] = last ? nv[1][1] : cv[1][1];
            PG8_LDB(B0, 0, 0); PG8_LDB(B1, 0, 1); PG8_SCHED; PG8_LDA(At, 0, 0); PG8_STAGE(PG8_SA(1, 1), a1, cv[1]);
            PG8_WAIT_V(8); PG8_WAIT_L(0); PG8_BAR; PG8_MMA(0, 0, At, B0); PG8_MMA(0, 1, At, B1); PG8_BAR; PG8_SCHED;
            PG8_LDA(At, 0, 1); PG8_STAGE(PG8_SB(0, 0), b2, voffB); PG8_STAGE(PG8_SB(0, 1), b2 + hstepB, voffB); PG8_STAGE(PG8_SA(0, 0), a2, x0);
            PG8_WAIT_V(8); PG8_WAIT_L(0); PG8_BAR; PG8_MMA(1, 0, At, B0); PG8_MMA(1, 1, At, B1); PG8_BAR; PG8_SCHED;
            PG8_LDB(B0, 1, 0); PG8_LDB(B1, 1, 1); PG8_SCHED; PG8_LDA(At, 1, 0); PG8_STAGE(PG8_SA(0, 1), a2, x1);
            PG8_WAIT_V(8); PG8_WAIT_L(0); PG8_BAR; PG8_MMA(0, 0, At, B0); PG8_MMA(0, 1, At, B1); PG8_BAR; PG8_SCHED;
            PG8_LDA(At, 1, 1); PG8_STAGE(PG8_SB(1, 0), b3, voffB); PG8_STAGE(PG8_SB(1, 1), b3 + hstepB, voffB); PG8_STAGE(PG8_SA(1, 0), a3, x0);
            PG8_WAIT_V(8); PG8_WAIT_L(0); PG8_BAR; PG8_MMA(1, 0, At, B0); PG8_MMA(1, 1, At, B1); PG8_BAR; PG8_SCHED;
        }
        if (wr == 0) PG8_BAR;
        E(acc, cur, wr, wc, fr, fq);
        if (!has_next) break;
#pragma unroll
        for (int a = 0; a < 2; ++a)
#pragma unroll
            for (int b = 0; b < 2; ++b)
#pragma unroll
                for (int m = 0; m < 4; ++m)
#pragma unroll
                    for (int n = 0; n < 2; ++n) acc[a][b][m][n] = (f32x4){0.f, 0.f, 0.f, 0.f};
        cur = nxt; cB = nB; ++ui;
#pragma unroll
        for (int h = 0; h < 2; ++h) { cv[h][0] = nv[h][0]; cv[h][1] = nv[h][1]; }
        if (wr == 1) PG8_BAR;
    }
    PG8_WAIT_V(0);
    PG8_BAR;
#undef PG8_SA
#undef PG8_SB
#undef PG8_STAGE
#undef PG8_VOFFA
#undef PG8_LDA
#undef PG8_LDB
#undef PG8_MMA
#undef PG8_WAIT_V
#undef PG8_WAIT_L
#undef PG8_BAR
#undef PG8_SCHED
}
}
__device__ __forceinline__ void conv_tile(const float* __restrict__ src, int ldn, int k0, int n0, const float* __restrict__ kscale, int kfrom,
                                          bf16_t* __restrict__ dst, int dld, int drow0, LAS unsigned* T, int lane, int dk0 = -1) {
    if (dk0 < 0) dk0 = k0;
    const int c4 = lane & 15, kq = lane >> 4;
    f32x4 v0[8], v1[8];
#pragma unroll
    for (int j = 0; j < 8; ++j) { const int kp = kq + 4 * j; const float* p = src + (size_t)(k0 + 2 * kp) * ldn + n0 + c4 * 4;
        v0[j] = *(const f32x4*)p; v1[j] = *(const f32x4*)(p + ldn); }
#pragma unroll
    for (int j = 0; j < 8; ++j) { const int kp = kq + 4 * j; const int k = k0 + 2 * kp;
        float s0 = 1.f, s1 = 1.f; if (kscale && k >= kfrom) { s0 = kscale[k - kfrom]; s1 = kscale[k + 1 - kfrom]; }
#pragma unroll
        for (int q = 0; q < 4; ++q) T[(c4 * 4 + q) * 33 + kp] = pk2(v0[j][q] * s0, v1[j][q] * s1); }
    asm volatile("s_waitcnt lgkmcnt(0)" ::: "memory"); __builtin_amdgcn_wave_barrier();
    const int ch = lane & 7, nr = lane >> 3;
#pragma unroll
    for (int ps = 0; ps < 8; ++ps) { const int n = ps * 8 + nr; const LAS unsigned* t = T + n * 33 + ch * 4;
        v4u o; o.x = t[0]; o.y = t[1]; o.z = t[2]; o.w = t[3];
        *(v4u*)(dst + (size_t)(drow0 + n) * dld + dk0 + ch * 8) = o; }
    asm volatile("s_waitcnt lgkmcnt(0)" ::: "memory"); __builtin_amdgcn_wave_barrier();
}

__device__ __forceinline__ void conv_tile128(const float* __restrict__ src, int ldn, int k0, int n0, bf16_t* __restrict__ dst, int dld, int drow0, LAS unsigned* T, int lane) {
    const int c4 = lane & 15, kq = lane >> 4;
    f32x4 v0[16], v1[16];
#pragma unroll
    for (int j = 0; j < 16; ++j) { const int kp = kq + 4 * j; const float* q = src + (size_t)(k0 + 2 * kp) * ldn + n0 + c4 * 4;
        v0[j] = __builtin_nontemporal_load((const f32x4*)q); v1[j] = __builtin_nontemporal_load((const f32x4*)(q + ldn)); }
#pragma unroll
    for (int j = 0; j < 16; ++j) { const int kp = kq + 4 * j;
#pragma unroll
        for (int q = 0; q < 4; ++q) T[(c4 * 4 + q) * 65 + kp] = pk2(v0[j][q], v1[j][q]); }
    asm volatile("s_waitcnt lgkmcnt(0)" ::: "memory"); __builtin_amdgcn_wave_barrier();
    const int ch = lane & 15, nr = lane >> 4;
#pragma unroll
    for (int ps = 0; ps < 16; ++ps) { const int n = ps * 4 + nr; const LAS unsigned* t = T + n * 65 + ch * 4;
        v4u o; o.x = t[0]; o.y = t[1]; o.z = t[2]; o.w = t[3];
        __builtin_nontemporal_store(o, (v4u*)(dst + (size_t)(drow0 + n) * dld + k0 + ch * 8)); }
    asm volatile("s_waitcnt lgkmcnt(0)" ::: "memory"); __builtin_amdgcn_wave_barrier();
}

__device__ __forceinline__ void ada_item(const float* __restrict__ c, const float* __restrict__ w, float* __restrict__ modp, int item, int lane) {
    const int cc = item % 48, ks = item / 48, col = cc * 256 + lane * 4;
    f32x4 acc[4];
#pragma unroll
    for (int b = 0; b < 4; ++b) acc[b] = (f32x4){0.f, 0.f, 0.f, 0.f};
#pragma unroll 1
    for (int half = 0; half < 2; ++half) {
        const int k0 = ks * 128 + half * 64;
        float cd[4];
#pragma unroll
        for (int b = 0; b < 4; ++b) cd[b] = siluf_(c[b * DM + k0 + lane]);
        const float* wp = w + (size_t)k0 * MODW + col;
#pragma unroll 16
        for (int kk = 0; kk < 64; ++kk) { const f32x4 wv = __builtin_nontemporal_load((const f32x4*)(wp + (size_t)kk * MODW));
#pragma unroll
            for (int b = 0; b < 4; ++b) { const float s = __builtin_bit_cast(float, __builtin_amdgcn_readlane(__builtin_bit_cast(int, cd[b]), kk)); acc[b] += wv * s; } }
    }
#pragma unroll
    for (int b = 0; b < 4; ++b) *(f32x4*)(modp + ((size_t)ks * 4 + b) * MODW + col) = acc[b];
}

constexpr int CT_ADA = 48 * 16;
constexpr int CT_IN = 32 * 77, CT_UQ = 8 * 24, CT_KV = 4 * 32, CT_OUT = 32 * 32, CT_G1 = 16 * 8, CT_D1 = 4 * 32;
constexpr int CT_ZERO = 192 * 4;
constexpr int CT_GU = 65 * 2 * CT_G1, CT_DN = 65 * CT_D1;
constexpr int CT_GU_LATE = 0;
constexpr int CT_TOTAL0 = CT_ADA + CT_IN + CT_UQ + CT_KV + CT_OUT + CT_ZERO + (CT_GU - CT_GU_LATE) + CT_DN;
constexpr int CW_QGU = 8192, CW_QDN = 8192 + 512;

__device__ __forceinline__ void conv_gu_tile(const Params& p, int r, LAS unsigned* T, int lane) {
    const int e = r / (2 * CT_G1); int q = r % (2 * CT_G1);
    bf16_t* gu = (bf16_t*)(p.ws + WS_BT_GU) + (size_t)e * 1024 * DM;
    const int up = q >= CT_G1; q -= up * CT_G1; const int kb = q / 8, nb = q % 8, n0 = nb * 64;
    const float* src = (e < 64) ? p.in[up ? 21 : 20] + (size_t)e * DM * DE : p.in[up ? 24 : 23];
    conv_tile128(src, DE, kb * 128, n0, gu, DM, (n0 >> 7) * 256 + up * 128 + (n0 & 127), T, lane);
}
__device__ __forceinline__ void conv_dn_tile(const Params& p, int r, LAS unsigned* T, int lane) {
    const int e = r / CT_D1, q = r % CT_D1, kb = q / 32, nb = q % 32;
    bf16_t* dn = (bf16_t*)(p.ws + WS_BT_DN) + (size_t)e * DM * DE;
    const float* src = (e < 64) ? p.in[22] + (size_t)e * DE * DM : p.in[25];
    conv_tile128(src, DM, kb * 128, nb * 64, dn, DE, nb * 64, T, lane);
}
template <bool DN>
__device__ __forceinline__ void conv_queue(const Params& p, LAS unsigned char* lds, int wave, int lane, int first, int total) {
    LAS unsigned* T = (LAS unsigned*)(lds + wave * 18432);
    unsigned* heads = (unsigned*)(p.ws + WS_CTL) + (DN ? CW_QDN : CW_QGU);
    const int n = total - first, per = (n + 7) / 8, xcd = (int)xb_xcc_id() & 7;
    for (int s = 0; s < 8; ++s) {
        const int sh = (xcd + s) & 7, lo = first + sh * per, hi = (lo + per < total) ? lo + per : total;
        for (;;) {
            unsigned i = 0; if (lane == 0) i = __hip_atomic_fetch_add(heads + 64 * sh, 2u, __ATOMIC_RELAXED, __HIP_MEMORY_SCOPE_AGENT);
            const int r = lo + (int)__builtin_amdgcn_readfirstlane(i);
            if (r >= hi) break;
            if (DN) conv_dn_tile(p, r, T, lane); else conv_gu_tile(p, r, T, lane);
            if (r + 1 < hi) { if (DN) conv_dn_tile(p, r + 1, T, lane); else conv_gu_tile(p, r + 1, T, lane); }
        }
    }
}

__device__ __forceinline__ void phase0(const Params& p, LAS unsigned char* lds, int wave, int lane) {
    LAS unsigned* T = (LAS unsigned*)(lds + wave * 18432);
    unsigned char* ws = p.ws;
    float* modp = (float*)(ws + WS_MODP);
    const int gw = blockIdx.x * NWAVES + wave, NGW = gridDim.x * NWAVES;
    for (int it = gw; it < CT_TOTAL0; it += NGW) {
        int r = it;
        if (r < CT_ADA) { ada_item(p.in[1], p.in[3], modp, r, lane); continue; } r -= CT_ADA;
        if (r < CT_IN) { const int kb = r / 77, nb = r % 77; conv_tile(p.in[7], INC, kb * 64, nb * 64, nullptr, 0, (bf16_t*)(ws + WS_BT_IN), DM, nb * 64, T, lane); continue; } r -= CT_IN;
        if (r < CT_UQ) { const int kb = r / 24, nb = r % 24; conv_tile(p.in[11], 1536, kb * 64, nb * 64, p.in[10], 0, (bf16_t*)(ws + WS_BT_UQ), QR, nb * 64, T, lane); continue; } r -= CT_UQ;
        if (r < CT_KV) { const int kb = r / 32, nb = r % 32, n0 = nb * 64, h = n0 >> 8, j0 = n0 & 255; const int dr = (j0 < 128) ? h * 128 + j0 : 1024 + h * 128 + (j0 - 128);
                         conv_tile(p.in[13], 2048, kb * 64, n0, p.in[12], 0, (bf16_t*)(ws + WS_BT_KV), KVR, dr, T, lane); continue; } r -= CT_KV;
        if (r < CT_OUT) { const int kb = r / 32, nb = r % 32; conv_tile(p.in[17], DM, kb * 64, nb * 64, p.in[16], 1024, (bf16_t*)(ws + WS_BT_OUT), DM, nb * 64, T, lane, (kb * 64 + 1024) & 2047); continue; } r -= CT_OUT;
        if (r < CT_ZERO) { const int row = INC + (r >> 2), pc = r & 3; v4u z = {0u, 0u, 0u, 0u}; *(v4u*)((bf16_t*)(ws + WS_BT_IN) + (size_t)row * DM + pc * 512 + lane * 8) = z; continue; } r -= CT_ZERO;
        if (r < CT_GU - CT_GU_LATE) { conv_gu_tile(p, r, T, lane); continue; } r -= CT_GU - CT_GU_LATE;
        conv_dn_tile(p, r, T, lane);
    }
}

__device__ __forceinline__ void norm_mod_row(const float* __restrict__ hrow, const float* __restrict__ g, const float* __restrict__ sc, const float* __restrict__ sh, bf16_t* __restrict__ urow, int lane) {
    f32x4 v[8]; float s = 0.f;
#pragma unroll
    for (int j = 0; j < 8; ++j) { v[j] = *(const f32x4*)(hrow + lane * 4 + 256 * j); s += (v[j].x * v[j].x + v[j].y * v[j].y) + (v[j].z * v[j].z + v[j].w * v[j].w); }
    const float r = rsqrtf(wave_sum(s) * (1.f / DM) + EPS);
#pragma unroll
    for (int j = 0; j < 8; ++j) { const int col = lane * 4 + 256 * j; const f32x4 gv = *(const f32x4*)(g + col), sv = *(const f32x4*)(sc + col), hv = *(const f32x4*)(sh + col);
        const f32x4 o = v[j] * r * gv * (sv + 1.f) + hv; v2u w; w.x = pk2(o.x, o.y); w.y = pk2(o.z, o.w); *(v2u*)(urow + col) = w; }
}
__device__ __forceinline__ float mod_reduce(const float* __restrict__ modp, const float* __restrict__ bias, int v) {
    float s = bias[v % MODW];
#pragma unroll
    for (int ks = 0; ks < 16; ++ks) s += modp[(size_t)ks * 4 * MODW + v];
    return s;
}
__device__ __forceinline__ void phase1(const Params& p, LAS unsigned char* lds, int wave, int lane) {
    const float* modp = (const float*)(p.ws + WS_MODP); float* mod = (float*)(p.ws + CTL_MOD); bf16_t* u16 = (bf16_t*)(p.ws + WS_U16);
    LAS float* sm = (LAS float*)lds;
    const int G = gridDim.x;
    for (int v = blockIdx.x * NTHR + threadIdx.x; v < NB * MODW; v += G * NTHR) mod[v] = mod_reduce(modp, p.in[4], v);
    for (int tb = blockIdx.x; tb < NT / 32; tb += G) {
        const int b = (tb * 32) / SEQ;
        __syncthreads();
        for (int i = threadIdx.x; i < 2 * DM; i += NTHR) sm[i] = mod_reduce(modp, p.in[4], b * MODW + i);
        __syncthreads();
#pragma unroll 1
        for (int rr = 0; rr < 4; ++rr) { const int t = tb * 32 + wave * 4 + rr;
            const float* hrow = p.in[0] + (size_t)t * DM; const float* g = p.in[5];
            f32x4 v[8]; float s = 0.f;
#pragma unroll
            for (int j = 0; j < 8; ++j) { v[j] = *(const f32x4*)(hrow + lane * 4 + 256 * j); s += (v[j].x * v[j].x + v[j].y * v[j].y) + (v[j].z * v[j].z + v[j].w * v[j].w); }
            const float r = rsqrtf(wave_sum(s) * (1.f / DM) + EPS);
#pragma unroll
            for (int j = 0; j < 8; ++j) { const int col = lane * 4 + 256 * j; const f32x4 gv = *(const f32x4*)(g + col);
                const f32x4 hv = *(const LAS f32x4*)(sm + col), sv = *(const LAS f32x4*)(sm + DM + col);
                const f32x4 o = v[j] * r * gv * (sv + 1.f) + hv; v2u w; w.x = pk2(o.x, o.y); w.y = pk2(o.z, o.w); *(v2u*)(u16 + (size_t)t * DM + col) = w; }
        }
    }
}

struct EpiInProj { static constexpr bool PERM = true, MIDK = false; bf16_t* O; float* ssq_q8; float* ssq_kv4;
    __device__ __forceinline__ void operator()(const pg8::f32x4 (&acc)[2][2][4][2], const pg8::Unit& u, int wr, int wc, int fr, int fq) const {
        const int row0 = u.pm * 256 + wr * 64 + fr, col0 = u.pn * 256 + wc * 32 + 8 * fq;
        const bool sq = (u.pn >= 16 && u.pn <= 18);
#pragma unroll
        for (int ai = 0; ai < 2; ++ai)
#pragma unroll
            for (int m = 0; m < 4; ++m) { if (!(u.mask & (3 << (ai * 2)))) continue; const int row = row0 + ai * 128 + m * 16; bf16_t* rowp = O + (size_t)row * INCP + col0; float ss = 0.f;
#pragma unroll
                for (int bj = 0; bj < 2; ++bj) { const pg8::f32x4 v0 = acc[ai][bj][m][0], v1 = acc[ai][bj][m][1];
                    v4u w; w.x = pk2(v0[0], v0[1]); w.y = pk2(v0[2], v0[3]); w.z = pk2(v1[0], v1[1]); w.w = pk2(v1[2], v1[3]);
                    *(v4u*)(rowp + bj * 128) = w;
                    ss += (v0[0] * v0[0] + v0[1] * v0[1]) + (v0[2] * v0[2] + v0[3] * v0[3]) + (v1[0] * v1[0] + v1[1] * v1[1]) + (v1[2] * v1[2] + v1[3] * v1[3]); }
                if (sq) { ss += __shfl_xor(ss, 16); ss += __shfl_xor(ss, 32);
                    if (fq == 0) { if (u.pn == 18) ssq_kv4[row * 4 + wc] = ss; else ssq_q8[row * 8 + (u.pn - 16) * 4 + wc] = ss; } } }
    }
};
__device__ __forceinline__ void phase2(const Params& p, LAS unsigned char* lds) {
    unsigned char* ws = p.ws;
    pg8::Gemm g{(const bf16_t*)(ws + WS_U16), (const bf16_t*)(ws + WS_BT_IN), nullptr, DM, DM, DM, 0};
    pg8::StaticOrder S; S.init(NT / 256, INCP / 256, gridDim.x, blockIdx.x, DM);
    EpiInProj E{(bf16_t*)(ws + WS_PROJ), (float*)(ws + TAB_SSQ_Q8), (float*)(ws + TAB_SSQ_KV4)};
    pg8::gemm_phase<EpiInProj, pg8::StaticOrder>((PG8_LAS unsigned char*)lds, g, S, E);
}
struct EpiBf16Store { static constexpr bool PERM = true, MIDK = false; bf16_t* O; int ldc, pad;
    __device__ __forceinline__ void operator()(const pg8::f32x4 (&acc)[2][2][4][2], const pg8::Unit& u, int wr, int wc, int fr, int fq) const {
        const int row0 = u.pm * 256 + wr * 64 + fr, col0 = u.pn * 256 + wc * 32 + 8 * fq;
#pragma unroll
        for (int ai = 0; ai < 2; ++ai)
#pragma unroll
            for (int m = 0; m < 4; ++m) { if (!(u.mask & (3 << (ai * 2)))) continue; bf16_t* rowp = O + (size_t)(row0 + ai * 128 + m * 16) * ldc + col0;
#pragma unroll
                for (int bj = 0; bj < 2; ++bj) { const pg8::f32x4 v0 = acc[ai][bj][m][0], v1 = acc[ai][bj][m][1];
                    v4u w; w.x = pk2(v0[0], v0[1]); w.y = pk2(v0[2], v0[3]); w.z = pk2(v1[0], v1[1]); w.w = pk2(v1[2], v1[3]); *(v4u*)(rowp + bj * 128) = w; } }
    }
};
struct EpiVt { static constexpr bool PERM = true, MIDK = false; bf16_t* Vt; const float* ssq_kv4;
    __device__ __forceinline__ void operator()(const pg8::f32x4 (&acc)[2][2][4][2], const pg8::Unit& u, int wr, int wc, int fr, int fq) const {
        const int row0 = u.pm * 256 + wr * 64 + fr, col0 = u.pn * 256 + wc * 32 + 8 * fq;
        const int pb = (col0 & ~15) + 4 * (fq & 1);
#pragma unroll
        for (int bj = 0; bj < 2; ++bj) {
            float rs[8];
#pragma unroll
            for (int j = 0; j < 8; ++j) { const pg8::f32x4 s4 = *(const pg8::f32x4*)(ssq_kv4 + (size_t)(col0 + bj * 128 + j) * 4); rs[j] = rsqrtf(((s4[0] + s4[1]) + (s4[2] + s4[3])) * (1.f / KVR) + EPS); }
#pragma unroll
            for (int ai = 0; ai < 2; ++ai)
#pragma unroll
                for (int m = 0; m < 4; ++m) { if (!(u.mask & (1 << (ai * 2 + bj)))) continue; bf16_t* rowp = Vt + (size_t)(row0 + ai * 128 + m * 16) * NT + pb + bj * 128;
                    const pg8::f32x4 v0 = acc[ai][bj][m][0], v1 = acc[ai][bj][m][1];
                    v2u a, b; a.x = pk2(v0[0] * rs[0], v0[1] * rs[1]); a.y = pk2(v0[2] * rs[2], v0[3] * rs[3]);
                    b.x = pk2(v1[0] * rs[4], v1[1] * rs[5]); b.y = pk2(v1[2] * rs[6], v1[3] * rs[7]);
                    *(v2u*)(rowp) = a; *(v2u*)(rowp + 8) = b; }
        }
    }
};
__device__ __forceinline__ void phase3_gemms(const Params& p, LAS unsigned char* lds) {
    unsigned char* ws = p.ws; const int G = gridDim.x, c = blockIdx.x;
    const bf16_t* proj = (const bf16_t*)(ws + WS_PROJ);
    { pg8::Gemm g{proj + 4096, (const bf16_t*)(ws + WS_BT_UQ), nullptr, INCP, QR, QR, 0};
      pg8::StaticOrder S; S.init(NT / 256, 6, G, c, QR); EpiBf16Store E{(bf16_t*)(ws + WS_QRAW), 1536, 0};
      pg8::gemm_phase<EpiBf16Store, pg8::StaticOrder>((PG8_LAS unsigned char*)lds, g, S, E); }
    { pg8::Gemm g{proj + 4608, (const bf16_t*)(ws + WS_BT_KV), nullptr, INCP, KVR, KVR, 0};
      pg8::StaticOrder S; S.init(NT / 256, 4, G, (c + 64) % G, KVR); EpiBf16Store E{(bf16_t*)(ws + WS_KRAW), 1024, 0};
      pg8::gemm_phase<EpiBf16Store, pg8::StaticOrder>((PG8_LAS unsigned char*)lds, g, S, E); }
    { pg8::Gemm g{(const bf16_t*)(ws + WS_BT_KV) + 1024 * KVR, proj + 4608, nullptr, KVR, INCP, KVR, 0};
      pg8::StaticOrder S; S.init(4, NT / 256, G, (c + 192) % G, INCP); EpiVt E{(bf16_t*)(ws + WS_VT), (const float*)(ws + TAB_SSQ_KV4)};
      pg8::gemm_phase<EpiVt, pg8::StaticOrder>((PG8_LAS unsigned char*)lds, g, S, E); }
}

constexpr float QSCALE = 0.07216878364870323f * 1.4426950408889634f;
__device__ __forceinline__ void phase4_qk(const Params& p, int wave, int lane) {
    unsigned char* ws = p.ws;
    const bf16_t* qraw = (const bf16_t*)(ws + WS_QRAW); const bf16_t* kraw = (const bf16_t*)(ws + WS_KRAW); const bf16_t* proj = (const bf16_t*)(ws + WS_PROJ);
    const float* ssq_q8 = (const float*)(ws + TAB_SSQ_Q8); const float* ssq_kv4 = (const float*)(ws + TAB_SSQ_KV4);
    const int* pos = (const int*)p.in[2]; const float* qg = p.in[14]; const float* kg = p.in[15];
    bf16_t* Q16 = (bf16_t*)(ws + WS_Q16); bf16_t* K16 = (bf16_t*)(ws + WS_K16);
    const float g0q = qg[lane], g1q = qg[64 + lane], g2q = qg[128 + lane], g0k = kg[lane], g1k = kg[64 + lane], g2k = kg[128 + lane];
    const int i = lane & 31; const float inv = exp2f(-(float)i * (13.287712379549449f / 32.f));
    const int gw = blockIdx.x * NWAVES + wave, NGW = gridDim.x * NWAVES;
    for (int it = gw; it < NT * MH; it += NGW) {
        const int t = it >> 3, h = it & 7, b = t / SEQ, s = t % SEQ;
        const pg8::f32x4 qa = *(const pg8::f32x4*)(ssq_q8 + (size_t)t * 8), qb = *(const pg8::f32x4*)(ssq_q8 + (size_t)t * 8 + 4), ka = *(const pg8::f32x4*)(ssq_kv4 + (size_t)t * 4);
        const float rq = rsqrtf((((qa[0] + qa[1]) + (qa[2] + qa[3])) + ((qb[0] + qb[1]) + (qb[2] + qb[3]))) * (1.f / QR) + EPS), rkv = rsqrtf(((ka[0] + ka[1]) + (ka[2] + ka[3])) * (1.f / KVR) + EPS);
        float q0 = bf2f(qraw[(size_t)t * 1536 + h * 192 + lane]) * rq, q1 = bf2f(qraw[(size_t)t * 1536 + h * 192 + 64 + lane]) * rq, q2 = bf2f(qraw[(size_t)t * 1536 + h * 192 + 128 + lane]) * rq;
        float k0 = bf2f(kraw[(size_t)t * 1024 + h * 128 + lane]) * rkv, k1 = bf2f(kraw[(size_t)t * 1024 + h * 128 + 64 + lane]) * rkv, k2 = bf2f(proj[(size_t)t * INCP + 4864 + lane]);
        const float sq = wave_sum(q0 * q0 + q1 * q1 + q2 * q2), sk = wave_sum(k0 * k0 + k1 * k1 + k2 * k2);
        const float nq = rsqrtf(sq * (1.f / 192.f) + EPS) * QSCALE, nk = rsqrtf(sk * (1.f / 192.f) + EPS);
        q0 *= nq * g0q; q1 *= nq * g1q; q2 *= nq * g2q; k0 *= nk * g0k; k1 *= nk * g1k; k2 *= nk * g2k;
        const float ang = (float)pos[t] * inv; const float rev = ang * 0.15915494309189535f; const float fr_ = rev - floorf(rev); const float sn = __builtin_amdgcn_sinf(fr_), cs = __builtin_amdgcn_cosf(fr_);
        const float q2o = __shfl_xor(q2, 32), k2o = __shfl_xor(k2, 32);
        const float q2r = lane < 32 ? q2 * cs - q2o * sn : q2 * cs + q2o * sn;
        const float k2r = lane < 32 ? k2 * cs - k2o * sn : k2 * cs + k2o * sn;
        const size_t base = ((size_t)(b * MH + h) * SEQ + s) * QKD;
        Q16[base + lane] = (bf16_t)f2bf(q0); Q16[base + 64 + lane] = (bf16_t)f2bf(q1); Q16[base + 128 + lane] = (bf16_t)f2bf(q2r);
        K16[base + lane] = (bf16_t)f2bf(k0); K16[base + 64 + lane] = (bf16_t)f2bf(k1); K16[base + 128 + lane] = (bf16_t)f2bf(k2r);
    }
}

typedef short bf16x8 __attribute__((ext_vector_type(8)));
typedef float f32x16 __attribute__((ext_vector_type(16)));
constexpr int AT_KP = 400, AT_VP = 144, AT_KB = 64 * AT_KP, AT_VB = 128 * AT_VP, AT_BUF = AT_KB + AT_VB;
__device__ __forceinline__ void phase5_attn(const Params& p, LAS unsigned char* lds, int wave, int lane) {
    unsigned char* ws = p.ws;
    const bf16_t* Q16 = (const bf16_t*)(ws + WS_Q16); const bf16_t* K16 = (const bf16_t*)(ws + WS_K16); const bf16_t* Vt = (const bf16_t*)(ws + WS_VT);
    bf16_t* merged = (bf16_t*)(ws + WS_MERGED); float* ssq_o8 = (float*)(ws + TAB_SSQ_O8);
    const int tid = threadIdx.x, cl = lane & 31, hh = lane >> 5, qsub = wave & 3, kpar = wave >> 2;
    float mq = 0.f, mk = 0.f;
    for (int i = 0; i < 3; ++i) { mq = fmaxf(mq, fabsf(p.in[14][lane + 64 * i])); mk = fmaxf(mk, fabsf(p.in[15][lane + 64 * i])); }
#pragma unroll
    for (int o = 1; o < 64; o <<= 1) { mq = fmaxf(mq, __shfl_xor(mq, o)); mk = fmaxf(mk, __shfl_xor(mk, o)); }
    const float negc0 = -(13.856406460551018f * 1.4426950408889634f * 1.02f) * mq * mk;
    int kso[3], vso[2]; size_t vgo[2];
#pragma unroll
    for (int i = 0; i < 3; ++i) { const int c = tid + 512 * i; kso[i] = (c / 24) * AT_KP + (c % 24) * 16; }
#pragma unroll
    for (int i = 0; i < 2; ++i) { const int c = tid + 512 * i, dv = c >> 3, ch = c & 7; vso[i] = AT_KB + dv * AT_VP + ch * 16; vgo[i] = (size_t)dv * NT * 2 + ch * 16; }
    for (int item = blockIdx.x; item < 256; item += gridDim.x) {
        const int bh = item >> 3, x = item & 7, b = bh >> 3, h = bh & 7;
        const char* Qg = (const char*)(Q16 + (size_t)bh * SEQ * QKD); const char* Kg = (const char*)(K16 + (size_t)bh * SEQ * QKD);
        const char* Vg = (const char*)(Vt + (size_t)(h * 128) * NT + b * SEQ);
#pragma unroll 1
        for (int pass = 0; pass < 2; ++pass) {
            const int qi = pass == 0 ? 15 - x : x, nsteps = 2 * (qi + 1), qrow0 = qi * 128 + qsub * 32;
            bf16x8 Qf[12];
#pragma unroll
            for (int ks = 0; ks < 12; ++ks) Qf[ks] = *(const bf16x8*)(Qg + ((size_t)(qrow0 + cl) * QKD + ks * 16 + hh * 8) * 2);
            f32x16 O[4];
#pragma unroll
            for (int vb = 0; vb < 4; ++vb)
#pragma unroll
                for (int r = 0; r < 16; ++r) O[vb][r] = 0.f;
            float lsum = 0.f;
            v4u kr[3], vr[2];
#define AT_LOAD(j) do { _Pragma("unroll") for (int i_ = 0; i_ < 3; ++i_) kr[i_] = *(const v4u*)(Kg + (size_t)(j) * 24576 + (size_t)(tid + 512 * i_) * 16); \
                        _Pragma("unroll") for (int i_ = 0; i_ < 2; ++i_) vr[i_] = *(const v4u*)(Vg + vgo[i_] + (size_t)(j) * 128); } while (0)
#define AT_WRITE(bo) do { _Pragma("unroll") for (int i_ = 0; i_ < 3; ++i_) *(LAS v4u*)(lds + (bo) + kso[i_]) = kr[i_]; \
                          _Pragma("unroll") for (int i_ = 0; i_ < 2; ++i_) *(LAS v4u*)(lds + (bo) + vso[i_]) = vr[i_]; } while (0)
            AT_LOAD(0); AT_WRITE(0); __syncthreads();
#pragma unroll 1
            for (int j = 0; j < nsteps; ++j) {
                const int bo = (j & 1) * AT_BUF;
                if (j + 1 < nsteps) AT_LOAD(j + 1);
                const int key0 = 64 * j + 32 * kpar;
                if (key0 <= qrow0 + 31) {
                    f32x16 S;
#pragma unroll
                    for (int r = 0; r < 16; ++r) S[r] = negc0;
                    const LAS unsigned char* kb = lds + bo + (32 * kpar + cl) * AT_KP + hh * 16;
#pragma unroll
                    for (int ks = 0; ks < 12; ++ks) { const bf16x8 a = *(const LAS bf16x8*)(kb + ks * 32); S = __builtin_amdgcn_mfma_f32_32x32x16_bf16(a, Qf[ks], S, 0, 0, 0); }
                    const bool diag = key0 + 31 > qrow0;
                    float pr[16];
#pragma unroll
                    for (int r = 0; r < 16; ++r) { float e = __builtin_amdgcn_exp2f(S[r]);
                        if (diag) { const int key = key0 + (r & 3) + 8 * (r >> 2) + 4 * hh; if (key > qrow0 + cl) e = 0.f; }
                        pr[r] = e; lsum += e; }
                    bf16x8 Pf[2];
#pragma unroll
                    for (int s = 0; s < 2; ++s) { v4u w; w.x = pk2(pr[8 * s + 0], pr[8 * s + 1]); w.y = pk2(pr[8 * s + 2], pr[8 * s + 3]); w.z = pk2(pr[8 * s + 4], pr[8 * s + 5]); w.w = pk2(pr[8 * s + 6], pr[8 * s + 7]);
                        Pf[s] = __builtin_bit_cast(bf16x8, w); }
                    const LAS unsigned char* vbp = lds + bo + AT_KB + cl * AT_VP + (32 * kpar + 8 * hh) * 2;
#pragma unroll
                    for (int vb = 0; vb < 4; ++vb)
#pragma unroll
                        for (int s = 0; s < 2; ++s) { const bf16x8 a = *(const LAS bf16x8*)(vbp + vb * 32 * AT_VP + s * 32); O[vb] = __builtin_amdgcn_mfma_f32_32x32x16_bf16(a, Pf[s], O[vb], 0, 0, 0); }
                }
                if (j + 1 < nsteps) AT_WRITE(((j + 1) & 1) * AT_BUF);
                __syncthreads();
            }
            LAS float* X = (LAS float*)lds;
            if (kpar == 1) {
#pragma unroll
                for (int vb = 0; vb < 4; ++vb)
#pragma unroll
                    for (int r = 0; r < 16; ++r) X[(qsub * 65 + vb * 16 + r) * 64 + lane] = O[vb][r];
                X[(qsub * 65 + 64) * 64 + lane] = lsum;
            }
            __syncthreads();
            if (kpar == 0) {
                float l = lsum + X[(qsub * 65 + 64) * 64 + lane];
                l += __shfl_xor(l, 32);
                const float il = 1.f / l; float ss = 0.f;
                const int t = b * SEQ + qrow0 + cl;
                bf16_t* op = merged + (size_t)t * DM + h * 128 + 4 * hh;
#pragma unroll
                for (int vb = 0; vb < 4; ++vb)
#pragma unroll
                    for (int rq = 0; rq < 4; ++rq) { float o[4];
#pragma unroll
                        for (int r3 = 0; r3 < 4; ++r3) { const int r = rq * 4 + r3; o[r3] = (O[vb][r] + X[(qsub * 65 + vb * 16 + r) * 64 + lane]) * il; ss += o[r3] * o[r3]; }
                        v2u w; w.x = pk2(o[0], o[1]); w.y = pk2(o[2], o[3]); *(v2u*)(op + vb * 32 + rq * 8) = w; }
                ss += __shfl_xor(ss, 32);
                if (hh == 0) ssq_o8[(size_t)t * 8 + h] = ss;
            }
            __syncthreads();
        }
    }
#undef AT_LOAD
#undef AT_WRITE
}

__device__ __forceinline__ void phase6_scale(const Params& p, int wave, int lane) {
    unsigned char* ws = p.ws; bf16_t* merged = (bf16_t*)(ws + WS_MERGED); const float* ssq_o8 = (const float*)(ws + TAB_SSQ_O8);
    const int gw = blockIdx.x * NWAVES + wave, NGW = gridDim.x * NWAVES;
    for (int t = gw; t < NT; t += NGW) { const pg8::f32x4 oa = *(const pg8::f32x4*)(ssq_o8 + (size_t)t * 8), ob = *(const pg8::f32x4*)(ssq_o8 + (size_t)t * 8 + 4);
        const float r = rsqrtf((((oa[0] + oa[1]) + (oa[2] + oa[3])) + ((ob[0] + ob[1]) + (ob[2] + ob[3]))) * (1.f / 1024.f) + EPS);
#pragma unroll
        for (int j = 0; j < 2; ++j) { v4u* q = (v4u*)(merged + (size_t)t * DM + 1024 + j * 512 + lane * 8); v4u y = *q;
            y.x = pk2(bflo(y.x) * r, bfhi(y.x) * r); y.y = pk2(bflo(y.y) * r, bfhi(y.y) * r); y.z = pk2(bflo(y.z) * r, bfhi(y.z) * r); y.w = pk2(bflo(y.w) * r, bfhi(y.w) * r); *q = y; } }
}

struct EpiResidF32 { static constexpr bool PERM = false, MIDK = true; const float* x; const float* gate; float* out; const LAS float* rs;
    __device__ __forceinline__ void mid(pg8::f32x4 (&acc)[2][2][4][2], const pg8::Unit& u, int wr, int wc, int fr, int fq) const {
        const LAS float* rp = rs + u.pad * 256 + wr * 64 + fr;
#pragma unroll
        for (int ai = 0; ai < 2; ++ai)
#pragma unroll
            for (int m = 0; m < 4; ++m) { const float r = rp[ai * 128 + m * 16];
#pragma unroll
                for (int bj = 0; bj < 2; ++bj)
#pragma unroll
                    for (int n = 0; n < 2; ++n) acc[ai][bj][m][n] = acc[ai][bj][m][n] * r; }
    }
    __device__ __forceinline__ void operator()(const pg8::f32x4 (&acc)[2][2][4][2], const pg8::Unit& u, int wr, int wc, int fr, int fq) const {
        const int row0 = u.pm * 256 + wr * 64 + fr, col0 = u.pn * 256 + wc * 32 + 4 * fq;
        const float* gp = gate + (size_t)((u.pm * 256) / SEQ) * MODW + col0;
        pg8::f32x4 gv[2][2];
#pragma unroll
        for (int bj = 0; bj < 2; ++bj)
#pragma unroll
            for (int n = 0; n < 2; ++n) gv[bj][n] = *(const pg8::f32x4*)(gp + bj * 128 + n * 16);
#pragma unroll
        for (int ai = 0; ai < 2; ++ai)
#pragma unroll
            for (int m = 0; m < 4; ++m) { if (!(u.mask & (3 << (ai * 2)))) continue; const size_t ro = (size_t)(row0 + ai * 128 + m * 16) * DM + col0;
#pragma unroll
                for (int bj = 0; bj < 2; ++bj)
#pragma unroll
                    for (int n = 0; n < 2; ++n) { const pg8::f32x4 xv = *(const pg8::f32x4*)(x + ro + bj * 128 + n * 16); *(pg8::f32x4*)(out + ro + bj * 128 + n * 16) = xv + gv[bj][n] * acc[ai][bj][m][n]; } }
    }
};
__device__ __forceinline__ void phase7(const Params& p, LAS unsigned char* lds) {
    unsigned char* ws = p.ws;
    pg8::Gemm g{(const bf16_t*)(ws + WS_MERGED), (const bf16_t*)(ws + WS_BT_OUT), nullptr, DM, DM, DM, 0};
    pg8::StaticOrder S; S.init(NT / 256, DM / 256, gridDim.x, blockIdx.x, DM);
    LAS float* rs = (LAS float*)(lds + RING_BYTES + 12288);
    { const float* ssq_o8 = (const float*)(ws + TAB_SSQ_O8); pg8::Unit u;
      for (int i = 0; i < 4 && S.next(i, u); ++i) if (threadIdx.x < 256) { const float* sp = ssq_o8 + (size_t)(u.pm * 256 + threadIdx.x) * 8; const pg8::f32x4 oa = *(const pg8::f32x4*)sp, ob = *(const pg8::f32x4*)(sp + 4);
          rs[i * 256 + threadIdx.x] = rsqrtf((((oa[0] + oa[1]) + (oa[2] + oa[3])) + ((ob[0] + ob[1]) + (ob[2] + ob[3]))) * (1.f / 1024.f) + EPS); }
      __syncthreads(); }
    EpiResidF32 E{p.in[0], (const float*)(ws + CTL_MOD) + 2 * DM, (float*)(ws + WS_H1), rs};
    pg8::gemm_phase<EpiResidF32, pg8::StaticOrder>((PG8_LAS unsigned char*)lds, g, S, E);
}
constexpr int HG_P = 272, HG_VP = 144;
constexpr int HG_A2 = 0, HG_A1 = 17408, HG_QB = 34816, HG_VT = 52224, HG_KT = 70656, HG_SEG = 89088, HG_RS = 91136, HG_FL = 92160, HG_QT = 109568;
struct HgPre { v4u fl[2], q[2], v[2]; };
template <bool NEEDQ>
__device__ __forceinline__ void hg_issue(const bf16_t* __restrict__ proj, int item, HgPre& P) {
    const int bh = item >> 5, c = item & 31, b = bh >> 3, h = bh & 7, t0 = b * SEQ + c * 64, tid = threadIdx.x;
#pragma unroll
    for (int i = 0; i < 2; ++i) { const int ch = tid + 512 * i, t = ch >> 4, c16 = ch & 15; const bf16_t* rp = proj + (size_t)(t0 + t) * INCP + h * 128 + c16 * 8;
        P.fl[i] = *(const v4u*)(rp + 1024); P.v[i] = *(const v4u*)(rp + 2048); if (NEEDQ) P.q[i] = *(const v4u*)rp; }
}
struct HgCol { float kv[16]; float b[16]; float blast, bmid; };
template <bool NEEDQ, bool PERM>
__device__ __forceinline__ void hg_stage(const HgPre& P, const float* __restrict__ lbl, int h, LAS unsigned char* lds, HgCol& C) {
    const int tid = threadIdx.x, k = tid & 127, seg = tid >> 7;
    __syncthreads();
#pragma unroll
    for (int i = 0; i < 2; ++i) { const int ch = tid + 512 * i, t = ch >> 4, c16 = ch & 15;
        *(LAS v4u*)(lds + HG_FL + t * HG_P + c16 * 16) = P.fl[i]; if (NEEDQ) *(LAS v4u*)(lds + HG_QT + t * HG_P + c16 * 16) = P.q[i];
        const v4u w = P.v[i]; const int o = t & 15, pos = PERM ? ((t & ~15) + 8 * ((o >> 2) & 1) + 4 * ((o >> 3) & 1) + (o & 3)) : t;
        LAS unsigned short* vp = (LAS unsigned short*)(lds + HG_VT + (c16 * 8) * HG_VP + (((pos >> 3) ^ (c16 & 7)) * 16) + (pos & 7) * 2);
        vp[0 * (HG_VP / 2)] = (unsigned short)(w.x & 0xffff); vp[1 * (HG_VP / 2)] = (unsigned short)(w.x >> 16);
        vp[2 * (HG_VP / 2)] = (unsigned short)(w.y & 0xffff); vp[3 * (HG_VP / 2)] = (unsigned short)(w.y >> 16);
        vp[4 * (HG_VP / 2)] = (unsigned short)(w.z & 0xffff); vp[5 * (HG_VP / 2)] = (unsigned short)(w.z >> 16);
        vp[6 * (HG_VP / 2)] = (unsigned short)(w.w & 0xffff); vp[7 * (HG_VP / 2)] = (unsigned short)(w.w >> 16); }
    const float l0 = lbl[h * 128 + k], l1 = lbl[1024 + h * 128 + k];
    const float lb = 1.f / (1.f + __expf(l1 - l0));
    __syncthreads();
    const LAS unsigned short* fp = (const LAS unsigned short*)(lds + HG_FL + (seg * 16) * HG_P + k * 2);
    float run = 0.f;
#pragma unroll
    for (int i = 0; i < 16; ++i) { const float fl = bf2f(fp[i * (HG_P / 2)]); const float f = lb + (1.f - lb) / (1.f + __expf(-fl)); C.kv[i] = 1.f - f; run += __logf(f); C.b[i] = run; }
    LAS float* SEG = (LAS float*)(lds + HG_SEG);
    SEG[seg * 128 + k] = run;
    __syncthreads();
    const float s0 = SEG[k], s1 = SEG[128 + k], s2 = SEG[256 + k], s3 = SEG[384 + k];
    const float off = (seg > 0 ? s0 : 0.f) + (seg > 1 ? s1 : 0.f) + (seg > 2 ? s2 : 0.f);
#pragma unroll
    for (int i = 0; i < 16; ++i) C.b[i] += off;
    C.bmid = s0 + s1; C.blast = (s0 + s1) + (s2 + s3);
}
__device__ __forceinline__ void hgrn_pass1(const Params& p, LAS unsigned char* lds, int wave, int lane) {
    unsigned char* ws = p.ws; const bf16_t* proj = (const bf16_t*)(ws + WS_PROJ);
    bf16_t* hgU = (bf16_t*)(ws + WS_HGU); float* hgd = (float*)(ws + TAB_HGD);
    const int tid = threadIdx.x, k = tid & 127, seg = tid >> 7, cl = lane & 31, hh = lane >> 5, G = gridDim.x;
    HgPre P; if ((int)blockIdx.x < 1024) hg_issue<false>(proj, blockIdx.x, P);
    for (int item = blockIdx.x; item < 1024; item += G) {
        const int h = (item >> 5) & 7;
        HgCol C; hg_stage<false, false>(P, p.in[8], h, lds, C);
        if (item + G < 1024) hg_issue<false>(proj, item + G, P);
        { unsigned w[8];
#pragma unroll
          for (int i = 0; i < 8; ++i) { const float a0 = C.kv[2 * i] * __expf(C.blast - C.b[2 * i]), a1 = C.kv[2 * i + 1] * __expf(C.blast - C.b[2 * i + 1]); w[i] = pk2(a0, a1); }
          LAS v4u* kp = (LAS v4u*)(lds + HG_KT + k * HG_VP + seg * 32); kp[0] = (v4u){w[0], w[1], w[2], w[3]}; kp[1] = (v4u){w[4], w[5], w[6], w[7]}; }
        if (seg == 0) hgd[item * 128 + k] = __expf(C.blast);
        __syncthreads();
        const int vb = wave >> 1;
        bf16x8 af[4];
#pragma unroll
        for (int ks = 0; ks < 4; ++ks) af[ks] = *(const LAS bf16x8*)(lds + HG_VT + (32 * vb + cl) * HG_VP + (((2 * ks + hh) ^ ((cl >> 3) & 3) ^ ((vb & 1) << 2)) * 16));
#pragma unroll
        for (int q = 0; q < 2; ++q) { const int kb = (wave & 1) * 2 + q; f32x16 acc;
#pragma unroll
            for (int r = 0; r < 16; ++r) acc[r] = 0.f;
#pragma unroll
            for (int ks = 0; ks < 4; ++ks) { const bf16x8 bfr = *(const LAS bf16x8*)(lds + HG_KT + (32 * kb + cl) * HG_VP + (16 * ks + 8 * hh) * 2); acc = __builtin_amdgcn_mfma_f32_32x32x16_bf16(af[ks], bfr, acc, 0, 0, 0); }
            bf16_t* up = hgU + (size_t)item * 16384 + 32 * kb + cl;
#pragma unroll
            for (int r = 0; r < 16; ++r) { const int v = 32 * vb + (r & 3) + 8 * (r >> 2) + 4 * hh; up[(size_t)v * 128] = (bf16_t)f2bf(acc[r]); } }
    }
}
__device__ __forceinline__ void hgrn_scan(const Params& p) {
    unsigned char* ws = p.ws; bf16_t* hgU = (bf16_t*)(ws + WS_HGU); const float* hgd = (const float*)(ws + TAB_HGD);
    for (int i = blockIdx.x * NTHR + threadIdx.x; i < 32 * 4096; i += gridDim.x * NTHR) {
        const int bh = i >> 12, e4 = i & 4095, k4 = (e4 & 31) * 4;
        float S[4] = {0.f, 0.f, 0.f, 0.f};
        v2u* up = (v2u*)(hgU + (size_t)bh * 32 * 16384 + (size_t)e4 * 4); const float* dp = hgd + (size_t)bh * 32 * 128 + k4;
#pragma unroll 1
        for (int c0 = 0; c0 < 32; c0 += 8) { v2u u[8]; f32x4 d[8];
#pragma unroll
            for (int j = 0; j < 8; ++j) { u[j] = up[(size_t)(c0 + j) * 4096]; d[j] = *(const f32x4*)(dp + (c0 + j) * 128); }
#pragma unroll
            for (int j = 0; j < 8; ++j) { v2u o; o.x = pk2(S[0], S[1]); o.y = pk2(S[2], S[3]); up[(size_t)(c0 + j) * 4096] = o;
                S[0] = d[j][0] * S[0] + bflo(u[j].x); S[1] = d[j][1] * S[1] + bfhi(u[j].x); S[2] = d[j][2] * S[2] + bflo(u[j].y); S[3] = d[j][3] * S[3] + bfhi(u[j].y); } }
    }
}
__device__ __forceinline__ void hgrn_pass3(const Params& p, LAS unsigned char* lds, int wave, int lane) {
    unsigned char* ws = p.ws; const bf16_t* proj = (const bf16_t*)(ws + WS_PROJ);
    const bf16_t* hgS = (const bf16_t*)(ws + WS_HGU); bf16_t* merged = (bf16_t*)(ws + WS_MERGED); const float* og = p.in[9];
    const int tid = threadIdx.x, k = tid & 127, seg = tid >> 7, cl = lane & 31, hh = lane >> 5, vb = wave & 3, tb = wave >> 2, G = gridDim.x;
    HgPre P; if ((int)blockIdx.x < 1024) hg_issue<true>(proj, blockIdx.x, P);
    for (int item = blockIdx.x; item < 1024; item += G) {
        const int bh = item >> 5, c = item & 31, b = bh >> 3, h = bh & 7, t0 = b * SEQ + c * 64;
        bf16x8 sf[8]; v2u gw[4];
        { const bf16_t* sp = hgS + (size_t)item * 16384 + (size_t)(32 * vb + cl) * 128 + 8 * hh;
#pragma unroll
          for (int ks = 0; ks < 8; ++ks) sf[ks] = *(const bf16x8*)(sp + 16 * ks);
          const int t = t0 + 32 * tb + cl;
#pragma unroll
          for (int rq = 0; rq < 4; ++rq) gw[rq] = *(const v2u*)(proj + (size_t)t * INCP + 3072 + h * 128 + 32 * vb + 8 * rq + 4 * hh); }
        HgCol C; hg_stage<true, true>(P, p.in[8], h, lds, C);
        { const LAS unsigned short* qp = (const LAS unsigned short*)(lds + HG_QT + (seg * 16) * HG_P + k * 2);
          LAS unsigned short* a2 = (LAS unsigned short*)(lds + HG_A2 + (seg * 16) * HG_P + k * 2);
          LAS unsigned short* a1 = (LAS unsigned short*)(lds + HG_A1 + (seg * 16) * HG_P + k * 2);
          LAS unsigned short* qb = (LAS unsigned short*)(lds + HG_QB + (seg * 16) * HG_P + k * 2);
          const float em = __expf(-C.bmid), ep = __expf(C.bmid);
#pragma unroll
          for (int i = 0; i < 16; i += 2) { const float q0 = bf2f(qp[i * (HG_P / 2)]), q1 = bf2f(qp[(i + 1) * (HG_P / 2)]);
              const float e0 = __expf(C.b[i]), e1 = __expf(C.b[i + 1]);
              const unsigned wa2 = pk2(C.kv[i] * ep * __builtin_amdgcn_rcpf(e0), C.kv[i + 1] * ep * __builtin_amdgcn_rcpf(e1));
              const unsigned wa1 = pk2(q0 * e0 * em, q1 * e1 * em), wqb = pk2(q0 * e0, q1 * e1);
              a2[i * (HG_P / 2)] = (unsigned short)(wa2 & 0xffff); a2[(i + 1) * (HG_P / 2)] = (unsigned short)(wa2 >> 16);
              a1[i * (HG_P / 2)] = (unsigned short)(wa1 & 0xffff); a1[(i + 1) * (HG_P / 2)] = (unsigned short)(wa1 >> 16);
              qb[i * (HG_P / 2)] = (unsigned short)(wqb & 0xffff); qb[(i + 1) * (HG_P / 2)] = (unsigned short)(wqb >> 16); } }
        __syncthreads();
        if (item + G < 1024) hg_issue<true>(proj, item + G, P);
        f32x16 O;
#pragma unroll
        for (int r = 0; r < 16; ++r) O[r] = 0.f;
#pragma unroll
        for (int ks = 0; ks < 8; ++ks) { const bf16x8 bq = *(const LAS bf16x8*)(lds + HG_QB + (32 * tb + cl) * HG_P + (16 * ks + 8 * hh) * 2); O = __builtin_amdgcn_mfma_f32_32x32x16_bf16(sf[ks], bq, O, 0, 0, 0); }
#pragma unroll
        for (int sb = 0; sb < 2; ++sb) {
            if (sb <= tb) {
                f32x16 X;
#pragma unroll
                for (int r = 0; r < 16; ++r) X[r] = 0.f;
#pragma unroll
                for (int ks = 0; ks < 8; ++ks) { const bf16x8 a = *(const LAS bf16x8*)(lds + HG_A2 + (32 * sb + cl) * HG_P + (16 * ks + 8 * hh) * 2);
                    const bf16x8 bq = *(const LAS bf16x8*)(lds + HG_A1 + (32 * tb + cl) * HG_P + (16 * ks + 8 * hh) * 2); X = __builtin_amdgcn_mfma_f32_32x32x16_bf16(a, bq, X, 0, 0, 0); }
                if (sb == tb) {
#pragma unroll
                    for (int r = 0; r < 16; ++r) { const int s = (r & 3) + 8 * (r >> 2) + 4 * hh; if (s > cl) X[r] = 0.f; } }
#pragma unroll
                for (int s2 = 0; s2 < 2; ++s2) { v4u w; w.x = pk2(X[8 * s2 + 0], X[8 * s2 + 1]); w.y = pk2(X[8 * s2 + 2], X[8 * s2 + 3]); w.z = pk2(X[8 * s2 + 4], X[8 * s2 + 5]); w.w = pk2(X[8 * s2 + 6], X[8 * s2 + 7]);
                    const bf16x8 a = *(const LAS bf16x8*)(lds + HG_VT + (32 * vb + cl) * HG_VP + (((4 * sb + 2 * s2 + hh) ^ ((cl >> 3) & 3) ^ ((vb & 1) << 2)) * 16));
                    O = __builtin_amdgcn_mfma_f32_32x32x16_bf16(a, __builtin_bit_cast(bf16x8, w), O, 0, 0, 0); }
            }
        }
        float ss = 0.f;
#pragma unroll
        for (int r = 0; r < 16; ++r) ss += O[r] * O[r];
        ss += __shfl_xor(ss, 32);
        LAS float* RS = (LAS float*)(lds + HG_RS);
        if (hh == 0) RS[(tb * 4 + vb) * 32 + cl] = ss;
        __syncthreads();
        const float tot = (RS[(tb * 4 + 0) * 32 + cl] + RS[(tb * 4 + 1) * 32 + cl]) + (RS[(tb * 4 + 2) * 32 + cl] + RS[(tb * 4 + 3) * 32 + cl]);
        const float rn = rsqrtf(tot * (1.f / 128.f) + EPS);
        const int t = t0 + 32 * tb + cl;
#pragma unroll
        for (int rq = 0; rq < 4; ++rq) { const int v = 32 * vb + 8 * rq + 4 * hh; const f32x4 gg = *(const f32x4*)(og + v);
            const float g0 = bflo(gw[rq].x), g1 = bfhi(gw[rq].x), g2 = bflo(gw[rq].y), g3 = bfhi(gw[rq].y);
            const float o0 = O[rq * 4 + 0] * rn * gg[0] * (g0 / (1.f + __expf(-g0))), o1 = O[rq * 4 + 1] * rn * gg[1] * (g1 / (1.f + __expf(-g1)));
            const float o2 = O[rq * 4 + 2] * rn * gg[2] * (g2 / (1.f + __expf(-g2))), o3 = O[rq * 4 + 3] * rn * gg[3] * (g3 / (1.f + __expf(-g3)));
            v2u w; w.x = pk2(o0, o1); w.y = pk2(o2, o3); *(v2u*)(merged + (size_t)t * DM + 1024 + h * 128 + v) = w; }
    }
}
typedef float f32x2v __attribute__((ext_vector_type(2)));
constexpr int UPITCH = 2050;
constexpr int LDS_HIST = RING_BYTES + 1024;
__device__ __forceinline__ void phase8(const Params& p, LAS unsigned char* lds, int wave, int lane) {
    unsigned char* ws = p.ws;
    const float* h1 = (const float*)(ws + WS_H1); const float* mod = (const float*)(ws + CTL_MOD);
    bf16_t* u16 = (bf16_t*)(ws + WS_U16);
    const float* wr_ = p.in[18]; const float* rbias = p.in[19];
    int* top_idx = (int*)(ws + TAB_TOPI); float* top_w = (float*)(ws + TAB_TOPW); int* slot = (int*)(ws + TAB_SLOT);
    LAS float* U = (LAS float*)lds;
    LAS int* hist = (LAS int*)(lds + LDS_HIST);
    if (threadIdx.x < 64) hist[threadIdx.x] = 0;
    __syncthreads();
    for (int task = blockIdx.x; task < NT / 16; task += gridDim.x) {
        const int t0 = task * 16;
        { f32x4 v[2][8];
#pragma unroll
          for (int rr = 0; rr < 2; ++rr) { const float* hrow = h1 + (size_t)(t0 + wave * 2 + rr) * DM;
#pragma unroll
              for (int j = 0; j < 8; ++j) v[rr][j] = *(const f32x4*)(hrow + lane * 4 + 256 * j); }
#pragma unroll
          for (int rr = 0; rr < 2; ++rr) {
            const int tl = wave * 2 + rr, t = t0 + tl, b = t / SEQ;
            const float* g = p.in[6]; const float* sc = mod + b * MODW + 4 * DM; const float* sh = mod + b * MODW + 3 * DM;
            float s = 0.f;
#pragma unroll
            for (int j = 0; j < 8; ++j) s += (v[rr][j].x * v[rr][j].x + v[rr][j].y * v[rr][j].y) + (v[rr][j].z * v[rr][j].z + v[rr][j].w * v[rr][j].w);
            const float r = rsqrtf(wave_sum(s) * (1.f / DM) + EPS);
#pragma unroll
            for (int j = 0; j < 8; ++j) { const int col = lane * 4 + 256 * j; const f32x4 gv = *(const f32x4*)(g + col), sv = *(const f32x4*)(sc + col), hv = *(const f32x4*)(sh + col);
                const f32x4 o = v[rr][j] * r * gv * (sv + 1.f) + hv; v2u w; w.x = pk2(o.x, o.y); w.y = pk2(o.z, o.w); *(v2u*)(u16 + (size_t)t * DM + col) = w;
                LAS f32x2v* up = (LAS f32x2v*)(U + tl * UPITCH + col); up[0] = (f32x2v){o.x, o.y}; up[1] = (f32x2v){o.z, o.w}; }
          } }
        __syncthreads();
        f32x4 acc[4];
#pragma unroll
        for (int c = 0; c < 4; ++c) acc[c] = (f32x4){0.f, 0.f, 0.f, 0.f};
        { const int kb = wave * 256 + (lane >> 4); const LAS float* ua = U + (lane & 15) * UPITCH + kb; const float* wb = wr_ + (size_t)kb * NE + 4 * (lane & 15);
#pragma unroll 1
          for (int k16 = 0; k16 < 64; k16 += 16) { f32x4 bv[16];
#pragma unroll
              for (int q = 0; q < 16; ++q) bv[q] = *(const f32x4*)(wb + (size_t)(k16 + q) * 4 * NE);
#pragma unroll
              for (int q = 0; q < 16; ++q) { const float a = ua[(k16 + q) * 4];
#pragma unroll
                  for (int c = 0; c < 4; ++c) acc[c] = __builtin_amdgcn_mfma_f32_16x16x4f32(a, bv[q][c], acc[c], 0, 0, 0); } } }
        __syncthreads();
        LAS float* P = (LAS float*)lds;
#pragma unroll
        for (int c = 0; c < 4; ++c)
#pragma unroll
            for (int r = 0; r < 4; ++r) P[wave * 1024 + ((lane >> 4) * 4 + r) * 64 + 4 * (lane & 15) + c] = acc[c][r];
        __syncthreads();
        LAS float* LG = (LAS float*)(lds + 32768);
#pragma unroll
        for (int q = 0; q < 2; ++q) { const int i = threadIdx.x + q * NTHR; float s = 0.f;
#pragma unroll
            for (int w = 0; w < 8; ++w) s += P[w * 1024 + i]; LG[i] = s; }
        __syncthreads();
#pragma unroll 1
        for (int rr = 0; rr < 2; ++rr) {
            const int tl = wave * 2 + rr, t = t0 + tl;
            const float sc = 1.f / (1.f + expf(-LG[tl * 64 + lane])); const float sel = sc + rbias[lane];
            float m1 = sel; m1 = fmaxf(m1, __shfl_xor(m1, 1)); m1 = fmaxf(m1, __shfl_xor(m1, 2)); m1 = fmaxf(m1, __shfl_xor(m1, 4));
            const unsigned long long gm = 0xFFull << (lane & 56);
            const int first = __ffsll((long long)(__ballot(sel == m1) & gm)) - 1;
            float m2 = (lane == first) ? -INFINITY : sel; m2 = fmaxf(m2, __shfl_xor(m2, 1)); m2 = fmaxf(m2, __shfl_xor(m2, 2)); m2 = fmaxf(m2, __shfl_xor(m2, 4));
            const float gs = m1 + m2; const int g = lane >> 3; int grank = 0;
#pragma unroll
            for (int gg = 0; gg < 8; ++gg) { const float og = __builtin_bit_cast(float, __builtin_amdgcn_readlane(__builtin_bit_cast(int, gs), gg * 8)); grank += (og > gs || (og == gs && gg < g)) ? 1 : 0; }
            const bool gsel = grank < 4; const float msel = gsel ? sel : -INFINITY; int rk = 0;
#pragma unroll
            for (int e = 0; e < 64; ++e) { const float o = __builtin_bit_cast(float, __builtin_amdgcn_readlane(__builtin_bit_cast(int, msel), e)); rk += (o > msel || (o == msel && e < lane)) ? 1 : 0; }
            const bool chosen = gsel && rk < 8;
            const unsigned long long cb = __ballot(chosen);
            const float wsum = wave_sum(chosen ? sc : 0.f);
            const int ks = __popcll(cb & ((1ull << lane) - 1ull));
            if (chosen) { const int lr = __hip_atomic_fetch_add((int*)(hist + lane), 1, __ATOMIC_RELAXED, __HIP_MEMORY_SCOPE_WORKGROUP); top_idx[t * 8 + ks] = lane; top_w[t * 8 + ks] = sc / wsum * 2.5f; slot[t * 8 + ks] = lr; }
        }
        __syncthreads();
    }
    if (threadIdx.x < 64) ((int*)(ws + CTL_HIST))[blockIdx.x * 64 + threadIdx.x] = hist[threadIdx.x];
}

__device__ __forceinline__ void phase9(const Params& p, LAS unsigned char* lds, int wave, int lane) {
    unsigned char* ws = p.ws;
    const int* bh = (const int*)(ws + CTL_HIST);
    int* top_idx = (int*)(ws + TAB_TOPI); int* slot = (int*)(ws + TAB_SLOT); int* row_tok = (int*)(ws + TAB_ROWTOK); int* tile_exp = (int*)(ws + TAB_TILEEXP);
    LAS int* rb = (LAS int*)(lds + LDS_HIST + 256);
    const int G = gridDim.x;
    {
        LAS int* part = (LAS int*)(lds + LDS_HIST + 2048);
        const int e = threadIdx.x & 63, pt = threadIdx.x >> 6, per = (G + 7) / 8, b0 = pt * per, b1 = (b0 + per < G) ? b0 + per : G;
        int cnt = 0, base = 0;
#pragma unroll 8
        for (int b = b0; b < b1; ++b) { const int v = bh[b * 64 + e]; base += (b < (int)blockIdx.x) ? v : 0; cnt += v; }
        part[pt * 64 + e] = cnt; part[512 + pt * 64 + e] = base;
    }
    __syncthreads();
    if (wave == 0) {
        LAS int* part = (LAS int*)(lds + LDS_HIST + 2048);
        int cnt = 0, base = 0;
#pragma unroll
        for (int q = 0; q < 8; ++q) { cnt += part[q * 64 + lane]; base += part[512 + q * 64 + lane]; }
        const int tiles = (cnt + 255) >> 8;
        int incl = tiles;
#pragma unroll
        for (int o = 1; o < 64; o <<= 1) { const int n = __shfl_up(incl, o); if (lane >= o) incl += n; }
        const int toff = incl - tiles;
        rb[lane] = toff * 256 + base;
        if (blockIdx.x == 0) { for (int i = 0; i < tiles; ++i) tile_exp[toff + i] = lane; if (lane == 63) tile_exp[512] = incl; if (lane < 32) tile_exp[320 + lane] = 64; }
        rb[64 + lane] = toff * 256 + cnt; rb[128 + lane] = (toff + tiles) * 256;
    }
    __syncthreads();
    for (int e = blockIdx.x; e < 64; e += G) { const int lo = rb[64 + e], hi = rb[128 + e]; for (int r = lo + (int)threadIdx.x; r < hi; r += NTHR) row_tok[r] = 0; }
    for (int i = blockIdx.x * NTHR + threadIdx.x; i < NT; i += G * NTHR) row_tok[ROUTED_ROWS_MAX + i] = i;
    for (int task = blockIdx.x; task < NT / 16; task += G) {
        const int t = task * 16 + wave * 2 + (lane >> 3), k = lane & 7;
        if (lane < 16) { const int e = top_idx[t * 8 + k]; const int pos = rb[e] + slot[t * 8 + k]; slot[t * 8 + k] = pos; row_tok[pos] = t; }
    }
}

constexpr int LDS_UNITS = RING_BYTES + 8192;
struct MoeOrder {
    LAS int* tab; int n;
    __device__ void init(LAS unsigned char* lds, const int* tile_exp, int nN, int G, int c, long estride, int ldb, int parts) {
        tab = (LAS int*)(lds + LDS_UNITS);
        const int ntr = tile_exp[512], nwg = (ntr + 32) * nN; const long bstep = (long)256 * ldb * 2;
        int T = nwg % G, nfull = nwg - T; if (true) { nfull = nwg; T = 0; }
        const int njobs = nfull + parts * T;
        const int i = threadIdx.x; n = 0;
        if (c < njobs) n = (njobs - 1 - c) / G + 1;
        if (i < 32 && i < n) {
            const int L = i * G + c; int wgid, mask = 15;
            if (L < nfull) wgid = L; else { const int j = L - nfull; wgid = nfull + j % T; const int part = j / T; mask = (parts == 2) ? (part ? 12 : 3) : (1 << part); }
            { const int q = nwg / 8, r = nwg % 8, xcd = wgid % 8, off = wgid / 8; wgid = (xcd < r ? xcd * (q + 1) : r * (q + 1) + (xcd - r) * q) + off; }
            const int ti = wgid / nN, pn = wgid % nN; int tile, e; if (ti < ntr) { tile = ti; e = tile_exp[ti]; } else { tile = 320 + (ti - ntr); e = 64; }
            const long boff = (long)e * estride + (long)pn * bstep;
            tab[i * 8 + 0] = tile; tab[i * 8 + 1] = pn; tab[i * 8 + 2] = (int)(boff & 0xffffffffl); tab[i * 8 + 3] = (int)(boff >> 32); tab[i * 8 + 4] = mask;
        }
        __syncthreads();
    }
    __device__ bool next(int i, pg8::Unit& u) const {
        if (i >= n) return false;
        u.pm = tab[i * 8 + 0]; u.pn = tab[i * 8 + 1]; u.boff = (long)(((unsigned long long)(unsigned)tab[i * 8 + 3] << 32) | (unsigned)tab[i * 8 + 2]); u.mask = tab[i * 8 + 4]; u.pad = 0; return true;
    }
};
struct EpiGateUp { static constexpr bool PERM = true, MIDK = false; bf16_t* H;
    __device__ __forceinline__ void operator()(const pg8::f32x4 (&acc)[2][2][4][2], const pg8::Unit& u, int wr, int wc, int fr, int fq) const {
        const int row0 = u.pm * 256 + wr * 64 + fr, col0 = u.pn * 128 + wc * 32 + 8 * fq;
#pragma unroll
        for (int ai = 0; ai < 2; ++ai)
#pragma unroll
            for (int m = 0; m < 4; ++m) { if (!(u.mask & (3 << (ai * 2)))) continue; const int row = row0 + ai * 128 + m * 16; float o[8];
#pragma unroll
                for (int n = 0; n < 2; ++n)
#pragma unroll
                    for (int j = 0; j < 4; ++j) { const float gt = acc[ai][0][m][n][j], up = acc[ai][1][m][n][j]; o[n * 4 + j] = gt / (1.f + __expf(-gt)) * up; }
                v4u w; w.x = pk2(o[0], o[1]); w.y = pk2(o[2], o[3]); w.z = pk2(o[4], o[5]); w.w = pk2(o[6], o[7]);
                *(v4u*)(H + (size_t)row * DE + col0) = w; }
    }
};
struct EpiDown { static constexpr bool PERM = true, MIDK = false; bf16_t* Y;
    __device__ __forceinline__ void operator()(const pg8::f32x4 (&acc)[2][2][4][2], const pg8::Unit& u, int wr, int wc, int fr, int fq) const {
        const int row0 = u.pm * 256 + wr * 64 + fr, col0 = u.pn * 256 + wc * 32 + 8 * fq;
#pragma unroll
        for (int ai = 0; ai < 2; ++ai)
#pragma unroll
            for (int m = 0; m < 4; ++m) { const int row = row0 + ai * 128 + m * 16; bf16_t* rowp = Y + (size_t)row * DM + col0;
#pragma unroll
                for (int bj = 0; bj < 2; ++bj) { if (!(u.mask & (1 << (ai * 2 + bj)))) continue; const pg8::f32x4 v0 = acc[ai][bj][m][0], v1 = acc[ai][bj][m][1];
                    v4u w; w.x = pk2(v0[0], v0[1]); w.y = pk2(v0[2], v0[3]); w.z = pk2(v1[0], v1[1]); w.w = pk2(v1[2], v1[3]); *(v4u*)(rowp + bj * 128) = w; } }
    }
};
__device__ __forceinline__ void phase10(const Params& p, LAS unsigned char* lds) {
    unsigned char* ws = p.ws;
    pg8::Gemm g{(const bf16_t*)(ws + WS_U16), (const bf16_t*)(ws + WS_BT_GU), (const int*)(ws + TAB_ROWTOK), DM, DM, DM, 0};
    MoeOrder S; S.init(lds, (const int*)(ws + TAB_TILEEXP), 4, gridDim.x, blockIdx.x, (long)1024 * DM * 2, DM, 2);
    EpiGateUp E{(bf16_t*)(ws + WS_HID)};
    pg8::gemm_phase<EpiGateUp, MoeOrder>((PG8_LAS unsigned char*)lds, g, S, E);
}
__device__ __forceinline__ void phase11(const Params& p, LAS unsigned char* lds) {
    unsigned char* ws = p.ws;
    pg8::Gemm g{(const bf16_t*)(ws + WS_HID), (const bf16_t*)(ws + WS_BT_DN), nullptr, DE, DE, DE, 0};
    MoeOrder S; S.init(lds, (const int*)(ws + TAB_TILEEXP), 8, gridDim.x, blockIdx.x, (long)DM * DE * 2, DE, 4);
    EpiDown E{(bf16_t*)(ws + WS_Y)};
    pg8::gemm_phase<EpiDown, MoeOrder>((PG8_LAS unsigned char*)lds, g, S, E);
}
__device__ __forceinline__ void phase12(const Params& p, int wave, int lane) {
    unsigned char* ws = p.ws;
    const float* h1 = (const float*)(ws + WS_H1); const float* mod = (const float*)(ws + CTL_MOD); const bf16_t* Y = (const bf16_t*)(ws + WS_Y);
    const int* slot = (const int*)(ws + TAB_SLOT); const float* top_w = (const float*)(ws + TAB_TOPW);
    const int gw = blockIdx.x * NWAVES + wave, NGW = gridDim.x * NWAVES;
    for (int t = gw; t < NT; t += NGW) {
        const int b = t / SEQ; const float* gt = mod + b * MODW + 5 * DM;
        int sl = 0; float wk = 0.f; if (lane < 8) { sl = slot[t * 8 + lane]; wk = top_w[t * 8 + lane]; }
#pragma unroll 1
        for (int j = 0; j < 4; ++j) {
            const int col = j * 512 + lane * 8; float a[8];
            { const v4u y = __builtin_nontemporal_load((const v4u*)(Y + (size_t)(ROUTED_ROWS_MAX + t) * DM + col)); a[0] = bflo(y.x); a[1] = bfhi(y.x); a[2] = bflo(y.y); a[3] = bfhi(y.y); a[4] = bflo(y.z); a[5] = bfhi(y.z); a[6] = bflo(y.w); a[7] = bfhi(y.w); }
#pragma unroll
            for (int k = 0; k < 8; ++k) { const int s = __builtin_amdgcn_readlane(sl, k); const float w = __builtin_bit_cast(float, __builtin_amdgcn_readlane(__builtin_bit_cast(int, wk), k));
                const v4u y = __builtin_nontemporal_load((const v4u*)(Y + (size_t)s * DM + col));
                a[0] += w * bflo(y.x); a[1] += w * bfhi(y.x); a[2] += w * bflo(y.y); a[3] += w * bfhi(y.y); a[4] += w * bflo(y.z); a[5] += w * bfhi(y.z); a[6] += w * bflo(y.w); a[7] += w * bfhi(y.w); }
            const f32x4 h0 = *(const f32x4*)(h1 + (size_t)t * DM + col), h4 = *(const f32x4*)(h1 + (size_t)t * DM + col + 4);
            const f32x4 g0 = *(const f32x4*)(gt + col), g4 = *(const f32x4*)(gt + col + 4);
            f32x4 o0, o4; o0.x = h0.x + g0.x * a[0]; o0.y = h0.y + g0.y * a[1]; o0.z = h0.z + g0.z * a[2]; o0.w = h0.w + g0.w * a[3];
            o4.x = h4.x + g4.x * a[4]; o4.y = h4.y + g4.y * a[5]; o4.z = h4.z + g4.z * a[6]; o4.w = h4.w + g4.w * a[7];
            __builtin_nontemporal_store(o0, (f32x4*)(p.out + (size_t)t * DM + col)); __builtin_nontemporal_store(o4, (f32x4*)(p.out + (size_t)t * DM + col + 4));
        }
    }
}

__global__ void __launch_bounds__(NTHR, 2) k_mega(Params p) {
    extern __shared__ __attribute__((aligned(16))) unsigned char lds_raw[];
    LAS unsigned char* lds = (LAS unsigned char*)lds_raw;
    const int tid = threadIdx.x, lane = tid & 63, wave = __builtin_amdgcn_readfirstlane(tid >> 6);
    volatile LAS unsigned* MISC = (volatile LAS unsigned*)(lds + MISC_OFF);
    for (int u = tid; u < (LDS_BYTES - RING_BYTES) / 4; u += NTHR) ((LAS unsigned*)(lds + RING_BYTES))[u] = 0u;
    __syncthreads();
    XcdBarrier bar = xcd_barrier_post((unsigned*)(p.ws + WS_CTL) + CW_BAR, MISC + 8);
    const int lo = p.ph_lo, hi = p.ph_hi;
#ifndef DUP_MASK
#define DUP_MASK 0
#endif
#define IN(k) (lo <= (k) && (k) < hi)
#define DUPK(k, body) do { if (IN(k)) { body; if ((DUP_MASK >> (k)) & 1) { xcd_barrier(bar); body; } } } while (0)
#define SEAM(k) do { if (IN(k) && IN((k) + 1)) xcd_barrier(bar); } while (0)
    DUPK(0, phase0(p, lds, wave, lane)); SEAM(0);
    DUPK(1, phase1(p, lds, wave, lane)); SEAM(1);
#ifdef EXTRA_BARS
    for (int eb = 0; eb < EXTRA_BARS; ++eb) xcd_barrier(bar);
#endif
    DUPK(2, phase2(p, lds)); SEAM(2);
    DUPK(3, phase3_gemms(p, lds); hgrn_pass1(p, lds, wave, lane)); SEAM(3);
    DUPK(4, hgrn_scan(p); phase4_qk(p, wave, lane); if ((DUP_MASK >> 17) & 1) { xcd_barrier(bar); phase4_qk(p, wave, lane); }); SEAM(4);
    DUPK(5, phase5_attn(p, lds, wave, lane); hgrn_pass3(p, lds, wave, lane); if ((DUP_MASK >> 16) & 1) { xcd_barrier(bar); hgrn_pass3(p, lds, wave, lane); }); if (IN(5) && IN(7)) xcd_barrier(bar);
    DUPK(7, phase7(p, lds)); SEAM(7);
    DUPK(8, phase8(p, lds, wave, lane)); SEAM(8);
    DUPK(9, phase9(p, lds, wave, lane)); SEAM(9);
    DUPK(10, phase10(p, lds)); SEAM(10);
    DUPK(11, phase11(p, lds)); SEAM(11);
    DUPK(12, phase12(p, wave, lane));
#undef IN
#undef SEAM
}
extern "C" void kernel_launch(void* const* d_in, const int* in_sizes, int n_in, void* d_out, int out_size, void* d_ws, size_t ws_size, hipStream_t stream) {
    static int grid = 0;
    if (grid == 0) {
        int dev = 0, cus = 0;
        if (hipGetDevice(&dev) != hipSuccess || hipDeviceGetAttribute(&cus, hipDeviceAttributeMultiprocessorCount, dev) != hipSuccess) { grid = -1; return; }
        if (hipFuncSetAttribute((const void*)k_mega, hipFuncAttributeMaxDynamicSharedMemorySize, LDS_BYTES) != hipSuccess) { fprintf(stderr, "kernel_launch: hipFuncSetAttribute failed\n"); grid = -1; return; }
        (void)hipGetLastError();
        grid = cus;
        if (n_in != 26 || ws_size < WS_END) { fprintf(stderr, "kernel_launch: unexpected inputs / workspace (%d, %zu)\n", n_in, ws_size); grid = -1; return; }
    }
    if (grid < 0) return;
    (void)hipMemsetAsync((char*)d_ws + WS_CTL, 0, CTL_ZERO_BYTES, stream);
    Params p{};
    for (int i = 0; i < 26; ++i) p.in[i] = (const float*)d_in[i];
    p.out = (float*)d_out; p.ws = (unsigned char*)d_ws; p.ph_lo = 0; p.ph_hi = 13;
    hipLaunchKernelGGL(k_mega, dim3(grid), dim3(NTHR), LDS_BYTES, stream, p);
}
```

```cpp
#include <hip/hip_runtime.h>
#include <cstdio>
#include <cstdint>
constexpr int NB = 4, SEQ = 2048, DM = 2048, NT = NB * SEQ;
constexpr int INC = 4928, INCP = 5120;
constexpr int MH = 8, QR = 512, KVR = 256, QKD = 192, VD = 128;
constexpr int NE = 64, DE = 512;
constexpr float EPS = 1e-6f;
constexpr int MODW = 6 * DM;
constexpr int NWAVES = 8, NTHR = 512;
constexpr int PROWS = 90112;
constexpr int ROUTED_ROWS_MAX = 81920;

constexpr size_t MiB = 1u << 20;
constexpr size_t WS_CTL = 0, CTL_ZERO_BYTES = 1 * MiB;
constexpr int CW_BAR = 1024;
constexpr size_t CTL_MOD = 64 * 1024;
constexpr size_t WS_MODP = 4 * MiB;
constexpr size_t TAB_SSQ_Q8 = 7 * MiB, TAB_SSQ_KV4 = 7 * MiB + 256 * 1024, TAB_SSQ_O8 = 7 * MiB + 512 * 1024;
constexpr size_t CTL_HIST = 416 * 1024;
constexpr size_t WS_TAB = 1 * MiB;
constexpr size_t TAB_HGD = WS_TAB;
constexpr size_t TAB_TOPI = WS_TAB + 1 * MiB;
constexpr size_t TAB_TOPW = TAB_TOPI + 256 * 1024;
constexpr size_t TAB_SLOT = TAB_TOPW + 256 * 1024;
constexpr size_t TAB_ROWTOK = TAB_SLOT + 256 * 1024;
constexpr size_t TAB_TILEEXP = TAB_ROWTOK + 512 * 1024;
constexpr size_t WS_BT_IN = 8 * MiB, WS_BT_UQ = 28 * MiB, WS_BT_KV = 30 * MiB, WS_BT_OUT = 32 * MiB, WS_BT_GU = 40 * MiB, WS_BT_DN = 300 * MiB;
constexpr size_t WS_U16 = 430 * MiB, WS_H1 = 462 * MiB, WS_HID = 526 * MiB, WS_X = 614 * MiB;
constexpr size_t WS_PROJ = WS_X, WS_QRAW = WS_X + 80 * MiB, WS_KRAW = WS_X + 104 * MiB, WS_VT = WS_X + 120 * MiB, WS_Q16 = WS_X + 136 * MiB, WS_K16 = WS_X + 160 * MiB,
                 WS_HGU = WS_X + 184 * MiB, WS_MERGED = WS_X + 216 * MiB, WS_Y = WS_X, WS_END = 966 * MiB;

constexpr int RING_BYTES = 131072, LDS_BYTES = 163840, MISC_OFF = LDS_BYTES - 256;

#define GAS __attribute__((address_space(1)))
#define LAS __attribute__((address_space(3)))
typedef unsigned short bf16_t;
typedef unsigned v4u __attribute__((ext_vector_type(4)));
typedef unsigned v2u __attribute__((ext_vector_type(2)));
typedef float f32x4 __attribute__((ext_vector_type(4)));
typedef GAS unsigned gu32;
#define RLX_AGENT __ATOMIC_RELAXED, __HIP_MEMORY_SCOPE_AGENT
__device__ __forceinline__ unsigned f2bf(float f) { unsigned u = __builtin_bit_cast(unsigned, f); return (u + 0x7fffu + ((u >> 16) & 1u)) >> 16; }
__device__ __forceinline__ unsigned pk2(float lo, float hi) { unsigned r; asm volatile("v_cvt_pk_bf16_f32 %0, %1, %2" : "=v"(r) : "v"(lo), "v"(hi)); return r; }
__device__ __forceinline__ float bf2f(unsigned short b) { return __builtin_bit_cast(float, ((unsigned)b) << 16); }
__device__ __forceinline__ float bflo(unsigned w) { return __builtin_bit_cast(float, w << 16); }
__device__ __forceinline__ float bfhi(unsigned w) { return __builtin_bit_cast(float, w & 0xffff0000u); }
__device__ __forceinline__ float sigmoidf_(float x) { return 1.f / (1.f + __expf(-x)); }
__device__ __forceinline__ float siluf_(float x) { return x / (1.f + __expf(-x)); }
__device__ __forceinline__ float wave_sum(float v) {
#pragma unroll
    for (int o = 1; o < 64; o <<= 1) v += __shfl_xor(v, o);
    return v;
}

#define XB_TMO      128
#define XB_XCNT(j)  (256  + 64 * (j))
#define XB_XSUB(j)  (1280 + 64 * (j))
#define XB_XGEN(j)  (2304 + 64 * (j))
#define XB_TOP      3328
#define XB_TOPGEN   3392
#define XCD_BAR_WORDS 3456
#define XB_SPIN_CAP (1u << 18)
__device__ __forceinline__ unsigned xb_ld(unsigned* p)              { return __hip_atomic_load(p, __ATOMIC_RELAXED, __HIP_MEMORY_SCOPE_AGENT); }
__device__ __forceinline__ unsigned xb_add(unsigned* p, unsigned v) { return __hip_atomic_fetch_add(p, v, __ATOMIC_RELAXED, __HIP_MEMORY_SCOPE_AGENT); }
__device__ __forceinline__ unsigned xb_xcc_id() { return (unsigned)__builtin_amdgcn_s_getreg((3 << 11) | 20) & 0xFu; }
#define XB_SPIN(cond, bar) do { unsigned _sp = 0; while (cond) { __builtin_amdgcn_s_sleep(1); \
    if ((++_sp & 255u) == 0u) { if (xb_ld(&(bar)[XB_TMO])) break; if (_sp > XB_SPIN_CAP) { atomicAdd(&(bar)[XB_TMO], 1u); break; } } } } while (0)
struct XcdBarrier { unsigned* bar; unsigned x; volatile LAS unsigned* st; };
__device__ __forceinline__ XcdBarrier xcd_barrier_post(unsigned* bar, volatile LAS unsigned* st) {
    XcdBarrier b; b.bar = bar; b.x = xb_xcc_id(); b.st = st;
    if (threadIdx.x == 0) (void)xb_add(&bar[XB_XCNT(b.x)], 1u);
    return b;
}
__device__ __forceinline__ void xcd_barrier_complete(unsigned* bar, unsigned x, unsigned& nloc, unsigned& nx) {
    const unsigned G = gridDim.x * gridDim.y * gridDim.z;
    unsigned sum, cnt, mine, sp = 0u;
    for (;;) {
        sum = 0u; cnt = 0u; mine = 0u;
#pragma unroll
        for (unsigned j = 0; j < 16; ++j) { const unsigned c = xb_ld(&bar[XB_XCNT(j)]); sum += c; cnt += (c > 0u) ? 1u : 0u; mine = (j == x) ? c : mine; }
        if (sum == G) break;
        __builtin_amdgcn_s_sleep(1);
        if ((++sp & 255u) == 0u) { if (xb_ld(&bar[XB_TMO])) break; if (sp > XB_SPIN_CAP) { atomicAdd(&bar[XB_TMO], 1u); break; } }
    }
    nloc = mine > 0u ? mine : 1u; nx = cnt > 0u ? cnt : 1u;
}
__device__ __forceinline__ void xcd_barrier(const XcdBarrier& b) {
    asm volatile("s_waitcnt vmcnt(0)" ::: "memory");
    __syncthreads();
    if (threadIdx.x == 0) {
        unsigned* bar = b.bar;
        __builtin_amdgcn_s_waitcnt(0);
        unsigned nloc = b.st[0], nx = b.st[1];
        if (nloc == 0u) { xcd_barrier_complete(bar, b.x, nloc, nx); b.st[0] = nloc; b.st[1] = nx; }
        const unsigned old = xb_add(&bar[XB_XSUB(b.x)], 1u);
        const unsigned gen = old / nloc;
        if (old + 1u == (gen + 1u) * nloc) {
            __builtin_amdgcn_fence(__ATOMIC_RELEASE, "agent");
            asm volatile("s_waitcnt vmcnt(0)" ::: "memory");
            const unsigned og = xb_add(&bar[XB_TOP], 1u);
            const unsigned tg = og / nx;
            if (og + 1u == (tg + 1u) * nx) xb_add(&bar[XB_TOPGEN], 1u);
            else XB_SPIN(xb_ld(&bar[XB_TOPGEN]) == tg, bar);
            __builtin_amdgcn_fence(__ATOMIC_ACQUIRE, "agent");
            xb_add(&bar[XB_XGEN(b.x)], 1u);
            asm volatile("s_waitcnt vmcnt(0)" ::: "memory");
        } else {
            XB_SPIN(xb_ld(&bar[XB_XGEN(b.x)]) == gen, bar);
            __builtin_amdgcn_fence(__ATOMIC_ACQUIRE, "agent");
            asm volatile("s_waitcnt vmcnt(0)" ::: "memory");
        }
    }
    __syncthreads();
}

struct Params { const float* in[26]; float* out; unsigned char* ws; int ph_lo, ph_hi; };
namespace pg8 {
#define PG8_LAS __attribute__((address_space(3)))
typedef unsigned short bf16_t;
typedef short bf16x8 __attribute__((ext_vector_type(8)));
typedef float f32x4 __attribute__((ext_vector_type(4)));
typedef unsigned u32x4 __attribute__((ext_vector_type(4)));
typedef unsigned u32x2 __attribute__((ext_vector_type(2)));
constexpr int BM = 256, BK = 64, HALF = 128, HTB = HALF * BK * 2, STAGE_BYTES = 8 * HTB, NXCD = 8, WGM = 8;

__host__ __device__ __forceinline__ int lds_byte(int r, int c) { const int st = (r >> 4) * 2 + (c >> 5), rr = r & 15, cc = c & 31, ob = rr * 64 + cc * 2; return st * 1024 + (ob ^ (((ob >> 9) & 1) << 5)); }
__host__ __device__ __forceinline__ void stage_rc(int b, int& R, int& C) { const int st = b / 1024, sb = b % 1024, swz = sb ^ (((sb >> 9) & 1) << 5); R = (st >> 1) * 16 + swz / 64; C = (st & 1) * 32 + (swz % 64) / 2; }
__host__ __device__ __forceinline__ int perm32(int rho) { const int n = rho >> 4, i = rho & 15; return 8 * (i >> 2) + 4 * n + (i & 3); }

struct Unit { int pm, pn; long boff; int mask, pad; };
struct Gemm { const bf16_t* A; const bf16_t* Bt; const int* rowtab; int lda, ldb, K, pad; };

__device__ __forceinline__ unsigned cvt_pk_bf16(float lo, float hi) { unsigned r; asm volatile("v_cvt_pk_bf16_f32 %0, %1, %2" : "=v"(r) : "v"(lo), "v"(hi)); return r; }

struct StaticOrder {
    int nM, nN, nwg, G, c, nfull, T; long bstep;
    __device__ void init(int nM_, int nN_, int G_, int c_, int ldb) { nM = nM_; nN = nN_; nwg = nM * nN; G = G_; c = c_; bstep = (long)BM * ldb * 2;
        T = 0; nfull = nwg; }
    __device__ bool next(int i, Unit& u) const {
        const long L = (long)i * G + c; int wgid, mask = 15;
        if (L < nfull) wgid = (int)L;
        else { const long j = L - nfull; if (j >= 2 * T) return false; wgid = nfull + (int)(j % T); mask = (j / T) ? 12 : 3; }
        { const int q = nwg / NXCD, r = nwg % NXCD, xcd = wgid % NXCD, off = wgid / NXCD; wgid = (xcd < r ? xcd * (q + 1) : r * (q + 1) + (xcd - r) * q) + off; }
        const int nig = WGM * nN, gid = wgid / nig, fm = gid * WGM, gsz = (nM - fm) < WGM ? (nM - fm) : WGM;
        u.pm = fm + ((wgid % nig) % gsz); u.pn = (wgid % nig) / gsz; u.boff = (long)u.pn * bstep; u.mask = mask; u.pad = i; return true;
    }
};

typedef long i64x2 __attribute__((ext_vector_type(2)));
template <class Epi, class Sched, int ES = 2, bool ALIGN_EPI = true>
__device__ __forceinline__ void gemm_phase(PG8_LAS unsigned char* lds, const Gemm g, const Sched& S, const Epi& E) {
    const int tid = threadIdx.x, wid = __builtin_amdgcn_readfirstlane(tid >> 6), lane = tid & 63, wr = wid >> 2, wc = wid & 3, fr = lane & 15, fq = lane >> 4;
    const int K = g.K, nt = K * ES / (BK * 2);
    int Rr[2]; unsigned Cb[2], voffB[2];
#pragma unroll
    for (int i = 0; i < 2; ++i) { int R, C; stage_rc(tid * 16 + i * 8192, R, C); const int Rb = Epi::PERM ? ((R & ~31) + perm32(R & 31)) : R;
        Rr[i] = R; Cb[i] = (unsigned)C * 2u; voffB[i] = (unsigned)(Rb * g.ldb) * (unsigned)ES + (unsigned)C * 2u; }
    const size_t kstep = (size_t)(BK * 2);
    const size_t hstepB = (size_t)HALF * g.ldb * ES;
    const unsigned lda2 = (unsigned)g.lda * (unsigned)ES;
    const unsigned ldsw = (unsigned)wid * 1024u;
    const int aoff = lds_byte(wr * 64 + fr, fq * 8), boff = lds_byte(wc * 32 + fr, fq * 8);
    const char* const Abase = (const char*)g.A; const char* const Bbase = (const char*)g.Bt;
#define PG8_SA(b, h) (((b) * 2 + (h)) * HTB)
#define PG8_SB(b, h) ((4 + (b) * 2 + (h)) * HTB)
#define PG8_STAGE(bufoff, gbase, voff) do { _Pragma("unroll") for (int _i = 0; _i < 2; ++_i) \
        __builtin_amdgcn_global_load_lds((const unsigned*)((const char*)(gbase) + (voff)[_i]), (PG8_LAS unsigned*)(lds + (bufoff) + ldsw + _i * 8192), 16, 0, 0); } while (0)
#define PG8_VOFFA(u, v) do { _Pragma("unroll") for (int _h = 0; _h < 2; ++_h) _Pragma("unroll") for (int _i = 0; _i < 2; ++_i) { const int _gr = (u).pm * BM + _h * HALF + Rr[_i]; \
        const int _src = g.rowtab ? g.rowtab[_gr] : _gr; (v)[_h][_i] = (unsigned)_src * lda2 + Cb[_i]; } } while (0)
#define PG8_LDA(dst, b, h) do { _Pragma("unroll") for (int m = 0; m < 4; ++m) _Pragma("unroll") for (int k = 0; k < 2; ++k) dst[m][k] = *(const PG8_LAS bf16x8*)(lds + PG8_SA(b, h) + aoff + m * 2048 + k * 1024); } while (0)
#define PG8_LDB(dst, b, h) do { _Pragma("unroll") for (int n = 0; n < 2; ++n) _Pragma("unroll") for (int k = 0; k < 2; ++k) dst[n][k] = *(const PG8_LAS bf16x8*)(lds + PG8_SB(b, h) + boff + n * 2048 + k * 1024); } while (0)
#define PG8_MMA(ai, bj, At, Bt) do { __builtin_amdgcn_s_setprio(1); \
        if constexpr (ES == 2) { _Pragma("unroll") for (int m = 0; m < 4; ++m) _Pragma("unroll") for (int n = 0; n < 2; ++n) _Pragma("unroll") for (int k = 0; k < 2; ++k) \
            acc[ai][bj][m][n] = __builtin_amdgcn_mfma_f32_16x16x32_bf16(Bt[n][k], At[m][k], acc[ai][bj][m][n], 0, 0, 0); } \
        else { _Pragma("unroll") for (int m = 0; m < 4; ++m) _Pragma("unroll") for (int n = 0; n < 2; ++n) _Pragma("unroll") for (int k = 0; k < 2; ++k) { \
            const i64x2 _a = __builtin_bit_cast(i64x2, At[m][k]), _b = __builtin_bit_cast(i64x2, Bt[n][k]); \
            acc[ai][bj][m][n] = __builtin_amdgcn_mfma_f32_16x16x32_fp8_fp8(_b.x, _a.x, acc[ai][bj][m][n], 0, 0, 0); \
            acc[ai][bj][m][n] = __builtin_amdgcn_mfma_f32_16x16x32_fp8_fp8(_b.y, _a.y, acc[ai][bj][m][n], 0, 0, 0); } } \
        __builtin_amdgcn_s_setprio(0); } while (0)
#define PG8_WAIT_V(n) asm volatile("s_waitcnt vmcnt(" #n ")" ::: "memory")
#define PG8_WAIT_L(n) asm volatile("s_waitcnt lgkmcnt(" #n ")" ::: "memory")
#define PG8_BAR __builtin_amdgcn_s_barrier()
#define PG8_SCHED __builtin_amdgcn_sched_barrier(0)
    Unit cur, nxt; int ui = 0;
    if (!S.next(0, cur)) return;
    f32x4 acc[2][2][4][2];
#pragma unroll
    for (int a = 0; a < 2; ++a)
#pragma unroll
        for (int b = 0; b < 2; ++b)
#pragma unroll
            for (int m = 0; m < 4; ++m)
#pragma unroll
                for (int n = 0; n < 2; ++n) acc[a][b][m][n] = (f32x4){0.f, 0.f, 0.f, 0.f};
    bf16x8 At[4][2], B0[2][2], B1[2][2];
    unsigned cv[2][2], nv[2][2];
    PG8_VOFFA(cur, cv);
#pragma unroll
    for (int h = 0; h < 2; ++h) { nv[h][0] = cv[h][0]; nv[h][1] = cv[h][1]; }
    const char* cB = Bbase + cur.boff;
    PG8_STAGE(PG8_SB(0, 0), cB, voffB); PG8_STAGE(PG8_SB(0, 1), cB + hstepB, voffB); PG8_STAGE(PG8_SA(0, 0), Abase, cv[0]); PG8_STAGE(PG8_SA(0, 1), Abase, cv[1]);
    if (wr == 1) PG8_BAR;
    PG8_WAIT_V(2); PG8_BAR;
    PG8_STAGE(PG8_SB(1, 0), cB + kstep, voffB); PG8_STAGE(PG8_SA(1, 0), Abase + kstep, cv[0]); PG8_STAGE(PG8_SB(1, 1), cB + hstepB + kstep, voffB);
    PG8_WAIT_V(6); PG8_BAR;
    for (;;) {
        const bool has_next = S.next(ui + 1, nxt);
        const char* nB = has_next ? Bbase + nxt.boff : cB;
#pragma unroll 1
        for (int t = 0; t < nt; t += 2) {
            const bool last = (t == nt - 2);
            if constexpr (Epi::MIDK) { if (t == nt / 2) E.mid(acc, cur, wr, wc, fr, fq); }
            if (last && has_next) { PG8_VOFFA(nxt, nv); }
            const char* a1 = Abase + (size_t)(t + 1) * kstep;
            const char* a2 = Abase + (last ? (size_t)0 : (size_t)(t + 2) * kstep); const char* a3 = a2 + kstep;
            const char* b2 = last ? nB : cB + (size_t)(t + 2) * kstep; const char* b3 = b2 + kstep;
            unsigned x0[2], x1[2];
            x0[0] = last ? nv[0][0] : cv[0][0]; x0[1] = last ? nv[0][1] : cv[0][1]; x1[0] = last ? nv[1][0] : cv[1][0]; x1[1] = last ? nv[1][1] : cv[1][1];
            PG8_LDB(B0, 0, 0); PG8_LDB(B1, 0, 1); PG8_SCHED; PG8_LDA(At, 0, 0); PG8_STAGE(PG8_SA(1, 1), a1, cv[1]);
            PG8_WAIT_V(8); PG8_WAIT_L(0); PG8_BAR; PG8_MMA(0, 0, At, B0); PG8_MMA(0, 1, At, B1); PG8_BAR; PG8_SCHED;
            PG8_LDA(At, 0, 1); PG8_STAGE(PG8_SB(0, 0), b2, voffB); PG8_STAGE(PG8_SB(0, 1), b2 + hstepB, voffB); PG8_STAGE(PG8_SA(0, 0), a2, x0);
            PG8_WAIT_V(8); PG8_WAIT_L(0); PG8_BAR; PG8_MMA(1, 0, At, B0); PG8_MMA(1, 1, At, B1); PG8_BAR; PG8_SCHED;
            PG8_LDB(B0, 1, 0); PG8_LDB(B1, 1, 1); PG8_SCHED; PG8_LDA(At, 1, 0); PG8_STAGE(PG8_SA(0, 1), a2, x1);
            PG8_WAIT_V(8); PG8_WAIT_L(0); PG8_BAR; PG8_MMA(0, 0, At, B0); PG8_MMA(0, 1, At, B1); PG8_BAR; PG8_SCHED;
            PG8_LDA(At, 1, 1); PG8_STAGE(PG8_SB(1, 0), b3, voffB); PG8_STAGE(PG8_SB(1, 1), b3 + hstepB, voffB); PG8_STAGE(PG8_SA(1, 0), a3, x0);
            PG8_WAIT_V(8); PG8_WAIT_L(0); PG8_BAR; PG8_MMA(1, 0, At, B0); PG8_MMA(1, 1, At, B1); PG8_BAR; PG8_SCHED;
        }
        if constexpr (ALIGN_EPI) { if (wr == 0) PG8_BAR; }
        E(acc, cur, wr, wc, fr, fq);
        if (!has_next) break;
#pragma unroll
        for (int a = 0; a < 2; ++a)
#pragma unroll
            for (int b = 0; b < 2; ++b)
#pragma unroll
                for (int m = 0; m < 4; ++m)
#pragma unroll
                    for (int n = 0; n < 2; ++n) acc[a][b][m][n] = (f32x4){0.f, 0.f, 0.f, 0.f};
        cur = nxt; cB = nB; ++ui;
#pragma unroll
        for (int h = 0; h < 2; ++h) { cv[h][0] = nv[h][0]; cv[h][1] = nv[h][1]; }
        if constexpr (ALIGN_EPI) { if (wr == 1) PG8_BAR; }
    }
    PG8_WAIT_V(0);
    if constexpr (!ALIGN_EPI) { if (wr == 0) PG8_BAR; }
    PG8_BAR;
#undef PG8_SA
#undef PG8_SB
#undef PG8_STAGE
#undef PG8_VOFFA
#undef PG8_LDA
#undef PG8_LDB
#undef PG8_MMA
#undef PG8_WAIT_V
#undef PG8_WAIT_L
#undef PG8_BAR
#undef PG8_SCHED
}
}
__device__ __forceinline__ void conv_tile(const float* __restrict__ src, int ldn, int k0, int n0, const float* __restrict__ kscale, int kfrom,
                                          bf16_t* __restrict__ dst, int dld, int drow0, LAS unsigned* T, int lane, int dk0 = -1) {
    if (dk0 < 0) dk0 = k0;
    const int c4 = lane & 15, kq = lane >> 4;
    f32x4 v0[8], v1[8];
#pragma unroll
    for (int j = 0; j < 8; ++j) { const int kp = kq + 4 * j; const float* p = src + (size_t)(k0 + 2 * kp) * ldn + n0 + c4 * 4;
        v0[j] = *(const f32x4*)p; v1[j] = *(const f32x4*)(p + ldn); }
#pragma unroll
    for (int j = 0; j < 8; ++j) { const int kp = kq + 4 * j; const int k = k0 + 2 * kp;
        float s0 = 1.f, s1 = 1.f; if (kscale && k >= kfrom) { s0 = kscale[k - kfrom]; s1 = kscale[k + 1 - kfrom]; }
#pragma unroll
        for (int q = 0; q < 4; ++q) T[(c4 * 4 + q) * 33 + kp] = pk2(v0[j][q] * s0, v1[j][q] * s1); }
    asm volatile("s_waitcnt lgkmcnt(0)" ::: "memory"); __builtin_amdgcn_wave_barrier();
    const int ch = lane & 7, nr = lane >> 3;
#pragma unroll
    for (int ps = 0; ps < 8; ++ps) { const int n = ps * 8 + nr; const LAS unsigned* t = T + n * 33 + ch * 4;
        v4u o; o.x = t[0]; o.y = t[1]; o.z = t[2]; o.w = t[3];
        *(v4u*)(dst + (size_t)(drow0 + n) * dld + dk0 + ch * 8) = o; }
    asm volatile("s_waitcnt lgkmcnt(0)" ::: "memory"); __builtin_amdgcn_wave_barrier();
}

__device__ __forceinline__ void conv_tile128(const float* __restrict__ src, int ldn, int k0, int n0, bf16_t* __restrict__ dst, int dld, int drow0, LAS unsigned* T, int lane) {
    const int c4 = lane & 15, kq = lane >> 4;
    f32x4 v0[16], v1[16];
#pragma unroll
    for (int j = 0; j < 16; ++j) { const int kp = kq + 4 * j; const float* q = src + (size_t)(k0 + 2 * kp) * ldn + n0 + c4 * 4;
        v0[j] = __builtin_nontemporal_load((const f32x4*)q); v1[j] = __builtin_nontemporal_load((const f32x4*)(q + ldn)); }
#pragma unroll
    for (int j = 0; j < 16; ++j) { const int kp = kq + 4 * j;
#pragma unroll
        for (int q = 0; q < 4; ++q) T[(c4 * 4 + q) * 65 + kp] = pk2(v0[j][q], v1[j][q]); }
    asm volatile("s_waitcnt lgkmcnt(0)" ::: "memory"); __builtin_amdgcn_wave_barrier();
    const int ch = lane & 15, nr = lane >> 4;
#pragma unroll
    for (int ps = 0; ps < 16; ++ps) { const int n = ps * 4 + nr; const LAS unsigned* t = T + n * 65 + ch * 4;
        v4u o; o.x = t[0]; o.y = t[1]; o.z = t[2]; o.w = t[3];
        __builtin_nontemporal_store(o, (v4u*)(dst + (size_t)(drow0 + n) * dld + k0 + ch * 8)); }
    asm volatile("s_waitcnt lgkmcnt(0)" ::: "memory"); __builtin_amdgcn_wave_barrier();
}

__device__ __forceinline__ unsigned pk4_fp8(float a, float b, float c, float d) {
    int w = 0; w = __builtin_amdgcn_cvt_pk_fp8_f32(__builtin_amdgcn_fmed3f(a, -448.f, 448.f), __builtin_amdgcn_fmed3f(b, -448.f, 448.f), w, false);
    w = __builtin_amdgcn_cvt_pk_fp8_f32(__builtin_amdgcn_fmed3f(c, -448.f, 448.f), __builtin_amdgcn_fmed3f(d, -448.f, 448.f), w, true); return (unsigned)w; }
__device__ __forceinline__ void conv_tile128_fp8(const float* __restrict__ src, int ldn, int k0, int n0, unsigned char* __restrict__ dst, int dld, int drow0, LAS unsigned* T, int lane) {
    const int c4 = lane & 15, kq = lane >> 4;
#pragma unroll 1
    for (int hf = 0; hf < 2; ++hf) {
        f32x4 v[8][4];
#pragma unroll
        for (int j = 0; j < 8; ++j) { const float* q = src + (size_t)(k0 + hf * 128 + 4 * (kq + 4 * j)) * ldn + n0 + c4 * 4;
#pragma unroll
            for (int r = 0; r < 4; ++r) v[j][r] = __builtin_nontemporal_load((const f32x4*)(q + (size_t)r * ldn)); }
#pragma unroll
        for (int j = 0; j < 8; ++j) { const int kp = hf * 32 + kq + 4 * j;
#pragma unroll
            for (int q = 0; q < 4; ++q) T[(c4 * 4 + q) * 65 + kp] = pk4_fp8(v[j][0][q] * 64.f, v[j][1][q] * 64.f, v[j][2][q] * 64.f, v[j][3][q] * 64.f); }
    }
    asm volatile("s_waitcnt lgkmcnt(0)" ::: "memory"); __builtin_amdgcn_wave_barrier();
    const int ch = lane & 15, nr = lane >> 4;
#pragma unroll
    for (int ps = 0; ps < 16; ++ps) { const int n = ps * 4 + nr; const LAS unsigned* t = T + n * 65 + ch * 4;
        v4u o; o.x = t[0]; o.y = t[1]; o.z = t[2]; o.w = t[3];
        __builtin_nontemporal_store(o, (v4u*)(dst + (size_t)(drow0 + n) * dld + k0 + ch * 16)); }
    asm volatile("s_waitcnt lgkmcnt(0)" ::: "memory"); __builtin_amdgcn_wave_barrier();
}

__device__ __forceinline__ void ada_item(const float* __restrict__ c, const float* __restrict__ w, float* __restrict__ modp, int item, int lane) {
    const int cc = item % 48, ks = item / 48, col = cc * 256 + lane * 4;
    f32x4 acc[4];
#pragma unroll
    for (int b = 0; b < 4; ++b) acc[b] = (f32x4){0.f, 0.f, 0.f, 0.f};
#pragma unroll 1
    for (int half = 0; half < 2; ++half) {
        const int k0 = ks * 128 + half * 64;
        float cd[4];
#pragma unroll
        for (int b = 0; b < 4; ++b) cd[b] = siluf_(c[b * DM + k0 + lane]);
        const float* wp = w + (size_t)k0 * MODW + col;
#pragma unroll 16
        for (int kk = 0; kk < 64; ++kk) { const f32x4 wv = __builtin_nontemporal_load((const f32x4*)(wp + (size_t)kk * MODW));
#pragma unroll
            for (int b = 0; b < 4; ++b) { const float s = __builtin_bit_cast(float, __builtin_amdgcn_readlane(__builtin_bit_cast(int, cd[b]), kk)); acc[b] += wv * s; } }
    }
#pragma unroll
    for (int b = 0; b < 4; ++b) *(f32x4*)(modp + ((size_t)ks * 4 + b) * MODW + col) = acc[b];
}

constexpr int CT_ADA = 48 * 16;
constexpr int CT_IN = 32 * 77, CT_UQ = 8 * 24, CT_KV = 4 * 32, CT_OUT = 32 * 32, CT_G1 = 8 * 8, CT_D1 = 2 * 32;
constexpr int CT_ZERO = 192 * 4;
constexpr int CT_GU = 65 * 2 * CT_G1, CT_DN = 65 * CT_D1;
constexpr int CT_GU_LATE = 0;
constexpr int CT_TOTAL0 = CT_ADA + CT_IN + CT_UQ + CT_KV + CT_OUT + CT_ZERO + (CT_GU - CT_GU_LATE) + CT_DN;
constexpr int CW_QGU = 8192, CW_QDN = 8192 + 512;

__device__ __forceinline__ void conv_gu_tile(const Params& p, int r, LAS unsigned* T, int lane) {
    const int e = r / (2 * CT_G1); int q = r % (2 * CT_G1);
    unsigned char* gu = p.ws + WS_BT_GU + (size_t)e * 1024 * DM;
    const int up = q >= CT_G1; q -= up * CT_G1; const int kb = q / 8, nb = q % 8, n0 = nb * 64;
    const float* src = (e < 64) ? p.in[up ? 21 : 20] + (size_t)e * DM * DE : p.in[up ? 24 : 23];
    conv_tile128_fp8(src, DE, kb * 256, n0, gu, DM, (n0 >> 7) * 256 + up * 128 + (n0 & 127), T, lane);
}
__device__ __forceinline__ void conv_dn_tile(const Params& p, int r, LAS unsigned* T, int lane) {
    const int e = r / CT_D1, q = r % CT_D1, kb = q / 32, nb = q % 32;
    unsigned char* dn = p.ws + WS_BT_DN + (size_t)e * DM * DE;
    const float* src = (e < 64) ? p.in[22] + (size_t)e * DE * DM : p.in[25];
    conv_tile128_fp8(src, DM, kb * 256, nb * 64, dn, DE, nb * 64, T, lane);
}
template <bool DN>
__device__ __forceinline__ void conv_queue(const Params& p, LAS unsigned char* lds, int wave, int lane, int first, int total) {
    LAS unsigned* T = (LAS unsigned*)(lds + wave * 18432);
    unsigned* heads = (unsigned*)(p.ws + WS_CTL) + (DN ? CW_QDN : CW_QGU);
    const int n = total - first, per = (n + 7) / 8, xcd = (int)xb_xcc_id() & 7;
    for (int s = 0; s < 8; ++s) {
        const int sh = (xcd + s) & 7, lo = first + sh * per, hi = (lo + per < total) ? lo + per : total;
        for (;;) {
            unsigned i = 0; if (lane == 0) i = __hip_atomic_fetch_add(heads + 64 * sh, 2u, __ATOMIC_RELAXED, __HIP_MEMORY_SCOPE_AGENT);
            const int r = lo + (int)__builtin_amdgcn_readfirstlane(i);
            if (r >= hi) break;
            if (DN) conv_dn_tile(p, r, T, lane); else conv_gu_tile(p, r, T, lane);
            if (r + 1 < hi) { if (DN) conv_dn_tile(p, r + 1, T, lane); else conv_gu_tile(p, r + 1, T, lane); }
        }
    }
}

__device__ __forceinline__ void phase0(const Params& p, LAS unsigned char* lds, int wave, int lane) {
    LAS unsigned* T = (LAS unsigned*)(lds + wave * 18432);
    unsigned char* ws = p.ws;
    float* modp = (float*)(ws + WS_MODP);
    const int gw = blockIdx.x * NWAVES + wave, NGW = gridDim.x * NWAVES;
    for (int it = gw; it < CT_TOTAL0; it += NGW) {
        int r = it;
        if (r < CT_ADA) { ada_item(p.in[1], p.in[3], modp, r, lane); continue; } r -= CT_ADA;
        if (r < CT_IN) { const int kb = r / 77, nb = r % 77; conv_tile(p.in[7], INC, kb * 64, nb * 64, nullptr, 0, (bf16_t*)(ws + WS_BT_IN), DM, nb * 64, T, lane); continue; } r -= CT_IN;
        if (r < CT_UQ) { const int kb = r / 24, nb = r % 24; conv_tile(p.in[11], 1536, kb * 64, nb * 64, p.in[10], 0, (bf16_t*)(ws + WS_BT_UQ), QR, nb * 64, T, lane); continue; } r -= CT_UQ;
        if (r < CT_KV) { const int kb = r / 32, nb = r % 32, n0 = nb * 64, h = n0 >> 8, j0 = n0 & 255; const int dr = (j0 < 128) ? h * 128 + j0 : 1024 + h * 128 + (j0 - 128);
                         conv_tile(p.in[13], 2048, kb * 64, n0, p.in[12], 0, (bf16_t*)(ws + WS_BT_KV), KVR, dr, T, lane); continue; } r -= CT_KV;
        if (r < CT_OUT) { const int kb = r / 32, nb = r % 32; conv_tile(p.in[17], DM, kb * 64, nb * 64, p.in[16], 1024, (bf16_t*)(ws + WS_BT_OUT), DM, nb * 64, T, lane, (kb * 64 + 1024) & 2047); continue; } r -= CT_OUT;
        if (r < CT_ZERO) { const int row = INC + (r >> 2), pc = r & 3; v4u z = {0u, 0u, 0u, 0u}; *(v4u*)((bf16_t*)(ws + WS_BT_IN) + (size_t)row * DM + pc * 512 + lane * 8) = z; continue; } r -= CT_ZERO;
        if (r < CT_GU - CT_GU_LATE) { conv_gu_tile(p, r, T, lane); continue; } r -= CT_GU - CT_GU_LATE;
        conv_dn_tile(p, r, T, lane);
    }
}

__device__ __forceinline__ void norm_mod_row(const float* __restrict__ hrow, const float* __restrict__ g, const float* __restrict__ sc, const float* __restrict__ sh, bf16_t* __restrict__ urow, int lane) {
    f32x4 v[8]; float s = 0.f;
#pragma unroll
    for (int j = 0; j < 8; ++j) { v[j] = *(const f32x4*)(hrow + lane * 4 + 256 * j); s += (v[j].x * v[j].x + v[j].y * v[j].y) + (v[j].z * v[j].z + v[j].w * v[j].w); }
    const float r = rsqrtf(wave_sum(s) * (1.f / DM) + EPS);
#pragma unroll
    for (int j = 0; j < 8; ++j) { const int col = lane * 4 + 256 * j; const f32x4 gv = *(const f32x4*)(g + col), sv = *(const f32x4*)(sc + col), hv = *(const f32x4*)(sh + col);
        const f32x4 o = v[j] * r * gv * (sv + 1.f) + hv; v2u w; w.x = pk2(o.x, o.y); w.y = pk2(o.z, o.w); *(v2u*)(urow + col) = w; }
}
__device__ __forceinline__ f32x4 mod_reduce4(const float* __restrict__ modp, const float* __restrict__ bias, int v) {
    f32x4 t[16];
#pragma unroll
    for (int ks = 0; ks < 16; ++ks) t[ks] = *(const f32x4*)(modp + (size_t)ks * 4 * MODW + v);
    f32x4 s = *(const f32x4*)(bias + v % MODW);
#pragma unroll
    for (int ks = 0; ks < 16; ++ks) s += t[ks];
    return s;
}
__device__ __forceinline__ void phase1(const Params& p, LAS unsigned char* lds, int wave, int lane) {
    const float* modp = (const float*)(p.ws + WS_MODP); float* mod = (float*)(p.ws + CTL_MOD); bf16_t* u16 = (bf16_t*)(p.ws + WS_U16);
    LAS float* sm = (LAS float*)lds;
    const int G = gridDim.x;
    for (int v4 = blockIdx.x * NTHR + threadIdx.x; v4 < NB * MODW / 4; v4 += G * NTHR) *(f32x4*)(mod + v4 * 4) = mod_reduce4(modp, p.in[4], v4 * 4);
    for (int tb = blockIdx.x; tb < NT / 32; tb += G) {
        const int b = (tb * 32) / SEQ;
        f32x4 v[8];
        { const float* hrow = p.in[0] + (size_t)(tb * 32 + wave * 4) * DM;
#pragma unroll
          for (int j = 0; j < 8; ++j) v[j] = __builtin_nontemporal_load((const f32x4*)(hrow + lane * 4 + 256 * j)); }
        __syncthreads();
        for (int i4 = threadIdx.x; i4 < 2 * DM / 4; i4 += NTHR) *(LAS f32x4*)(sm + i4 * 4) = mod_reduce4(modp, p.in[4], b * MODW + i4 * 4);
        __syncthreads();
#pragma unroll 1
        for (int rr = 0; rr < 4; ++rr) { const int t = tb * 32 + wave * 4 + rr; const float* g = p.in[5];
            f32x4 vn[8];
            if (rr < 3) { const float* hrow = p.in[0] + (size_t)(t + 1) * DM;
#pragma unroll
                for (int j = 0; j < 8; ++j) vn[j] = __builtin_nontemporal_load((const f32x4*)(hrow + lane * 4 + 256 * j)); }
            float s = 0.f;
#pragma unroll
            for (int j = 0; j < 8; ++j) s += (v[j].x * v[j].x + v[j].y * v[j].y) + (v[j].z * v[j].z + v[j].w * v[j].w);
            const float r = rsqrtf(wave_sum(s) * (1.f / DM) + EPS);
#pragma unroll
            for (int j = 0; j < 8; ++j) { const int col = lane * 4 + 256 * j; const f32x4 gv = *(const f32x4*)(g + col);
                const f32x4 hv = *(const LAS f32x4*)(sm + col), sv = *(const LAS f32x4*)(sm + DM + col);
                const f32x4 o = v[j] * r * gv * (sv + 1.f) + hv; v2u w; w.x = pk2(o.x, o.y); w.y = pk2(o.z, o.w); *(v2u*)(u16 + (size_t)t * DM + col) = w; }
            if (rr < 3) {
#pragma unroll
                for (int j = 0; j < 8; ++j) v[j] = vn[j]; }
        }
    }
}

struct EpiInProj { static constexpr bool PERM = true, MIDK = false; bf16_t* O; float* ssq_q8; float* ssq_kv4;
    __device__ __forceinline__ void operator()(const pg8::f32x4 (&acc)[2][2][4][2], const pg8::Unit& u, int wr, int wc, int fr, int fq) const {
        const int row0 = u.pm * 256 + wr * 64 + fr, col0 = u.pn * 256 + wc * 32 + 8 * fq;
        const bool sq = (u.pn >= 16 && u.pn <= 18);
#pragma unroll
        for (int ai = 0; ai < 2; ++ai)
#pragma unroll
            for (int m = 0; m < 4; ++m) { if (!(u.mask & (3 << (ai * 2)))) continue; const int row = row0 + ai * 128 + m * 16; bf16_t* rowp = O + (size_t)row * INCP + col0; float ss = 0.f;
#pragma unroll
                for (int bj = 0; bj < 2; ++bj) { const pg8::f32x4 v0 = acc[ai][bj][m][0], v1 = acc[ai][bj][m][1];
                    v4u w; w.x = pk2(v0[0], v0[1]); w.y = pk2(v0[2], v0[3]); w.z = pk2(v1[0], v1[1]); w.w = pk2(v1[2], v1[3]);
                    *(v4u*)(rowp + bj * 128) = w;
                    ss += (v0[0] * v0[0] + v0[1] * v0[1]) + (v0[2] * v0[2] + v0[3] * v0[3]) + (v1[0] * v1[0] + v1[1] * v1[1]) + (v1[2] * v1[2] + v1[3] * v1[3]); }
                if (sq) { ss += __shfl_xor(ss, 16); ss += __shfl_xor(ss, 32);
                    if (fq == 0) { if (u.pn == 18) ssq_kv4[row * 4 + wc] = ss; else ssq_q8[row * 8 + (u.pn - 16) * 4 + wc] = ss; } } }
    }
};
__device__ __forceinline__ void phase2(const Params& p, LAS unsigned char* lds) {
    unsigned char* ws = p.ws;
    pg8::Gemm g{(const bf16_t*)(ws + WS_U16), (const bf16_t*)(ws + WS_BT_IN), nullptr, DM, DM, DM, 0};
    pg8::StaticOrder S; S.init(NT / 256, INCP / 256, gridDim.x, blockIdx.x, DM);
    EpiInProj E{(bf16_t*)(ws + WS_PROJ), (float*)(ws + TAB_SSQ_Q8), (float*)(ws + TAB_SSQ_KV4)};
    pg8::gemm_phase<EpiInProj, pg8::StaticOrder>((PG8_LAS unsigned char*)lds, g, S, E);
}
struct EpiBf16Store { static constexpr bool PERM = true, MIDK = false; bf16_t* O; int ldc, pad;
    __device__ __forceinline__ void operator()(const pg8::f32x4 (&acc)[2][2][4][2], const pg8::Unit& u, int wr, int wc, int fr, int fq) const {
        const int row0 = u.pm * 256 + wr * 64 + fr, col0 = u.pn * 256 + wc * 32 + 8 * fq;
#pragma unroll
        for (int ai = 0; ai < 2; ++ai)
#pragma unroll
            for (int m = 0; m < 4; ++m) { if (!(u.mask & (3 << (ai * 2)))) continue; bf16_t* rowp = O + (size_t)(row0 + ai * 128 + m * 16) * ldc + col0;
#pragma unroll
                for (int bj = 0; bj < 2; ++bj) { const pg8::f32x4 v0 = acc[ai][bj][m][0], v1 = acc[ai][bj][m][1];
                    v4u w; w.x = pk2(v0[0], v0[1]); w.y = pk2(v0[2], v0[3]); w.z = pk2(v1[0], v1[1]); w.w = pk2(v1[2], v1[3]); *(v4u*)(rowp + bj * 128) = w; } }
    }
};
struct EpiVt { static constexpr bool PERM = true, MIDK = false; bf16_t* Vt; const float* ssq_kv4;
    __device__ __forceinline__ void operator()(const pg8::f32x4 (&acc)[2][2][4][2], const pg8::Unit& u, int wr, int wc, int fr, int fq) const {
        const int row0 = u.pm * 256 + wr * 64 + fr, col0 = u.pn * 256 + wc * 32 + 8 * fq;
        const int pb = (col0 & ~15) + 4 * (fq & 1);
#pragma unroll
        for (int bj = 0; bj < 2; ++bj) {
            float rs[8];
#pragma unroll
            for (int j = 0; j < 8; ++j) { const pg8::f32x4 s4 = *(const pg8::f32x4*)(ssq_kv4 + (size_t)(col0 + bj * 128 + j) * 4); rs[j] = rsqrtf(((s4[0] + s4[1]) + (s4[2] + s4[3])) * (1.f / KVR) + EPS); }
#pragma unroll
            for (int ai = 0; ai < 2; ++ai)
#pragma unroll
                for (int m = 0; m < 4; ++m) { if (!(u.mask & (1 << (ai * 2 + bj)))) continue; bf16_t* rowp = Vt + (size_t)(row0 + ai * 128 + m * 16) * NT + pb + bj * 128;
                    const pg8::f32x4 v0 = acc[ai][bj][m][0], v1 = acc[ai][bj][m][1];
                    v2u a, b; a.x = pk2(v0[0] * rs[0], v0[1] * rs[1]); a.y = pk2(v0[2] * rs[2], v0[3] * rs[3]);
                    b.x = pk2(v1[0] * rs[4], v1[1] * rs[5]); b.y = pk2(v1[2] * rs[6], v1[3] * rs[7]);
                    *(v2u*)(rowp) = a; *(v2u*)(rowp + 8) = b; }
        }
    }
};
__device__ __forceinline__ void phase3_gemms(const Params& p, LAS unsigned char* lds) {
    unsigned char* ws = p.ws; const int G = gridDim.x, c = blockIdx.x;
    const bf16_t* proj = (const bf16_t*)(ws + WS_PROJ);
    { pg8::Gemm g{proj + 4096, (const bf16_t*)(ws + WS_BT_UQ), nullptr, INCP, QR, QR, 0};
      pg8::StaticOrder S; S.init(NT / 256, 6, G, c, QR); EpiBf16Store E{(bf16_t*)(ws + WS_QRAW), 1536, 0};
      pg8::gemm_phase<EpiBf16Store, pg8::StaticOrder>((PG8_LAS unsigned char*)lds, g, S, E); }
    { pg8::Gemm g{proj + 4608, (const bf16_t*)(ws + WS_BT_KV), nullptr, INCP, KVR, KVR, 0};
      pg8::StaticOrder S; S.init(NT / 256, 4, G, (c + 64) % G, KVR); EpiBf16Store E{(bf16_t*)(ws + WS_KRAW), 1024, 0};
      pg8::gemm_phase<EpiBf16Store, pg8::StaticOrder>((PG8_LAS unsigned char*)lds, g, S, E); }
    { pg8::Gemm g{(const bf16_t*)(ws + WS_BT_KV) + 1024 * KVR, proj + 4608, nullptr, KVR, INCP, KVR, 0};
      pg8::StaticOrder S; S.init(4, NT / 256, G, (c + 192) % G, INCP); EpiVt E{(bf16_t*)(ws + WS_VT), (const float*)(ws + TAB_SSQ_KV4)};
      pg8::gemm_phase<EpiVt, pg8::StaticOrder>((PG8_LAS unsigned char*)lds, g, S, E); }
}

constexpr float QSCALE = 0.07216878364870323f * 1.4426950408889634f;
__device__ __forceinline__ void phase4_qk(const Params& p, int wave, int lane) {
    unsigned char* ws = p.ws;
    const bf16_t* qraw = (const bf16_t*)(ws + WS_QRAW); const bf16_t* kraw = (const bf16_t*)(ws + WS_KRAW); const bf16_t* proj = (const bf16_t*)(ws + WS_PROJ);
    const float* ssq_q8 = (const float*)(ws + TAB_SSQ_Q8); const float* ssq_kv4 = (const float*)(ws + TAB_SSQ_KV4);
    const int* pos = (const int*)p.in[2]; const float* qg = p.in[14]; const float* kg = p.in[15];
    bf16_t* Q16 = (bf16_t*)(ws + WS_Q16); bf16_t* K16 = (bf16_t*)(ws + WS_K16);
    const float g0q = qg[lane], g1q = qg[64 + lane], g2q = qg[128 + lane], g0k = kg[lane], g1k = kg[64 + lane], g2k = kg[128 + lane];
    const int i = lane & 31; const float inv = exp2f(-(float)i * (13.287712379549449f / 32.f));
    const int gw = blockIdx.x * NWAVES + wave, NGW = gridDim.x * NWAVES;
    for (int it0 = gw; it0 < NT * MH; it0 += 2 * NGW) {
        float q0[2], q1[2], q2[2], k0[2], k1[2], k2[2], rq[2], rkv[2], ps[2];
#pragma unroll
        for (int u = 0; u < 2; ++u) { const int it = it0 + u * NGW; const int t = it >> 3, h = it & 7;
            const pg8::f32x4 qa = *(const pg8::f32x4*)(ssq_q8 + (size_t)t * 8), qb = *(const pg8::f32x4*)(ssq_q8 + (size_t)t * 8 + 4), ka = *(const pg8::f32x4*)(ssq_kv4 + (size_t)t * 4);
            rq[u] = rsqrtf((((qa[0] + qa[1]) + (qa[2] + qa[3])) + ((qb[0] + qb[1]) + (qb[2] + qb[3]))) * (1.f / QR) + EPS); rkv[u] = rsqrtf(((ka[0] + ka[1]) + (ka[2] + ka[3])) * (1.f / KVR) + EPS);
            q0[u] = bf2f(qraw[(size_t)t * 1536 + h * 192 + lane]); q1[u] = bf2f(qraw[(size_t)t * 1536 + h * 192 + 64 + lane]); q2[u] = bf2f(qraw[(size_t)t * 1536 + h * 192 + 128 + lane]);
            k0[u] = bf2f(kraw[(size_t)t * 1024 + h * 128 + lane]); k1[u] = bf2f(kraw[(size_t)t * 1024 + h * 128 + 64 + lane]); k2[u] = bf2f(proj[(size_t)t * INCP + 4864 + lane]); ps[u] = (float)pos[t]; }
#pragma unroll
        for (int u = 0; u < 2; ++u) { const int it = it0 + u * NGW; const int t = it >> 3, h = it & 7, b = t / SEQ, s = t % SEQ;
            float a0 = q0[u] * rq[u], a1 = q1[u] * rq[u], a2 = q2[u] * rq[u], c0 = k0[u] * rkv[u], c1 = k1[u] * rkv[u], c2 = k2[u];
            const float sq = wave_sum(a0 * a0 + a1 * a1 + a2 * a2), sk = wave_sum(c0 * c0 + c1 * c1 + c2 * c2);
            const float nq = rsqrtf(sq * (1.f / 192.f) + EPS) * QSCALE, nk = rsqrtf(sk * (1.f / 192.f) + EPS);
            a0 *= nq * g0q; a1 *= nq * g1q; a2 *= nq * g2q; c0 *= nk * g0k; c1 *= nk * g1k; c2 *= nk * g2k;
            const float ang = ps[u] * inv; const float rev = ang * 0.15915494309189535f; const float fr_ = rev - floorf(rev); const float sn = __builtin_amdgcn_sinf(fr_), cs = __builtin_amdgcn_cosf(fr_);
            const float a2o = __shfl_xor(a2, 32), c2o = __shfl_xor(c2, 32);
            const float a2r = lane < 32 ? a2 * cs - a2o * sn : a2 * cs + a2o * sn;
            const float c2r = lane < 32 ? c2 * cs - c2o * sn : c2 * cs + c2o * sn;
            const size_t base = ((size_t)(b * MH + h) * SEQ + s) * QKD;
            Q16[base + lane] = (bf16_t)f2bf(a0); Q16[base + 64 + lane] = (bf16_t)f2bf(a1); Q16[base + 128 + lane] = (bf16_t)f2bf(a2r);
            K16[base + lane] = (bf16_t)f2bf(c0); K16[base + 64 + lane] = (bf16_t)f2bf(c1); K16[base + 128 + lane] = (bf16_t)f2bf(c2r); }
    }
}

typedef short bf16x8 __attribute__((ext_vector_type(8)));
typedef float f32x16 __attribute__((ext_vector_type(16)));
constexpr int AT_KP = 400, AT_VP = 144, AT_KB = 64 * AT_KP, AT_VB = 128 * AT_VP, AT_BUF = AT_KB + AT_VB;
__device__ __forceinline__ void phase5_attn(const Params& p, LAS unsigned char* lds, int wave, int lane) {
    unsigned char* ws = p.ws;
    const bf16_t* Q16 = (const bf16_t*)(ws + WS_Q16); const bf16_t* K16 = (const bf16_t*)(ws + WS_K16); const bf16_t* Vt = (const bf16_t*)(ws + WS_VT);
    bf16_t* merged = (bf16_t*)(ws + WS_MERGED); float* ssq_o8 = (float*)(ws + TAB_SSQ_O8);
    const int tid = threadIdx.x, cl = lane & 31, hh = lane >> 5, qsub = wave & 3, kpar = wave >> 2;
    float mq = 0.f, mk = 0.f;
    for (int i = 0; i < 3; ++i) { mq = fmaxf(mq, fabsf(p.in[14][lane + 64 * i])); mk = fmaxf(mk, fabsf(p.in[15][lane + 64 * i])); }
#pragma unroll
    for (int o = 1; o < 64; o <<= 1) { mq = fmaxf(mq, __shfl_xor(mq, o)); mk = fmaxf(mk, __shfl_xor(mk, o)); }
    const float negc0 = -(13.856406460551018f * 1.4426950408889634f * 1.02f) * mq * mk;
    int kso[3], vso[2]; size_t vgo[2];
#pragma unroll
    for (int i = 0; i < 3; ++i) { const int c = tid + 512 * i; kso[i] = (c / 24) * AT_KP + (c % 24) * 16; }
#pragma unroll
    for (int i = 0; i < 2; ++i) { const int c = tid + 512 * i, dv = c >> 3, ch = c & 7; vso[i] = AT_KB + dv * AT_VP + ch * 16; vgo[i] = (size_t)dv * NT * 2 + ch * 16; }
    for (int item = blockIdx.x; item < 256; item += gridDim.x) {
        const int bh = item >> 3, x = item & 7, b = bh >> 3, h = bh & 7;
        const char* Qg = (const char*)(Q16 + (size_t)bh * SEQ * QKD); const char* Kg = (const char*)(K16 + (size_t)bh * SEQ * QKD);
        const char* Vg = (const char*)(Vt + (size_t)(h * 128) * NT + b * SEQ);
#pragma unroll 1
        for (int pass = 0; pass < 2; ++pass) {
            const int qi = pass == 0 ? 15 - x : x, nsteps = 2 * (qi + 1), qrow0 = qi * 128 + qsub * 32;
            bf16x8 Qf[12];
#pragma unroll
            for (int ks = 0; ks < 12; ++ks) Qf[ks] = *(const bf16x8*)(Qg + ((size_t)(qrow0 + cl) * QKD + ks * 16 + hh * 8) * 2);
            f32x16 O[4];
#pragma unroll
            for (int vb = 0; vb < 4; ++vb)
#pragma unroll
                for (int r = 0; r < 16; ++r) O[vb][r] = 0.f;
            float lsum = 0.f;
            v4u kr[3], vr[2];
#define AT_LOAD(j) do { _Pragma("unroll") for (int i_ = 0; i_ < 3; ++i_) kr[i_] = *(const v4u*)(Kg + (size_t)(j) * 24576 + (size_t)(tid + 512 * i_) * 16); \
                        _Pragma("unroll") for (int i_ = 0; i_ < 2; ++i_) vr[i_] = *(const v4u*)(Vg + vgo[i_] + (size_t)(j) * 128); } while (0)
#define AT_WRITE(bo) do { _Pragma("unroll") for (int i_ = 0; i_ < 3; ++i_) *(LAS v4u*)(lds + (bo) + kso[i_]) = kr[i_]; \
                          _Pragma("unroll") for (int i_ = 0; i_ < 2; ++i_) *(LAS v4u*)(lds + (bo) + vso[i_]) = vr[i_]; } while (0)
            AT_LOAD(0); AT_WRITE(0); __syncthreads();
#pragma unroll 1
            for (int j = 0; j < nsteps; ++j) {
                const int bo = (j & 1) * AT_BUF;
                if (j + 1 < nsteps) AT_LOAD(j + 1);
                const int key0 = 64 * j + 32 * kpar;
                if (key0 <= qrow0 + 31) {
                    f32x16 S;
#pragma unroll
                    for (int r = 0; r < 16; ++r) S[r] = negc0;
                    const LAS unsigned char* kb = lds + bo + (32 * kpar + cl) * AT_KP + hh * 16;
                    __builtin_amdgcn_s_setprio(1);
#pragma unroll
                    for (int ks = 0; ks < 12; ++ks) { const bf16x8 a = *(const LAS bf16x8*)(kb + ks * 32); S = __builtin_amdgcn_mfma_f32_32x32x16_bf16(a, Qf[ks], S, 0, 0, 0); }
                    __builtin_amdgcn_s_setprio(0);
                    const bool diag = key0 + 31 > qrow0;
                    float pr[16];
#pragma unroll
                    for (int r = 0; r < 16; ++r) { float e = __builtin_amdgcn_exp2f(S[r]);
                        if (diag) { const int key = key0 + (r & 3) + 8 * (r >> 2) + 4 * hh; if (key > qrow0 + cl) e = 0.f; }
                        pr[r] = e; lsum += e; }
                    bf16x8 Pf[2];
#pragma unroll
                    for (int s = 0; s < 2; ++s) { v4u w; w.x = pk2(pr[8 * s + 0], pr[8 * s + 1]); w.y = pk2(pr[8 * s + 2], pr[8 * s + 3]); w.z = pk2(pr[8 * s + 4], pr[8 * s + 5]); w.w = pk2(pr[8 * s + 6], pr[8 * s + 7]);
                        Pf[s] = __builtin_bit_cast(bf16x8, w); }
                    const LAS unsigned char* vbp = lds + bo + AT_KB + cl * AT_VP + (32 * kpar + 8 * hh) * 2;
                    __builtin_amdgcn_s_setprio(1);
#pragma unroll
                    for (int vb = 0; vb < 4; ++vb)
#pragma unroll
                        for (int s = 0; s < 2; ++s) { const bf16x8 a = *(const LAS bf16x8*)(vbp + vb * 32 * AT_VP + s * 32); O[vb] = __builtin_amdgcn_mfma_f32_32x32x16_bf16(a, Pf[s], O[vb], 0, 0, 0); }
                    __builtin_amdgcn_s_setprio(0);
                }
                if (j + 1 < nsteps) AT_WRITE(((j + 1) & 1) * AT_BUF);
                __syncthreads();
            }
            LAS float* X = (LAS float*)lds;
            if (kpar == 1) {
#pragma unroll
                for (int vb = 0; vb < 4; ++vb)
#pragma unroll
                    for (int r = 0; r < 16; ++r) X[(qsub * 65 + vb * 16 + r) * 64 + lane] = O[vb][r];
                X[(qsub * 65 + 64) * 64 + lane] = lsum;
            }
            __syncthreads();
            if (kpar == 0) {
                float l = lsum + X[(qsub * 65 + 64) * 64 + lane];
                l += __shfl_xor(l, 32);
                const float il = 1.f / l; float ss = 0.f;
                const int t = b * SEQ + qrow0 + cl;
                bf16_t* op = merged + (size_t)t * DM + h * 128 + 4 * hh;
#pragma unroll
                for (int vb = 0; vb < 4; ++vb)
#pragma unroll
                    for (int rq = 0; rq < 4; ++rq) { float o[4];
#pragma unroll
                        for (int r3 = 0; r3 < 4; ++r3) { const int r = rq * 4 + r3; o[r3] = (O[vb][r] + X[(qsub * 65 + vb * 16 + r) * 64 + lane]) * il; ss += o[r3] * o[r3]; }
                        v2u w; w.x = pk2(o[0], o[1]); w.y = pk2(o[2], o[3]); *(v2u*)(op + vb * 32 + rq * 8) = w; }
                ss += __shfl_xor(ss, 32);
                if (hh == 0) ssq_o8[(size_t)t * 8 + h] = ss;
            }
            __syncthreads();
        }
    }
#undef AT_LOAD
#undef AT_WRITE
}

__device__ __forceinline__ void phase6_scale(const Params& p, int wave, int lane) {
    unsigned char* ws = p.ws; bf16_t* merged = (bf16_t*)(ws + WS_MERGED); const float* ssq_o8 = (const float*)(ws + TAB_SSQ_O8);
    const int gw = blockIdx.x * NWAVES + wave, NGW = gridDim.x * NWAVES;
    for (int t = gw; t < NT; t += NGW) { const pg8::f32x4 oa = *(const pg8::f32x4*)(ssq_o8 + (size_t)t * 8), ob = *(const pg8::f32x4*)(ssq_o8 + (size_t)t * 8 + 4);
        const float r = rsqrtf((((oa[0] + oa[1]) + (oa[2] + oa[3])) + ((ob[0] + ob[1]) + (ob[2] + ob[3]))) * (1.f / 1024.f) + EPS);
#pragma unroll
        for (int j = 0; j < 2; ++j) { v4u* q = (v4u*)(merged + (size_t)t * DM + 1024 + j * 512 + lane * 8); v4u y = *q;
            y.x = pk2(bflo(y.x) * r, bfhi(y.x) * r); y.y = pk2(bflo(y.y) * r, bfhi(y.y) * r); y.z = pk2(bflo(y.z) * r, bfhi(y.z) * r); y.w = pk2(bflo(y.w) * r, bfhi(y.w) * r); *q = y; } }
}

struct EpiResidF32 { static constexpr bool PERM = false, MIDK = true; const float* x; const float* gate; float* out; const LAS float* rs;
    __device__ __forceinline__ void mid(pg8::f32x4 (&acc)[2][2][4][2], const pg8::Unit& u, int wr, int wc, int fr, int fq) const {
        const LAS float* rp = rs + u.pad * 256 + wr * 64 + fr;
#pragma unroll
        for (int ai = 0; ai < 2; ++ai)
#pragma unroll
            for (int m = 0; m < 4; ++m) { const float r = rp[ai * 128 + m * 16];
#pragma unroll
                for (int bj = 0; bj < 2; ++bj)
#pragma unroll
                    for (int n = 0; n < 2; ++n) acc[ai][bj][m][n] = acc[ai][bj][m][n] * r; }
    }
    __device__ __forceinline__ void operator()(const pg8::f32x4 (&acc)[2][2][4][2], const pg8::Unit& u, int wr, int wc, int fr, int fq) const {
        const int row0 = u.pm * 256 + wr * 64 + fr, col0 = u.pn * 256 + wc * 32 + 4 * fq;
        const float* gp = gate + (size_t)((u.pm * 256) / SEQ) * MODW + col0;
        pg8::f32x4 gv[2][2];
#pragma unroll
        for (int bj = 0; bj < 2; ++bj)
#pragma unroll
            for (int n = 0; n < 2; ++n) gv[bj][n] = *(const pg8::f32x4*)(gp + bj * 128 + n * 16);
#pragma unroll
        for (int ai = 0; ai < 2; ++ai)
#pragma unroll
            for (int m = 0; m < 4; ++m) { if (!(u.mask & (3 << (ai * 2)))) continue; const size_t ro = (size_t)(row0 + ai * 128 + m * 16) * DM + col0;
#pragma unroll
                for (int bj = 0; bj < 2; ++bj)
#pragma unroll
                    for (int n = 0; n < 2; ++n) { const pg8::f32x4 xv = *(const pg8::f32x4*)(x + ro + bj * 128 + n * 16); *(pg8::f32x4*)(out + ro + bj * 128 + n * 16) = xv + gv[bj][n] * acc[ai][bj][m][n]; } }
    }
};
__device__ __forceinline__ void phase7(const Params& p, LAS unsigned char* lds) {
    unsigned char* ws = p.ws;
    pg8::Gemm g{(const bf16_t*)(ws + WS_MERGED), (const bf16_t*)(ws + WS_BT_OUT), nullptr, DM, DM, DM, 0};
    pg8::StaticOrder S; S.init(NT / 256, DM / 256, gridDim.x, blockIdx.x, DM);
    LAS float* rs = (LAS float*)(lds + RING_BYTES + 12288);
    { const float* ssq_o8 = (const float*)(ws + TAB_SSQ_O8); pg8::Unit u;
      for (int i = 0; i < 4 && S.next(i, u); ++i) if (threadIdx.x < 256) { const float* sp = ssq_o8 + (size_t)(u.pm * 256 + threadIdx.x) * 8; const pg8::f32x4 oa = *(const pg8::f32x4*)sp, ob = *(const pg8::f32x4*)(sp + 4);
          rs[i * 256 + threadIdx.x] = rsqrtf((((oa[0] + oa[1]) + (oa[2] + oa[3])) + ((ob[0] + ob[1]) + (ob[2] + ob[3]))) * (1.f / 1024.f) + EPS); }
      __syncthreads(); }
    EpiResidF32 E{p.in[0], (const float*)(ws + CTL_MOD) + 2 * DM, (float*)(ws + WS_H1), rs};
    pg8::gemm_phase<EpiResidF32, pg8::StaticOrder>((PG8_LAS unsigned char*)lds, g, S, E);
}
constexpr int HG_P = 272, HG_VP = 144;
constexpr int HG_A2 = 0, HG_A1 = 17408, HG_QB = 34816, HG_VT = 52224, HG_KT = 70656, HG_SEG = 89088, HG_RS = 91136, HG_FL = 92160, HG_QT = 109568;
struct HgPre { v4u fl[2], q[2], v[2]; };
template <bool NEEDQ>
__device__ __forceinline__ void hg_issue(const bf16_t* __restrict__ proj, int item, HgPre& P) {
    const int bh = item >> 5, c = item & 31, b = bh >> 3, h = bh & 7, t0 = b * SEQ + c * 64, tid = threadIdx.x;
#pragma unroll
    for (int i = 0; i < 2; ++i) { const int ch = tid + 512 * i, t = ch >> 4, c16 = ch & 15; const bf16_t* rp = proj + (size_t)(t0 + t) * INCP + h * 128 + c16 * 8;
        P.fl[i] = *(const v4u*)(rp + 1024); P.v[i] = *(const v4u*)(rp + 2048); if (NEEDQ) P.q[i] = *(const v4u*)rp; }
}
struct HgCol { float kv[16]; float b[16]; float blast, bmid; };
template <bool NEEDQ, bool PERM>
__device__ __forceinline__ void hg_stage(const HgPre& P, const float* __restrict__ lbl, int h, LAS unsigned char* lds, HgCol& C) {
    const int tid = threadIdx.x, k = tid & 127, seg = tid >> 7;
    __syncthreads();
#pragma unroll
    for (int i = 0; i < 2; ++i) { const int ch = tid + 512 * i, t = ch >> 4, c16 = ch & 15;
        *(LAS v4u*)(lds + HG_FL + t * HG_P + c16 * 16) = P.fl[i]; if (NEEDQ) *(LAS v4u*)(lds + HG_QT + t * HG_P + c16 * 16) = P.q[i];
        const v4u w = P.v[i]; const int o = t & 15, pos = PERM ? ((t & ~15) + 8 * ((o >> 2) & 1) + 4 * ((o >> 3) & 1) + (o & 3)) : t;
        LAS unsigned short* vp = (LAS unsigned short*)(lds + HG_VT + (c16 * 8) * HG_VP + (((pos >> 3) ^ (c16 & 7)) * 16) + (pos & 7) * 2);
        vp[0 * (HG_VP / 2)] = (unsigned short)(w.x & 0xffff); vp[1 * (HG_VP / 2)] = (unsigned short)(w.x >> 16);
        vp[2 * (HG_VP / 2)] = (unsigned short)(w.y & 0xffff); vp[3 * (HG_VP / 2)] = (unsigned short)(w.y >> 16);
        vp[4 * (HG_VP / 2)] = (unsigned short)(w.z & 0xffff); vp[5 * (HG_VP / 2)] = (unsigned short)(w.z >> 16);
        vp[6 * (HG_VP / 2)] = (unsigned short)(w.w & 0xffff); vp[7 * (HG_VP / 2)] = (unsigned short)(w.w >> 16); }
    const float l0 = lbl[h * 128 + k], l1 = lbl[1024 + h * 128 + k];
    const float lb = 1.f / (1.f + __expf(l1 - l0));
    __syncthreads();
    const LAS unsigned short* fp = (const LAS unsigned short*)(lds + HG_FL + (seg * 16) * HG_P + k * 2);
    float run = 0.f;
#pragma unroll
    for (int i = 0; i < 16; ++i) { const float fl = bf2f(fp[i * (HG_P / 2)]); const float f = lb + (1.f - lb) / (1.f + __expf(-fl)); C.kv[i] = 1.f - f; run += __logf(f); C.b[i] = run; }
    LAS float* SEG = (LAS float*)(lds + HG_SEG);
    SEG[seg * 128 + k] = run;
    __syncthreads();
    const float s0 = SEG[k], s1 = SEG[128 + k], s2 = SEG[256 + k], s3 = SEG[384 + k];
    const float off = (seg > 0 ? s0 : 0.f) + (seg > 1 ? s1 : 0.f) + (seg > 2 ? s2 : 0.f);
#pragma unroll
    for (int i = 0; i < 16; ++i) C.b[i] += off;
    C.bmid = s0 + s1; C.blast = (s0 + s1) + (s2 + s3);
}
__device__ __forceinline__ void hgrn_pass1(const Params& p, LAS unsigned char* lds, int wave, int lane) {
    unsigned char* ws = p.ws; const bf16_t* proj = (const bf16_t*)(ws + WS_PROJ);
    bf16_t* hgU = (bf16_t*)(ws + WS_HGU); float* hgd = (float*)(ws + TAB_HGD);
    const int tid = threadIdx.x, k = tid & 127, seg = tid >> 7, cl = lane & 31, hh = lane >> 5, G = gridDim.x;
    HgPre P; if ((int)blockIdx.x < 1024) hg_issue<false>(proj, blockIdx.x, P);
    for (int item = blockIdx.x; item < 1024; item += G) {
        const int h = (item >> 5) & 7;
        HgCol C; hg_stage<false, false>(P, p.in[8], h, lds, C);
        if (item + G < 1024) hg_issue<false>(proj, item + G, P);
        { unsigned w[8];
#pragma unroll
          for (int i = 0; i < 8; ++i) { const float a0 = C.kv[2 * i] * __expf(C.blast - C.b[2 * i]), a1 = C.kv[2 * i + 1] * __expf(C.blast - C.b[2 * i + 1]); w[i] = pk2(a0, a1); }
          LAS v4u* kp = (LAS v4u*)(lds + HG_KT + k * HG_VP + seg * 32); kp[0] = (v4u){w[0], w[1], w[2], w[3]}; kp[1] = (v4u){w[4], w[5], w[6], w[7]}; }
        if (seg == 0) hgd[item * 128 + k] = __expf(C.blast);
        __syncthreads();
        const int vb = wave >> 1;
        bf16x8 af[4];
#pragma unroll
        for (int ks = 0; ks < 4; ++ks) af[ks] = *(const LAS bf16x8*)(lds + HG_VT + (32 * vb + cl) * HG_VP + (((2 * ks + hh) ^ ((cl >> 3) & 3) ^ ((vb & 1) << 2)) * 16));
#pragma unroll
        for (int q = 0; q < 2; ++q) { const int kb = (wave & 1) * 2 + q; f32x16 acc;
#pragma unroll
            for (int r = 0; r < 16; ++r) acc[r] = 0.f;
#pragma unroll
            for (int ks = 0; ks < 4; ++ks) { const bf16x8 bfr = *(const LAS bf16x8*)(lds + HG_KT + (32 * kb + cl) * HG_VP + (16 * ks + 8 * hh) * 2); acc = __builtin_amdgcn_mfma_f32_32x32x16_bf16(af[ks], bfr, acc, 0, 0, 0); }
            bf16_t* up = hgU + (size_t)item * 16384 + 32 * kb + cl;
#pragma unroll
            for (int r = 0; r < 16; ++r) { const int v = 32 * vb + (r & 3) + 8 * (r >> 2) + 4 * hh; up[(size_t)v * 128] = (bf16_t)f2bf(acc[r]); } }
    }
}
__device__ __forceinline__ void hgrn_scan(const Params& p) {
    unsigned char* ws = p.ws; bf16_t* hgU = (bf16_t*)(ws + WS_HGU); const float* hgd = (const float*)(ws + TAB_HGD);
    for (int i = blockIdx.x * NTHR + threadIdx.x; i < 32 * 4096; i += gridDim.x * NTHR) {
        const int bh = i >> 12, e4 = i & 4095, k4 = (e4 & 31) * 4;
        float S[4] = {0.f, 0.f, 0.f, 0.f};
        v2u* up = (v2u*)(hgU + (size_t)bh * 32 * 16384 + (size_t)e4 * 4); const float* dp = hgd + (size_t)bh * 32 * 128 + k4;
#pragma unroll 1
        for (int c0 = 0; c0 < 32; c0 += 8) { v2u u[8]; f32x4 d[8];
#pragma unroll
            for (int j = 0; j < 8; ++j) { u[j] = up[(size_t)(c0 + j) * 4096]; d[j] = *(const f32x4*)(dp + (c0 + j) * 128); }
#pragma unroll
            for (int j = 0; j < 8; ++j) { v2u o; o.x = pk2(S[0], S[1]); o.y = pk2(S[2], S[3]); up[(size_t)(c0 + j) * 4096] = o;
                S[0] = d[j][0] * S[0] + bflo(u[j].x); S[1] = d[j][1] * S[1] + bfhi(u[j].x); S[2] = d[j][2] * S[2] + bflo(u[j].y); S[3] = d[j][3] * S[3] + bfhi(u[j].y); } }
    }
}
__device__ __forceinline__ void hgrn_pass3(const Params& p, LAS unsigned char* lds, int wave, int lane) {
    unsigned char* ws = p.ws; const bf16_t* proj = (const bf16_t*)(ws + WS_PROJ);
    const bf16_t* hgS = (const bf16_t*)(ws + WS_HGU); bf16_t* merged = (bf16_t*)(ws + WS_MERGED); const float* og = p.in[9];
    const int tid = threadIdx.x, k = tid & 127, seg = tid >> 7, cl = lane & 31, hh = lane >> 5, vb = wave & 3, tb = wave >> 2, G = gridDim.x;
    HgPre P; if ((int)blockIdx.x < 1024) hg_issue<true>(proj, blockIdx.x, P);
    for (int item = blockIdx.x; item < 1024; item += G) {
        const int bh = item >> 5, c = item & 31, b = bh >> 3, h = bh & 7, t0 = b * SEQ + c * 64;
        bf16x8 sf[8]; v2u gw[4];
        { const bf16_t* sp = hgS + (size_t)item * 16384 + (size_t)(32 * vb + cl) * 128 + 8 * hh;
#pragma unroll
          for (int ks = 0; ks < 8; ++ks) sf[ks] = *(const bf16x8*)(sp + 16 * ks);
          const int t = t0 + 32 * tb + cl;
#pragma unroll
          for (int rq = 0; rq < 4; ++rq) gw[rq] = *(const v2u*)(proj + (size_t)t * INCP + 3072 + h * 128 + 32 * vb + 8 * rq + 4 * hh); }
        HgCol C; hg_stage<true, true>(P, p.in[8], h, lds, C);
        { const LAS unsigned short* qp = (const LAS unsigned short*)(lds + HG_QT + (seg * 16) * HG_P + k * 2);
          LAS unsigned short* a2 = (LAS unsigned short*)(lds + HG_A2 + (seg * 16) * HG_P + k * 2);
          LAS unsigned short* a1 = (LAS unsigned short*)(lds + HG_A1 + (seg * 16) * HG_P + k * 2);
          LAS unsigned short* qb = (LAS unsigned short*)(lds + HG_QB + (seg * 16) * HG_P + k * 2);
          const float em = __expf(-C.bmid), ep = __expf(C.bmid);
#pragma unroll
          for (int i = 0; i < 16; i += 2) { const float q0 = bf2f(qp[i * (HG_P / 2)]), q1 = bf2f(qp[(i + 1) * (HG_P / 2)]);
              const float e0 = __expf(C.b[i]), e1 = __expf(C.b[i + 1]);
              const unsigned wa2 = pk2(C.kv[i] * ep * __builtin_amdgcn_rcpf(e0), C.kv[i + 1] * ep * __builtin_amdgcn_rcpf(e1));
              const unsigned wa1 = pk2(q0 * e0 * em, q1 * e1 * em), wqb = pk2(q0 * e0, q1 * e1);
              a2[i * (HG_P / 2)] = (unsigned short)(wa2 & 0xffff); a2[(i + 1) * (HG_P / 2)] = (unsigned short)(wa2 >> 16);
              a1[i * (HG_P / 2)] = (unsigned short)(wa1 & 0xffff); a1[(i + 1) * (HG_P / 2)] = (unsigned short)(wa1 >> 16);
              qb[i * (HG_P / 2)] = (unsigned short)(wqb & 0xffff); qb[(i + 1) * (HG_P / 2)] = (unsigned short)(wqb >> 16); } }
        __syncthreads();
        if (item + G < 1024) hg_issue<true>(proj, item + G, P);
        f32x16 O;
#pragma unroll
        for (int r = 0; r < 16; ++r) O[r] = 0.f;
#pragma unroll
        for (int ks = 0; ks < 8; ++ks) { const bf16x8 bq = *(const LAS bf16x8*)(lds + HG_QB + (32 * tb + cl) * HG_P + (16 * ks + 8 * hh) * 2); O = __builtin_amdgcn_mfma_f32_32x32x16_bf16(sf[ks], bq, O, 0, 0, 0); }
#pragma unroll
        for (int sb = 0; sb < 2; ++sb) {
            if (sb <= tb) {
                f32x16 X;
#pragma unroll
                for (int r = 0; r < 16; ++r) X[r] = 0.f;
#pragma unroll
                for (int ks = 0; ks < 8; ++ks) { const bf16x8 a = *(const LAS bf16x8*)(lds + HG_A2 + (32 * sb + cl) * HG_P + (16 * ks + 8 * hh) * 2);
                    const bf16x8 bq = *(const LAS bf16x8*)(lds + HG_A1 + (32 * tb + cl) * HG_P + (16 * ks + 8 * hh) * 2); X = __builtin_amdgcn_mfma_f32_32x32x16_bf16(a, bq, X, 0, 0, 0); }
                if (sb == tb) {
#pragma unroll
                    for (int r = 0; r < 16; ++r) { const int s = (r & 3) + 8 * (r >> 2) + 4 * hh; if (s > cl) X[r] = 0.f; } }
#pragma unroll
                for (int s2 = 0; s2 < 2; ++s2) { v4u w; w.x = pk2(X[8 * s2 + 0], X[8 * s2 + 1]); w.y = pk2(X[8 * s2 + 2], X[8 * s2 + 3]); w.z = pk2(X[8 * s2 + 4], X[8 * s2 + 5]); w.w = pk2(X[8 * s2 + 6], X[8 * s2 + 7]);
                    const bf16x8 a = *(const LAS bf16x8*)(lds + HG_VT + (32 * vb + cl) * HG_VP + (((4 * sb + 2 * s2 + hh) ^ ((cl >> 3) & 3) ^ ((vb & 1) << 2)) * 16));
                    O = __builtin_amdgcn_mfma_f32_32x32x16_bf16(a, __builtin_bit_cast(bf16x8, w), O, 0, 0, 0); }
            }
        }
        float ss = 0.f;
#pragma unroll
        for (int r = 0; r < 16; ++r) ss += O[r] * O[r];
        ss += __shfl_xor(ss, 32);
        LAS float* RS = (LAS float*)(lds + HG_RS);
        if (hh == 0) RS[(tb * 4 + vb) * 32 + cl] = ss;
        __syncthreads();
        const float tot = (RS[(tb * 4 + 0) * 32 + cl] + RS[(tb * 4 + 1) * 32 + cl]) + (RS[(tb * 4 + 2) * 32 + cl] + RS[(tb * 4 + 3) * 32 + cl]);
        const float rn = rsqrtf(tot * (1.f / 128.f) + EPS);
        const int t = t0 + 32 * tb + cl;
#pragma unroll
        for (int rq = 0; rq < 4; ++rq) { const int v = 32 * vb + 8 * rq + 4 * hh; const f32x4 gg = *(const f32x4*)(og + v);
            const float g0 = bflo(gw[rq].x), g1 = bfhi(gw[rq].x), g2 = bflo(gw[rq].y), g3 = bfhi(gw[rq].y);
            const float o0 = O[rq * 4 + 0] * rn * gg[0] * (g0 / (1.f + __expf(-g0))), o1 = O[rq * 4 + 1] * rn * gg[1] * (g1 / (1.f + __expf(-g1)));
            const float o2 = O[rq * 4 + 2] * rn * gg[2] * (g2 / (1.f + __expf(-g2))), o3 = O[rq * 4 + 3] * rn * gg[3] * (g3 / (1.f + __expf(-g3)));
            v2u w; w.x = pk2(o0, o1); w.y = pk2(o2, o3); *(v2u*)(merged + (size_t)t * DM + 1024 + h * 128 + v) = w; }
    }
}
typedef float f32x2v __attribute__((ext_vector_type(2)));
constexpr int UPITCH = 2050;
constexpr int LDS_HIST = RING_BYTES + 1024;
__device__ __forceinline__ void phase8(const Params& p, LAS unsigned char* lds, int wave, int lane) {
    unsigned char* ws = p.ws;
    const float* h1 = (const float*)(ws + WS_H1); const float* mod = (const float*)(ws + CTL_MOD);
    unsigned char* u8 = ws + WS_U16;
    const float* wr_ = p.in[18]; const float* rbias = p.in[19];
    int* top_idx = (int*)(ws + TAB_TOPI); float* top_w = (float*)(ws + TAB_TOPW); int* slot = (int*)(ws + TAB_SLOT);
    LAS float* U = (LAS float*)lds;
    LAS int* hist = (LAS int*)(lds + LDS_HIST);
    if (threadIdx.x < 64) hist[threadIdx.x] = 0;
    LAS float* SS = (LAS float*)(lds + RING_BYTES + 5120);
    const int TPB = (NT / 16 + gridDim.x - 1) / gridDim.x;
    int ssb = -1;
    for (int task = blockIdx.x * TPB; task < NT / 16 && task < (int)(blockIdx.x + 1) * TPB; ++task) {
        const int t0 = task * 16;
        if (t0 / SEQ != ssb) { ssb = t0 / SEQ; __syncthreads();
            for (int i4 = threadIdx.x; i4 < DM / 4; i4 += NTHR) { const f32x4 gv = *(const f32x4*)(p.in[6] + i4 * 4), sv = *(const f32x4*)(mod + ssb * MODW + 4 * DM + i4 * 4), hv = *(const f32x4*)(mod + ssb * MODW + 3 * DM + i4 * 4);
                *(LAS f32x4*)(SS + i4 * 4) = gv * (sv + 1.f); *(LAS f32x4*)(SS + DM + i4 * 4) = hv; } }
        __syncthreads();
        { f32x4 v[2][8];
#pragma unroll
          for (int rr = 0; rr < 2; ++rr) { const float* hrow = h1 + (size_t)(t0 + wave * 2 + rr) * DM;
#pragma unroll
              for (int j = 0; j < 8; ++j) v[rr][j] = *(const f32x4*)(hrow + lane * 4 + 256 * j); }
#pragma unroll
          for (int rr = 0; rr < 2; ++rr) {
            const int tl = wave * 2 + rr, t = t0 + tl, b = t / SEQ;
            float s = 0.f;
#pragma unroll
            for (int j = 0; j < 8; ++j) s += (v[rr][j].x * v[rr][j].x + v[rr][j].y * v[rr][j].y) + (v[rr][j].z * v[rr][j].z + v[rr][j].w * v[rr][j].w);
            const float r = rsqrtf(wave_sum(s) * (1.f / DM) + EPS);
#pragma unroll
            for (int j = 0; j < 8; ++j) { const int col = lane * 4 + 256 * j; const f32x4 gs = *(const LAS f32x4*)(SS + col), hv = *(const LAS f32x4*)(SS + DM + col);
                const f32x4 o = v[rr][j] * r * gs + hv; *(unsigned*)(u8 + (size_t)t * DM + col) = pk4_fp8(o.x * 4.f, o.y * 4.f, o.z * 4.f, o.w * 4.f);
                LAS f32x2v* up = (LAS f32x2v*)(U + tl * UPITCH + col); up[0] = (f32x2v){o.x, o.y}; up[1] = (f32x2v){o.z, o.w}; }
          } }
        __syncthreads();
        f32x4 acc[4];
#pragma unroll
        for (int c = 0; c < 4; ++c) acc[c] = (f32x4){0.f, 0.f, 0.f, 0.f};
        { const int kb = wave * 256 + (lane >> 4); const LAS float* ua = U + (lane & 15) * UPITCH + kb; const float* wb = wr_ + (size_t)kb * NE + 4 * (lane & 15);
          f32x4 bv[8], bn[8];
#pragma unroll
          for (int q = 0; q < 8; ++q) bv[q] = *(const f32x4*)(wb + (size_t)q * 4 * NE);
#pragma unroll 1
          for (int k8 = 0; k8 < 64; k8 += 8) {
              if (k8 + 8 < 64) {
#pragma unroll
                  for (int q = 0; q < 8; ++q) bn[q] = *(const f32x4*)(wb + (size_t)(k8 + 8 + q) * 4 * NE); }
#pragma unroll
              for (int q = 0; q < 8; ++q) { const float a = ua[(k8 + q) * 4];
#pragma unroll
                  for (int c = 0; c < 4; ++c) acc[c] = __builtin_amdgcn_mfma_f32_16x16x4f32(a, bv[q][c], acc[c], 0, 0, 0); }
#pragma unroll
              for (int q = 0; q < 8; ++q) bv[q] = bn[q]; } }
        __syncthreads();
        LAS float* P = (LAS float*)lds;
#pragma unroll
        for (int c = 0; c < 4; ++c)
#pragma unroll
            for (int r = 0; r < 4; ++r) P[wave * 1024 + ((lane >> 4) * 4 + r) * 64 + 4 * (lane & 15) + c] = acc[c][r];
        __syncthreads();
        LAS float* LG = (LAS float*)(lds + 32768);
#pragma unroll
        for (int q = 0; q < 2; ++q) { const int i = threadIdx.x + q * NTHR; float s = 0.f;
#pragma unroll
            for (int w = 0; w < 8; ++w) s += P[w * 1024 + i]; LG[i] = s; }
        __syncthreads();
#pragma unroll 1
        for (int rr = 0; rr < 2; ++rr) {
            const int tl = wave * 2 + rr, t = t0 + tl;
            int lanev = lane; asm volatile("" : "+v"(lanev));
            const float sc = 1.f / (1.f + expf(-LG[tl * 64 + lane])); const float sel = sc + rbias[lane];
            float m1 = sel; m1 = fmaxf(m1, __shfl_xor(m1, 1)); m1 = fmaxf(m1, __shfl_xor(m1, 2)); m1 = fmaxf(m1, __shfl_xor(m1, 4));
            const unsigned long long gm = 0xFFull << (lanev & 56);
            const int first = __ffsll((long long)(__ballot(sel == m1) & gm)) - 1;
            float m2 = (lanev == first) ? -INFINITY : sel; m2 = fmaxf(m2, __shfl_xor(m2, 1)); m2 = fmaxf(m2, __shfl_xor(m2, 2)); m2 = fmaxf(m2, __shfl_xor(m2, 4));
            const float gs = m1 + m2; const int g = lanev >> 3; int grank = 0;
#pragma unroll
            for (int gg = 0; gg < 8; ++gg) { const float og = __builtin_bit_cast(float, __builtin_amdgcn_readlane(__builtin_bit_cast(int, gs), gg * 8)); grank += (og > gs || (og == gs && gg < g)) ? 1 : 0; }
            const bool gsel = grank < 4; int rk = 0;
            unsigned kb_ = __builtin_bit_cast(unsigned, sel); kb_ = (kb_ & 0x80000000u) ? ~kb_ : (kb_ | 0x80000000u);
            const unsigned long long key = gsel ? (((unsigned long long)kb_ << 6) | (unsigned long long)(63 - lanev)) : 0ull;
            const int klo = (int)(unsigned)key, khi = (int)(unsigned)(key >> 32);
#pragma unroll
            for (int e = 0; e < 64; ++e) { const unsigned long long o = ((unsigned long long)(unsigned)__builtin_amdgcn_readlane(khi, e) << 32) | (unsigned)__builtin_amdgcn_readlane(klo, e); rk += (o > key) ? 1 : 0; }
            const bool chosen = gsel && rk < 8;
            const unsigned long long cb = __ballot(chosen);
            const float wsum = wave_sum(chosen ? sc : 0.f);
            const int ks = __popcll(cb & ((1ull << lanev) - 1ull));
            if (chosen) { const int lr = __hip_atomic_fetch_add((int*)(hist + lane), 1, __ATOMIC_RELAXED, __HIP_MEMORY_SCOPE_WORKGROUP); top_idx[t * 8 + ks] = lane; top_w[t * 8 + ks] = sc / wsum * 2.5f; slot[t * 8 + ks] = lr; }
        }
        __syncthreads();
    }
    if (threadIdx.x < 64) ((int*)(ws + CTL_HIST))[blockIdx.x * 64 + threadIdx.x] = hist[threadIdx.x];
}

__device__ __forceinline__ void phase9(const Params& p, LAS unsigned char* lds, int wave, int lane) {
    unsigned char* ws = p.ws;
    const int* bh = (const int*)(ws + CTL_HIST);
    int* top_idx = (int*)(ws + TAB_TOPI); int* slot = (int*)(ws + TAB_SLOT); int* row_tok = (int*)(ws + TAB_ROWTOK); int* tile_exp = (int*)(ws + TAB_TILEEXP);
    LAS int* rb = (LAS int*)(lds + LDS_HIST + 256);
    const int G = gridDim.x;
    {
        LAS int* part = (LAS int*)(lds + LDS_HIST + 2048);
        const int e = threadIdx.x & 63, pt = threadIdx.x >> 6, per = (G + 7) / 8, b0 = pt * per, b1 = (b0 + per < G) ? b0 + per : G;
        int cnt = 0, base = 0;
#pragma unroll 8
        for (int b = b0; b < b1; ++b) { const int v = bh[b * 64 + e]; base += (b < (int)blockIdx.x) ? v : 0; cnt += v; }
        part[pt * 64 + e] = cnt; part[512 + pt * 64 + e] = base;
    }
    __syncthreads();
    if (wave == 0) {
        LAS int* part = (LAS int*)(lds + LDS_HIST + 2048);
        int cnt = 0, base = 0;
#pragma unroll
        for (int q = 0; q < 8; ++q) { cnt += part[q * 64 + lane]; base += part[512 + q * 64 + lane]; }
        const int tiles = (cnt + 255) >> 8;
        int incl = tiles;
#pragma unroll
        for (int o = 1; o < 64; o <<= 1) { const int n = __shfl_up(incl, o); if (lane >= o) incl += n; }
        const int toff = incl - tiles;
        rb[lane] = toff * 256 + base;
        if (blockIdx.x == 0) { for (int i = 0; i < tiles; ++i) tile_exp[toff + i] = lane; if (lane == 63) tile_exp[512] = incl; if (lane < 32) tile_exp[320 + lane] = 64; }
        rb[64 + lane] = toff * 256 + cnt; rb[128 + lane] = (toff + tiles) * 256;
    }
    __syncthreads();
    for (int e = blockIdx.x; e < 64; e += G) { const int lo = rb[64 + e], hi = rb[128 + e]; for (int r = lo + (int)threadIdx.x; r < hi; r += NTHR) row_tok[r] = 0; }
    for (int i = blockIdx.x * NTHR + threadIdx.x; i < NT; i += G * NTHR) row_tok[ROUTED_ROWS_MAX + i] = i;
    const int TPB = (NT / 16 + G - 1) / G;
    for (int task = blockIdx.x * TPB; task < NT / 16 && task < (int)(blockIdx.x + 1) * TPB; ++task) {
        const int t = task * 16 + wave * 2 + (lane >> 3), k = lane & 7;
        if (lane < 16) { const int e = top_idx[t * 8 + k]; const int pos = rb[e] + slot[t * 8 + k]; slot[t * 8 + k] = pos; row_tok[pos] = t; }
    }
}

constexpr int LDS_UNITS = RING_BYTES + 8192;
struct MoeOrder {
    LAS int* tab; int n;
    __device__ void init(LAS unsigned char* lds, const int* tile_exp, int nN, int G, int c, long estride, long bstep, int parts) {
        tab = (LAS int*)(lds + LDS_UNITS);
        const int ntr = tile_exp[512], nwg = (ntr + 32) * nN;
        int T = nwg % G, nfull = nwg - T; if (true) { nfull = nwg; T = 0; }
        const int njobs = nfull + parts * T;
        const int i = threadIdx.x; n = 0;
        if (c < njobs) n = (njobs - 1 - c) / G + 1;
        if (i < 32 && i < n) {
            const int L = i * G + c; int wgid, mask = 15;
            if (L < nfull) wgid = L; else { const int j = L - nfull; wgid = nfull + j % T; const int part = j / T; mask = (parts == 2) ? (part ? 12 : 3) : (1 << part); }
            { const int q = nwg / 8, r = nwg % 8, xcd = wgid % 8, off = wgid / 8; wgid = (xcd < r ? xcd * (q + 1) : r * (q + 1) + (xcd - r) * q) + off; }
            const int ti = wgid / nN, pn = wgid % nN; int tile, e; if (ti < ntr) { tile = ti; e = tile_exp[ti]; } else { tile = 320 + (ti - ntr); e = 64; }
            const long boff = (long)e * estride + (long)pn * bstep;
            tab[i * 8 + 0] = tile; tab[i * 8 + 1] = pn; tab[i * 8 + 2] = (int)(boff & 0xffffffffl); tab[i * 8 + 3] = (int)(boff >> 32); tab[i * 8 + 4] = mask;
        }
        __syncthreads();
    }
    __device__ bool next(int i, pg8::Unit& u) const {
        if (i >= n) return false;
        u.pm = tab[i * 8 + 0]; u.pn = tab[i * 8 + 1]; u.boff = (long)(((unsigned long long)(unsigned)tab[i * 8 + 3] << 32) | (unsigned)tab[i * 8 + 2]); u.mask = tab[i * 8 + 4]; u.pad = 0; return true;
    }
};
struct EpiGateUp { static constexpr bool PERM = true, MIDK = false; unsigned char* H;
    __device__ __forceinline__ void operator()(const pg8::f32x4 (&acc)[2][2][4][2], const pg8::Unit& u, int wr, int wc, int fr, int fq) const {
        const int row0 = u.pm * 256 + wr * 64 + fr, col0 = u.pn * 128 + wc * 32 + 8 * fq;
#pragma unroll
        for (int ai = 0; ai < 2; ++ai)
#pragma unroll
            for (int m = 0; m < 4; ++m) { const int row = row0 + ai * 128 + m * 16; float o[8];
#pragma unroll
                for (int n = 0; n < 2; ++n)
#pragma unroll
                    for (int j = 0; j < 4; ++j) { const float gt = acc[ai][0][m][n][j] * (1.f / 256.f), up = acc[ai][1][m][n][j] * (8.f / 256.f); o[n * 4 + j] = gt / (1.f + __expf(-gt)) * up; }
                v2u w; w.x = pk4_fp8(o[0], o[1], o[2], o[3]); w.y = pk4_fp8(o[4], o[5], o[6], o[7]);
                *(v2u*)(H + (size_t)row * DE + col0) = w; }
    }
};
struct EpiDown { static constexpr bool PERM = true, MIDK = false; unsigned char* Y;
    __device__ __forceinline__ void operator()(const pg8::f32x4 (&acc)[2][2][4][2], const pg8::Unit& u, int wr, int wc, int fr, int fq) const {
        const int row0 = u.pm * 256 + wr * 64 + fr, col0 = u.pn * 256 + wc * 32 + 8 * fq; const float s = 16.f / 512.f;
#pragma unroll
        for (int ai = 0; ai < 2; ++ai)
#pragma unroll
            for (int m = 0; m < 4; ++m) { const int row = row0 + ai * 128 + m * 16; unsigned char* rowp = Y + (size_t)row * DM + col0;
#pragma unroll
                for (int bj = 0; bj < 2; ++bj) { const pg8::f32x4 v0 = acc[ai][bj][m][0] * s, v1 = acc[ai][bj][m][1] * s;
                    v2u w; w.x = pk4_fp8(v0[0], v0[1], v0[2], v0[3]); w.y = pk4_fp8(v1[0], v1[1], v1[2], v1[3]); *(v2u*)(rowp + bj * 128) = w; } }
    }
};
__device__ __forceinline__ void phase10(const Params& p, LAS unsigned char* lds) {
    unsigned char* ws = p.ws;
    pg8::Gemm g{(const bf16_t*)(ws + WS_U16), (const bf16_t*)(ws + WS_BT_GU), (const int*)(ws + TAB_ROWTOK), DM, DM, DM, 0};
    MoeOrder S; S.init(lds, (const int*)(ws + TAB_TILEEXP), 4, gridDim.x, blockIdx.x, (long)1024 * DM, (long)256 * DM, 2);
    EpiGateUp E{ws + WS_HID};
    pg8::gemm_phase<EpiGateUp, MoeOrder, 1>((PG8_LAS unsigned char*)lds, g, S, E);
}
__device__ __forceinline__ void phase11(const Params& p, LAS unsigned char* lds) {
    unsigned char* ws = p.ws;
    pg8::Gemm g{(const bf16_t*)(ws + WS_HID), (const bf16_t*)(ws + WS_BT_DN), nullptr, DE, DE, DE, 0};
    MoeOrder S; S.init(lds, (const int*)(ws + TAB_TILEEXP), 8, gridDim.x, blockIdx.x, (long)DM * DE, (long)256 * DE, 4);
    EpiDown E{ws + WS_Y};
    pg8::gemm_phase<EpiDown, MoeOrder, 1>((PG8_LAS unsigned char*)lds, g, S, E);
}
__device__ __forceinline__ void fp8x8_fma(const v2u y, float w, float (&a)[8]) {
#pragma unroll
    for (int q = 0; q < 2; ++q) { const unsigned d = y[q];
        a[q * 4 + 0] += w * __builtin_amdgcn_cvt_f32_fp8((int)d, 0); a[q * 4 + 1] += w * __builtin_amdgcn_cvt_f32_fp8((int)d, 1);
        a[q * 4 + 2] += w * __builtin_amdgcn_cvt_f32_fp8((int)d, 2); a[q * 4 + 3] += w * __builtin_amdgcn_cvt_f32_fp8((int)d, 3); }
}
__device__ __forceinline__ void phase12(const Params& p, int wave, int lane) {
    unsigned char* ws = p.ws;
    const float* h1 = (const float*)(ws + WS_H1); const float* mod = (const float*)(ws + CTL_MOD); const unsigned char* Y = ws + WS_Y;
    const int* slot = (const int*)(ws + TAB_SLOT); const float* top_w = (const float*)(ws + TAB_TOPW);
    const int gw = blockIdx.x * NWAVES + wave, NGW = gridDim.x * NWAVES;
    for (int t = gw; t < NT; t += NGW) {
        const int b = t / SEQ; const float* gt = mod + b * MODW + 5 * DM;
        int sl = 0; float wk = 0.f; if (lane < 8) { sl = slot[t * 8 + lane]; wk = top_w[t * 8 + lane] * (1.f / 16.f); }
#pragma unroll 2
        for (int j = 0; j < 4; ++j) {
            const int col = j * 512 + lane * 4;
            float a[8];
#pragma unroll
            for (int i = 0; i < 8; ++i) a[i] = 0.f;
            v2u yr[9];
            { const unsigned char* yp = Y + (size_t)(ROUTED_ROWS_MAX + t) * DM + col; yr[8].x = __builtin_nontemporal_load((const unsigned*)yp); yr[8].y = __builtin_nontemporal_load((const unsigned*)(yp + 256)); }
#pragma unroll
            for (int k = 0; k < 8; ++k) { const int s = __builtin_amdgcn_readlane(sl, k); const unsigned char* yp = Y + (size_t)s * DM + col;
                yr[k].x = __builtin_nontemporal_load((const unsigned*)yp); yr[k].y = __builtin_nontemporal_load((const unsigned*)(yp + 256)); }
            const f32x4 h0 = *(const f32x4*)(h1 + (size_t)t * DM + col), h4 = *(const f32x4*)(h1 + (size_t)t * DM + col + 256);
            const f32x4 g0 = *(const f32x4*)(gt + col), g4 = *(const f32x4*)(gt + col + 256);
            fp8x8_fma(yr[8], 1.f / 16.f, a);
#pragma unroll
            for (int k = 0; k < 8; ++k) { const float w = __builtin_bit_cast(float, __builtin_amdgcn_readlane(__builtin_bit_cast(int, wk), k)); fp8x8_fma(yr[k], w, a); }
            f32x4 o0, o4; o0.x = h0.x + g0.x * a[0]; o0.y = h0.y + g0.y * a[1]; o0.z = h0.z + g0.z * a[2]; o0.w = h0.w + g0.w * a[3];
            o4.x = h4.x + g4.x * a[4]; o4.y = h4.y + g4.y * a[5]; o4.z = h4.z + g4.z * a[6]; o4.w = h4.w + g4.w * a[7];
            __builtin_nontemporal_store(o0, (f32x4*)(p.out + (size_t)t * DM + col)); __builtin_nontemporal_store(o4, (f32x4*)(p.out + (size_t)t * DM + col + 256));
        }
    }
}

__global__ void __launch_bounds__(NTHR, 2) k_mega(Params p) {
    extern __shared__ __attribute__((aligned(16))) unsigned char lds_raw[];
    LAS unsigned char* lds = (LAS unsigned char*)lds_raw;
    const int tid = threadIdx.x, lane = tid & 63, wave = __builtin_amdgcn_readfirstlane(tid >> 6);
    volatile LAS unsigned* MISC = (volatile LAS unsigned*)(lds + MISC_OFF);
    for (int u = tid; u < (LDS_BYTES - RING_BYTES) / 4; u += NTHR) ((LAS unsigned*)(lds + RING_BYTES))[u] = 0u;
    __syncthreads();
    XcdBarrier bar = xcd_barrier_post((unsigned*)(p.ws + WS_CTL) + CW_BAR, MISC + 8);
    const int lo = p.ph_lo, hi = p.ph_hi;
#ifndef DUP_MASK
#define DUP_MASK 0
#endif
#define IN(k) (lo <= (k) && (k) < hi)
#define DUPK(k, body) do { if (IN(k)) { body; if ((DUP_MASK >> (k)) & 1) { xcd_barrier(bar); body; } } } while (0)
#ifdef SPIN_PHASE
#define STAMP(k) do { if (blockIdx.x == 0 && tid == 0) ((unsigned long long*)(p.ws + 49152))[k] = __builtin_amdgcn_s_memrealtime(); } while (0)
#else
#define STAMP(k) do { } while (0)
#endif
#define SEAM(k) do { if (IN(k) && IN((k) + 1)) { xcd_barrier(bar); STAMP((k) + 1); } } while (0)
    STAMP(0);
    DUPK(0, phase0(p, lds, wave, lane)); SEAM(0);
    DUPK(1, phase1(p, lds, wave, lane)); SEAM(1);
#ifdef EXTRA_BARS
    for (int eb = 0; eb < EXTRA_BARS; ++eb) xcd_barrier(bar);
#endif
    DUPK(2, phase2(p, lds)); SEAM(2);
    DUPK(3, phase3_gemms(p, lds); hgrn_pass1(p, lds, wave, lane)); SEAM(3);
    DUPK(4, hgrn_scan(p); phase4_qk(p, wave, lane); if ((DUP_MASK >> 17) & 1) { xcd_barrier(bar); phase4_qk(p, wave, lane); }); SEAM(4);
    DUPK(5, phase5_attn(p, lds, wave, lane); hgrn_pass3(p, lds, wave, lane); if ((DUP_MASK >> 16) & 1) { xcd_barrier(bar); hgrn_pass3(p, lds, wave, lane); }); if (IN(5) && IN(7)) { xcd_barrier(bar); STAMP(6); STAMP(7); }
    DUPK(7, phase7(p, lds)); SEAM(7);
    DUPK(8, phase8(p, lds, wave, lane)); SEAM(8);
    DUPK(9, phase9(p, lds, wave, lane)); SEAM(9);
    DUPK(10, phase10(p, lds)); SEAM(10);
    DUPK(11, phase11(p, lds)); SEAM(11);
    DUPK(12, phase12(p, wave, lane));
#ifdef SPIN_NTR
    { const int ntr = ((const int*)(p.ws + TAB_TILEEXP))[512]; const unsigned long long d = (unsigned long long)(ntr - 256) * 1000ull;
      const unsigned long long t0 = __builtin_amdgcn_s_memrealtime(); while (__builtin_amdgcn_s_memrealtime() - t0 < d) __builtin_amdgcn_s_sleep(8); }
#endif
#ifdef SPIN_PHASE
    xcd_barrier(bar); STAMP(13);
    xcd_barrier(bar);
    { const unsigned long long* ts = (const unsigned long long*)(p.ws + 49152);
      const unsigned long long d = __hip_atomic_load(ts + SPIN_PHASE + 1, __ATOMIC_RELAXED, __HIP_MEMORY_SCOPE_AGENT) - __hip_atomic_load(ts + SPIN_PHASE, __ATOMIC_RELAXED, __HIP_MEMORY_SCOPE_AGENT);
      const unsigned long long t0 = __builtin_amdgcn_s_memrealtime(); while (__builtin_amdgcn_s_memrealtime() - t0 < 4ull * d) __builtin_amdgcn_s_sleep(8); }
#endif
#undef IN
#undef SEAM
}
extern "C" void kernel_launch(void* const* d_in, const int* in_sizes, int n_in, void* d_out, int out_size, void* d_ws, size_t ws_size, hipStream_t stream) {
    static int grid = 0;
    if (grid == 0) {
        int dev = 0, cus = 0;
        if (hipGetDevice(&dev) != hipSuccess || hipDeviceGetAttribute(&cus, hipDeviceAttributeMultiprocessorCount, dev) != hipSuccess) { grid = -1; return; }
        if (hipFuncSetAttribute((const void*)k_mega, hipFuncAttributeMaxDynamicSharedMemorySize, LDS_BYTES) != hipSuccess) { fprintf(stderr, "kernel_launch: hipFuncSetAttribute failed\n"); grid = -1; return; }
        (void)hipGetLastError();
        grid = cus;
        if (n_in != 26 || ws_size < WS_END) { fprintf(stderr, "kernel_launch: unexpected inputs / workspace (%d, %zu)\n", n_in, ws_size); grid = -1; return; }
    }
    if (grid < 0) return;
    (void)hipMemsetAsync((char*)d_ws + WS_CTL, 0, CTL_ZERO_BYTES, stream);
    Params p{};
    for (int i = 0; i < 26; ++i) p.in[i] = (const float*)d_in[i];
    p.out = (float*)d_out; p.ws = (unsigned char*)d_ws; p.ph_lo = 0; p.ph_hi = 13;
    hipLaunchKernelGGL(k_mega, dim3(grid), dim3(NTHR), LDS_BYTES, stream, p);
}
```

```cpp
#include <hip/hip_runtime.h>
#include <cstdio>
#include <cstdint>
constexpr int NB = 4, SEQ = 2048, DM = 2048, NT = NB * SEQ;
constexpr int INC = 4928, INCP = 5120;
constexpr int MH = 8, QR = 512, KVR = 256, QKD = 192, VD = 128;
constexpr int NE = 64, DE = 512;
constexpr float EPS = 1e-6f;
constexpr int MODW = 6 * DM;
constexpr int NWAVES = 8, NTHR = 512;
constexpr int PROWS = 90112;
constexpr int ROUTED_ROWS_MAX = 81920;

constexpr size_t MiB = 1u << 20;
constexpr size_t WS_CTL = 0, CTL_ZERO_BYTES = 1 * MiB;
constexpr int CW_BAR = 1024;
constexpr size_t CTL_MOD = 64 * 1024;
constexpr size_t WS_MODP = 4 * MiB;
constexpr size_t TAB_SSQ_Q8 = 7 * MiB, TAB_SSQ_KV4 = 7 * MiB + 256 * 1024, TAB_SSQ_O8 = 7 * MiB + 512 * 1024;
constexpr size_t CTL_HIST = 416 * 1024;
constexpr size_t WS_TAB = 1 * MiB;
constexpr size_t TAB_HGD = WS_TAB;
constexpr size_t TAB_TOPI = WS_TAB + 1 * MiB;
constexpr size_t TAB_TOPW = TAB_TOPI + 256 * 1024;
constexpr size_t TAB_SLOT = TAB_TOPW + 256 * 1024;
constexpr size_t TAB_ROWTOK = TAB_SLOT + 256 * 1024;
constexpr size_t TAB_TILEEXP = TAB_ROWTOK + 512 * 1024;
constexpr size_t WS_BT_IN = 8 * MiB, WS_BT_UQ = 28 * MiB, WS_BT_KV = 30 * MiB, WS_BT_OUT = 32 * MiB, WS_BT_GU = 40 * MiB, WS_BT_DN = 300 * MiB;
constexpr size_t WS_U16 = 430 * MiB, WS_H1 = 462 * MiB, WS_HID = 526 * MiB, WS_X = 614 * MiB;
constexpr size_t WS_PROJ = WS_X, WS_QRAW = WS_X + 80 * MiB, WS_KRAW = WS_X + 104 * MiB, WS_VT = WS_X + 120 * MiB, WS_Q16 = WS_X + 136 * MiB, WS_K16 = WS_X + 160 * MiB,
                 WS_HGU = WS_X + 184 * MiB, WS_MERGED = WS_X + 216 * MiB, WS_Y = WS_X, WS_END = 966 * MiB;

constexpr int RING_BYTES = 131072, LDS_BYTES = 163840, MISC_OFF = LDS_BYTES - 256;

#define GAS __attribute__((address_space(1)))
#define LAS __attribute__((address_space(3)))
typedef unsigned short bf16_t;
typedef unsigned v4u __attribute__((ext_vector_type(4)));
typedef unsigned v2u __attribute__((ext_vector_type(2)));
typedef float f32x4 __attribute__((ext_vector_type(4)));
typedef GAS unsigned gu32;
#define RLX_AGENT __ATOMIC_RELAXED, __HIP_MEMORY_SCOPE_AGENT
__device__ __forceinline__ unsigned f2bf(float f) { unsigned u = __builtin_bit_cast(unsigned, f); return (u + 0x7fffu + ((u >> 16) & 1u)) >> 16; }
__device__ __forceinline__ unsigned pk2(float lo, float hi) { unsigned r; asm volatile("v_cvt_pk_bf16_f32 %0, %1, %2" : "=v"(r) : "v"(lo), "v"(hi)); return r; }
__device__ __forceinline__ float bf2f(unsigned short b) { return __builtin_bit_cast(float, ((unsigned)b) << 16); }
__device__ __forceinline__ float bflo(unsigned w) { return __builtin_bit_cast(float, w << 16); }
__device__ __forceinline__ float bfhi(unsigned w) { return __builtin_bit_cast(float, w & 0xffff0000u); }
__device__ __forceinline__ float sigmoidf_(float x) { return 1.f / (1.f + __expf(-x)); }
__device__ __forceinline__ float siluf_(float x) { return x / (1.f + __expf(-x)); }
__device__ __forceinline__ float wave_sum(float v) {
#pragma unroll
    for (int o = 1; o < 64; o <<= 1) v += __shfl_xor(v, o);
    return v;
}

#define XB_TMO      128
#define XB_XCNT(j)  (256  + 64 * (j))
#define XB_XSUB(j)  (1280 + 64 * (j))
#define XB_XGEN(j)  (2304 + 64 * (j))
#define XB_TOP      3328
#define XB_TOPGEN   3392
#define XCD_BAR_WORDS 3456
#define XB_SPIN_CAP (1u << 18)
__device__ __forceinline__ unsigned xb_ld(unsigned* p)              { return __hip_atomic_load(p, __ATOMIC_RELAXED, __HIP_MEMORY_SCOPE_AGENT); }
__device__ __forceinline__ unsigned xb_add(unsigned* p, unsigned v) { return __hip_atomic_fetch_add(p, v, __ATOMIC_RELAXED, __HIP_MEMORY_SCOPE_AGENT); }
__device__ __forceinline__ unsigned xb_xcc_id() { return (unsigned)__builtin_amdgcn_s_getreg((3 << 11) | 20) & 0xFu; }
#define XB_SPIN(cond, bar) do { unsigned _sp = 0; while (cond) { __builtin_amdgcn_s_sleep(1); \
    if ((++_sp & 255u) == 0u) { if (xb_ld(&(bar)[XB_TMO])) break; if (_sp > XB_SPIN_CAP) { atomicAdd(&(bar)[XB_TMO], 1u); break; } } } } while (0)
struct XcdBarrier { unsigned* bar; unsigned x; volatile LAS unsigned* st; };
__device__ __forceinline__ XcdBarrier xcd_barrier_post(unsigned* bar, volatile LAS unsigned* st) {
    XcdBarrier b; b.bar = bar; b.x = xb_xcc_id(); b.st = st;
    if (threadIdx.x == 0) (void)xb_add(&bar[XB_XCNT(b.x)], 1u);
    return b;
}
__device__ __forceinline__ void xcd_barrier_complete(unsigned* bar, unsigned x, unsigned& nloc, unsigned& nx) {
    const unsigned G = gridDim.x * gridDim.y * gridDim.z;
    unsigned sum, cnt, mine, sp = 0u;
    for (;;) {
        sum = 0u; cnt = 0u; mine = 0u;
#pragma unroll
        for (unsigned j = 0; j < 16; ++j) { const unsigned c = xb_ld(&bar[XB_XCNT(j)]); sum += c; cnt += (c > 0u) ? 1u : 0u; mine = (j == x) ? c : mine; }
        if (sum == G) break;
        __builtin_amdgcn_s_sleep(1);
        if ((++sp & 255u) == 0u) { if (xb_ld(&bar[XB_TMO])) break; if (sp > XB_SPIN_CAP) { atomicAdd(&bar[XB_TMO], 1u); break; } }
    }
    nloc = mine > 0u ? mine : 1u; nx = cnt > 0u ? cnt : 1u;
}
__device__ __forceinline__ void xcd_barrier(const XcdBarrier& b) {
    asm volatile("s_waitcnt vmcnt(0)" ::: "memory");
    __syncthreads();
    if (threadIdx.x == 0) {
        unsigned* bar = b.bar;
        __builtin_amdgcn_s_waitcnt(0);
        unsigned nloc = b.st[0], nx = b.st[1];
        if (nloc == 0u) { xcd_barrier_complete(bar, b.x, nloc, nx); b.st[0] = nloc; b.st[1] = nx; }
        const unsigned old = xb_add(&bar[XB_XSUB(b.x)], 1u);
        const unsigned gen = old / nloc;
        if (old + 1u == (gen + 1u) * nloc) {
            __builtin_amdgcn_fence(__ATOMIC_RELEASE, "agent");
            asm volatile("s_waitcnt vmcnt(0)" ::: "memory");
            const unsigned og = xb_add(&bar[XB_TOP], 1u);
            const unsigned tg = og / nx;
            if (og + 1u == (tg + 1u) * nx) xb_add(&bar[XB_TOPGEN], 1u);
            else XB_SPIN(xb_ld(&bar[XB_TOPGEN]) == tg, bar);
            __builtin_amdgcn_fence(__ATOMIC_ACQUIRE, "agent");
            xb_add(&bar[XB_XGEN(b.x)], 1u);
            asm volatile("s_waitcnt vmcnt(0)" ::: "memory");
        } else {
            XB_SPIN(xb_ld(&bar[XB_XGEN(b.x)]) == gen, bar);
            __builtin_amdgcn_fence(__ATOMIC_ACQUIRE, "agent");
            asm volatile("s_waitcnt vmcnt(0)" ::: "memory");
        }
    }
    __syncthreads();
}

struct Params { const float* in[26]; float* out; unsigned char* ws; int ph_lo, ph_hi; };
namespace pg8 {
#define PG8_LAS __attribute__((address_space(3)))
typedef unsigned short bf16_t;
typedef short bf16x8 __attribute__((ext_vector_type(8)));
typedef float f32x4 __attribute__((ext_vector_type(4)));
typedef unsigned u32x4 __attribute__((ext_vector_type(4)));
typedef unsigned u32x2 __attribute__((ext_vector_type(2)));
constexpr int BM = 256, BK = 64, HALF = 128, HTB = HALF * BK * 2, STAGE_BYTES = 8 * HTB, NXCD = 8, WGM = 8;

__host__ __device__ __forceinline__ int lds_byte(int r, int c) { const int st = (r >> 4) * 2 + (c >> 5), rr = r & 15, cc = c & 31, ob = rr * 64 + cc * 2; return st * 1024 + (ob ^ (((ob >> 9) & 1) << 5)); }
__host__ __device__ __forceinline__ void stage_rc(int b, int& R, int& C) { const int st = b / 1024, sb = b % 1024, swz = sb ^ (((sb >> 9) & 1) << 5); R = (st >> 1) * 16 + swz / 64; C = (st & 1) * 32 + (swz % 64) / 2; }
__host__ __device__ __forceinline__ int perm32(int rho) { const int n = rho >> 4, i = rho & 15; return 8 * (i >> 2) + 4 * n + (i & 3); }

struct Unit { int pm, pn; long boff; int mask, pad; };
struct Gemm { const bf16_t* A; const bf16_t* Bt; const int* rowtab; int lda, ldb, K, pad; };

__device__ __forceinline__ unsigned cvt_pk_bf16(float lo, float hi) { unsigned r; asm volatile("v_cvt_pk_bf16_f32 %0, %1, %2" : "=v"(r) : "v"(lo), "v"(hi)); return r; }

struct StaticOrder {
    int nM, nN, nwg, G, c, nfull, T; long bstep;
    __device__ void init(int nM_, int nN_, int G_, int c_, int ldb) { nM = nM_; nN = nN_; nwg = nM * nN; G = G_; c = c_; bstep = (long)BM * ldb * 2;
        T = 0; nfull = nwg; }
    __device__ bool next(int i, Unit& u) const {
        const long L = (long)i * G + c; int wgid, mask = 15;
        if (L < nfull) wgid = (int)L;
        else { const long j = L - nfull; if (j >= 2 * T) return false; wgid = nfull + (int)(j % T); mask = (j / T) ? 12 : 3; }
        { const int q = nwg / NXCD, r = nwg % NXCD, xcd = wgid % NXCD, off = wgid / NXCD; wgid = (xcd < r ? xcd * (q + 1) : r * (q + 1) + (xcd - r) * q) + off; }
        const int nig = WGM * nN, gid = wgid / nig, fm = gid * WGM, gsz = (nM - fm) < WGM ? (nM - fm) : WGM;
        u.pm = fm + ((wgid % nig) % gsz); u.pn = (wgid % nig) / gsz; u.boff = (long)u.pn * bstep; u.mask = mask; u.pad = i; return true;
    }
};

typedef long i64x2 __attribute__((ext_vector_type(2)));
template <class Epi, class Sched, int ES = 2, bool ALIGN_EPI = true>
__device__ __forceinline__ void gemm_phase(PG8_LAS unsigned char* lds, const Gemm g, const Sched& S, const Epi& E) {
    const int tid = threadIdx.x, wid = __builtin_amdgcn_readfirstlane(tid >> 6), lane = tid & 63, wr = wid >> 2, wc = wid & 3, fr = lane & 15, fq = lane >> 4;
    const int K = g.K, nt = K * ES / (BK * 2);
    int Rr[2]; unsigned Cb[2], voffB[2];
#pragma unroll
    for (int i = 0; i < 2; ++i) { int R, C; stage_rc(tid * 16 + i * 8192, R, C); const int Rb = Epi::PERM ? ((R & ~31) + perm32(R & 31)) : R;
        Rr[i] = R; Cb[i] = (unsigned)C * 2u; voffB[i] = (unsigned)(Rb * g.ldb) * (unsigned)ES + (unsigned)C * 2u; }
    const size_t kstep = (size_t)(BK * 2);
    const size_t hstepB = (size_t)HALF * g.ldb * ES;
    const unsigned lda2 = (unsigned)g.lda * (unsigned)ES;
    const unsigned ldsw = (unsigned)wid * 1024u;
    const int aoff = lds_byte(wr * 64 + fr, fq * 8), boff = lds_byte(wc * 32 + fr, fq * 8);
    const char* const Abase = (const char*)g.A; const char* const Bbase = (const char*)g.Bt;
#define PG8_SA(b, h) (((b) * 2 + (h)) * HTB)
#define PG8_SB(b, h) ((4 + (b) * 2 + (h)) * HTB)
#define PG8_STAGE(bufoff, gbase, voff) do { _Pragma("unroll") for (int _i = 0; _i < 2; ++_i) \
        __builtin_amdgcn_global_load_lds((const unsigned*)((const char*)(gbase) + (voff)[_i]), (PG8_LAS unsigned*)(lds + (bufoff) + ldsw + _i * 8192), 16, 0, 0); } while (0)
#define PG8_VOFFA(u, v) do { _Pragma("unroll") for (int _h = 0; _h < 2; ++_h) _Pragma("unroll") for (int _i = 0; _i < 2; ++_i) { const int _gr = (u).pm * BM + _h * HALF + Rr[_i]; \
        const int _src = g.rowtab ? g.rowtab[_gr] : _gr; (v)[_h][_i] = (unsigned)_src * lda2 + Cb[_i]; } } while (0)
#define PG8_LDA(dst, b, h) do { _Pragma("unroll") for (int m = 0; m < 4; ++m) _Pragma("unroll") for (int k = 0; k < 2; ++k) dst[m][k] = *(const PG8_LAS bf16x8*)(lds + PG8_SA(b, h) + aoff + m * 2048 + k * 1024); } while (0)
#define PG8_LDB(dst, b, h) do { _Pragma("unroll") for (int n = 0; n < 2; ++n) _Pragma("unroll") for (int k = 0; k < 2; ++k) dst[n][k] = *(const PG8_LAS bf16x8*)(lds + PG8_SB(b, h) + boff + n * 2048 + k * 1024); } while (0)
#define PG8_MMA(ai, bj, At, Bt) do { __builtin_amdgcn_s_setprio(1); \
        if constexpr (ES == 2) { _Pragma("unroll") for (int m = 0; m < 4; ++m) _Pragma("unroll") for (int n = 0; n < 2; ++n) _Pragma("unroll") for (int k = 0; k < 2; ++k) \
            acc[ai][bj][m][n] = __builtin_amdgcn_mfma_f32_16x16x32_bf16(Bt[n][k], At[m][k], acc[ai][bj][m][n], 0, 0, 0); } \
        else { _Pragma("unroll") for (int m = 0; m < 4; ++m) _Pragma("unroll") for (int n = 0; n < 2; ++n) _Pragma("unroll") for (int k = 0; k < 2; ++k) { \
            const i64x2 _a = __builtin_bit_cast(i64x2, At[m][k]), _b = __builtin_bit_cast(i64x2, Bt[n][k]); \
            acc[ai][bj][m][n] = __builtin_amdgcn_mfma_f32_16x16x32_fp8_fp8(_b.x, _a.x, acc[ai][bj][m][n], 0, 0, 0); \
            acc[ai][bj][m][n] = __builtin_amdgcn_mfma_f32_16x16x32_fp8_fp8(_b.y, _a.y, acc[ai][bj][m][n], 0, 0, 0); } } \
        __builtin_amdgcn_s_setprio(0); } while (0)
#define PG8_WAIT_V(n) asm volatile("s_waitcnt vmcnt(" #n ")" ::: "memory")
#define PG8_WAIT_L(n) asm volatile("s_waitcnt lgkmcnt(" #n ")" ::: "memory")
#define PG8_BAR __builtin_amdgcn_s_barrier()
#define PG8_SCHED __builtin_amdgcn_sched_barrier(0)
    Unit cur, nxt; int ui = 0;
    if (!S.next(0, cur)) return;
    f32x4 acc[2][2][4][2];
#pragma unroll
    for (int a = 0; a < 2; ++a)
#pragma unroll
        for (int b = 0; b < 2; ++b)
#pragma unroll
            for (int m = 0; m < 4; ++m)
#pragma unroll
                for (int n = 0; n < 2; ++n) acc[a][b][m][n] = (f32x4){0.f, 0.f, 0.f, 0.f};
    bf16x8 At[4][2], B0[2][2], B1[2][2];
    unsigned cv[2][2], nv[2][2];
    PG8_VOFFA(cur, cv);
#pragma unroll
    for (int h = 0; h < 2; ++h) { nv[h][0] = cv[h][0]; nv[h][1] = cv[h][1]; }
    const char* cB = Bbase + cur.boff;
    PG8_STAGE(PG8_SB(0, 0), cB, voffB); PG8_STAGE(PG8_SB(0, 1), cB + hstepB, voffB); PG8_STAGE(PG8_SA(0, 0), Abase, cv[0]); PG8_STAGE(PG8_SA(0, 1), Abase, cv[1]);
    if (wr == 1) PG8_BAR;
    PG8_WAIT_V(2); PG8_BAR;
    PG8_STAGE(PG8_SB(1, 0), cB + kstep, voffB); PG8_STAGE(PG8_SA(1, 0), Abase + kstep, cv[0]); PG8_STAGE(PG8_SB(1, 1), cB + hstepB + kstep, voffB);
    PG8_WAIT_V(6); PG8_BAR;
    for (;;) {
        const bool has_next = S.next(ui + 1, nxt);
        const char* nB = has_next ? Bbase + nxt.boff : cB;
#pragma unroll 1
        for (int t = 0; t < nt; t += 2) {
            const bool last = (t == nt - 2);
            if constexpr (Epi::MIDK) { if (t == nt / 2) E.mid(acc, cur, wr, wc, fr, fq); }
            if (last && has_next) { PG8_VOFFA(nxt, nv); }
            const char* a1 = Abase + (size_t)(t + 1) * kstep;
            const char* a2 = Abase + (last ? (size_t)0 : (size_t)(t + 2) * kstep); const char* a3 = a2 + kstep;
            const char* b2 = last ? nB : cB + (size_t)(t + 2) * kstep; const char* b3 = b2 + kstep;
            unsigned x0[2], x1[2];
            x0[0] = last ? nv[0][0] : cv[0][0]; x0[1] = last ? nv[0][1] : cv[0][1]; x1[0] = last ? nv[1][0] : cv[1][0]; x1[1] = last ? nv[1][1] : cv[1][1];
            PG8_LDB(B0, 0, 0); PG8_LDB(B1, 0, 1); PG8_SCHED; PG8_LDA(At, 0, 0); PG8_STAGE(PG8_SA(1, 1), a1, cv[1]);
            PG8_WAIT_V(8); PG8_WAIT_L(0); PG8_BAR; PG8_MMA(0, 0, At, B0); PG8_MMA(0, 1, At, B1); PG8_BAR; PG8_SCHED;
            PG8_LDA(At, 0, 1); PG8_STAGE(PG8_SB(0, 0), b2, voffB); PG8_STAGE(PG8_SB(0, 1), b2 + hstepB, voffB); PG8_STAGE(PG8_SA(0, 0), a2, x0);
            PG8_WAIT_V(8); PG8_WAIT_L(0); PG8_BAR; PG8_MMA(1, 0, At, B0); PG8_MMA(1, 1, At, B1); PG8_BAR; PG8_SCHED;
            PG8_LDB(B0, 1, 0); PG8_LDB(B1, 1, 1); PG8_SCHED; PG8_LDA(At, 1, 0); PG8_STAGE(PG8_SA(0, 1), a2, x1);
            PG8_WAIT_V(8); PG8_WAIT_L(0); PG8_BAR; PG8_MMA(0, 0, At, B0); PG8_MMA(0, 1, At, B1); PG8_BAR; PG8_SCHED;
            PG8_LDA(At, 1, 1); PG8_STAGE(PG8_SB(1, 0), b3, voffB); PG8_STAGE(PG8_SB(1, 1), b3 + hstepB, voffB); PG8_STAGE(PG8_SA(1, 0), a3, x0);
            PG8_WAIT_V(8); PG8_WAIT_L(0); PG8_BAR; PG8_MMA(1, 0, At, B0); PG8_MMA(1, 1, At, B1); PG8_BAR; PG8_SCHED;
        }
        if constexpr (ALIGN_EPI) { if (wr == 0) PG8_BAR; }
        E(acc, cur, wr, wc, fr, fq);
        if (!has_next) break;
#pragma unroll
        for (int a = 0; a < 2; ++a)
#pragma unroll
            for (int b = 0; b < 2; ++b)
#pragma unroll
                for (int m = 0; m < 4; ++m)
#pragma unroll
                    for (int n = 0; n < 2; ++n) acc[a][b][m][n] = (f32x4){0.f, 0.f, 0.f, 0.f};
        cur = nxt; cB = nB; ++ui;
#pragma unroll
        for (int h = 0; h < 2; ++h) { cv[h][0] = nv[h][0]; cv[h][1] = nv[h][1]; }
        if constexpr (ALIGN_EPI) { if (wr == 1) PG8_BAR; }
    }
    PG8_WAIT_V(0);
    if constexpr (!ALIGN_EPI) { if (wr == 0) PG8_BAR; }
    PG8_BAR;
#undef PG8_SA
#undef PG8_SB
#undef PG8_STAGE
#undef PG8_VOFFA
#undef PG8_LDA
#undef PG8_LDB
#undef PG8_MMA
#undef PG8_WAIT_V
#undef PG8_WAIT_L
#undef PG8_BAR
#undef PG8_SCHED
}
}
__device__ __forceinline__ void conv_tile(const float* __restrict__ src, int ldn, int k0, int n0, const float* __restrict__ kscale, int kfrom,
                                          bf16_t* __restrict__ dst, int dld, int drow0, LAS unsigned* T, int lane, int dk0 = -1) {
    if (dk0 < 0) dk0 = k0;
    const int c4 = lane & 15, kq = lane >> 4;
    f32x4 v0[8], v1[8];
#pragma unroll
    for (int j = 0; j < 8; ++j) { const int kp = kq + 4 * j; const float* p = src + (size_t)(k0 + 2 * kp) * ldn + n0 + c4 * 4;
        v0[j] = *(const f32x4*)p; v1[j] = *(const f32x4*)(p + ldn); }
#pragma unroll
    for (int j = 0; j < 8; ++j) { const int kp = kq + 4 * j; const int k = k0 + 2 * kp;
        float s0 = 1.f, s1 = 1.f; if (kscale && k >= kfrom) { s0 = kscale[k - kfrom]; s1 = kscale[k + 1 - kfrom]; }
#pragma unroll
        for (int q = 0; q < 4; ++q) T[(c4 * 4 + q) * 33 + kp] = pk2(v0[j][q] * s0, v1[j][q] * s1); }
    asm volatile("s_waitcnt lgkmcnt(0)" ::: "memory"); __builtin_amdgcn_wave_barrier();
    const int ch = lane & 7, nr = lane >> 3;
#pragma unroll
    for (int ps = 0; ps < 8; ++ps) { const int n = ps * 8 + nr; const LAS unsigned* t = T + n * 33 + ch * 4;
        v4u o; o.x = t[0]; o.y = t[1]; o.z = t[2]; o.w = t[3];
        *(v4u*)(dst + (size_t)(drow0 + n) * dld + dk0 + ch * 8) = o; }
    asm volatile("s_waitcnt lgkmcnt(0)" ::: "memory"); __builtin_amdgcn_wave_barrier();
}

__device__ __forceinline__ void conv_tile128(const float* __restrict__ src, int ldn, int k0, int n0, bf16_t* __restrict__ dst, int dld, int drow0, LAS unsigned* T, int lane) {
    const int c4 = lane & 15, kq = lane >> 4;
    f32x4 v0[16], v1[16];
#pragma unroll
    for (int j = 0; j < 16; ++j) { const int kp = kq + 4 * j; const float* q = src + (size_t)(k0 + 2 * kp) * ldn + n0 + c4 * 4;
        v0[j] = __builtin_nontemporal_load((const f32x4*)q); v1[j] = __builtin_nontemporal_load((const f32x4*)(q + ldn)); }
#pragma unroll
    for (int j = 0; j < 16; ++j) { const int kp = kq + 4 * j;
#pragma unroll
        for (int q = 0; q < 4; ++q) T[(c4 * 4 + q) * 65 + kp] = pk2(v0[j][q], v1[j][q]); }
    asm volatile("s_waitcnt lgkmcnt(0)" ::: "memory"); __builtin_amdgcn_wave_barrier();
    const int ch = lane & 15, nr = lane >> 4;
#pragma unroll
    for (int ps = 0; ps < 16; ++ps) { const int n = ps * 4 + nr; const LAS unsigned* t = T + n * 65 + ch * 4;
        v4u o; o.x = t[0]; o.y = t[1]; o.z = t[2]; o.w = t[3];
        __builtin_nontemporal_store(o, (v4u*)(dst + (size_t)(drow0 + n) * dld + k0 + ch * 8)); }
    asm volatile("s_waitcnt lgkmcnt(0)" ::: "memory"); __builtin_amdgcn_wave_barrier();
}

__device__ __forceinline__ unsigned pk4_fp8(float a, float b, float c, float d) {
    int w = 0; w = __builtin_amdgcn_cvt_pk_fp8_f32(__builtin_amdgcn_fmed3f(a, -448.f, 448.f), __builtin_amdgcn_fmed3f(b, -448.f, 448.f), w, false);
    w = __builtin_amdgcn_cvt_pk_fp8_f32(__builtin_amdgcn_fmed3f(c, -448.f, 448.f), __builtin_amdgcn_fmed3f(d, -448.f, 448.f), w, true); return (unsigned)w; }
__device__ __forceinline__ void conv_tile128_fp8(const float* __restrict__ src, int ldn, int k0, int n0, unsigned char* __restrict__ dst, int dld, int drow0, LAS unsigned* T, int lane) {
    const int c4 = lane & 15, kq = lane >> 4;
#pragma unroll 1
    for (int hf = 0; hf < 2; ++hf) {
        f32x4 v[8][4];
#pragma unroll
        for (int j = 0; j < 8; ++j) { const float* q = src + (size_t)(k0 + hf * 128 + 4 * (kq + 4 * j)) * ldn + n0 + c4 * 4;
#pragma unroll
            for (int r = 0; r < 4; ++r) v[j][r] = __builtin_nontemporal_load((const f32x4*)(q + (size_t)r * ldn)); }
#pragma unroll
        for (int j = 0; j < 8; ++j) { const int kp = hf * 32 + kq + 4 * j;
#pragma unroll
            for (int q = 0; q < 4; ++q) T[(c4 * 4 + q) * 65 + kp] = pk4_fp8(v[j][0][q] * 64.f, v[j][1][q] * 64.f, v[j][2][q] * 64.f, v[j][3][q] * 64.f); }
    }
    asm volatile("s_waitcnt lgkmcnt(0)" ::: "memory"); __builtin_amdgcn_wave_barrier();
    const int ch = lane & 15, nr = lane >> 4;
#pragma unroll
    for (int ps = 0; ps < 16; ++ps) { const int n = ps * 4 + nr; const LAS unsigned* t = T + n * 65 + ch * 4;
        v4u o; o.x = t[0]; o.y = t[1]; o.z = t[2]; o.w = t[3];
        __builtin_nontemporal_store(o, (v4u*)(dst + (size_t)(drow0 + n) * dld + k0 + ch * 16)); }
    asm volatile("s_waitcnt lgkmcnt(0)" ::: "memory"); __builtin_amdgcn_wave_barrier();
}

__device__ __forceinline__ void ada_item(const float* __restrict__ c, const float* __restrict__ w, float* __restrict__ modp, int item, int lane) {
    const int cc = item % 48, ks = item / 48, col = cc * 256 + lane * 4;
    f32x4 acc[4];
#pragma unroll
    for (int b = 0; b < 4; ++b) acc[b] = (f32x4){0.f, 0.f, 0.f, 0.f};
#pragma unroll 1
    for (int half = 0; half < 2; ++half) {
        const int k0 = ks * 128 + half * 64;
        float cd[4];
#pragma unroll
        for (int b = 0; b < 4; ++b) cd[b] = siluf_(c[b * DM + k0 + lane]);
        const float* wp = w + (size_t)k0 * MODW + col;
#pragma unroll 16
        for (int kk = 0; kk < 64; ++kk) { const f32x4 wv = __builtin_nontemporal_load((const f32x4*)(wp + (size_t)kk * MODW));
#pragma unroll
            for (int b = 0; b < 4; ++b) { const float s = __builtin_bit_cast(float, __builtin_amdgcn_readlane(__builtin_bit_cast(int, cd[b]), kk)); acc[b] += wv * s; } }
    }
#pragma unroll
    for (int b = 0; b < 4; ++b) *(f32x4*)(modp + ((size_t)ks * 4 + b) * MODW + col) = acc[b];
}

constexpr int CT_ADA = 48 * 16;
constexpr int CT_IN = 32 * 77, CT_UQ = 8 * 24, CT_KV = 4 * 32, CT_OUT = 32 * 32, CT_G1 = 8 * 8, CT_D1 = 2 * 32;
constexpr int CT_ZERO = 192 * 4;
constexpr int CT_GU = 65 * 2 * CT_G1, CT_DN = 65 * CT_D1;
constexpr int CT_GU_LATE = 0;
constexpr int CT_TOTAL0 = CT_ADA + CT_IN + CT_UQ + CT_KV + CT_OUT + CT_ZERO + (CT_GU - CT_GU_LATE) + CT_DN;
constexpr int CW_QGU = 8192, CW_QDN = 8192 + 512;

__device__ __forceinline__ void conv_gu_tile(const Params& p, int r, LAS unsigned* T, int lane) {
    const int e = r / (2 * CT_G1); int q = r % (2 * CT_G1);
    unsigned char* gu = p.ws + WS_BT_GU + (size_t)e * 1024 * DM;
    const int up = q >= CT_G1; q -= up * CT_G1; const int kb = q / 8, nb = q % 8, n0 = nb * 64;
    const float* src = (e < 64) ? p.in[up ? 21 : 20] + (size_t)e * DM * DE : p.in[up ? 24 : 23];
    conv_tile128_fp8(src, DE, kb * 256, n0, gu, DM, (n0 >> 7) * 256 + up * 128 + (n0 & 127), T, lane);
}
__device__ __forceinline__ void conv_dn_tile(const Params& p, int r, LAS unsigned* T, int lane) {
    const int e = r / CT_D1, q = r % CT_D1, kb = q / 32, nb = q % 32;
    unsigned char* dn = p.ws + WS_BT_DN + (size_t)e * DM * DE;
    const float* src = (e < 64) ? p.in[22] + (size_t)e * DE * DM : p.in[25];
    conv_tile128_fp8(src, DM, kb * 256, nb * 64, dn, DE, nb * 64, T, lane);
}
template <bool DN>
__device__ __forceinline__ void conv_queue(const Params& p, LAS unsigned char* lds, int wave, int lane, int first, int total) {
    LAS unsigned* T = (LAS unsigned*)(lds + wave * 18432);
    unsigned* heads = (unsigned*)(p.ws + WS_CTL) + (DN ? CW_QDN : CW_QGU);
    const int n = total - first, per = (n + 7) / 8, xcd = (int)xb_xcc_id() & 7;
    for (int s = 0; s < 8; ++s) {
        const int sh = (xcd + s) & 7, lo = first + sh * per, hi = (lo + per < total) ? lo + per : total;
        for (;;) {
            unsigned i = 0; if (lane == 0) i = __hip_atomic_fetch_add(heads + 64 * sh, 2u, __ATOMIC_RELAXED, __HIP_MEMORY_SCOPE_AGENT);
            const int r = lo + (int)__builtin_amdgcn_readfirstlane(i);
            if (r >= hi) break;
            if (DN) conv_dn_tile(p, r, T, lane); else conv_gu_tile(p, r, T, lane);
            if (r + 1 < hi) { if (DN) conv_dn_tile(p, r + 1, T, lane); else conv_gu_tile(p, r + 1, T, lane); }
        }
    }
}

struct ETile { const float* src; unsigned char* dst; int ldn, dld; };
__device__ __forceinline__ ETile etile_decode(const Params& p, int r) {
    ETile t;
    if (r < CT_GU) { const int e = r / (2 * CT_G1); int q = r % (2 * CT_G1); const int up = q >= CT_G1; q -= up * CT_G1; const int kb = q / 8, nb = q % 8, n0 = nb * 64;
        t.src = ((e < 64) ? p.in[up ? 21 : 20] + (size_t)e * DM * DE : p.in[up ? 24 : 23]) + (size_t)(kb * 256) * DE + n0; t.ldn = DE;
        t.dst = p.ws + WS_BT_GU + (size_t)e * 1024 * DM + (size_t)((n0 >> 7) * 256 + up * 128 + (n0 & 127)) * DM + kb * 256; t.dld = DM; }
    else { const int rr = r - CT_GU; const int e = rr / CT_D1, q = rr % CT_D1, kb = q / 32, nb = q % 32;
        t.src = ((e < 64) ? p.in[22] + (size_t)e * DE * DM : p.in[25]) + (size_t)(kb * 256) * DM + nb * 64; t.ldn = DM;
        t.dst = p.ws + WS_BT_DN + (size_t)e * DM * DE + (size_t)(nb * 64) * DE + kb * 256; t.dld = DE; }
    return t;
}
__device__ __forceinline__ void expert_stream(const Params& p, LAS unsigned* T, int gw, int NGW, int lane) {
    constexpr int NEXP = CT_GU + CT_DN;
    int r = gw; if (r >= NEXP) return;
    const int c4 = lane & 15, kq = lane >> 4, ch = lane & 15, nr = lane >> 4;
    ETile cur = etile_decode(p, r);
    f32x4 A[16], B[16];
#define ES_LOADQ(R, t, qd) do { _Pragma("unroll") for (int j = 0; j < 4; ++j) { const float* q_ = (t).src + (size_t)((qd) * 64 + 4 * (kq + 4 * j)) * (t).ldn + c4 * 4; \
        _Pragma("unroll") for (int rr = 0; rr < 4; ++rr) R[j * 4 + rr] = __builtin_nontemporal_load((const f32x4*)(q_ + (size_t)rr * (t).ldn)); } } while (0)
#define ES_CONVQ(R, qd) do { _Pragma("unroll") for (int j = 0; j < 4; ++j) { const int kp = (qd) * 16 + kq + 4 * j; \
        _Pragma("unroll") for (int q = 0; q < 4; ++q) T[(c4 * 4 + q) * 65 + kp] = pk4_fp8(R[j * 4 + 0][q] * 64.f, R[j * 4 + 1][q] * 64.f, R[j * 4 + 2][q] * 64.f, R[j * 4 + 3][q] * 64.f); } } while (0)
    ES_LOADQ(A, cur, 0);
    for (;;) {
        const int rn = r + NGW; const bool hn = rn < NEXP; const ETile nxt = hn ? etile_decode(p, rn) : cur;
        ES_LOADQ(B, cur, 1); ES_CONVQ(A, 0);
        ES_LOADQ(A, cur, 2); ES_CONVQ(B, 1);
        ES_LOADQ(B, cur, 3); ES_CONVQ(A, 2);
        if (hn) ES_LOADQ(A, nxt, 0);
        ES_CONVQ(B, 3);
        asm volatile("s_waitcnt lgkmcnt(0)" ::: "memory"); __builtin_amdgcn_wave_barrier();
#pragma unroll
        for (int ps = 0; ps < 16; ++ps) { const int n = ps * 4 + nr; const LAS unsigned* t = T + n * 65 + ch * 4;
            v4u o; o.x = t[0]; o.y = t[1]; o.z = t[2]; o.w = t[3];
            __builtin_nontemporal_store(o, (v4u*)(cur.dst + (size_t)n * cur.dld + ch * 16)); }
        asm volatile("s_waitcnt lgkmcnt(0)" ::: "memory"); __builtin_amdgcn_wave_barrier();
        if (!hn) break;
        cur = nxt; r = rn;
    }
#undef ES_LOADQ
#undef ES_CONVQ
}

constexpr int CT_SMALL = CT_IN + CT_UQ + CT_KV + CT_OUT + CT_ZERO;
__device__ __forceinline__ void phase0(const Params& p, LAS unsigned char* lds, int wave, int lane) {
    LAS unsigned* T = (LAS unsigned*)(lds + wave * 18432);
    unsigned char* ws = p.ws;
    float* modp = (float*)(ws + WS_MODP);
    const int gw = blockIdx.x * NWAVES + wave, NGW = gridDim.x * NWAVES;
    for (int it = gw; it < CT_ADA; it += NGW) ada_item(p.in[1], p.in[3], modp, it, lane);
    expert_stream(p, T, (gw + NGW - (CT_ADA % NGW)) % NGW, NGW, lane);
    for (int it = gw; it < CT_SMALL; it += NGW) {
        int r = it;
        if (r < CT_IN) { const int kb = r / 77, nb = r % 77; conv_tile(p.in[7], INC, kb * 64, nb * 64, nullptr, 0, (bf16_t*)(ws + WS_BT_IN), DM, nb * 64, T, lane); continue; } r -= CT_IN;
        if (r < CT_UQ) { const int kb = r / 24, nb = r % 24; conv_tile(p.in[11], 1536, kb * 64, nb * 64, p.in[10], 0, (bf16_t*)(ws + WS_BT_UQ), QR, nb * 64, T, lane); continue; } r -= CT_UQ;
        if (r < CT_KV) { const int kb = r / 32, nb = r % 32, n0 = nb * 64, h = n0 >> 8, j0 = n0 & 255; const int dr = (j0 < 128) ? h * 128 + j0 : 1024 + h * 128 + (j0 - 128);
                         conv_tile(p.in[13], 2048, kb * 64, n0, p.in[12], 0, (bf16_t*)(ws + WS_BT_KV), KVR, dr, T, lane); continue; } r -= CT_KV;
        if (r < CT_OUT) { const int kb = r / 32, nb = r % 32; conv_tile(p.in[17], DM, kb * 64, nb * 64, p.in[16], 1024, (bf16_t*)(ws + WS_BT_OUT), DM, nb * 64, T, lane, (kb * 64 + 1024) & 2047); continue; } r -= CT_OUT;
        { const int row = INC + (r >> 2), pc = r & 3; v4u z = {0u, 0u, 0u, 0u}; *(v4u*)((bf16_t*)(ws + WS_BT_IN) + (size_t)row * DM + pc * 512 + lane * 8) = z; }
    }
}

__device__ __forceinline__ void norm_mod_row(const float* __restrict__ hrow, const float* __restrict__ g, const float* __restrict__ sc, const float* __restrict__ sh, bf16_t* __restrict__ urow, int lane) {
    f32x4 v[8]; float s = 0.f;
#pragma unroll
    for (int j = 0; j < 8; ++j) { v[j] = *(const f32x4*)(hrow + lane * 4 + 256 * j); s += (v[j].x * v[j].x + v[j].y * v[j].y) + (v[j].z * v[j].z + v[j].w * v[j].w); }
    const float r = rsqrtf(wave_sum(s) * (1.f / DM) + EPS);
#pragma unroll
    for (int j = 0; j < 8; ++j) { const int col = lane * 4 + 256 * j; const f32x4 gv = *(const f32x4*)(g + col), sv = *(const f32x4*)(sc + col), hv = *(const f32x4*)(sh + col);
        const f32x4 o = v[j] * r * gv * (sv + 1.f) + hv; v2u w; w.x = pk2(o.x, o.y); w.y = pk2(o.z, o.w); *(v2u*)(urow + col) = w; }
}
__device__ __forceinline__ f32x4 mod_reduce4(const float* __restrict__ modp, const float* __restrict__ bias, int v) {
    f32x4 t[16];
#pragma unroll
    for (int ks = 0; ks < 16; ++ks) t[ks] = *(const f32x4*)(modp + (size_t)ks * 4 * MODW + v);
    f32x4 s = *(const f32x4*)(bias + v % MODW);
#pragma unroll
    for (int ks = 0; ks < 16; ++ks) s += t[ks];
    return s;
}
__device__ __forceinline__ void phase1(const Params& p, LAS unsigned char* lds, int wave, int lane) {
    const float* modp = (const float*)(p.ws + WS_MODP); float* mod = (float*)(p.ws + CTL_MOD); bf16_t* u16 = (bf16_t*)(p.ws + WS_U16);
    LAS float* sm = (LAS float*)lds;
    const int G = gridDim.x;
    for (int v4 = blockIdx.x * NTHR + threadIdx.x; v4 < NB * MODW / 4; v4 += G * NTHR) *(f32x4*)(mod + v4 * 4) = mod_reduce4(modp, p.in[4], v4 * 4);
    for (int tb = blockIdx.x; tb < NT / 32; tb += G) {
        const int b = (tb * 32) / SEQ;
        f32x4 v[8];
        { const float* hrow = p.in[0] + (size_t)(tb * 32 + wave * 4) * DM;
#pragma unroll
          for (int j = 0; j < 8; ++j) v[j] = __builtin_nontemporal_load((const f32x4*)(hrow + lane * 4 + 256 * j)); }
        __syncthreads();
        for (int i4 = threadIdx.x; i4 < 2 * DM / 4; i4 += NTHR) *(LAS f32x4*)(sm + i4 * 4) = mod_reduce4(modp, p.in[4], b * MODW + i4 * 4);
        __syncthreads();
#pragma unroll 1
        for (int rr = 0; rr < 4; ++rr) { const int t = tb * 32 + wave * 4 + rr; const float* g = p.in[5];
            f32x4 vn[8];
            if (rr < 3) { const float* hrow = p.in[0] + (size_t)(t + 1) * DM;
#pragma unroll
                for (int j = 0; j < 8; ++j) vn[j] = __builtin_nontemporal_load((const f32x4*)(hrow + lane * 4 + 256 * j)); }
            float s = 0.f;
#pragma unroll
            for (int j = 0; j < 8; ++j) s += (v[j].x * v[j].x + v[j].y * v[j].y) + (v[j].z * v[j].z + v[j].w * v[j].w);
            const float r = rsqrtf(wave_sum(s) * (1.f / DM) + EPS);
#pragma unroll
            for (int j = 0; j < 8; ++j) { const int col = lane * 4 + 256 * j; const f32x4 gv = *(const f32x4*)(g + col);
                const f32x4 hv = *(const LAS f32x4*)(sm + col), sv = *(const LAS f32x4*)(sm + DM + col);
                const f32x4 o = v[j] * r * gv * (sv + 1.f) + hv; v2u w; w.x = pk2(o.x, o.y); w.y = pk2(o.z, o.w); *(v2u*)(u16 + (size_t)t * DM + col) = w; }
            if (rr < 3) {
#pragma unroll
                for (int j = 0; j < 8; ++j) v[j] = vn[j]; }
        }
    }
}

struct EpiInProj { static constexpr bool PERM = true, MIDK = false; bf16_t* O; float* ssq_q8; float* ssq_kv4;
    __device__ __forceinline__ void operator()(const pg8::f32x4 (&acc)[2][2][4][2], const pg8::Unit& u, int wr, int wc, int fr, int fq) const {
        const int row0 = u.pm * 256 + wr * 64 + fr, col0 = u.pn * 256 + wc * 32 + 8 * fq;
        const bool sq = (u.pn >= 16 && u.pn <= 18);
#pragma unroll
        for (int ai = 0; ai < 2; ++ai)
#pragma unroll
            for (int m = 0; m < 4; ++m) { if (!(u.mask & (3 << (ai * 2)))) continue; const int row = row0 + ai * 128 + m * 16; bf16_t* rowp = O + (size_t)row * INCP + col0; float ss = 0.f;
#pragma unroll
                for (int bj = 0; bj < 2; ++bj) { const pg8::f32x4 v0 = acc[ai][bj][m][0], v1 = acc[ai][bj][m][1];
                    v4u w; w.x = pk2(v0[0], v0[1]); w.y = pk2(v0[2], v0[3]); w.z = pk2(v1[0], v1[1]); w.w = pk2(v1[2], v1[3]);
                    *(v4u*)(rowp + bj * 128) = w;
                    ss += (v0[0] * v0[0] + v0[1] * v0[1]) + (v0[2] * v0[2] + v0[3] * v0[3]) + (v1[0] * v1[0] + v1[1] * v1[1]) + (v1[2] * v1[2] + v1[3] * v1[3]); }
                if (sq) { ss += __shfl_xor(ss, 16); ss += __shfl_xor(ss, 32);
                    if (fq == 0) { if (u.pn == 18) ssq_kv4[row * 4 + wc] = ss; else ssq_q8[row * 8 + (u.pn - 16) * 4 + wc] = ss; } } }
    }
};
__device__ __forceinline__ void phase2(const Params& p, LAS unsigned char* lds) {
    unsigned char* ws = p.ws;
    pg8::Gemm g{(const bf16_t*)(ws + WS_U16), (const bf16_t*)(ws + WS_BT_IN), nullptr, DM, DM, DM, 0};
    pg8::StaticOrder S; S.init(NT / 256, INCP / 256, gridDim.x, blockIdx.x, DM);
    EpiInProj E{(bf16_t*)(ws + WS_PROJ), (float*)(ws + TAB_SSQ_Q8), (float*)(ws + TAB_SSQ_KV4)};
    pg8::gemm_phase<EpiInProj, pg8::StaticOrder>((PG8_LAS unsigned char*)lds, g, S, E);
}
struct EpiBf16Store { static constexpr bool PERM = true, MIDK = false; bf16_t* O; int ldc, pad;
    __device__ __forceinline__ void operator()(const pg8::f32x4 (&acc)[2][2][4][2], const pg8::Unit& u, int wr, int wc, int fr, int fq) const {
        const int row0 = u.pm * 256 + wr * 64 + fr, col0 = u.pn * 256 + wc * 32 + 8 * fq;
#pragma unroll
        for (int ai = 0; ai < 2; ++ai)
#pragma unroll
            for (int m = 0; m < 4; ++m) { if (!(u.mask & (3 << (ai * 2)))) continue; bf16_t* rowp = O + (size_t)(row0 + ai * 128 + m * 16) * ldc + col0;
#pragma unroll
                for (int bj = 0; bj < 2; ++bj) { const pg8::f32x4 v0 = acc[ai][bj][m][0], v1 = acc[ai][bj][m][1];
                    v4u w; w.x = pk2(v0[0], v0[1]); w.y = pk2(v0[2], v0[3]); w.z = pk2(v1[0], v1[1]); w.w = pk2(v1[2], v1[3]); *(v4u*)(rowp + bj * 128) = w; } }
    }
};
struct EpiVt { static constexpr bool PERM = true, MIDK = false; bf16_t* Vt; const float* ssq_kv4;
    __device__ __forceinline__ void operator()(const pg8::f32x4 (&acc)[2][2][4][2], const pg8::Unit& u, int wr, int wc, int fr, int fq) const {
        const int row0 = u.pm * 256 + wr * 64 + fr, col0 = u.pn * 256 + wc * 32 + 8 * fq;
        const int pb = (col0 & ~15) + 4 * (fq & 1);
#pragma unroll
        for (int bj = 0; bj < 2; ++bj) {
            float rs[8];
#pragma unroll
            for (int j = 0; j < 8; ++j) { const pg8::f32x4 s4 = *(const pg8::f32x4*)(ssq_kv4 + (size_t)(col0 + bj * 128 + j) * 4); rs[j] = rsqrtf(((s4[0] + s4[1]) + (s4[2] + s4[3])) * (1.f / KVR) + EPS); }
#pragma unroll
            for (int ai = 0; ai < 2; ++ai)
#pragma unroll
                for (int m = 0; m < 4; ++m) { if (!(u.mask & (1 << (ai * 2 + bj)))) continue; bf16_t* rowp = Vt + (size_t)(row0 + ai * 128 + m * 16) * NT + pb + bj * 128;
                    const pg8::f32x4 v0 = acc[ai][bj][m][0], v1 = acc[ai][bj][m][1];
                    v2u a, b; a.x = pk2(v0[0] * rs[0], v0[1] * rs[1]); a.y = pk2(v0[2] * rs[2], v0[3] * rs[3]);
                    b.x = pk2(v1[0] * rs[4], v1[1] * rs[5]); b.y = pk2(v1[2] * rs[6], v1[3] * rs[7]);
                    *(v2u*)(rowp) = a; *(v2u*)(rowp + 8) = b; }
        }
    }
};
__device__ __forceinline__ void phase3_gemms(const Params& p, LAS unsigned char* lds) {
    unsigned char* ws = p.ws; const int G = gridDim.x, c = blockIdx.x;
    const bf16_t* proj = (const bf16_t*)(ws + WS_PROJ);
    { pg8::Gemm g{proj + 4096, (const bf16_t*)(ws + WS_BT_UQ), nullptr, INCP, QR, QR, 0};
      pg8::StaticOrder S; S.init(NT / 256, 6, G, c, QR); EpiBf16Store E{(bf16_t*)(ws + WS_QRAW), 1536, 0};
      pg8::gemm_phase<EpiBf16Store, pg8::StaticOrder>((PG8_LAS unsigned char*)lds, g, S, E); }
    { pg8::Gemm g{proj + 4608, (const bf16_t*)(ws + WS_BT_KV), nullptr, INCP, KVR, KVR, 0};
      pg8::StaticOrder S; S.init(NT / 256, 4, G, (c + 64) % G, KVR); EpiBf16Store E{(bf16_t*)(ws + WS_KRAW), 1024, 0};
      pg8::gemm_phase<EpiBf16Store, pg8::StaticOrder>((PG8_LAS unsigned char*)lds, g, S, E); }
    { pg8::Gemm g{(const bf16_t*)(ws + WS_BT_KV) + 1024 * KVR, proj + 4608, nullptr, KVR, INCP, KVR, 0};
      pg8::StaticOrder S; S.init(4, NT / 256, G, (c + 192) % G, INCP); EpiVt E{(bf16_t*)(ws + WS_VT), (const float*)(ws + TAB_SSQ_KV4)};
      pg8::gemm_phase<EpiVt, pg8::StaticOrder>((PG8_LAS unsigned char*)lds, g, S, E); }
}

constexpr float QSCALE = 0.07216878364870323f * 1.4426950408889634f;
__device__ __forceinline__ void phase4_qk(const Params& p, int wave, int lane) {
    unsigned char* ws = p.ws;
    const bf16_t* qraw = (const bf16_t*)(ws + WS_QRAW); const bf16_t* kraw = (const bf16_t*)(ws + WS_KRAW); const bf16_t* proj = (const bf16_t*)(ws + WS_PROJ);
    const float* ssq_q8 = (const float*)(ws + TAB_SSQ_Q8); const float* ssq_kv4 = (const float*)(ws + TAB_SSQ_KV4);
    const int* pos = (const int*)p.in[2]; const float* qg = p.in[14]; const float* kg = p.in[15];
    bf16_t* Q16 = (bf16_t*)(ws + WS_Q16); bf16_t* K16 = (bf16_t*)(ws + WS_K16);
    const float g0q = qg[lane], g1q = qg[64 + lane], g2q = qg[128 + lane], g0k = kg[lane], g1k = kg[64 + lane], g2k = kg[128 + lane];
    const int i = lane & 31; const float inv = exp2f(-(float)i * (13.287712379549449f / 32.f));
    const int gw = blockIdx.x * NWAVES + wave, NGW = gridDim.x * NWAVES;
    for (int it0 = gw; it0 < NT * MH; it0 += 2 * NGW) {
        float q0[2], q1[2], q2[2], k0[2], k1[2], k2[2], rq[2], rkv[2], ps[2];
#pragma unroll
        for (int u = 0; u < 2; ++u) { const int it = it0 + u * NGW; const int t = it >> 3, h = it & 7;
            const pg8::f32x4 qa = *(const pg8::f32x4*)(ssq_q8 + (size_t)t * 8), qb = *(const pg8::f32x4*)(ssq_q8 + (size_t)t * 8 + 4), ka = *(const pg8::f32x4*)(ssq_kv4 + (size_t)t * 4);
            rq[u] = rsqrtf((((qa[0] + qa[1]) + (qa[2] + qa[3])) + ((qb[0] + qb[1]) + (qb[2] + qb[3]))) * (1.f / QR) + EPS); rkv[u] = rsqrtf(((ka[0] + ka[1]) + (ka[2] + ka[3])) * (1.f / KVR) + EPS);
            q0[u] = bf2f(qraw[(size_t)t * 1536 + h * 192 + lane]); q1[u] = bf2f(qraw[(size_t)t * 1536 + h * 192 + 64 + lane]); q2[u] = bf2f(qraw[(size_t)t * 1536 + h * 192 + 128 + lane]);
            k0[u] = bf2f(kraw[(size_t)t * 1024 + h * 128 + lane]); k1[u] = bf2f(kraw[(size_t)t * 1024 + h * 128 + 64 + lane]); k2[u] = bf2f(proj[(size_t)t * INCP + 4864 + lane]); ps[u] = (float)pos[t]; }
#pragma unroll
        for (int u = 0; u < 2; ++u) { const int it = it0 + u * NGW; const int t = it >> 3, h = it & 7, b = t / SEQ, s = t % SEQ;
            float a0 = q0[u] * rq[u], a1 = q1[u] * rq[u], a2 = q2[u] * rq[u], c0 = k0[u] * rkv[u], c1 = k1[u] * rkv[u], c2 = k2[u];
            const float sq = wave_sum(a0 * a0 + a1 * a1 + a2 * a2), sk = wave_sum(c0 * c0 + c1 * c1 + c2 * c2);
            const float nq = rsqrtf(sq * (1.f / 192.f) + EPS) * QSCALE, nk = rsqrtf(sk * (1.f / 192.f) + EPS);
            a0 *= nq * g0q; a1 *= nq * g1q; a2 *= nq * g2q; c0 *= nk * g0k; c1 *= nk * g1k; c2 *= nk * g2k;
            const float ang = ps[u] * inv; const float rev = ang * 0.15915494309189535f; const float fr_ = rev - floorf(rev); const float sn = __builtin_amdgcn_sinf(fr_), cs = __builtin_amdgcn_cosf(fr_);
            const float a2o = __shfl_xor(a2, 32), c2o = __shfl_xor(c2, 32);
            const float a2r = lane < 32 ? a2 * cs - a2o * sn : a2 * cs + a2o * sn;
            const float c2r = lane < 32 ? c2 * cs - c2o * sn : c2 * cs + c2o * sn;
            const size_t base = ((size_t)(b * MH + h) * SEQ + s) * QKD;
            Q16[base + lane] = (bf16_t)f2bf(a0); Q16[base + 64 + lane] = (bf16_t)f2bf(a1); Q16[base + 128 + lane] = (bf16_t)f2bf(a2r);
            K16[base + lane] = (bf16_t)f2bf(c0); K16[base + 64 + lane] = (bf16_t)f2bf(c1); K16[base + 128 + lane] = (bf16_t)f2bf(c2r); }
    }
}

typedef short bf16x8 __attribute__((ext_vector_type(8)));
typedef float f32x16 __attribute__((ext_vector_type(16)));
constexpr int AT_KP = 400, AT_VP = 144, AT_KB = 64 * AT_KP, AT_VB = 128 * AT_VP, AT_BUF = AT_KB + AT_VB;
__device__ __forceinline__ void phase5_attn(const Params& p, LAS unsigned char* lds, int wave, int lane) {
    unsigned char* ws = p.ws;
    const bf16_t* Q16 = (const bf16_t*)(ws + WS_Q16); const bf16_t* K16 = (const bf16_t*)(ws + WS_K16); const bf16_t* Vt = (const bf16_t*)(ws + WS_VT);
    bf16_t* merged = (bf16_t*)(ws + WS_MERGED); float* ssq_o8 = (float*)(ws + TAB_SSQ_O8);
    const int tid = threadIdx.x, cl = lane & 31, hh = lane >> 5, qsub = wave & 3, kpar = wave >> 2;
    float mq = 0.f, mk = 0.f;
    for (int i = 0; i < 3; ++i) { mq = fmaxf(mq, fabsf(p.in[14][lane + 64 * i])); mk = fmaxf(mk, fabsf(p.in[15][lane + 64 * i])); }
#pragma unroll
    for (int o = 1; o < 64; o <<= 1) { mq = fmaxf(mq, __shfl_xor(mq, o)); mk = fmaxf(mk, __shfl_xor(mk, o)); }
    const float negc0 = -(13.856406460551018f * 1.4426950408889634f * 1.02f) * mq * mk;
    int kso[3], vso[2]; size_t vgo[2];
#pragma unroll
    for (int i = 0; i < 3; ++i) { const int c = tid + 512 * i; kso[i] = (c / 24) * AT_KP + (c % 24) * 16; }
#pragma unroll
    for (int i = 0; i < 2; ++i) { const int c = tid + 512 * i, dv = c >> 3, ch = c & 7; vso[i] = AT_KB + dv * AT_VP + ch * 16; vgo[i] = (size_t)dv * NT * 2 + ch * 16; }
    for (int item = blockIdx.x; item < 256; item += gridDim.x) {
        const int bh = item >> 3, x = item & 7, b = bh >> 3, h = bh & 7;
        const char* Qg = (const char*)(Q16 + (size_t)bh * SEQ * QKD); const char* Kg = (const char*)(K16 + (size_t)bh * SEQ * QKD);
        const char* Vg = (const char*)(Vt + (size_t)(h * 128) * NT + b * SEQ);
#pragma unroll 1
        for (int pass = 0; pass < 2; ++pass) {
            const int qi = pass == 0 ? 15 - x : x, nsteps = 2 * (qi + 1), qrow0 = qi * 128 + qsub * 32;
            bf16x8 Qf[12];
#pragma unroll
            for (int ks = 0; ks < 12; ++ks) Qf[ks] = *(const bf16x8*)(Qg + ((size_t)(qrow0 + cl) * QKD + ks * 16 + hh * 8) * 2);
            f32x16 O[4];
#pragma unroll
            for (int vb = 0; vb < 4; ++vb)
#pragma unroll
                for (int r = 0; r < 16; ++r) O[vb][r] = 0.f;
            float lsum = 0.f;
            v4u kr[3], vr[2];
#define AT_LOAD(j) do { _Pragma("unroll") for (int i_ = 0; i_ < 3; ++i_) kr[i_] = *(const v4u*)(Kg + (size_t)(j) * 24576 + (size_t)(tid + 512 * i_) * 16); \
                        _Pragma("unroll") for (int i_ = 0; i_ < 2; ++i_) vr[i_] = *(const v4u*)(Vg + vgo[i_] + (size_t)(j) * 128); } while (0)
#define AT_WRITE(bo) do { _Pragma("unroll") for (int i_ = 0; i_ < 3; ++i_) *(LAS v4u*)(lds + (bo) + kso[i_]) = kr[i_]; \
                          _Pragma("unroll") for (int i_ = 0; i_ < 2; ++i_) *(LAS v4u*)(lds + (bo) + vso[i_]) = vr[i_]; } while (0)
            AT_LOAD(0); AT_WRITE(0); __syncthreads();
#pragma unroll 1
            for (int j = 0; j < nsteps; ++j) {
                const int bo = (j & 1) * AT_BUF;
                if (j + 1 < nsteps) AT_LOAD(j + 1);
                const int key0 = 64 * j + 32 * kpar;
                if (key0 <= qrow0 + 31) {
                    f32x16 S;
#pragma unroll
                    for (int r = 0; r < 16; ++r) S[r] = negc0;
                    const LAS unsigned char* kb = lds + bo + (32 * kpar + cl) * AT_KP + hh * 16;
                    __builtin_amdgcn_s_setprio(1);
#pragma unroll
                    for (int ks = 0; ks < 12; ++ks) { const bf16x8 a = *(const LAS bf16x8*)(kb + ks * 32); S = __builtin_amdgcn_mfma_f32_32x32x16_bf16(a, Qf[ks], S, 0, 0, 0); }
                    __builtin_amdgcn_s_setprio(0);
                    const bool diag = key0 + 31 > qrow0;
                    float pr[16];
#pragma unroll
                    for (int r = 0; r < 16; ++r) { float e = __builtin_amdgcn_exp2f(S[r]);
                        if (diag) { const int key = key0 + (r & 3) + 8 * (r >> 2) + 4 * hh; if (key > qrow0 + cl) e = 0.f; }
                        pr[r] = e; lsum += e; }
                    bf16x8 Pf[2];
#pragma unroll
                    for (int s = 0; s < 2; ++s) { v4u w; w.x = pk2(pr[8 * s + 0], pr[8 * s + 1]); w.y = pk2(pr[8 * s + 2], pr[8 * s + 3]); w.z = pk2(pr[8 * s + 4], pr[8 * s + 5]); w.w = pk2(pr[8 * s + 6], pr[8 * s + 7]);
                        Pf[s] = __builtin_bit_cast(bf16x8, w); }
                    const LAS unsigned char* vbp = lds + bo + AT_KB + cl * AT_VP + (32 * kpar + 8 * hh) * 2;
                    __builtin_amdgcn_s_setprio(1);
#pragma unroll
                    for (int vb = 0; vb < 4; ++vb)
#pragma unroll
                        for (int s = 0; s < 2; ++s) { const bf16x8 a = *(const LAS bf16x8*)(vbp + vb * 32 * AT_VP + s * 32); O[vb] = __builtin_amdgcn_mfma_f32_32x32x16_bf16(a, Pf[s], O[vb], 0, 0, 0); }
                    __builtin_amdgcn_s_setprio(0);
                }
                if (j + 1 < nsteps) AT_WRITE(((j + 1) & 1) * AT_BUF);
                __syncthreads();
            }
            LAS float* X = (LAS float*)lds;
            if (kpar == 1) {
#pragma unroll
                for (int vb = 0; vb < 4; ++vb)
#pragma unroll
                    for (int r = 0; r < 16; ++r) X[(qsub * 65 + vb * 16 + r) * 64 + lane] = O[vb][r];
                X[(qsub * 65 + 64) * 64 + lane] = lsum;
            }
            __syncthreads();
            if (kpar == 0) {
                float l = lsum + X[(qsub * 65 + 64) * 64 + lane];
                l += __shfl_xor(l, 32);
                const float il = 1.f / l; float ss = 0.f;
                const int t = b * SEQ + qrow0 + cl;
                bf16_t* op = merged + (size_t)t * DM + h * 128 + 4 * hh;
#pragma unroll
                for (int vb = 0; vb < 4; ++vb)
#pragma unroll
                    for (int rq = 0; rq < 4; ++rq) { float o[4];
#pragma unroll
                        for (int r3 = 0; r3 < 4; ++r3) { const int r = rq * 4 + r3; o[r3] = (O[vb][r] + X[(qsub * 65 + vb * 16 + r) * 64 + lane]) * il; ss += o[r3] * o[r3]; }
                        v2u w; w.x = pk2(o[0], o[1]); w.y = pk2(o[2], o[3]); *(v2u*)(op + vb * 32 + rq * 8) = w; }
                ss += __shfl_xor(ss, 32);
                if (hh == 0) ssq_o8[(size_t)t * 8 + h] = ss;
            }
            __syncthreads();
        }
    }
#undef AT_LOAD
#undef AT_WRITE
}

__device__ __forceinline__ void phase6_scale(const Params& p, int wave, int lane) {
    unsigned char* ws = p.ws; bf16_t* merged = (bf16_t*)(ws + WS_MERGED); const float* ssq_o8 = (const float*)(ws + TAB_SSQ_O8);
    const int gw = blockIdx.x * NWAVES + wave, NGW = gridDim.x * NWAVES;
    for (int t = gw; t < NT; t += NGW) { const pg8::f32x4 oa = *(const pg8::f32x4*)(ssq_o8 + (size_t)t * 8), ob = *(const pg8::f32x4*)(ssq_o8 + (size_t)t * 8 + 4);
        const float r = rsqrtf((((oa[0] + oa[1]) + (oa[2] + oa[3])) + ((ob[0] + ob[1]) + (ob[2] + ob[3]))) * (1.f / 1024.f) + EPS);
#pragma unroll
        for (int j = 0; j < 2; ++j) { v4u* q = (v4u*)(merged + (size_t)t * DM + 1024 + j * 512 + lane * 8); v4u y = *q;
            y.x = pk2(bflo(y.x) * r, bfhi(y.x) * r); y.y = pk2(bflo(y.y) * r, bfhi(y.y) * r); y.z = pk2(bflo(y.z) * r, bfhi(y.z) * r); y.w = pk2(bflo(y.w) * r, bfhi(y.w) * r); *q = y; } }
}

struct EpiResidF32 { static constexpr bool PERM = false, MIDK = true; const float* x; const float* gate; float* out; const LAS float* rs;
    __device__ __forceinline__ void mid(pg8::f32x4 (&acc)[2][2][4][2], const pg8::Unit& u, int wr, int wc, int fr, int fq) const {
        const LAS float* rp = rs + u.pad * 256 + wr * 64 + fr;
#pragma unroll
        for (int ai = 0; ai < 2; ++ai)
#pragma unroll
            for (int m = 0; m < 4; ++m) { const float r = rp[ai * 128 + m * 16];
#pragma unroll
                for (int bj = 0; bj < 2; ++bj)
#pragma unroll
                    for (int n = 0; n < 2; ++n) acc[ai][bj][m][n] = acc[ai][bj][m][n] * r; }
    }
    __device__ __forceinline__ void operator()(const pg8::f32x4 (&acc)[2][2][4][2], const pg8::Unit& u, int wr, int wc, int fr, int fq) const {
        const int row0 = u.pm * 256 + wr * 64 + fr, col0 = u.pn * 256 + wc * 32 + 4 * fq;
        const float* gp = gate + (size_t)((u.pm * 256) / SEQ) * MODW + col0;
        pg8::f32x4 gv[2][2];
#pragma unroll
        for (int bj = 0; bj < 2; ++bj)
#pragma unroll
            for (int n = 0; n < 2; ++n) gv[bj][n] = *(const pg8::f32x4*)(gp + bj * 128 + n * 16);
#pragma unroll
        for (int ai = 0; ai < 2; ++ai)
#pragma unroll
            for (int m = 0; m < 4; ++m) { if (!(u.mask & (3 << (ai * 2)))) continue; const size_t ro = (size_t)(row0 + ai * 128 + m * 16) * DM + col0;
#pragma unroll
                for (int bj = 0; bj < 2; ++bj)
#pragma unroll
                    for (int n = 0; n < 2; ++n) { const pg8::f32x4 xv = *(const pg8::f32x4*)(x + ro + bj * 128 + n * 16); *(pg8::f32x4*)(out + ro + bj * 128 + n * 16) = xv + gv[bj][n] * acc[ai][bj][m][n]; } }
    }
};
__device__ __forceinline__ void phase7(const Params& p, LAS unsigned char* lds) {
    unsigned char* ws = p.ws;
    pg8::Gemm g{(const bf16_t*)(ws + WS_MERGED), (const bf16_t*)(ws + WS_BT_OUT), nullptr, DM, DM, DM, 0};
    pg8::StaticOrder S; S.init(NT / 256, DM / 256, gridDim.x, blockIdx.x, DM);
    LAS float* rs = (LAS float*)(lds + RING_BYTES + 12288);
    { const float* ssq_o8 = (const float*)(ws + TAB_SSQ_O8); pg8::Unit u;
      for (int i = 0; i < 4 && S.next(i, u); ++i) if (threadIdx.x < 256) { const float* sp = ssq_o8 + (size_t)(u.pm * 256 + threadIdx.x) * 8; const pg8::f32x4 oa = *(const pg8::f32x4*)sp, ob = *(const pg8::f32x4*)(sp + 4);
          rs[i * 256 + threadIdx.x] = rsqrtf((((oa[0] + oa[1]) + (oa[2] + oa[3])) + ((ob[0] + ob[1]) + (ob[2] + ob[3]))) * (1.f / 1024.f) + EPS); }
      __syncthreads(); }
    EpiResidF32 E{p.in[0], (const float*)(ws + CTL_MOD) + 2 * DM, (float*)(ws + WS_H1), rs};
    pg8::gemm_phase<EpiResidF32, pg8::StaticOrder>((PG8_LAS unsigned char*)lds, g, S, E);
}
constexpr int HG_P = 272, HG_VP = 144;
constexpr int HG_A2 = 0, HG_A1 = 17408, HG_QB = 34816, HG_VT = 52224, HG_KT = 70656, HG_SEG = 89088, HG_RS = 91136, HG_FL = 92160, HG_QT = 109568;
struct HgPre { v4u fl[2], q[2], v[2]; };
template <bool NEEDQ>
__device__ __forceinline__ void hg_issue(const bf16_t* __restrict__ proj, int item, HgPre& P) {
    const int bh = item >> 5, c = item & 31, b = bh >> 3, h = bh & 7, t0 = b * SEQ + c * 64, tid = threadIdx.x;
#pragma unroll
    for (int i = 0; i < 2; ++i) { const int ch = tid + 512 * i, t = ch >> 4, c16 = ch & 15; const bf16_t* rp = proj + (size_t)(t0 + t) * INCP + h * 128 + c16 * 8;
        P.fl[i] = *(const v4u*)(rp + 1024); P.v[i] = *(const v4u*)(rp + 2048); if (NEEDQ) P.q[i] = *(const v4u*)rp; }
}
struct HgCol { float kv[16]; float b[16]; float blast, bmid; };
template <bool NEEDQ, bool PERM>
__device__ __forceinline__ void hg_stage(const HgPre& P, const float* __restrict__ lbl, int h, LAS unsigned char* lds, HgCol& C) {
    const int tid = threadIdx.x, k = tid & 127, seg = tid >> 7;
    __syncthreads();
#pragma unroll
    for (int i = 0; i < 2; ++i) { const int ch = tid + 512 * i, t = ch >> 4, c16 = ch & 15;
        *(LAS v4u*)(lds + HG_FL + t * HG_P + c16 * 16) = P.fl[i]; if (NEEDQ) *(LAS v4u*)(lds + HG_QT + t * HG_P + c16 * 16) = P.q[i];
        const v4u w = P.v[i]; const int o = t & 15, pos = PERM ? ((t & ~15) + 8 * ((o >> 2) & 1) + 4 * ((o >> 3) & 1) + (o & 3)) : t;
        LAS unsigned short* vp = (LAS unsigned short*)(lds + HG_VT + (c16 * 8) * HG_VP + (((pos >> 3) ^ (c16 & 7)) * 16) + (pos & 7) * 2);
        vp[0 * (HG_VP / 2)] = (unsigned short)(w.x & 0xffff); vp[1 * (HG_VP / 2)] = (unsigned short)(w.x >> 16);
        vp[2 * (HG_VP / 2)] = (unsigned short)(w.y & 0xffff); vp[3 * (HG_VP / 2)] = (unsigned short)(w.y >> 16);
        vp[4 * (HG_VP / 2)] = (unsigned short)(w.z & 0xffff); vp[5 * (HG_VP / 2)] = (unsigned short)(w.z >> 16);
        vp[6 * (HG_VP / 2)] = (unsigned short)(w.w & 0xffff); vp[7 * (HG_VP / 2)] = (unsigned short)(w.w >> 16); }
    const float l0 = lbl[h * 128 + k], l1 = lbl[1024 + h * 128 + k];
    const float lb = 1.f / (1.f + __expf(l1 - l0));
    __syncthreads();
    const LAS unsigned short* fp = (const LAS unsigned short*)(lds + HG_FL + (seg * 16) * HG_P + k * 2);
    float run = 0.f;
#pragma unroll
    for (int i = 0; i < 16; ++i) { const float fl = bf2f(fp[i * (HG_P / 2)]); const float f = lb + (1.f - lb) / (1.f + __expf(-fl)); C.kv[i] = 1.f - f; run += __logf(f); C.b[i] = run; }
    LAS float* SEG = (LAS float*)(lds + HG_SEG);
    SEG[seg * 128 + k] = run;
    __syncthreads();
    const float s0 = SEG[k], s1 = SEG[128 + k], s2 = SEG[256 + k], s3 = SEG[384 + k];
    const float off = (seg > 0 ? s0 : 0.f) + (seg > 1 ? s1 : 0.f) + (seg > 2 ? s2 : 0.f);
#pragma unroll
    for (int i = 0; i < 16; ++i) C.b[i] += off;
    C.bmid = s0 + s1; C.blast = (s0 + s1) + (s2 + s3);
}
__device__ __forceinline__ void hgrn_pass1(const Params& p, LAS unsigned char* lds, int wave, int lane) {
    unsigned char* ws = p.ws; const bf16_t* proj = (const bf16_t*)(ws + WS_PROJ);
    bf16_t* hgU = (bf16_t*)(ws + WS_HGU); float* hgd = (float*)(ws + TAB_HGD);
    const int tid = threadIdx.x, k = tid & 127, seg = tid >> 7, cl = lane & 31, hh = lane >> 5, G = gridDim.x;
    HgPre P; if ((int)blockIdx.x < 1024) hg_issue<false>(proj, blockIdx.x, P);
    for (int item = blockIdx.x; item < 1024; item += G) {
        const int h = (item >> 5) & 7;
        HgCol C; hg_stage<false, false>(P, p.in[8], h, lds, C);
        if (item + G < 1024) hg_issue<false>(proj, item + G, P);
        { unsigned w[8];
#pragma unroll
          for (int i = 0; i < 8; ++i) { const float a0 = C.kv[2 * i] * __expf(C.blast - C.b[2 * i]), a1 = C.kv[2 * i + 1] * __expf(C.blast - C.b[2 * i + 1]); w[i] = pk2(a0, a1); }
          LAS v4u* kp = (LAS v4u*)(lds + HG_KT + k * HG_VP + seg * 32); kp[0] = (v4u){w[0], w[1], w[2], w[3]}; kp[1] = (v4u){w[4], w[5], w[6], w[7]}; }
        if (seg == 0) hgd[item * 128 + k] = __expf(C.blast);
        __syncthreads();
        const int vb = wave >> 1;
        bf16x8 af[4];
#pragma unroll
        for (int ks = 0; ks < 4; ++ks) af[ks] = *(const LAS bf16x8*)(lds + HG_VT + (32 * vb + cl) * HG_VP + (((2 * ks + hh) ^ ((cl >> 3) & 3) ^ ((vb & 1) << 2)) * 16));
#pragma unroll
        for (int q = 0; q < 2; ++q) { const int kb = (wave & 1) * 2 + q; f32x16 acc;
#pragma unroll
            for (int r = 0; r < 16; ++r) acc[r] = 0.f;
#pragma unroll
            for (int ks = 0; ks < 4; ++ks) { const bf16x8 bfr = *(const LAS bf16x8*)(lds + HG_KT + (32 * kb + cl) * HG_VP + (16 * ks + 8 * hh) * 2); acc = __builtin_amdgcn_mfma_f32_32x32x16_bf16(af[ks], bfr, acc, 0, 0, 0); }
            bf16_t* up = hgU + (size_t)item * 16384 + 32 * kb + cl;
#pragma unroll
            for (int r = 0; r < 16; ++r) { const int v = 32 * vb + (r & 3) + 8 * (r >> 2) + 4 * hh; up[(size_t)v * 128] = (bf16_t)f2bf(acc[r]); } }
    }
}
__device__ __forceinline__ void hgrn_scan(const Params& p) {
    unsigned char* ws = p.ws; bf16_t* hgU = (bf16_t*)(ws + WS_HGU); const float* hgd = (const float*)(ws + TAB_HGD);
    for (int i = blockIdx.x * NTHR + threadIdx.x; i < 32 * 4096; i += gridDim.x * NTHR) {
        const int bh = i >> 12, e4 = i & 4095, k4 = (e4 & 31) * 4;
        float S[4] = {0.f, 0.f, 0.f, 0.f};
        v2u* up = (v2u*)(hgU + (size_t)bh * 32 * 16384 + (size_t)e4 * 4); const float* dp = hgd + (size_t)bh * 32 * 128 + k4;
#pragma unroll 1
        for (int c0 = 0; c0 < 32; c0 += 8) { v2u u[8]; f32x4 d[8];
#pragma unroll
            for (int j = 0; j < 8; ++j) { u[j] = up[(size_t)(c0 + j) * 4096]; d[j] = *(const f32x4*)(dp + (c0 + j) * 128); }
#pragma unroll
            for (int j = 0; j < 8; ++j) { v2u o; o.x = pk2(S[0], S[1]); o.y = pk2(S[2], S[3]); up[(size_t)(c0 + j) * 4096] = o;
                S[0] = d[j][0] * S[0] + bflo(u[j].x); S[1] = d[j][1] * S[1] + bfhi(u[j].x); S[2] = d[j][2] * S[2] + bflo(u[j].y); S[3] = d[j][3] * S[3] + bfhi(u[j].y); } }
    }
}
__device__ __forceinline__ void hgrn_pass3(const Params& p, LAS unsigned char* lds, int wave, int lane) {
    unsigned char* ws = p.ws; const bf16_t* proj = (const bf16_t*)(ws + WS_PROJ);
    const bf16_t* hgS = (const bf16_t*)(ws + WS_HGU); bf16_t* merged = (bf16_t*)(ws + WS_MERGED); const float* og = p.in[9];
    const int tid = threadIdx.x, k = tid & 127, seg = tid >> 7, cl = lane & 31, hh = lane >> 5, vb = wave & 3, tb = wave >> 2, G = gridDim.x;
    HgPre P; if ((int)blockIdx.x < 1024) hg_issue<true>(proj, blockIdx.x, P);
    for (int item = blockIdx.x; item < 1024; item += G) {
        const int bh = item >> 5, c = item & 31, b = bh >> 3, h = bh & 7, t0 = b * SEQ + c * 64;
        bf16x8 sf[8]; v2u gw[4];
        { const bf16_t* sp = hgS + (size_t)item * 16384 + (size_t)(32 * vb + cl) * 128 + 8 * hh;
#pragma unroll
          for (int ks = 0; ks < 8; ++ks) sf[ks] = *(const bf16x8*)(sp + 16 * ks);
          const int t = t0 + 32 * tb + cl;
#pragma unroll
          for (int rq = 0; rq < 4; ++rq) gw[rq] = *(const v2u*)(proj + (size_t)t * INCP + 3072 + h * 128 + 32 * vb + 8 * rq + 4 * hh); }
        HgCol C; hg_stage<true, true>(P, p.in[8], h, lds, C);
        { const LAS unsigned short* qp = (const LAS unsigned short*)(lds + HG_QT + (seg * 16) * HG_P + k * 2);
          LAS unsigned short* a2 = (LAS unsigned short*)(lds + HG_A2 + (seg * 16) * HG_P + k * 2);
          LAS unsigned short* a1 = (LAS unsigned short*)(lds + HG_A1 + (seg * 16) * HG_P + k * 2);
          LAS unsigned short* qb = (LAS unsigned short*)(lds + HG_QB + (seg * 16) * HG_P + k * 2);
          const float em = __expf(-C.bmid), ep = __expf(C.bmid);
#pragma unroll
          for (int i = 0; i < 16; i += 2) { const float q0 = bf2f(qp[i * (HG_P / 2)]), q1 = bf2f(qp[(i + 1) * (HG_P / 2)]);
              const float e0 = __expf(C.b[i]), e1 = __expf(C.b[i + 1]);
              const unsigned wa2 = pk2(C.kv[i] * ep * __builtin_amdgcn_rcpf(e0), C.kv[i + 1] * ep * __builtin_amdgcn_rcpf(e1));
              const unsigned wa1 = pk2(q0 * e0 * em, q1 * e1 * em), wqb = pk2(q0 * e0, q1 * e1);
              a2[i * (HG_P / 2)] = (unsigned short)(wa2 & 0xffff); a2[(i + 1) * (HG_P / 2)] = (unsigned short)(wa2 >> 16);
              a1[i * (HG_P / 2)] = (unsigned short)(wa1 & 0xffff); a1[(i + 1) * (HG_P / 2)] = (unsigned short)(wa1 >> 16);
              qb[i * (HG_P / 2)] = (unsigned short)(wqb & 0xffff); qb[(i + 1) * (HG_P / 2)] = (unsigned short)(wqb >> 16); } }
        __syncthreads();
        if (item + G < 1024) hg_issue<true>(proj, item + G, P);
        f32x16 O;
#pragma unroll
        for (int r = 0; r < 16; ++r) O[r] = 0.f;
#pragma unroll
        for (int ks = 0; ks < 8; ++ks) { const bf16x8 bq = *(const LAS bf16x8*)(lds + HG_QB + (32 * tb + cl) * HG_P + (16 * ks + 8 * hh) * 2); O = __builtin_amdgcn_mfma_f32_32x32x16_bf16(sf[ks], bq, O, 0, 0, 0); }
#pragma unroll
        for (int sb = 0; sb < 2; ++sb) {
            if (sb <= tb) {
                f32x16 X;
#pragma unroll
                for (int r = 0; r < 16; ++r) X[r] = 0.f;
#pragma unroll
                for (int ks = 0; ks < 8; ++ks) { const bf16x8 a = *(const LAS bf16x8*)(lds + HG_A2 + (32 * sb + cl) * HG_P + (16 * ks + 8 * hh) * 2);
                    const bf16x8 bq = *(const LAS bf16x8*)(lds + HG_A1 + (32 * tb + cl) * HG_P + (16 * ks + 8 * hh) * 2); X = __builtin_amdgcn_mfma_f32_32x32x16_bf16(a, bq, X, 0, 0, 0); }
                if (sb == tb) {
#pragma unroll
                    for (int r = 0; r < 16; ++r) { const int s = (r & 3) + 8 * (r >> 2) + 4 * hh; if (s > cl) X[r] = 0.f; } }
#pragma unroll
                for (int s2 = 0; s2 < 2; ++s2) { v4u w; w.x = pk2(X[8 * s2 + 0], X[8 * s2 + 1]); w.y = pk2(X[8 * s2 + 2], X[8 * s2 + 3]); w.z = pk2(X[8 * s2 + 4], X[8 * s2 + 5]); w.w = pk2(X[8 * s2 + 6], X[8 * s2 + 7]);
                    const bf16x8 a = *(const LAS bf16x8*)(lds + HG_VT + (32 * vb + cl) * HG_VP + (((4 * sb + 2 * s2 + hh) ^ ((cl >> 3) & 3) ^ ((vb & 1) << 2)) * 16));
                    O = __builtin_amdgcn_mfma_f32_32x32x16_bf16(a, __builtin_bit_cast(bf16x8, w), O, 0, 0, 0); }
            }
        }
        float ss = 0.f;
#pragma unroll
        for (int r = 0; r < 16; ++r) ss += O[r] * O[r];
        ss += __shfl_xor(ss, 32);
        LAS float* RS = (LAS float*)(lds + HG_RS);
        if (hh == 0) RS[(tb * 4 + vb) * 32 + cl] = ss;
        __syncthreads();
        const float tot = (RS[(tb * 4 + 0) * 32 + cl] + RS[(tb * 4 + 1) * 32 + cl]) + (RS[(tb * 4 + 2) * 32 + cl] + RS[(tb * 4 + 3) * 32 + cl]);
        const float rn = rsqrtf(tot * (1.f / 128.f) + EPS);
        const int t = t0 + 32 * tb + cl;
#pragma unroll
        for (int rq = 0; rq < 4; ++rq) { const int v = 32 * vb + 8 * rq + 4 * hh; const f32x4 gg = *(const f32x4*)(og + v);
            const float g0 = bflo(gw[rq].x), g1 = bfhi(gw[rq].x), g2 = bflo(gw[rq].y), g3 = bfhi(gw[rq].y);
            const float o0 = O[rq * 4 + 0] * rn * gg[0] * (g0 / (1.f + __expf(-g0))), o1 = O[rq * 4 + 1] * rn * gg[1] * (g1 / (1.f + __expf(-g1)));
            const float o2 = O[rq * 4 + 2] * rn * gg[2] * (g2 / (1.f + __expf(-g2))), o3 = O[rq * 4 + 3] * rn * gg[3] * (g3 / (1.f + __expf(-g3)));
            v2u w; w.x = pk2(o0, o1); w.y = pk2(o2, o3); *(v2u*)(merged + (size_t)t * DM + 1024 + h * 128 + v) = w; }
    }
}
typedef float f32x2v __attribute__((ext_vector_type(2)));
constexpr int UPITCH = 2050;
constexpr int LDS_HIST = RING_BYTES + 1024;
__device__ __forceinline__ void phase8(const Params& p, LAS unsigned char* lds, int wave, int lane) {
    unsigned char* ws = p.ws;
    const float* h1 = (const float*)(ws + WS_H1); const float* mod = (const float*)(ws + CTL_MOD);
    unsigned char* u8 = ws + WS_U16;
    const float* wr_ = p.in[18]; const float* rbias = p.in[19];
    int* top_idx = (int*)(ws + TAB_TOPI); float* top_w = (float*)(ws + TAB_TOPW); int* slot = (int*)(ws + TAB_SLOT);
    LAS float* U = (LAS float*)lds;
    LAS int* hist = (LAS int*)(lds + LDS_HIST);
    if (threadIdx.x < 64) hist[threadIdx.x] = 0;
    LAS float* SS = (LAS float*)(lds + RING_BYTES + 5120);
    const int TPB = (NT / 16 + gridDim.x - 1) / gridDim.x;
    int ssb = -1;
    for (int task = blockIdx.x * TPB; task < NT / 16 && task < (int)(blockIdx.x + 1) * TPB; ++task) {
        const int t0 = task * 16;
        if (t0 / SEQ != ssb) { ssb = t0 / SEQ; __syncthreads();
            for (int i4 = threadIdx.x; i4 < DM / 4; i4 += NTHR) { const f32x4 gv = *(const f32x4*)(p.in[6] + i4 * 4), sv = *(const f32x4*)(mod + ssb * MODW + 4 * DM + i4 * 4), hv = *(const f32x4*)(mod + ssb * MODW + 3 * DM + i4 * 4);
                *(LAS f32x4*)(SS + i4 * 4) = gv * (sv + 1.f); *(LAS f32x4*)(SS + DM + i4 * 4) = hv; } }
        __syncthreads();
        { f32x4 v[2][8];
#pragma unroll
          for (int rr = 0; rr < 2; ++rr) { const float* hrow = h1 + (size_t)(t0 + wave * 2 + rr) * DM;
#pragma unroll
              for (int j = 0; j < 8; ++j) v[rr][j] = *(const f32x4*)(hrow + lane * 4 + 256 * j); }
#pragma unroll
          for (int rr = 0; rr < 2; ++rr) {
            const int tl = wave * 2 + rr, t = t0 + tl, b = t / SEQ;
            float s = 0.f;
#pragma unroll
            for (int j = 0; j < 8; ++j) s += (v[rr][j].x * v[rr][j].x + v[rr][j].y * v[rr][j].y) + (v[rr][j].z * v[rr][j].z + v[rr][j].w * v[rr][j].w);
            const float r = rsqrtf(wave_sum(s) * (1.f / DM) + EPS);
#pragma unroll
            for (int j = 0; j < 8; ++j) { const int col = lane * 4 + 256 * j; const f32x4 gs = *(const LAS f32x4*)(SS + col), hv = *(const LAS f32x4*)(SS + DM + col);
                const f32x4 o = v[rr][j] * r * gs + hv; *(unsigned*)(u8 + (size_t)t * DM + col) = pk4_fp8(o.x * 4.f, o.y * 4.f, o.z * 4.f, o.w * 4.f);
                LAS f32x2v* up = (LAS f32x2v*)(U + tl * UPITCH + col); up[0] = (f32x2v){o.x, o.y}; up[1] = (f32x2v){o.z, o.w}; }
          } }
        __syncthreads();
        f32x4 acc[4];
#pragma unroll
        for (int c = 0; c < 4; ++c) acc[c] = (f32x4){0.f, 0.f, 0.f, 0.f};
        { const int kb = wave * 256 + (lane >> 4); const LAS float* ua = U + (lane & 15) * UPITCH + kb; const float* wb = wr_ + (size_t)kb * NE + 4 * (lane & 15);
          f32x4 bv[8], bn[8];
#pragma unroll
          for (int q = 0; q < 8; ++q) bv[q] = *(const f32x4*)(wb + (size_t)q * 4 * NE);
#pragma unroll 1
          for (int k8 = 0; k8 < 64; k8 += 8) {
              if (k8 + 8 < 64) {
#pragma unroll
                  for (int q = 0; q < 8; ++q) bn[q] = *(const f32x4*)(wb + (size_t)(k8 + 8 + q) * 4 * NE); }
#pragma unroll
              for (int q = 0; q < 8; ++q) { const float a = ua[(k8 + q) * 4];
#pragma unroll
                  for (int c = 0; c < 4; ++c) acc[c] = __builtin_amdgcn_mfma_f32_16x16x4f32(a, bv[q][c], acc[c], 0, 0, 0); }
#pragma unroll
              for (int q = 0; q < 8; ++q) bv[q] = bn[q]; } }
        __syncthreads();
        LAS float* P = (LAS float*)lds;
#pragma unroll
        for (int c = 0; c < 4; ++c)
#pragma unroll
            for (int r = 0; r < 4; ++r) P[wave * 1024 + ((lane >> 4) * 4 + r) * 64 + 4 * (lane & 15) + c] = acc[c][r];
        __syncthreads();
        LAS float* LG = (LAS float*)(lds + 32768);
#pragma unroll
        for (int q = 0; q < 2; ++q) { const int i = threadIdx.x + q * NTHR; float s = 0.f;
#pragma unroll
            for (int w = 0; w < 8; ++w) s += P[w * 1024 + i]; LG[i] = s; }
        __syncthreads();
#pragma unroll 1
        for (int rr = 0; rr < 2; ++rr) {
            const int tl = wave * 2 + rr, t = t0 + tl;
            int lanev = lane; asm volatile("" : "+v"(lanev));
            const float sc = 1.f / (1.f + expf(-LG[tl * 64 + lane])); const float sel = sc + rbias[lane];
            float m1 = sel; m1 = fmaxf(m1, __shfl_xor(m1, 1)); m1 = fmaxf(m1, __shfl_xor(m1, 2)); m1 = fmaxf(m1, __shfl_xor(m1, 4));
            const unsigned long long gm = 0xFFull << (lanev & 56);
            const int first = __ffsll((long long)(__ballot(sel == m1) & gm)) - 1;
            float m2 = (lanev == first) ? -INFINITY : sel; m2 = fmaxf(m2, __shfl_xor(m2, 1)); m2 = fmaxf(m2, __shfl_xor(m2, 2)); m2 = fmaxf(m2, __shfl_xor(m2, 4));
            const float gs = m1 + m2; const int g = lanev >> 3; int grank = 0;
#pragma unroll
            for (int gg = 0; gg < 8; ++gg) { const float og = __builtin_bit_cast(float, __builtin_amdgcn_readlane(__builtin_bit_cast(int, gs), gg * 8)); grank += (og > gs || (og == gs && gg < g)) ? 1 : 0; }
            const bool gsel = grank < 4; int rk = 0;
            unsigned kb_ = __builtin_bit_cast(unsigned, sel); kb_ = (kb_ & 0x80000000u) ? ~kb_ : (kb_ | 0x80000000u);
            const unsigned long long key = gsel ? (((unsigned long long)kb_ << 6) | (unsigned long long)(63 - lanev)) : 0ull;
            const int klo = (int)(unsigned)key, khi = (int)(unsigned)(key >> 32);
#pragma unroll
            for (int e = 0; e < 64; ++e) { const unsigned long long o = ((unsigned long long)(unsigned)__builtin_amdgcn_readlane(khi, e) << 32) | (unsigned)__builtin_amdgcn_readlane(klo, e); rk += (o > key) ? 1 : 0; }
            const bool chosen = gsel && rk < 8;
            const unsigned long long cb = __ballot(chosen);
            const float wsum = wave_sum(chosen ? sc : 0.f);
            const int ks = __popcll(cb & ((1ull << lanev) - 1ull));
            if (chosen) { const int lr = __hip_atomic_fetch_add((int*)(hist + lane), 1, __ATOMIC_RELAXED, __HIP_MEMORY_SCOPE_WORKGROUP); top_idx[t * 8 + ks] = lane; top_w[t * 8 + ks] = sc / wsum * 2.5f; slot[t * 8 + ks] = lr; }
        }
        __syncthreads();
    }
    if (threadIdx.x < 64) ((int*)(ws + CTL_HIST))[blockIdx.x * 64 + threadIdx.x] = hist[threadIdx.x];
}

__device__ __forceinline__ void phase9(const Params& p, LAS unsigned char* lds, int wave, int lane) {
    unsigned char* ws = p.ws;
    const int* bh = (const int*)(ws + CTL_HIST);
    int* top_idx = (int*)(ws + TAB_TOPI); int* slot = (int*)(ws + TAB_SLOT); int* row_tok = (int*)(ws + TAB_ROWTOK); int* tile_exp = (int*)(ws + TAB_TILEEXP);
    LAS int* rb = (LAS int*)(lds + LDS_HIST + 256);
    const int G = gridDim.x;
    {
        LAS int* part = (LAS int*)(lds + LDS_HIST + 2048);
        const int e = threadIdx.x & 63, pt = threadIdx.x >> 6, per = (G + 7) / 8, b0 = pt * per, b1 = (b0 + per < G) ? b0 + per : G;
        int cnt = 0, base = 0;
#pragma unroll 8
        for (int b = b0; b < b1; ++b) { const int v = bh[b * 64 + e]; base += (b < (int)blockIdx.x) ? v : 0; cnt += v; }
        part[pt * 64 + e] = cnt; part[512 + pt * 64 + e] = base;
    }
    __syncthreads();
    if (wave == 0) {
        LAS int* part = (LAS int*)(lds + LDS_HIST + 2048);
        int cnt = 0, base = 0;
#pragma unroll
        for (int q = 0; q < 8; ++q) { cnt += part[q * 64 + lane]; base += part[512 + q * 64 + lane]; }
        const int tiles = (cnt + 255) >> 8;
        int incl = tiles;
#pragma unroll
        for (int o = 1; o < 64; o <<= 1) { const int n = __shfl_up(incl, o); if (lane >= o) incl += n; }
        const int toff = incl - tiles;
        rb[lane] = toff * 256 + base;
        if (blockIdx.x == 0) { for (int i = 0; i < tiles; ++i) tile_exp[toff + i] = lane; if (lane == 63) tile_exp[512] = incl; if (lane < 32) tile_exp[320 + lane] = 64; }
        rb[64 + lane] = toff * 256 + cnt; rb[128 + lane] = (toff + tiles) * 256;
    }
    __syncthreads();
    for (int e = blockIdx.x; e < 64; e += G) { const int lo = rb[64 + e], hi = rb[128 + e]; for (int r = lo + (int)threadIdx.x; r < hi; r += NTHR) row_tok[r] = 0; }
    for (int i = blockIdx.x * NTHR + threadIdx.x; i < NT; i += G * NTHR) row_tok[ROUTED_ROWS_MAX + i] = i;
    const int TPB = (NT / 16 + G - 1) / G;
    for (int task = blockIdx.x * TPB; task < NT / 16 && task < (int)(blockIdx.x + 1) * TPB; ++task) {
        const int t = task * 16 + wave * 2 + (lane >> 3), k = lane & 7;
        if (lane < 16) { const int e = top_idx[t * 8 + k]; const int pos = rb[e] + slot[t * 8 + k]; slot[t * 8 + k] = pos; row_tok[pos] = t; }
    }
}

constexpr int LDS_UNITS = RING_BYTES + 8192;
struct MoeOrder {
    LAS int* tab; int n;
    __device__ void init(LAS unsigned char* lds, const int* tile_exp, int nN, int G, int c, long estride, long bstep, int parts) {
        tab = (LAS int*)(lds + LDS_UNITS);
        const int ntr = tile_exp[512], nwg = (ntr + 32) * nN;
        int T = nwg % G, nfull = nwg - T; if (true) { nfull = nwg; T = 0; }
        const int njobs = nfull + parts * T;
        const int i = threadIdx.x; n = 0;
        if (c < njobs) n = (njobs - 1 - c) / G + 1;
        if (i < 32 && i < n) {
            const int L = i * G + c; int wgid, mask = 15;
            if (L < nfull) wgid = L; else { const int j = L - nfull; wgid = nfull + j % T; const int part = j / T; mask = (parts == 2) ? (part ? 12 : 3) : (1 << part); }
            { const int q = nwg / 8, r = nwg % 8, xcd = wgid % 8, off = wgid / 8; wgid = (xcd < r ? xcd * (q + 1) : r * (q + 1) + (xcd - r) * q) + off; }
            const int ti = wgid / nN, pn = wgid % nN; int tile, e; if (ti < ntr) { tile = ti; e = tile_exp[ti]; } else { tile = 320 + (ti - ntr); e = 64; }
            const long boff = (long)e * estride + (long)pn * bstep;
            tab[i * 8 + 0] = tile; tab[i * 8 + 1] = pn; tab[i * 8 + 2] = (int)(boff & 0xffffffffl); tab[i * 8 + 3] = (int)(boff >> 32); tab[i * 8 + 4] = mask;
        }
        __syncthreads();
    }
    __device__ bool next(int i, pg8::Unit& u) const {
        if (i >= n) return false;
        u.pm = tab[i * 8 + 0]; u.pn = tab[i * 8 + 1]; u.boff = (long)(((unsigned long long)(unsigned)tab[i * 8 + 3] << 32) | (unsigned)tab[i * 8 + 2]); u.mask = tab[i * 8 + 4]; u.pad = 0; return true;
    }
};
struct EpiGateUp { static constexpr bool PERM = true, MIDK = false; unsigned char* H;
    __device__ __forceinline__ void operator()(const pg8::f32x4 (&acc)[2][2][4][2], const pg8::Unit& u, int wr, int wc, int fr, int fq) const {
        const int row0 = u.pm * 256 + wr * 64 + fr, col0 = u.pn * 128 + wc * 32 + 8 * fq;
#pragma unroll
        for (int ai = 0; ai < 2; ++ai)
#pragma unroll
            for (int m = 0; m < 4; ++m) { const int row = row0 + ai * 128 + m * 16; float o[8];
#pragma unroll
                for (int n = 0; n < 2; ++n)
#pragma unroll
                    for (int j = 0; j < 4; ++j) { const float gt = acc[ai][0][m][n][j] * (1.f / 256.f), up = acc[ai][1][m][n][j] * (8.f / 256.f); o[n * 4 + j] = gt / (1.f + __expf(-gt)) * up; }
                v2u w; w.x = pk4_fp8(o[0], o[1], o[2], o[3]); w.y = pk4_fp8(o[4], o[5], o[6], o[7]);
                *(v2u*)(H + (size_t)row * DE + col0) = w; }
    }
};
struct EpiDown { static constexpr bool PERM = true, MIDK = false; unsigned char* Y;
    __device__ __forceinline__ void operator()(const pg8::f32x4 (&acc)[2][2][4][2], const pg8::Unit& u, int wr, int wc, int fr, int fq) const {
        const int row0 = u.pm * 256 + wr * 64 + fr, col0 = u.pn * 256 + wc * 32 + 8 * fq; const float s = 16.f / 512.f;
#pragma unroll
        for (int ai = 0; ai < 2; ++ai)
#pragma unroll
            for (int m = 0; m < 4; ++m) { const int row = row0 + ai * 128 + m * 16; unsigned char* rowp = Y + (size_t)row * DM + col0;
#pragma unroll
                for (int bj = 0; bj < 2; ++bj) { const pg8::f32x4 v0 = acc[ai][bj][m][0] * s, v1 = acc[ai][bj][m][1] * s;
                    v2u w; w.x = pk4_fp8(v0[0], v0[1], v0[2], v0[3]); w.y = pk4_fp8(v1[0], v1[1], v1[2], v1[3]); *(v2u*)(rowp + bj * 128) = w; } }
    }
};
__device__ __forceinline__ void phase10(const Params& p, LAS unsigned char* lds) {
    unsigned char* ws = p.ws;
    pg8::Gemm g{(const bf16_t*)(ws + WS_U16), (const bf16_t*)(ws + WS_BT_GU), (const int*)(ws + TAB_ROWTOK), DM, DM, DM, 0};
    MoeOrder S; S.init(lds, (const int*)(ws + TAB_TILEEXP), 4, gridDim.x, blockIdx.x, (long)1024 * DM, (long)256 * DM, 2);
    EpiGateUp E{ws + WS_HID};
    pg8::gemm_phase<EpiGateUp, MoeOrder, 1>((PG8_LAS unsigned char*)lds, g, S, E);
}
__device__ __forceinline__ void phase11(const Params& p, LAS unsigned char* lds) {
    unsigned char* ws = p.ws;
    pg8::Gemm g{(const bf16_t*)(ws + WS_HID), (const bf16_t*)(ws + WS_BT_DN), nullptr, DE, DE, DE, 0};
    MoeOrder S; S.init(lds, (const int*)(ws + TAB_TILEEXP), 8, gridDim.x, blockIdx.x, (long)DM * DE, (long)256 * DE, 4);
    EpiDown E{ws + WS_Y};
    pg8::gemm_phase<EpiDown, MoeOrder, 1>((PG8_LAS unsigned char*)lds, g, S, E);
}
__device__ __forceinline__ void fp8x8_fma(const v2u y, float w, float (&a)[8]) {
#pragma unroll
    for (int q = 0; q < 2; ++q) { const unsigned d = y[q];
        a[q * 4 + 0] += w * __builtin_amdgcn_cvt_f32_fp8((int)d, 0); a[q * 4 + 1] += w * __builtin_amdgcn_cvt_f32_fp8((int)d, 1);
        a[q * 4 + 2] += w * __builtin_amdgcn_cvt_f32_fp8((int)d, 2); a[q * 4 + 3] += w * __builtin_amdgcn_cvt_f32_fp8((int)d, 3); }
}
__device__ __forceinline__ void phase12(const Params& p, int wave, int lane) {
    unsigned char* ws = p.ws;
    const float* h1 = (const float*)(ws + WS_H1); const float* mod = (const float*)(ws + CTL_MOD); const unsigned char* Y = ws + WS_Y;
    const int* slot = (const int*)(ws + TAB_SLOT); const float* top_w = (const float*)(ws + TAB_TOPW);
    const int gw = blockIdx.x * NWAVES + wave, NGW = gridDim.x * NWAVES;
    for (int t = gw; t < NT; t += NGW) {
        const int b = t / SEQ; const float* gt = mod + b * MODW + 5 * DM;
        int sl = 0; float wk = 0.f; if (lane < 8) { sl = slot[t * 8 + lane]; wk = top_w[t * 8 + lane] * (1.f / 16.f); }
#pragma unroll 2
        for (int j = 0; j < 4; ++j) {
            const int col = j * 512 + lane * 4;
            float a[8];
#pragma unroll
            for (int i = 0; i < 8; ++i) a[i] = 0.f;
            v2u yr[9];
            { const unsigned char* yp = Y + (size_t)(ROUTED_ROWS_MAX + t) * DM + col; yr[8].x = __builtin_nontemporal_load((const unsigned*)yp); yr[8].y = __builtin_nontemporal_load((const unsigned*)(yp + 256)); }
#pragma unroll
            for (int k = 0; k < 8; ++k) { const int s = __builtin_amdgcn_readlane(sl, k); const unsigned char* yp = Y + (size_t)s * DM + col;
                yr[k].x = __builtin_nontemporal_load((const unsigned*)yp); yr[k].y = __builtin_nontemporal_load((const unsigned*)(yp + 256)); }
            const f32x4 h0 = *(const f32x4*)(h1 + (size_t)t * DM + col), h4 = *(const f32x4*)(h1 + (size_t)t * DM + col + 256);
            const f32x4 g0 = *(const f32x4*)(gt + col), g4 = *(const f32x4*)(gt + col + 256);
            fp8x8_fma(yr[8], 1.f / 16.f, a);
#pragma unroll
            for (int k = 0; k < 8; ++k) { const float w = __builtin_bit_cast(float, __builtin_amdgcn_readlane(__builtin_bit_cast(int, wk), k)); fp8x8_fma(yr[k], w, a); }
            f32x4 o0, o4; o0.x = h0.x + g0.x * a[0]; o0.y = h0.y + g0.y * a[1]; o0.z = h0.z + g0.z * a[2]; o0.w = h0.w + g0.w * a[3];
            o4.x = h4.x + g4.x * a[4]; o4.y = h4.y + g4.y * a[5]; o4.z = h4.z + g4.z * a[6]; o4.w = h4.w + g4.w * a[7];
            __builtin_nontemporal_store(o0, (f32x4*)(p.out + (size_t)t * DM + col)); __builtin_nontemporal_store(o4, (f32x4*)(p.out + (size_t)t * DM + col + 256));
        }
    }
}

__global__ void __launch_bounds__(NTHR, 2) k_mega(Params p) {
    extern __shared__ __attribute__((aligned(16))) unsigned char lds_raw[];
    LAS unsigned char* lds = (LAS unsigned char*)lds_raw;
    const int tid = threadIdx.x, lane = tid & 63, wave = __builtin_amdgcn_readfirstlane(tid >> 6);
    volatile LAS unsigned* MISC = (volatile LAS unsigned*)(lds + MISC_OFF);
    for (int u = tid; u < (LDS_BYTES - RING_BYTES) / 4; u += NTHR) ((LAS unsigned*)(lds + RING_BYTES))[u] = 0u;
    __syncthreads();
    XcdBarrier bar = xcd_barrier_post((unsigned*)(p.ws + WS_CTL) + CW_BAR, MISC + 8);
    const int lo = p.ph_lo, hi = p.ph_hi;
#ifndef DUP_MASK
#define DUP_MASK 0
#endif
#define IN(k) (lo <= (k) && (k) < hi)
#define DUPK(k, body) do { if (IN(k)) { body; if ((DUP_MASK >> (k)) & 1) { xcd_barrier(bar); body; } } } while (0)
#ifdef SPIN_PHASE
#define STAMP(k) do { if (blockIdx.x == 0 && tid == 0) ((unsigned long long*)(p.ws + 49152))[k] = __builtin_amdgcn_s_memrealtime(); } while (0)
#else
#define STAMP(k) do { } while (0)
#endif
#define SEAM(k) do { if (IN(k) && IN((k) + 1)) { xcd_barrier(bar); STAMP((k) + 1); } } while (0)
    STAMP(0);
    DUPK(0, phase0(p, lds, wave, lane)); SEAM(0);
    DUPK(1, phase1(p, lds, wave, lane)); SEAM(1);
#ifdef EXTRA_BARS
    for (int eb = 0; eb < EXTRA_BARS; ++eb) xcd_barrier(bar);
#endif
    DUPK(2, phase2(p, lds)); SEAM(2);
    DUPK(3, phase3_gemms(p, lds); hgrn_pass1(p, lds, wave, lane)); SEAM(3);
    DUPK(4, hgrn_scan(p); phase4_qk(p, wave, lane); if ((DUP_MASK >> 17) & 1) { xcd_barrier(bar); phase4_qk(p, wave, lane); }); SEAM(4);
    DUPK(5, phase5_attn(p, lds, wave, lane); hgrn_pass3(p, lds, wave, lane); if ((DUP_MASK >> 16) & 1) { xcd_barrier(bar); hgrn_pass3(p, lds, wave, lane); }); if (IN(5) && IN(7)) { xcd_barrier(bar); STAMP(6); STAMP(7); }
    DUPK(7, phase7(p, lds)); SEAM(7);
    DUPK(8, phase8(p, lds, wave, lane)); SEAM(8);
    DUPK(9, phase9(p, lds, wave, lane)); SEAM(9);
    DUPK(10, phase10(p, lds)); SEAM(10);
    DUPK(11, phase11(p, lds)); SEAM(11);
    DUPK(12, phase12(p, wave, lane));
#ifdef SPIN_NTR
    { const int ntr = ((const int*)(p.ws + TAB_TILEEXP))[512]; const unsigned long long d = (unsigned long long)(ntr - 256) * 1000ull;
      const unsigned long long t0 = __builtin_amdgcn_s_memrealtime(); while (__builtin_amdgcn_s_memrealtime() - t0 < d) __builtin_amdgcn_s_sleep(8); }
#endif
#ifdef SPIN_PHASE
    xcd_barrier(bar); STAMP(13);
    xcd_barrier(bar);
    { const unsigned long long* ts = (const unsigned long long*)(p.ws + 49152);
      const unsigned long long d = __hip_atomic_load(ts + SPIN_PHASE + 1, __ATOMIC_RELAXED, __HIP_MEMORY_SCOPE_AGENT) - __hip_atomic_load(ts + SPIN_PHASE, __ATOMIC_RELAXED, __HIP_MEMORY_SCOPE_AGENT);
      const unsigned long long t0 = __builtin_amdgcn_s_memrealtime(); while (__builtin_amdgcn_s_memrealtime() - t0 < 4ull * d) __builtin_amdgcn_s_sleep(8); }
#endif
#undef IN
#undef SEAM
}
extern "C" void kernel_launch(void* const* d_in, const int* in_sizes, int n_in, void* d_out, int out_size, void* d_ws, size_t ws_size, hipStream_t stream) {
    static int grid = 0;
    if (grid == 0) {
        int dev = 0, cus = 0;
        if (hipGetDevice(&dev) != hipSuccess || hipDeviceGetAttribute(&cus, hipDeviceAttributeMultiprocessorCount, dev) != hipSuccess) { grid = -1; return; }
        if (hipFuncSetAttribute((const void*)k_mega, hipFuncAttributeMaxDynamicSharedMemorySize, LDS_BYTES) != hipSuccess) { fprintf(stderr, "kernel_launch: hipFuncSetAttribute failed\n"); grid = -1; return; }
        (void)hipGetLastError();
        grid = cus;
        if (n_in != 26 || ws_size < WS_END) { fprintf(stderr, "kernel_launch: unexpected inputs / workspace (%d, %zu)\n", n_in, ws_size); grid = -1; return; }
    }
    if (grid < 0) return;
    (void)hipMemsetAsync((char*)d_ws + WS_CTL, 0, CTL_ZERO_BYTES, stream);
    Params p{};
    for (int i = 0; i < 26; ++i) p.in[i] = (const float*)d_in[i];
    p.out = (float*)d_out; p.ws = (unsigned char*)d_ws; p.ph_lo = 0; p.ph_hi = 13;
    hipLaunchKernelGGL(k_mega, dim3(grid), dim3(NTHR), LDS_BYTES, stream, p);
}
```

```cpp
#include <hip/hip_runtime.h>
#include <cstdio>
#include <cstdint>
constexpr int NB = 4, SEQ = 2048, DM = 2048, NT = NB * SEQ;
constexpr int INC = 4928, INCP = 5120;
constexpr int MH = 8, QR = 512, KVR = 256, QKD = 192, VD = 128;
constexpr int NE = 64, DE = 512;
constexpr float EPS = 1e-6f;
constexpr int MODW = 6 * DM;
constexpr int NWAVES = 8, NTHR = 512;
constexpr int PROWS = 90112;
constexpr int ROUTED_ROWS_MAX = 81920;

constexpr size_t MiB = 1u << 20;
constexpr size_t WS_CTL = 0, CTL_ZERO_BYTES = 1 * MiB;
constexpr int CW_BAR = 1024;
constexpr size_t CTL_MOD = 64 * 1024;
constexpr size_t WS_MODP = 4 * MiB;
constexpr size_t TAB_SSQ_Q8 = 7 * MiB, TAB_SSQ_KV4 = 7 * MiB + 256 * 1024, TAB_SSQ_O8 = 7 * MiB + 512 * 1024;
constexpr size_t CTL_HIST = 416 * 1024;
constexpr size_t WS_TAB = 1 * MiB;
constexpr size_t TAB_HGD = WS_TAB;
constexpr size_t TAB_TOPI = WS_TAB + 1 * MiB;
constexpr size_t TAB_TOPW = TAB_TOPI + 256 * 1024;
constexpr size_t TAB_SLOT = TAB_TOPW + 256 * 1024;
constexpr size_t TAB_ROWTOK = TAB_SLOT + 256 * 1024;
constexpr size_t TAB_TILEEXP = TAB_ROWTOK + 512 * 1024;
constexpr size_t WS_BT_IN = 8 * MiB, WS_BT_UQ = 28 * MiB, WS_BT_KV = 30 * MiB, WS_BT_OUT = 32 * MiB, WS_BT_GU = 40 * MiB, WS_BT_DN = 300 * MiB;
constexpr size_t WS_U16 = 430 * MiB, WS_H1 = 462 * MiB, WS_HID = 526 * MiB, WS_X = 614 * MiB;
constexpr size_t WS_PROJ = WS_X, WS_QRAW = WS_X + 80 * MiB, WS_KRAW = WS_X + 104 * MiB, WS_VT = WS_X + 120 * MiB, WS_Q16 = WS_X + 136 * MiB, WS_K16 = WS_X + 160 * MiB,
                 WS_HGU = WS_X + 184 * MiB, WS_MERGED = WS_X + 216 * MiB, WS_Y = WS_X, WS_END = 966 * MiB;

constexpr int RING_BYTES = 131072, LDS_BYTES = 163840, MISC_OFF = LDS_BYTES - 256;

#define GAS __attribute__((address_space(1)))
#define LAS __attribute__((address_space(3)))
typedef unsigned short bf16_t;
typedef unsigned v4u __attribute__((ext_vector_type(4)));
typedef unsigned v2u __attribute__((ext_vector_type(2)));
typedef float f32x4 __attribute__((ext_vector_type(4)));
typedef GAS unsigned gu32;
#define RLX_AGENT __ATOMIC_RELAXED, __HIP_MEMORY_SCOPE_AGENT
__device__ __forceinline__ unsigned f2bf(float f) { unsigned u = __builtin_bit_cast(unsigned, f); return (u + 0x7fffu + ((u >> 16) & 1u)) >> 16; }
__device__ __forceinline__ unsigned pk2(float lo, float hi) { unsigned r; asm volatile("v_cvt_pk_bf16_f32 %0, %1, %2" : "=v"(r) : "v"(lo), "v"(hi)); return r; }
__device__ __forceinline__ float bf2f(unsigned short b) { return __builtin_bit_cast(float, ((unsigned)b) << 16); }
__device__ __forceinline__ float bflo(unsigned w) { return __builtin_bit_cast(float, w << 16); }
__device__ __forceinline__ float bfhi(unsigned w) { return __builtin_bit_cast(float, w & 0xffff0000u); }
__device__ __forceinline__ float sigmoidf_(float x) { return 1.f / (1.f + __expf(-x)); }
__device__ __forceinline__ float siluf_(float x) { return x / (1.f + __expf(-x)); }
__device__ __forceinline__ float wave_sum(float v) {
#pragma unroll
    for (int o = 1; o < 64; o <<= 1) v += __shfl_xor(v, o);
    return v;
}

#define XB_TMO      128
#define XB_XCNT(j)  (256  + 64 * (j))
#define XB_XSUB(j)  (1280 + 64 * (j))
#define XB_XGEN(j)  (2304 + 64 * (j))
#define XB_TOP      3328
#define XB_TOPGEN   3392
#define XCD_BAR_WORDS 3456
#define XB_SPIN_CAP (1u << 18)
__device__ __forceinline__ unsigned xb_ld(unsigned* p)              { return __hip_atomic_load(p, __ATOMIC_RELAXED, __HIP_MEMORY_SCOPE_AGENT); }
__device__ __forceinline__ unsigned xb_add(unsigned* p, unsigned v) { return __hip_atomic_fetch_add(p, v, __ATOMIC_RELAXED, __HIP_MEMORY_SCOPE_AGENT); }
__device__ __forceinline__ unsigned xb_xcc_id() { return (unsigned)__builtin_amdgcn_s_getreg((3 << 11) | 20) & 0xFu; }
#define XB_SPIN(cond, bar) do { unsigned _sp = 0; while (cond) { __builtin_amdgcn_s_sleep(1); \
    if ((++_sp & 255u) == 0u) { if (xb_ld(&(bar)[XB_TMO])) break; if (_sp > XB_SPIN_CAP) { atomicAdd(&(bar)[XB_TMO], 1u); break; } } } } while (0)
struct XcdBarrier { unsigned* bar; unsigned x; volatile LAS unsigned* st; };
__device__ __forceinline__ XcdBarrier xcd_barrier_post(unsigned* bar, volatile LAS unsigned* st) {
    XcdBarrier b; b.bar = bar; b.x = xb_xcc_id(); b.st = st;
    if (threadIdx.x == 0) (void)xb_add(&bar[XB_XCNT(b.x)], 1u);
    return b;
}
__device__ __forceinline__ void xcd_barrier_complete(unsigned* bar, unsigned x, unsigned& nloc, unsigned& nx) {
    const unsigned G = gridDim.x * gridDim.y * gridDim.z;
    unsigned sum, cnt, mine, sp = 0u;
    for (;;) {
        sum = 0u; cnt = 0u; mine = 0u;
#pragma unroll
        for (unsigned j = 0; j < 16; ++j) { const unsigned c = xb_ld(&bar[XB_XCNT(j)]); sum += c; cnt += (c > 0u) ? 1u : 0u; mine = (j == x) ? c : mine; }
        if (sum == G) break;
        __builtin_amdgcn_s_sleep(1);
        if ((++sp & 255u) == 0u) { if (xb_ld(&bar[XB_TMO])) break; if (sp > XB_SPIN_CAP) { atomicAdd(&bar[XB_TMO], 1u); break; } }
    }
    nloc = mine > 0u ? mine : 1u; nx = cnt > 0u ? cnt : 1u;
}
__device__ __forceinline__ void xcd_barrier(const XcdBarrier& b) {
    asm volatile("s_waitcnt vmcnt(0)" ::: "memory");
    __syncthreads();
    if (threadIdx.x == 0) {
        unsigned* bar = b.bar;
        __builtin_amdgcn_s_waitcnt(0);
        unsigned nloc = b.st[0], nx = b.st[1];
        if (nloc == 0u) { xcd_barrier_complete(bar, b.x, nloc, nx); b.st[0] = nloc; b.st[1] = nx; }
        const unsigned old = xb_add(&bar[XB_XSUB(b.x)], 1u);
        const unsigned gen = old / nloc;
        if (old + 1u == (gen + 1u) * nloc) {
            __builtin_amdgcn_fence(__ATOMIC_RELEASE, "agent");
            asm volatile("s_waitcnt vmcnt(0)" ::: "memory");
            const unsigned og = xb_add(&bar[XB_TOP], 1u);
            const unsigned tg = og / nx;
            if (og + 1u == (tg + 1u) * nx) xb_add(&bar[XB_TOPGEN], 1u);
            else XB_SPIN(xb_ld(&bar[XB_TOPGEN]) == tg, bar);
            __builtin_amdgcn_fence(__ATOMIC_ACQUIRE, "agent");
            xb_add(&bar[XB_XGEN(b.x)], 1u);
            asm volatile("s_waitcnt vmcnt(0)" ::: "memory");
        } else {
            XB_SPIN(xb_ld(&bar[XB_XGEN(b.x)]) == gen, bar);
            __builtin_amdgcn_fence(__ATOMIC_ACQUIRE, "agent");
            asm volatile("s_waitcnt vmcnt(0)" ::: "memory");
        }
    }
    __syncthreads();
}

struct Params { const float* in[26]; float* out; unsigned char* ws; int ph_lo, ph_hi; };
namespace pg8 {
#define PG8_LAS __attribute__((address_space(3)))
typedef unsigned short bf16_t;
typedef short bf16x8 __attribute__((ext_vector_type(8)));
typedef float f32x4 __attribute__((ext_vector_type(4)));
typedef unsigned u32x4 __attribute__((ext_vector_type(4)));
typedef unsigned u32x2 __attribute__((ext_vector_type(2)));
constexpr int BM = 256, BK = 64, HALF = 128, HTB = HALF * BK * 2, STAGE_BYTES = 8 * HTB, NXCD = 8, WGM = 8;

__host__ __device__ __forceinline__ int lds_byte(int r, int c) { const int st = (r >> 4) * 2 + (c >> 5), rr = r & 15, cc = c & 31, ob = rr * 64 + cc * 2; return st * 1024 + (ob ^ (((ob >> 9) & 1) << 5)); }
__host__ __device__ __forceinline__ void stage_rc(int b, int& R, int& C) { const int st = b / 1024, sb = b % 1024, swz = sb ^ (((sb >> 9) & 1) << 5); R = (st >> 1) * 16 + swz / 64; C = (st & 1) * 32 + (swz % 64) / 2; }
__host__ __device__ __forceinline__ int perm32(int rho) { const int n = rho >> 4, i = rho & 15; return 8 * (i >> 2) + 4 * n + (i & 3); }

struct Unit { int pm, pn; long boff; int mask, pad; };
struct Gemm { const bf16_t* A; const bf16_t* Bt; const int* rowtab; int lda, ldb, K, pad; };

__device__ __forceinline__ unsigned cvt_pk_bf16(float lo, float hi) { unsigned r; asm volatile("v_cvt_pk_bf16_f32 %0, %1, %2" : "=v"(r) : "v"(lo), "v"(hi)); return r; }

struct StaticOrder {
    int nM, nN, nwg, G, c, nfull, T; long bstep;
    __device__ void init(int nM_, int nN_, int G_, int c_, int ldb) { nM = nM_; nN = nN_; nwg = nM * nN; G = G_; c = c_; bstep = (long)BM * ldb * 2;
        T = 0; nfull = nwg; }
    __device__ bool next(int i, Unit& u) const {
        const long L = (long)i * G + c; int wgid, mask = 15;
        if (L < nfull) wgid = (int)L;
        else { const long j = L - nfull; if (j >= 2 * T) return false; wgid = nfull + (int)(j % T); mask = (j / T) ? 12 : 3; }
        { const int q = nwg / NXCD, r = nwg % NXCD, xcd = wgid % NXCD, off = wgid / NXCD; wgid = (xcd < r ? xcd * (q + 1) : r * (q + 1) + (xcd - r) * q) + off; }
        const int nig = WGM * nN, gid = wgid / nig, fm = gid * WGM, gsz = (nM - fm) < WGM ? (nM - fm) : WGM;
        u.pm = fm + ((wgid % nig) % gsz); u.pn = (wgid % nig) / gsz; u.boff = (long)u.pn * bstep; u.mask = mask; u.pad = i; return true;
    }
};

typedef long i64x2 __attribute__((ext_vector_type(2)));
template <class Epi, class Sched, int ES = 2, bool ALIGN_EPI = true>
__device__ __forceinline__ void gemm_phase(PG8_LAS unsigned char* lds, const Gemm g, const Sched& S, const Epi& E) {
    const int tid = threadIdx.x, wid = __builtin_amdgcn_readfirstlane(tid >> 6), lane = tid & 63, wr = wid >> 2, wc = wid & 3, fr = lane & 15, fq = lane >> 4;
    const int K = g.K, nt = K * ES / (BK * 2);
    int Rr[2]; unsigned Cb[2], voffB[2];
#pragma unroll
    for (int i = 0; i < 2; ++i) { int R, C; stage_rc(tid * 16 + i * 8192, R, C); const int Rb = Epi::PERM ? ((R & ~31) + perm32(R & 31)) : R;
        Rr[i] = R; Cb[i] = (unsigned)C * 2u; voffB[i] = (unsigned)(Rb * g.ldb) * (unsigned)ES + (unsigned)C * 2u; }
    const size_t kstep = (size_t)(BK * 2);
    const size_t hstepB = (size_t)HALF * g.ldb * ES;
    const unsigned lda2 = (unsigned)g.lda * (unsigned)ES;
    const unsigned ldsw = (unsigned)wid * 1024u;
    const int aoff = lds_byte(wr * 64 + fr, fq * 8), boff = lds_byte(wc * 32 + fr, fq * 8);
    const char* const Abase = (const char*)g.A; const char* const Bbase = (const char*)g.Bt;
#define PG8_SA(b, h) (((b) * 2 + (h)) * HTB)
#define PG8_SB(b, h) ((4 + (b) * 2 + (h)) * HTB)
#define PG8_STAGE(bufoff, gbase, voff) do { _Pragma("unroll") for (int _i = 0; _i < 2; ++_i) \
        __builtin_amdgcn_global_load_lds((const unsigned*)((const char*)(gbase) + (voff)[_i]), (PG8_LAS unsigned*)(lds + (bufoff) + ldsw + _i * 8192), 16, 0, 0); } while (0)
#define PG8_VOFFA(u, v) do { _Pragma("unroll") for (int _h = 0; _h < 2; ++_h) _Pragma("unroll") for (int _i = 0; _i < 2; ++_i) { const int _gr = (u).pm * BM + _h * HALF + Rr[_i]; \
        const int _src = g.rowtab ? g.rowtab[_gr] : _gr; (v)[_h][_i] = (unsigned)_src * lda2 + Cb[_i]; } } while (0)
#define PG8_LDA(dst, b, h) do { _Pragma("unroll") for (int m = 0; m < 4; ++m) _Pragma("unroll") for (int k = 0; k < 2; ++k) dst[m][k] = *(const PG8_LAS bf16x8*)(lds + PG8_SA(b, h) + aoff + m * 2048 + k * 1024); } while (0)
#define PG8_LDB(dst, b, h) do { _Pragma("unroll") for (int n = 0; n < 2; ++n) _Pragma("unroll") for (int k = 0; k < 2; ++k) dst[n][k] = *(const PG8_LAS bf16x8*)(lds + PG8_SB(b, h) + boff + n * 2048 + k * 1024); } while (0)
#define PG8_MMA(ai, bj, At, Bt) do { __builtin_amdgcn_s_setprio(1); \
        if constexpr (ES == 2) { _Pragma("unroll") for (int m = 0; m < 4; ++m) _Pragma("unroll") for (int n = 0; n < 2; ++n) _Pragma("unroll") for (int k = 0; k < 2; ++k) \
            acc[ai][bj][m][n] = __builtin_amdgcn_mfma_f32_16x16x32_bf16(Bt[n][k], At[m][k], acc[ai][bj][m][n], 0, 0, 0); } \
        else { _Pragma("unroll") for (int m = 0; m < 4; ++m) _Pragma("unroll") for (int n = 0; n < 2; ++n) _Pragma("unroll") for (int k = 0; k < 2; ++k) { \
            const i64x2 _a = __builtin_bit_cast(i64x2, At[m][k]), _b = __builtin_bit_cast(i64x2, Bt[n][k]); \
            acc[ai][bj][m][n] = __builtin_amdgcn_mfma_f32_16x16x32_fp8_fp8(_b.x, _a.x, acc[ai][bj][m][n], 0, 0, 0); \
            acc[ai][bj][m][n] = __builtin_amdgcn_mfma_f32_16x16x32_fp8_fp8(_b.y, _a.y, acc[ai][bj][m][n], 0, 0, 0); } } \
        __builtin_amdgcn_s_setprio(0); } while (0)
#define PG8_WAIT_V(n) asm volatile("s_waitcnt vmcnt(" #n ")" ::: "memory")
#define PG8_WAIT_L(n) asm volatile("s_waitcnt lgkmcnt(" #n ")" ::: "memory")
#define PG8_BAR __builtin_amdgcn_s_barrier()
#define PG8_SCHED __builtin_amdgcn_sched_barrier(0)
    Unit cur, nxt; int ui = 0;
    if (!S.next(0, cur)) return;
    f32x4 acc[2][2][4][2];
#pragma unroll
    for (int a = 0; a < 2; ++a)
#pragma unroll
        for (int b = 0; b < 2; ++b)
#pragma unroll
            for (int m = 0; m < 4; ++m)
#pragma unroll
                for (int n = 0; n < 2; ++n) acc[a][b][m][n] = (f32x4){0.f, 0.f, 0.f, 0.f};
    bf16x8 At[4][2], B0[2][2], B1[2][2];
    unsigned cv[2][2], nv[2][2];
    PG8_VOFFA(cur, cv);
#pragma unroll
    for (int h = 0; h < 2; ++h) { nv[h][0] = cv[h][0]; nv[h][1] = cv[h][1]; }
    const char* cB = Bbase + cur.boff;
    PG8_STAGE(PG8_SB(0, 0), cB, voffB); PG8_STAGE(PG8_SB(0, 1), cB + hstepB, voffB); PG8_STAGE(PG8_SA(0, 0), Abase, cv[0]); PG8_STAGE(PG8_SA(0, 1), Abase, cv[1]);
    if (wr == 1) PG8_BAR;
    PG8_WAIT_V(2); PG8_BAR;
    PG8_STAGE(PG8_SB(1, 0), cB + kstep, voffB); PG8_STAGE(PG8_SA(1, 0), Abase + kstep, cv[0]); PG8_STAGE(PG8_SB(1, 1), cB + hstepB + kstep, voffB);
    PG8_WAIT_V(6); PG8_BAR;
    for (;;) {
        const bool has_next = S.next(ui + 1, nxt);
        const char* nB = has_next ? Bbase + nxt.boff : cB;
#pragma unroll 1
        for (int t = 0; t < nt; t += 2) {
            const bool last = (t == nt - 2);
            if constexpr (Epi::MIDK) { if (t == nt / 2) E.mid(acc, cur, wr, wc, fr, fq); }
            if (last && has_next) { PG8_VOFFA(nxt, nv); }
            const char* a1 = Abase + (size_t)(t + 1) * kstep;
            const char* a2 = Abase + (last ? (size_t)0 : (size_t)(t + 2) * kstep); const char* a3 = a2 + kstep;
            const char* b2 = last ? nB : cB + (size_t)(t + 2) * kstep; const char* b3 = b2 + kstep;
            unsigned x0[2], x1[2];
            x0[0] = last ? nv[0][0] : cv[0][0]; x0[1] = last ? nv[0][1] : cv[0][1]; x1[0] = last ? nv[1][0] : cv[1][0]; x1[1] = last ? nv[1][1] : cv[1][1];
            PG8_LDB(B0, 0, 0); PG8_LDB(B1, 0, 1); PG8_SCHED; PG8_LDA(At, 0, 0); PG8_STAGE(PG8_SA(1, 1), a1, cv[1]);
            PG8_WAIT_V(8); PG8_WAIT_L(0); PG8_BAR; PG8_MMA(0, 0, At, B0); PG8_MMA(0, 1, At, B1); PG8_BAR; PG8_SCHED;
            PG8_LDA(At, 0, 1); PG8_STAGE(PG8_SB(0, 0), b2, voffB); PG8_STAGE(PG8_SB(0, 1), b2 + hstepB, voffB); PG8_STAGE(PG8_SA(0, 0), a2, x0);
            PG8_WAIT_V(8); PG8_WAIT_L(0); PG8_BAR; PG8_MMA(1, 0, At, B0); PG8_MMA(1, 1, At, B1); PG8_BAR; PG8_SCHED;
            PG8_LDB(B0, 1, 0); PG8_LDB(B1, 1, 1); PG8_SCHED; PG8_LDA(At, 1, 0); PG8_STAGE(PG8_SA(0, 1), a2, x1);
            PG8_WAIT_V(8); PG8_WAIT_L(0); PG8_BAR; PG8_MMA(0, 0, At, B0); PG8_MMA(0, 1, At, B1); PG8_BAR; PG8_SCHED;
            PG8_LDA(At, 1, 1); PG8_STAGE(PG8_SB(1, 0), b3, voffB); PG8_STAGE(PG8_SB(1, 1), b3 + hstepB, voffB); PG8_STAGE(PG8_SA(1, 0), a3, x0);
            PG8_WAIT_V(8); PG8_WAIT_L(0); PG8_BAR; PG8_MMA(1, 0, At, B0); PG8_MMA(1, 1, At, B1); PG8_BAR; PG8_SCHED;
        }
        if constexpr (ALIGN_EPI) { if (wr == 0) PG8_BAR; }
        E(acc, cur, wr, wc, fr, fq);
        if (!has_next) break;
#pragma unroll
        for (int a = 0; a < 2; ++a)
#pragma unroll
            for (int b = 0; b < 2; ++b)
#pragma unroll
                for (int m = 0; m < 4; ++m)
#pragma unroll
                    for (int n = 0; n < 2; ++n) acc[a][b][m][n] = (f32x4){0.f, 0.f, 0.f, 0.f};
        cur = nxt; cB = nB; ++ui;
#pragma unroll
        for (int h = 0; h < 2; ++h) { cv[h][0] = nv[h][0]; cv[h][1] = nv[h][1]; }
        if constexpr (ALIGN_EPI) { if (wr == 1) PG8_BAR; }
    }
    PG8_WAIT_V(0);
    if constexpr (!ALIGN_EPI) { if (wr == 0) PG8_BAR; }
    PG8_BAR;
#undef PG8_SA
#undef PG8_SB
#undef PG8_STAGE
#undef PG8_VOFFA
#undef PG8_LDA
#undef PG8_LDB
#undef PG8_MMA
#undef PG8_WAIT_V
#undef PG8_WAIT_L
#undef PG8_BAR
#undef PG8_SCHED
}
}
__device__ __forceinline__ void conv_tile(const float* __restrict__ src, int ldn, int k0, int n0, const float* __restrict__ kscale, int kfrom,
                                          bf16_t* __restrict__ dst, int dld, int drow0, LAS unsigned* T, int lane, int dk0 = -1) {
    if (dk0 < 0) dk0 = k0;
    const int c4 = lane & 15, kq = lane >> 4;
    f32x4 v0[8], v1[8];
#pragma unroll
    for (int j = 0; j < 8; ++j) { const int kp = kq + 4 * j; const float* p = src + (size_t)(k0 + 2 * kp) * ldn + n0 + c4 * 4;
        v0[j] = *(const f32x4*)p; v1[j] = *(const f32x4*)(p + ldn); }
#pragma unroll
    for (int j = 0; j < 8; ++j) { const int kp = kq + 4 * j; const int k = k0 + 2 * kp;
        float s0 = 1.f, s1 = 1.f; if (kscale && k >= kfrom) { s0 = kscale[k - kfrom]; s1 = kscale[k + 1 - kfrom]; }
#pragma unroll
        for (int q = 0; q < 4; ++q) T[(c4 * 4 + q) * 33 + kp] = pk2(v0[j][q] * s0, v1[j][q] * s1); }
    asm volatile("s_waitcnt lgkmcnt(0)" ::: "memory"); __builtin_amdgcn_wave_barrier();
    const int ch = lane & 7, nr = lane >> 3;
#pragma unroll
    for (int ps = 0; ps < 8; ++ps) { const int n = ps * 8 + nr; const LAS unsigned* t = T + n * 33 + ch * 4;
        v4u o; o.x = t[0]; o.y = t[1]; o.z = t[2]; o.w = t[3];
        *(v4u*)(dst + (size_t)(drow0 + n) * dld + dk0 + ch * 8) = o; }
    asm volatile("s_waitcnt lgkmcnt(0)" ::: "memory"); __builtin_amdgcn_wave_barrier();
}

__device__ __forceinline__ void conv_tile128(const float* __restrict__ src, int ldn, int k0, int n0, bf16_t* __restrict__ dst, int dld, int drow0, LAS unsigned* T, int lane) {
    const int c4 = lane & 15, kq = lane >> 4;
    f32x4 v0[16], v1[16];
#pragma unroll
    for (int j = 0; j < 16; ++j) { const int kp = kq + 4 * j; const float* q = src + (size_t)(k0 + 2 * kp) * ldn + n0 + c4 * 4;
        v0[j] = __builtin_nontemporal_load((const f32x4*)q); v1[j] = __builtin_nontemporal_load((const f32x4*)(q + ldn)); }
#pragma unroll
    for (int j = 0; j < 16; ++j) { const int kp = kq + 4 * j;
#pragma unroll
        for (int q = 0; q < 4; ++q) T[(c4 * 4 + q) * 65 + kp] = pk2(v0[j][q], v1[j][q]); }
    asm volatile("s_waitcnt lgkmcnt(0)" ::: "memory"); __builtin_amdgcn_wave_barrier();
    const int ch = lane & 15, nr = lane >> 4;
#pragma unroll
    for (int ps = 0; ps < 16; ++ps) { const int n = ps * 4 + nr; const LAS unsigned* t = T + n * 65 + ch * 4;
        v4u o; o.x = t[0]; o.y = t[1]; o.z = t[2]; o.w = t[3];
        __builtin_nontemporal_store(o, (v4u*)(dst + (size_t)(drow0 + n) * dld + k0 + ch * 8)); }
    asm volatile("s_waitcnt lgkmcnt(0)" ::: "memory"); __builtin_amdgcn_wave_barrier();
}

__device__ __forceinline__ unsigned pk4_fp8(float a, float b, float c, float d) {
    int w = 0; w = __builtin_amdgcn_cvt_pk_fp8_f32(__builtin_amdgcn_fmed3f(a, -448.f, 448.f), __builtin_amdgcn_fmed3f(b, -448.f, 448.f), w, false);
    w = __builtin_amdgcn_cvt_pk_fp8_f32(__builtin_amdgcn_fmed3f(c, -448.f, 448.f), __builtin_amdgcn_fmed3f(d, -448.f, 448.f), w, true); return (unsigned)w; }
__device__ __forceinline__ void conv_tile128_fp8(const float* __restrict__ src, int ldn, int k0, int n0, unsigned char* __restrict__ dst, int dld, int drow0, LAS unsigned* T, int lane) {
    const int c4 = lane & 15, kq = lane >> 4;
#pragma unroll 1
    for (int hf = 0; hf < 2; ++hf) {
        f32x4 v[8][4];
#pragma unroll
        for (int j = 0; j < 8; ++j) { const float* q = src + (size_t)(k0 + hf * 128 + 4 * (kq + 4 * j)) * ldn + n0 + c4 * 4;
#pragma unroll
            for (int r = 0; r < 4; ++r) v[j][r] = __builtin_nontemporal_load((const f32x4*)(q + (size_t)r * ldn)); }
#pragma unroll
        for (int j = 0; j < 8; ++j) { const int kp = hf * 32 + kq + 4 * j;
#pragma unroll
            for (int q = 0; q < 4; ++q) T[(c4 * 4 + q) * 65 + kp] = pk4_fp8(v[j][0][q] * 64.f, v[j][1][q] * 64.f, v[j][2][q] * 64.f, v[j][3][q] * 64.f); }
    }
    asm volatile("s_waitcnt lgkmcnt(0)" ::: "memory"); __builtin_amdgcn_wave_barrier();
    const int ch = lane & 15, nr = lane >> 4;
#pragma unroll
    for (int ps = 0; ps < 16; ++ps) { const int n = ps * 4 + nr; const LAS unsigned* t = T + n * 65 + ch * 4;
        v4u o; o.x = t[0]; o.y = t[1]; o.z = t[2]; o.w = t[3];
        __builtin_nontemporal_store(o, (v4u*)(dst + (size_t)(drow0 + n) * dld + k0 + ch * 16)); }
    asm volatile("s_waitcnt lgkmcnt(0)" ::: "memory"); __builtin_amdgcn_wave_barrier();
}

__device__ __forceinline__ void ada_item(const float* __restrict__ c, const float* __restrict__ w, float* __restrict__ modp, int item, int lane) {
    const int cc = item % 48, ks = item / 48, col = cc * 256 + lane * 4;
    f32x4 acc[4];
#pragma unroll
    for (int b = 0; b < 4; ++b) acc[b] = (f32x4){0.f, 0.f, 0.f, 0.f};
#pragma unroll 1
    for (int half = 0; half < 2; ++half) {
        const int k0 = ks * 128 + half * 64;
        float cd[4];
#pragma unroll
        for (int b = 0; b < 4; ++b) cd[b] = siluf_(c[b * DM + k0 + lane]);
        const float* wp = w + (size_t)k0 * MODW + col;
#pragma unroll 16
        for (int kk = 0; kk < 64; ++kk) { const f32x4 wv = __builtin_nontemporal_load((const f32x4*)(wp + (size_t)kk * MODW));
#pragma unroll
            for (int b = 0; b < 4; ++b) { const float s = __builtin_bit_cast(float, __builtin_amdgcn_readlane(__builtin_bit_cast(int, cd[b]), kk)); acc[b] += wv * s; } }
    }
#pragma unroll
    for (int b = 0; b < 4; ++b) *(f32x4*)(modp + ((size_t)ks * 4 + b) * MODW + col) = acc[b];
}

constexpr int CT_ADA = 48 * 16;
constexpr int CT_IN = 32 * 77, CT_UQ = 8 * 24, CT_KV = 4 * 32, CT_OUT = 32 * 32, CT_G1 = 8 * 8, CT_D1 = 2 * 32;
constexpr int CT_ZERO = 192 * 4;
constexpr int CT_GU = 65 * 2 * CT_G1, CT_DN = 65 * CT_D1;
constexpr int CT_GU_LATE = 0;
constexpr int CT_TOTAL0 = CT_ADA + CT_IN + CT_UQ + CT_KV + CT_OUT + CT_ZERO + (CT_GU - CT_GU_LATE) + CT_DN;
constexpr int CW_QGU = 8192, CW_QDN = 8192 + 512;

__device__ __forceinline__ void conv_gu_tile(const Params& p, int r, LAS unsigned* T, int lane) {
    const int e = r / (2 * CT_G1); int q = r % (2 * CT_G1);
    unsigned char* gu = p.ws + WS_BT_GU + (size_t)e * 1024 * DM;
    const int up = q >= CT_G1; q -= up * CT_G1; const int kb = q / 8, nb = q % 8, n0 = nb * 64;
    const float* src = (e < 64) ? p.in[up ? 21 : 20] + (size_t)e * DM * DE : p.in[up ? 24 : 23];
    conv_tile128_fp8(src, DE, kb * 256, n0, gu, DM, (n0 >> 7) * 256 + up * 128 + (n0 & 127), T, lane);
}
__device__ __forceinline__ void conv_dn_tile(const Params& p, int r, LAS unsigned* T, int lane) {
    const int e = r / CT_D1, q = r % CT_D1, kb = q / 32, nb = q % 32;
    unsigned char* dn = p.ws + WS_BT_DN + (size_t)e * DM * DE;
    const float* src = (e < 64) ? p.in[22] + (size_t)e * DE * DM : p.in[25];
    conv_tile128_fp8(src, DM, kb * 256, nb * 64, dn, DE, nb * 64, T, lane);
}
template <bool DN>
__device__ __forceinline__ void conv_queue(const Params& p, LAS unsigned char* lds, int wave, int lane, int first, int total) {
    LAS unsigned* T = (LAS unsigned*)(lds + wave * 18432);
    unsigned* heads = (unsigned*)(p.ws + WS_CTL) + (DN ? CW_QDN : CW_QGU);
    const int n = total - first, per = (n + 7) / 8, xcd = (int)xb_xcc_id() & 7;
    for (int s = 0; s < 8; ++s) {
        const int sh = (xcd + s) & 7, lo = first + sh * per, hi = (lo + per < total) ? lo + per : total;
        for (;;) {
            unsigned i = 0; if (lane == 0) i = __hip_atomic_fetch_add(heads + 64 * sh, 2u, __ATOMIC_RELAXED, __HIP_MEMORY_SCOPE_AGENT);
            const int r = lo + (int)__builtin_amdgcn_readfirstlane(i);
            if (r >= hi) break;
            if (DN) conv_dn_tile(p, r, T, lane); else conv_gu_tile(p, r, T, lane);
            if (r + 1 < hi) { if (DN) conv_dn_tile(p, r + 1, T, lane); else conv_gu_tile(p, r + 1, T, lane); }
        }
    }
}

struct ETile { const float* src; unsigned char* dst; int ldn, dld; };
__device__ __forceinline__ ETile etile_decode(const Params& p, int r) {
    ETile t;
    if (r < CT_GU) { const int e = r / (2 * CT_G1); int q = r % (2 * CT_G1); const int up = q >= CT_G1; q -= up * CT_G1; const int kb = q / 8, nb = q % 8, n0 = nb * 64;
        t.src = ((e < 64) ? p.in[up ? 21 : 20] + (size_t)e * DM * DE : p.in[up ? 24 : 23]) + (size_t)(kb * 256) * DE + n0; t.ldn = DE;
        t.dst = p.ws + WS_BT_GU + (size_t)e * 1024 * DM + (size_t)((n0 >> 7) * 256 + up * 128 + (n0 & 127)) * DM + kb * 256; t.dld = DM; }
    else { const int rr = r - CT_GU; const int e = rr / CT_D1, q = rr % CT_D1, kb = q / 32, nb = q % 32;
        t.src = ((e < 64) ? p.in[22] + (size_t)e * DE * DM : p.in[25]) + (size_t)(kb * 256) * DM + nb * 64; t.ldn = DM;
        t.dst = p.ws + WS_BT_DN + (size_t)e * DM * DE + (size_t)(nb * 64) * DE + kb * 256; t.dld = DE; }
    return t;
}
constexpr int CT_EXP_LATE2 = 2048, CT_EXP_LATE3 = 1024;
__device__ __forceinline__ int p2_first_idle(int G) { const int nunits = (NT / 256) * (INCP / 256), rounds = (nunits + G - 1) / G; return nunits - (rounds - 1) * G; }
__device__ __forceinline__ int exp_late2(int G) { return (p2_first_idle(G) < G && (G - p2_first_idle(G)) * NWAVES * 2 >= CT_EXP_LATE2) ? CT_EXP_LATE2 : 0; }
__device__ __forceinline__ int exp_late3(int G) { return (G == 256) ? CT_EXP_LATE3 : 0; }
__device__ __forceinline__ void expert_stream(const Params& p, LAS unsigned* T, int gw, int NGW, int lane, int NEXP) {
    int r = gw; if (r >= NEXP) return;
    const int c4 = lane & 15, kq = lane >> 4, ch = lane & 15, nr = lane >> 4;
    ETile cur = etile_decode(p, r);
    f32x4 A[16], B[16];
#define ES_LOADQ(R, t, qd) do { _Pragma("unroll") for (int j = 0; j < 4; ++j) { const float* q_ = (t).src + (size_t)((qd) * 64 + 4 * (kq + 4 * j)) * (t).ldn + c4 * 4; \
        _Pragma("unroll") for (int rr = 0; rr < 4; ++rr) R[j * 4 + rr] = __builtin_nontemporal_load((const f32x4*)(q_ + (size_t)rr * (t).ldn)); } } while (0)
#define ES_CONVQ(R, qd) do { _Pragma("unroll") for (int j = 0; j < 4; ++j) { const int kp = (qd) * 16 + kq + 4 * j; \
        _Pragma("unroll") for (int q = 0; q < 4; ++q) T[(c4 * 4 + q) * 65 + kp] = pk4_fp8(R[j * 4 + 0][q] * 64.f, R[j * 4 + 1][q] * 64.f, R[j * 4 + 2][q] * 64.f, R[j * 4 + 3][q] * 64.f); } } while (0)
    ES_LOADQ(A, cur, 0);
    for (;;) {
        const int rn = r + NGW; const bool hn = rn < NEXP; const ETile nxt = hn ? etile_decode(p, rn) : cur;
        ES_LOADQ(B, cur, 1); ES_CONVQ(A, 0);
        ES_LOADQ(A, cur, 2); ES_CONVQ(B, 1);
        ES_LOADQ(B, cur, 3); ES_CONVQ(A, 2);
        if (hn) ES_LOADQ(A, nxt, 0);
        ES_CONVQ(B, 3);
        asm volatile("s_waitcnt lgkmcnt(0)" ::: "memory"); __builtin_amdgcn_wave_barrier();
#pragma unroll
        for (int ps = 0; ps < 16; ++ps) { const int n = ps * 4 + nr; const LAS unsigned* t = T + n * 65 + ch * 4;
            v4u o; o.x = t[0]; o.y = t[1]; o.z = t[2]; o.w = t[3];
            __builtin_nontemporal_store(o, (v4u*)(cur.dst + (size_t)n * cur.dld + ch * 16)); }
        asm volatile("s_waitcnt lgkmcnt(0)" ::: "memory"); __builtin_amdgcn_wave_barrier();
        if (!hn) break;
        cur = nxt; r = rn;
    }
#undef ES_LOADQ
#undef ES_CONVQ
}

constexpr int CT_SMALL = CT_IN + CT_UQ + CT_KV + CT_OUT + CT_ZERO;
__device__ __forceinline__ void phase0(const Params& p, LAS unsigned char* lds, int wave, int lane) {
    LAS unsigned* T = (LAS unsigned*)(lds + wave * 18432);
    unsigned char* ws = p.ws;
    float* modp = (float*)(ws + WS_MODP);
    const int gw = blockIdx.x * NWAVES + wave, NGW = gridDim.x * NWAVES;
    for (int it = gw; it < CT_ADA; it += NGW) ada_item(p.in[1], p.in[3], modp, it, lane);
    expert_stream(p, T, (gw + NGW - (CT_ADA % NGW)) % NGW, NGW, lane, CT_GU + CT_DN - exp_late2(gridDim.x) - exp_late3(gridDim.x));
    for (int it = gw; it < CT_SMALL; it += NGW) {
        int r = it;
        if (r < CT_IN) { const int kb = r / 77, nb = r % 77; conv_tile(p.in[7], INC, kb * 64, nb * 64, nullptr, 0, (bf16_t*)(ws + WS_BT_IN), DM, nb * 64, T, lane); continue; } r -= CT_IN;
        if (r < CT_UQ) { const int kb = r / 24, nb = r % 24; conv_tile(p.in[11], 1536, kb * 64, nb * 64, p.in[10], 0, (bf16_t*)(ws + WS_BT_UQ), QR, nb * 64, T, lane); continue; } r -= CT_UQ;
        if (r < CT_KV) { const int kb = r / 32, nb = r % 32, n0 = nb * 64, h = n0 >> 8, j0 = n0 & 255; const int dr = (j0 < 128) ? h * 128 + j0 : 1024 + h * 128 + (j0 - 128);
                         conv_tile(p.in[13], 2048, kb * 64, n0, p.in[12], 0, (bf16_t*)(ws + WS_BT_KV), KVR, dr, T, lane); continue; } r -= CT_KV;
        if (r < CT_OUT) { const int kb = r / 32, nb = r % 32; conv_tile(p.in[17], DM, kb * 64, nb * 64, p.in[16], 1024, (bf16_t*)(ws + WS_BT_OUT), DM, nb * 64, T, lane, (kb * 64 + 1024) & 2047); continue; } r -= CT_OUT;
        { const int row = INC + (r >> 2), pc = r & 3; v4u z = {0u, 0u, 0u, 0u}; *(v4u*)((bf16_t*)(ws + WS_BT_IN) + (size_t)row * DM + pc * 512 + lane * 8) = z; }
    }
}

__device__ __forceinline__ void norm_mod_row(const float* __restrict__ hrow, const float* __restrict__ g, const float* __restrict__ sc, const float* __restrict__ sh, bf16_t* __restrict__ urow, int lane) {
    f32x4 v[8]; float s = 0.f;
#pragma unroll
    for (int j = 0; j < 8; ++j) { v[j] = *(const f32x4*)(hrow + lane * 4 + 256 * j); s += (v[j].x * v[j].x + v[j].y * v[j].y) + (v[j].z * v[j].z + v[j].w * v[j].w); }
    const float r = rsqrtf(wave_sum(s) * (1.f / DM) + EPS);
#pragma unroll
    for (int j = 0; j < 8; ++j) { const int col = lane * 4 + 256 * j; const f32x4 gv = *(const f32x4*)(g + col), sv = *(const f32x4*)(sc + col), hv = *(const f32x4*)(sh + col);
        const f32x4 o = v[j] * r * gv * (sv + 1.f) + hv; v2u w; w.x = pk2(o.x, o.y); w.y = pk2(o.z, o.w); *(v2u*)(urow + col) = w; }
}
__device__ __forceinline__ f32x4 mod_reduce4(const float* __restrict__ modp, const float* __restrict__ bias, int v) {
    f32x4 t[16];
#pragma unroll
    for (int ks = 0; ks < 16; ++ks) t[ks] = *(const f32x4*)(modp + (size_t)ks * 4 * MODW + v);
    f32x4 s = *(const f32x4*)(bias + v % MODW);
#pragma unroll
    for (int ks = 0; ks < 16; ++ks) s += t[ks];
    return s;
}
__device__ __forceinline__ void phase1(const Params& p, LAS unsigned char* lds, int wave, int lane) {
    const float* modp = (const float*)(p.ws + WS_MODP); float* mod = (float*)(p.ws + CTL_MOD); bf16_t* u16 = (bf16_t*)(p.ws + WS_U16);
    LAS float* sm = (LAS float*)lds;
    const int G = gridDim.x;
    for (int v4 = blockIdx.x * NTHR + threadIdx.x; v4 < NB * MODW / 4; v4 += G * NTHR) *(f32x4*)(mod + v4 * 4) = mod_reduce4(modp, p.in[4], v4 * 4);
    for (int tb = blockIdx.x; tb < NT / 32; tb += G) {
        const int b = (tb * 32) / SEQ;
        f32x4 v[8];
        { const float* hrow = p.in[0] + (size_t)(tb * 32 + wave * 4) * DM;
#pragma unroll
          for (int j = 0; j < 8; ++j) v[j] = __builtin_nontemporal_load((const f32x4*)(hrow + lane * 4 + 256 * j)); }
        __syncthreads();
        for (int i4 = threadIdx.x; i4 < 2 * DM / 4; i4 += NTHR) *(LAS f32x4*)(sm + i4 * 4) = mod_reduce4(modp, p.in[4], b * MODW + i4 * 4);
        __syncthreads();
#pragma unroll 1
        for (int rr = 0; rr < 4; ++rr) { const int t = tb * 32 + wave * 4 + rr; const float* g = p.in[5];
            f32x4 vn[8];
            if (rr < 3) { const float* hrow = p.in[0] + (size_t)(t + 1) * DM;
#pragma unroll
                for (int j = 0; j < 8; ++j) vn[j] = __builtin_nontemporal_load((const f32x4*)(hrow + lane * 4 + 256 * j)); }
            float s = 0.f;
#pragma unroll
            for (int j = 0; j < 8; ++j) s += (v[j].x * v[j].x + v[j].y * v[j].y) + (v[j].z * v[j].z + v[j].w * v[j].w);
            const float r = rsqrtf(wave_sum(s) * (1.f / DM) + EPS);
#pragma unroll
            for (int j = 0; j < 8; ++j) { const int col = lane * 4 + 256 * j; const f32x4 gv = *(const f32x4*)(g + col);
                const f32x4 hv = *(const LAS f32x4*)(sm + col), sv = *(const LAS f32x4*)(sm + DM + col);
                const f32x4 o = v[j] * r * gv * (sv + 1.f) + hv; v2u w; w.x = pk2(o.x, o.y); w.y = pk2(o.z, o.w); *(v2u*)(u16 + (size_t)t * DM + col) = w; }
            if (rr < 3) {
#pragma unroll
                for (int j = 0; j < 8; ++j) v[j] = vn[j]; }
        }
    }
}

struct EpiInProj { static constexpr bool PERM = true, MIDK = false; bf16_t* O; float* ssq_q8; float* ssq_kv4;
    __device__ __forceinline__ void operator()(const pg8::f32x4 (&acc)[2][2][4][2], const pg8::Unit& u, int wr, int wc, int fr, int fq) const {
        const int row0 = u.pm * 256 + wr * 64 + fr, col0 = u.pn * 256 + wc * 32 + 8 * fq;
        const bool sq = (u.pn >= 16 && u.pn <= 18);
#pragma unroll
        for (int ai = 0; ai < 2; ++ai)
#pragma unroll
            for (int m = 0; m < 4; ++m) { if (!(u.mask & (3 << (ai * 2)))) continue; const int row = row0 + ai * 128 + m * 16; bf16_t* rowp = O + (size_t)row * INCP + col0; float ss = 0.f;
#pragma unroll
                for (int bj = 0; bj < 2; ++bj) { const pg8::f32x4 v0 = acc[ai][bj][m][0], v1 = acc[ai][bj][m][1];
                    v4u w; w.x = pk2(v0[0], v0[1]); w.y = pk2(v0[2], v0[3]); w.z = pk2(v1[0], v1[1]); w.w = pk2(v1[2], v1[3]);
                    *(v4u*)(rowp + bj * 128) = w;
                    ss += (v0[0] * v0[0] + v0[1] * v0[1]) + (v0[2] * v0[2] + v0[3] * v0[3]) + (v1[0] * v1[0] + v1[1] * v1[1]) + (v1[2] * v1[2] + v1[3] * v1[3]); }
                if (sq) { ss += __shfl_xor(ss, 16); ss += __shfl_xor(ss, 32);
                    if (fq == 0) { if (u.pn == 18) ssq_kv4[row * 4 + wc] = ss; else ssq_q8[row * 8 + (u.pn - 16) * 4 + wc] = ss; } } }
    }
};
__device__ __forceinline__ void phase2(const Params& p, LAS unsigned char* lds) {
    unsigned char* ws = p.ws;
    pg8::Gemm g{(const bf16_t*)(ws + WS_U16), (const bf16_t*)(ws + WS_BT_IN), nullptr, DM, DM, DM, 0};
    pg8::StaticOrder S; S.init(NT / 256, INCP / 256, gridDim.x, blockIdx.x, DM);
    EpiInProj E{(bf16_t*)(ws + WS_PROJ), (float*)(ws + TAB_SSQ_Q8), (float*)(ws + TAB_SSQ_KV4)};
    pg8::gemm_phase<EpiInProj, pg8::StaticOrder>((PG8_LAS unsigned char*)lds, g, S, E);
    { const int G = gridDim.x, firstidle = p2_first_idle(G), l2 = exp_late2(G);
      if (l2 > 0 && (int)blockIdx.x >= firstidle) { const int wave = __builtin_amdgcn_readfirstlane(threadIdx.x >> 6), j = ((int)blockIdx.x - firstidle) * NWAVES + wave, nw = (G - firstidle) * NWAVES;
          const int base = CT_GU + CT_DN - l2;
          for (int r = base + j; r < CT_GU + CT_DN; r += nw) expert_stream(p, (LAS unsigned*)(lds + wave * 18432), r, 1 << 30, threadIdx.x & 63, CT_GU + CT_DN); } }
}
struct EpiBf16Store { static constexpr bool PERM = true, MIDK = false; bf16_t* O; int ldc, pad;
    __device__ __forceinline__ void operator()(const pg8::f32x4 (&acc)[2][2][4][2], const pg8::Unit& u, int wr, int wc, int fr, int fq) const {
        const int row0 = u.pm * 256 + wr * 64 + fr, col0 = u.pn * 256 + wc * 32 + 8 * fq;
#pragma unroll
        for (int ai = 0; ai < 2; ++ai)
#pragma unroll
            for (int m = 0; m < 4; ++m) { if (!(u.mask & (3 << (ai * 2)))) continue; bf16_t* rowp = O + (size_t)(row0 + ai * 128 + m * 16) * ldc + col0;
#pragma unroll
                for (int bj = 0; bj < 2; ++bj) { const pg8::f32x4 v0 = acc[ai][bj][m][0], v1 = acc[ai][bj][m][1];
                    v4u w; w.x = pk2(v0[0], v0[1]); w.y = pk2(v0[2], v0[3]); w.z = pk2(v1[0], v1[1]); w.w = pk2(v1[2], v1[3]); *(v4u*)(rowp + bj * 128) = w; } }
    }
};
struct EpiVt { static constexpr bool PERM = true, MIDK = false; bf16_t* Vt; const float* ssq_kv4;
    __device__ __forceinline__ void operator()(const pg8::f32x4 (&acc)[2][2][4][2], const pg8::Unit& u, int wr, int wc, int fr, int fq) const {
        const int row0 = u.pm * 256 + wr * 64 + fr, col0 = u.pn * 256 + wc * 32 + 8 * fq;
        const int pb = (col0 & ~15) + 4 * (fq & 1);
#pragma unroll
        for (int bj = 0; bj < 2; ++bj) {
            float rs[8];
#pragma unroll
            for (int j = 0; j < 8; ++j) { const pg8::f32x4 s4 = *(const pg8::f32x4*)(ssq_kv4 + (size_t)(col0 + bj * 128 + j) * 4); rs[j] = rsqrtf(((s4[0] + s4[1]) + (s4[2] + s4[3])) * (1.f / KVR) + EPS); }
#pragma unroll
            for (int ai = 0; ai < 2; ++ai)
#pragma unroll
                for (int m = 0; m < 4; ++m) { if (!(u.mask & (1 << (ai * 2 + bj)))) continue; bf16_t* rowp = Vt + (size_t)(row0 + ai * 128 + m * 16) * NT + pb + bj * 128;
                    const pg8::f32x4 v0 = acc[ai][bj][m][0], v1 = acc[ai][bj][m][1];
                    v2u a, b; a.x = pk2(v0[0] * rs[0], v0[1] * rs[1]); a.y = pk2(v0[2] * rs[2], v0[3] * rs[3]);
                    b.x = pk2(v1[0] * rs[4], v1[1] * rs[5]); b.y = pk2(v1[2] * rs[6], v1[3] * rs[7]);
                    *(v2u*)(rowp) = a; *(v2u*)(rowp + 8) = b; }
        }
    }
};
__device__ __forceinline__ void phase3_gemms(const Params& p, LAS unsigned char* lds) {
    unsigned char* ws = p.ws; const int G = gridDim.x, c = blockIdx.x;
    const bf16_t* proj = (const bf16_t*)(ws + WS_PROJ);
    { pg8::Gemm g{proj + 4096, (const bf16_t*)(ws + WS_BT_UQ), nullptr, INCP, QR, QR, 0};
      pg8::StaticOrder S; S.init(NT / 256, 6, G, c, QR); EpiBf16Store E{(bf16_t*)(ws + WS_QRAW), 1536, 0};
      pg8::gemm_phase<EpiBf16Store, pg8::StaticOrder>((PG8_LAS unsigned char*)lds, g, S, E); }
    { pg8::Gemm g{proj + 4608, (const bf16_t*)(ws + WS_BT_KV), nullptr, INCP, KVR, KVR, 0};
      pg8::StaticOrder S; S.init(NT / 256, 4, G, (c + 64) % G, KVR); EpiBf16Store E{(bf16_t*)(ws + WS_KRAW), 1024, 0};
      pg8::gemm_phase<EpiBf16Store, pg8::StaticOrder>((PG8_LAS unsigned char*)lds, g, S, E); }
    { pg8::Gemm g{(const bf16_t*)(ws + WS_BT_KV) + 1024 * KVR, proj + 4608, nullptr, KVR, INCP, KVR, 0};
      pg8::StaticOrder S; S.init(4, NT / 256, G, (c + 192) % G, INCP); EpiVt E{(bf16_t*)(ws + WS_VT), (const float*)(ws + TAB_SSQ_KV4)};
      pg8::gemm_phase<EpiVt, pg8::StaticOrder>((PG8_LAS unsigned char*)lds, g, S, E); }
    if (exp_late3(G) > 0 && c >= 192) { const int wave = __builtin_amdgcn_readfirstlane(threadIdx.x >> 6), j = (c - 192) * NWAVES + wave, base = CT_GU + CT_DN - exp_late2(G) - exp_late3(G);
        for (int r = base + j; r < base + CT_EXP_LATE3; r += 64 * NWAVES) expert_stream(p, (LAS unsigned*)(lds + wave * 18432), r, 1 << 30, threadIdx.x & 63, CT_GU + CT_DN); }
}

constexpr float QSCALE = 0.07216878364870323f * 1.4426950408889634f;
__device__ __forceinline__ void phase4_qk(const Params& p, int wave, int lane) {
    unsigned char* ws = p.ws;
    const bf16_t* qraw = (const bf16_t*)(ws + WS_QRAW); const bf16_t* kraw = (const bf16_t*)(ws + WS_KRAW); const bf16_t* proj = (const bf16_t*)(ws + WS_PROJ);
    const float* ssq_q8 = (const float*)(ws + TAB_SSQ_Q8); const float* ssq_kv4 = (const float*)(ws + TAB_SSQ_KV4);
    const int* pos = (const int*)p.in[2]; const float* qg = p.in[14]; const float* kg = p.in[15];
    bf16_t* Q16 = (bf16_t*)(ws + WS_Q16); bf16_t* K16 = (bf16_t*)(ws + WS_K16);
    const float g0q = qg[lane], g1q = qg[64 + lane], g2q = qg[128 + lane], g0k = kg[lane], g1k = kg[64 + lane], g2k = kg[128 + lane];
    const int i = lane & 31; const float inv = exp2f(-(float)i * (13.287712379549449f / 32.f));
    const int gw = blockIdx.x * NWAVES + wave, NGW = gridDim.x * NWAVES;
    for (int it0 = gw; it0 < NT * MH; it0 += 2 * NGW) {
        float q0[2], q1[2], q2[2], k0[2], k1[2], k2[2], rq[2], rkv[2], ps[2];
#pragma unroll
        for (int u = 0; u < 2; ++u) { const int it = it0 + u * NGW; const int t = it >> 3, h = it & 7;
            const pg8::f32x4 qa = *(const pg8::f32x4*)(ssq_q8 + (size_t)t * 8), qb = *(const pg8::f32x4*)(ssq_q8 + (size_t)t * 8 + 4), ka = *(const pg8::f32x4*)(ssq_kv4 + (size_t)t * 4);
            rq[u] = rsqrtf((((qa[0] + qa[1]) + (qa[2] + qa[3])) + ((qb[0] + qb[1]) + (qb[2] + qb[3]))) * (1.f / QR) + EPS); rkv[u] = rsqrtf(((ka[0] + ka[1]) + (ka[2] + ka[3])) * (1.f / KVR) + EPS);
            q0[u] = bf2f(qraw[(size_t)t * 1536 + h * 192 + lane]); q1[u] = bf2f(qraw[(size_t)t * 1536 + h * 192 + 64 + lane]); q2[u] = bf2f(qraw[(size_t)t * 1536 + h * 192 + 128 + lane]);
            k0[u] = bf2f(kraw[(size_t)t * 1024 + h * 128 + lane]); k1[u] = bf2f(kraw[(size_t)t * 1024 + h * 128 + 64 + lane]); k2[u] = bf2f(proj[(size_t)t * INCP + 4864 + lane]); ps[u] = (float)pos[t]; }
#pragma unroll
        for (int u = 0; u < 2; ++u) { const int it = it0 + u * NGW; const int t = it >> 3, h = it & 7, b = t / SEQ, s = t % SEQ;
            float a0 = q0[u] * rq[u], a1 = q1[u] * rq[u], a2 = q2[u] * rq[u], c0 = k0[u] * rkv[u], c1 = k1[u] * rkv[u], c2 = k2[u];
            const float sq = wave_sum(a0 * a0 + a1 * a1 + a2 * a2), sk = wave_sum(c0 * c0 + c1 * c1 + c2 * c2);
            const float nq = rsqrtf(sq * (1.f / 192.f) + EPS) * QSCALE, nk = rsqrtf(sk * (1.f / 192.f) + EPS);
            a0 *= nq * g0q; a1 *= nq * g1q; a2 *= nq * g2q; c0 *= nk * g0k; c1 *= nk * g1k; c2 *= nk * g2k;
            const float ang = ps[u] * inv; const float rev = ang * 0.15915494309189535f; const float fr_ = rev - floorf(rev); const float sn = __builtin_amdgcn_sinf(fr_), cs = __builtin_amdgcn_cosf(fr_);
            const float a2o = __shfl_xor(a2, 32), c2o = __shfl_xor(c2, 32);
            const float a2r = lane < 32 ? a2 * cs - a2o * sn : a2 * cs + a2o * sn;
            const float c2r = lane < 32 ? c2 * cs - c2o * sn : c2 * cs + c2o * sn;
            const size_t base = ((size_t)(b * MH + h) * SEQ + s) * QKD;
            Q16[base + lane] = (bf16_t)f2bf(a0); Q16[base + 64 + lane] = (bf16_t)f2bf(a1); Q16[base + 128 + lane] = (bf16_t)f2bf(a2r);
            K16[base + lane] = (bf16_t)f2bf(c0); K16[base + 64 + lane] = (bf16_t)f2bf(c1); K16[base + 128 + lane] = (bf16_t)f2bf(c2r); }
    }
}

typedef short bf16x8 __attribute__((ext_vector_type(8)));
typedef float f32x16 __attribute__((ext_vector_type(16)));
constexpr int AT_KP = 400, AT_VP = 144, AT_KB = 64 * AT_KP, AT_VB = 128 * AT_VP, AT_BUF = AT_KB + AT_VB;
__device__ __forceinline__ void phase5_attn(const Params& p, LAS unsigned char* lds, int wave, int lane) {
    unsigned char* ws = p.ws;
    const bf16_t* Q16 = (const bf16_t*)(ws + WS_Q16); const bf16_t* K16 = (const bf16_t*)(ws + WS_K16); const bf16_t* Vt = (const bf16_t*)(ws + WS_VT);
    bf16_t* merged = (bf16_t*)(ws + WS_MERGED); float* ssq_o8 = (float*)(ws + TAB_SSQ_O8);
    const int tid = threadIdx.x, cl = lane & 31, hh = lane >> 5, qsub = wave & 3, kpar = wave >> 2;
    float mq = 0.f, mk = 0.f;
    for (int i = 0; i < 3; ++i) { mq = fmaxf(mq, fabsf(p.in[14][lane + 64 * i])); mk = fmaxf(mk, fabsf(p.in[15][lane + 64 * i])); }
#pragma unroll
    for (int o = 1; o < 64; o <<= 1) { mq = fmaxf(mq, __shfl_xor(mq, o)); mk = fmaxf(mk, __shfl_xor(mk, o)); }
    const float negc0 = -(13.856406460551018f * 1.4426950408889634f * 1.02f) * mq * mk;
    int kso[3], vso[2]; size_t vgo[2];
#pragma unroll
    for (int i = 0; i < 3; ++i) { const int c = tid + 512 * i; kso[i] = (c / 24) * AT_KP + (c % 24) * 16; }
#pragma unroll
    for (int i = 0; i < 2; ++i) { const int c = tid + 512 * i, dv = c >> 3, ch = c & 7; vso[i] = AT_KB + dv * AT_VP + ch * 16; vgo[i] = (size_t)dv * NT * 2 + ch * 16; }
    for (int item = blockIdx.x; item < 256; item += gridDim.x) {
        const int bh = item >> 3, x = item & 7, b = bh >> 3, h = bh & 7;
        const char* Qg = (const char*)(Q16 + (size_t)bh * SEQ * QKD); const char* Kg = (const char*)(K16 + (size_t)bh * SEQ * QKD);
        const char* Vg = (const char*)(Vt + (size_t)(h * 128) * NT + b * SEQ);
#pragma unroll 1
        for (int pass = 0; pass < 2; ++pass) {
            const int qi = pass == 0 ? 15 - x : x, nsteps = 2 * (qi + 1), qrow0 = qi * 128 + qsub * 32;
            bf16x8 Qf[12];
#pragma unroll
            for (int ks = 0; ks < 12; ++ks) Qf[ks] = *(const bf16x8*)(Qg + ((size_t)(qrow0 + cl) * QKD + ks * 16 + hh * 8) * 2);
            f32x16 O[4];
#pragma unroll
            for (int vb = 0; vb < 4; ++vb)
#pragma unroll
                for (int r = 0; r < 16; ++r) O[vb][r] = 0.f;
            float lsum = 0.f;
            v4u kr[3], vr[2];
#define AT_LOAD(j) do { _Pragma("unroll") for (int i_ = 0; i_ < 3; ++i_) kr[i_] = *(const v4u*)(Kg + (size_t)(j) * 24576 + (size_t)(tid + 512 * i_) * 16); \
                        _Pragma("unroll") for (int i_ = 0; i_ < 2; ++i_) vr[i_] = *(const v4u*)(Vg + vgo[i_] + (size_t)(j) * 128); } while (0)
#define AT_WRITE(bo) do { _Pragma("unroll") for (int i_ = 0; i_ < 3; ++i_) *(LAS v4u*)(lds + (bo) + kso[i_]) = kr[i_]; \
                          _Pragma("unroll") for (int i_ = 0; i_ < 2; ++i_) *(LAS v4u*)(lds + (bo) + vso[i_]) = vr[i_]; } while (0)
            AT_LOAD(0); AT_WRITE(0); __syncthreads();
#pragma unroll 1
            for (int j = 0; j < nsteps; ++j) {
                const int bo = (j & 1) * AT_BUF;
                if (j + 1 < nsteps) AT_LOAD(j + 1);
                const int key0 = 64 * j + 32 * kpar;
                if (key0 <= qrow0 + 31) {
                    f32x16 S;
#pragma unroll
                    for (int r = 0; r < 16; ++r) S[r] = negc0;
                    const LAS unsigned char* kb = lds + bo + (32 * kpar + cl) * AT_KP + hh * 16;
                    __builtin_amdgcn_s_setprio(1);
#pragma unroll
                    for (int ks = 0; ks < 12; ++ks) { const bf16x8 a = *(const LAS bf16x8*)(kb + ks * 32); S = __builtin_amdgcn_mfma_f32_32x32x16_bf16(a, Qf[ks], S, 0, 0, 0); }
                    __builtin_amdgcn_s_setprio(0);
                    const bool diag = key0 + 31 > qrow0;
                    float pr[16];
#pragma unroll
                    for (int r = 0; r < 16; ++r) { float e = __builtin_amdgcn_exp2f(S[r]);
                        if (diag) { const int key = key0 + (r & 3) + 8 * (r >> 2) + 4 * hh; if (key > qrow0 + cl) e = 0.f; }
                        pr[r] = e; lsum += e; }
                    bf16x8 Pf[2];
#pragma unroll
                    for (int s = 0; s < 2; ++s) { v4u w; w.x = pk2(pr[8 * s + 0], pr[8 * s + 1]); w.y = pk2(pr[8 * s + 2], pr[8 * s + 3]); w.z = pk2(pr[8 * s + 4], pr[8 * s + 5]); w.w = pk2(pr[8 * s + 6], pr[8 * s + 7]);
                        Pf[s] = __builtin_bit_cast(bf16x8, w); }
                    const LAS unsigned char* vbp = lds + bo + AT_KB + cl * AT_VP + (32 * kpar + 8 * hh) * 2;
                    __builtin_amdgcn_s_setprio(1);
#pragma unroll
                    for (int vb = 0; vb < 4; ++vb)
#pragma unroll
                        for (int s = 0; s < 2; ++s) { const bf16x8 a = *(const LAS bf16x8*)(vbp + vb * 32 * AT_VP + s * 32); O[vb] = __builtin_amdgcn_mfma_f32_32x32x16_bf16(a, Pf[s], O[vb], 0, 0, 0); }
                    __builtin_amdgcn_s_setprio(0);
                }
                if (j + 1 < nsteps) AT_WRITE(((j + 1) & 1) * AT_BUF);
                __syncthreads();
            }
            LAS float* X = (LAS float*)lds;
            if (kpar == 1) {
#pragma unroll
                for (int vb = 0; vb < 4; ++vb)
#pragma unroll
                    for (int r = 0; r < 16; ++r) X[(qsub * 65 + vb * 16 + r) * 64 + lane] = O[vb][r];
                X[(qsub * 65 + 64) * 64 + lane] = lsum;
            }
            __syncthreads();
            if (kpar == 0) {
                float l = lsum + X[(qsub * 65 + 64) * 64 + lane];
                l += __shfl_xor(l, 32);
                const float il = 1.f / l; float ss = 0.f;
                const int t = b * SEQ + qrow0 + cl;
                bf16_t* op = merged + (size_t)t * DM + h * 128 + 4 * hh;
#pragma unroll
                for (int vb = 0; vb < 4; ++vb)
#pragma unroll
                    for (int rq = 0; rq < 4; ++rq) { float o[4];
#pragma unroll
                        for (int r3 = 0; r3 < 4; ++r3) { const int r = rq * 4 + r3; o[r3] = (O[vb][r] + X[(qsub * 65 + vb * 16 + r) * 64 + lane]) * il; ss += o[r3] * o[r3]; }
                        v2u w; w.x = pk2(o[0], o[1]); w.y = pk2(o[2], o[3]); *(v2u*)(op + vb * 32 + rq * 8) = w; }
                ss += __shfl_xor(ss, 32);
                if (hh == 0) ssq_o8[(size_t)t * 8 + h] = ss;
            }
            __syncthreads();
        }
    }
#undef AT_LOAD
#undef AT_WRITE
}

__device__ __forceinline__ void phase6_scale(const Params& p, int wave, int lane) {
    unsigned char* ws = p.ws; bf16_t* merged = (bf16_t*)(ws + WS_MERGED); const float* ssq_o8 = (const float*)(ws + TAB_SSQ_O8);
    const int gw = blockIdx.x * NWAVES + wave, NGW = gridDim.x * NWAVES;
    for (int t = gw; t < NT; t += NGW) { const pg8::f32x4 oa = *(const pg8::f32x4*)(ssq_o8 + (size_t)t * 8), ob = *(const pg8::f32x4*)(ssq_o8 + (size_t)t * 8 + 4);
        const float r = rsqrtf((((oa[0] + oa[1]) + (oa[2] + oa[3])) + ((ob[0] + ob[1]) + (ob[2] + ob[3]))) * (1.f / 1024.f) + EPS);
#pragma unroll
        for (int j = 0; j < 2; ++j) { v4u* q = (v4u*)(merged + (size_t)t * DM + 1024 + j * 512 + lane * 8); v4u y = *q;
            y.x = pk2(bflo(y.x) * r, bfhi(y.x) * r); y.y = pk2(bflo(y.y) * r, bfhi(y.y) * r); y.z = pk2(bflo(y.z) * r, bfhi(y.z) * r); y.w = pk2(bflo(y.w) * r, bfhi(y.w) * r); *q = y; } }
}

struct EpiResidF32 { static constexpr bool PERM = false, MIDK = true; const float* x; const float* gate; float* out; const LAS float* rs;
    __device__ __forceinline__ void mid(pg8::f32x4 (&acc)[2][2][4][2], const pg8::Unit& u, int wr, int wc, int fr, int fq) const {
        const LAS float* rp = rs + u.pad * 256 + wr * 64 + fr;
#pragma unroll
        for (int ai = 0; ai < 2; ++ai)
#pragma unroll
            for (int m = 0; m < 4; ++m) { const float r = rp[ai * 128 + m * 16];
#pragma unroll
                for (int bj = 0; bj < 2; ++bj)
#pragma unroll
                    for (int n = 0; n < 2; ++n) acc[ai][bj][m][n] = acc[ai][bj][m][n] * r; }
    }
    __device__ __forceinline__ void operator()(const pg8::f32x4 (&acc)[2][2][4][2], const pg8::Unit& u, int wr, int wc, int fr, int fq) const {
        const int row0 = u.pm * 256 + wr * 64 + fr, col0 = u.pn * 256 + wc * 32 + 4 * fq;
        const float* gp = gate + (size_t)((u.pm * 256) / SEQ) * MODW + col0;
        pg8::f32x4 gv[2][2];
#pragma unroll
        for (int bj = 0; bj < 2; ++bj)
#pragma unroll
            for (int n = 0; n < 2; ++n) gv[bj][n] = *(const pg8::f32x4*)(gp + bj * 128 + n * 16);
#pragma unroll
        for (int ai = 0; ai < 2; ++ai)
#pragma unroll
            for (int m = 0; m < 4; ++m) { if (!(u.mask & (3 << (ai * 2)))) continue; const size_t ro = (size_t)(row0 + ai * 128 + m * 16) * DM + col0;
#pragma unroll
                for (int bj = 0; bj < 2; ++bj)
#pragma unroll
                    for (int n = 0; n < 2; ++n) { const pg8::f32x4 xv = *(const pg8::f32x4*)(x + ro + bj * 128 + n * 16); *(pg8::f32x4*)(out + ro + bj * 128 + n * 16) = xv + gv[bj][n] * acc[ai][bj][m][n]; } }
    }
};
__device__ __forceinline__ void phase7(const Params& p, LAS unsigned char* lds) {
    unsigned char* ws = p.ws;
    pg8::Gemm g{(const bf16_t*)(ws + WS_MERGED), (const bf16_t*)(ws + WS_BT_OUT), nullptr, DM, DM, DM, 0};
    pg8::StaticOrder S; S.init(NT / 256, DM / 256, gridDim.x, blockIdx.x, DM);
    LAS float* rs = (LAS float*)(lds + RING_BYTES + 12288);
    { const float* ssq_o8 = (const float*)(ws + TAB_SSQ_O8); pg8::Unit u;
      for (int i = 0; i < 4 && S.next(i, u); ++i) if (threadIdx.x < 256) { const float* sp = ssq_o8 + (size_t)(u.pm * 256 + threadIdx.x) * 8; const pg8::f32x4 oa = *(const pg8::f32x4*)sp, ob = *(const pg8::f32x4*)(sp + 4);
          rs[i * 256 + threadIdx.x] = rsqrtf((((oa[0] + oa[1]) + (oa[2] + oa[3])) + ((ob[0] + ob[1]) + (ob[2] + ob[3]))) * (1.f / 1024.f) + EPS); }
      __syncthreads(); }
    EpiResidF32 E{p.in[0], (const float*)(ws + CTL_MOD) + 2 * DM, (float*)(ws + WS_H1), rs};
    pg8::gemm_phase<EpiResidF32, pg8::StaticOrder>((PG8_LAS unsigned char*)lds, g, S, E);
}
constexpr int HG_P = 272, HG_VP = 144;
constexpr int HG_A2 = 0, HG_A1 = 17408, HG_QB = 34816, HG_VT = 52224, HG_KT = 70656, HG_SEG = 89088, HG_RS = 91136, HG_FL = 92160, HG_QT = 109568;
struct HgPre { v4u fl[2], q[2], v[2]; };
template <bool NEEDQ>
__device__ __forceinline__ void hg_issue(const bf16_t* __restrict__ proj, int item, HgPre& P) {
    const int bh = item >> 5, c = item & 31, b = bh >> 3, h = bh & 7, t0 = b * SEQ + c * 64, tid = threadIdx.x;
#pragma unroll
    for (int i = 0; i < 2; ++i) { const int ch = tid + 512 * i, t = ch >> 4, c16 = ch & 15; const bf16_t* rp = proj + (size_t)(t0 + t) * INCP + h * 128 + c16 * 8;
        P.fl[i] = *(const v4u*)(rp + 1024); P.v[i] = *(const v4u*)(rp + 2048); if (NEEDQ) P.q[i] = *(const v4u*)rp; }
}
struct HgCol { float kv[16]; float b[16]; float blast, bmid; };
template <bool NEEDQ, bool PERM>
__device__ __forceinline__ void hg_stage(const HgPre& P, const float* __restrict__ lbl, int h, LAS unsigned char* lds, HgCol& C) {
    const int tid = threadIdx.x, k = tid & 127, seg = tid >> 7;
    __syncthreads();
#pragma unroll
    for (int i = 0; i < 2; ++i) { const int ch = tid + 512 * i, t = ch >> 4, c16 = ch & 15;
        *(LAS v4u*)(lds + HG_FL + t * HG_P + c16 * 16) = P.fl[i]; if (NEEDQ) *(LAS v4u*)(lds + HG_QT + t * HG_P + c16 * 16) = P.q[i];
        const v4u w = P.v[i]; const int o = t & 15, pos = PERM ? ((t & ~15) + 8 * ((o >> 2) & 1) + 4 * ((o >> 3) & 1) + (o & 3)) : t;
        LAS unsigned short* vp = (LAS unsigned short*)(lds + HG_VT + (c16 * 8) * HG_VP + (((pos >> 3) ^ (c16 & 7)) * 16) + (pos & 7) * 2);
        vp[0 * (HG_VP / 2)] = (unsigned short)(w.x & 0xffff); vp[1 * (HG_VP / 2)] = (unsigned short)(w.x >> 16);
        vp[2 * (HG_VP / 2)] = (unsigned short)(w.y & 0xffff); vp[3 * (HG_VP / 2)] = (unsigned short)(w.y >> 16);
        vp[4 * (HG_VP / 2)] = (unsigned short)(w.z & 0xffff); vp[5 * (HG_VP / 2)] = (unsigned short)(w.z >> 16);
        vp[6 * (HG_VP / 2)] = (unsigned short)(w.w & 0xffff); vp[7 * (HG_VP / 2)] = (unsigned short)(w.w >> 16); }
    const float l0 = lbl[h * 128 + k], l1 = lbl[1024 + h * 128 + k];
    const float lb = 1.f / (1.f + __expf(l1 - l0));
    __syncthreads();
    const LAS unsigned short* fp = (const LAS unsigned short*)(lds + HG_FL + (seg * 16) * HG_P + k * 2);
    float run = 0.f;
#pragma unroll
    for (int i = 0; i < 16; ++i) { const float fl = bf2f(fp[i * (HG_P / 2)]); const float f = lb + (1.f - lb) / (1.f + __expf(-fl)); C.kv[i] = 1.f - f; run += __logf(f); C.b[i] = run; }
    LAS float* SEG = (LAS float*)(lds + HG_SEG);
    SEG[seg * 128 + k] = run;
    __syncthreads();
    const float s0 = SEG[k], s1 = SEG[128 + k], s2 = SEG[256 + k], s3 = SEG[384 + k];
    const float off = (seg > 0 ? s0 : 0.f) + (seg > 1 ? s1 : 0.f) + (seg > 2 ? s2 : 0.f);
#pragma unroll
    for (int i = 0; i < 16; ++i) C.b[i] += off;
    C.bmid = s0 + s1; C.blast = (s0 + s1) + (s2 + s3);
}
__device__ __forceinline__ void hgrn_pass1(const Params& p, LAS unsigned char* lds, int wave, int lane) {
    unsigned char* ws = p.ws; const bf16_t* proj = (const bf16_t*)(ws + WS_PROJ);
    bf16_t* hgU = (bf16_t*)(ws + WS_HGU); float* hgd = (float*)(ws + TAB_HGD);
    const int tid = threadIdx.x, k = tid & 127, seg = tid >> 7, cl = lane & 31, hh = lane >> 5, G = gridDim.x;
    HgPre P; if ((int)blockIdx.x < 1024) hg_issue<false>(proj, blockIdx.x, P);
    for (int item = blockIdx.x; item < 1024; item += G) {
        const int h = (item >> 5) & 7;
        HgCol C; hg_stage<false, false>(P, p.in[8], h, lds, C);
        if (item + G < 1024) hg_issue<false>(proj, item + G, P);
        { unsigned w[8];
#pragma unroll
          for (int i = 0; i < 8; ++i) { const float a0 = C.kv[2 * i] * __expf(C.blast - C.b[2 * i]), a1 = C.kv[2 * i + 1] * __expf(C.blast - C.b[2 * i + 1]); w[i] = pk2(a0, a1); }
          LAS v4u* kp = (LAS v4u*)(lds + HG_KT + k * HG_VP + seg * 32); kp[0] = (v4u){w[0], w[1], w[2], w[3]}; kp[1] = (v4u){w[4], w[5], w[6], w[7]}; }
        if (seg == 0) hgd[item * 128 + k] = __expf(C.blast);
        __syncthreads();
        const int vb = wave >> 1;
        bf16x8 af[4];
#pragma unroll
        for (int ks = 0; ks < 4; ++ks) af[ks] = *(const LAS bf16x8*)(lds + HG_VT + (32 * vb + cl) * HG_VP + (((2 * ks + hh) ^ ((cl >> 3) & 3) ^ ((vb & 1) << 2)) * 16));
#pragma unroll
        for (int q = 0; q < 2; ++q) { const int kb = (wave & 1) * 2 + q; f32x16 acc;
#pragma unroll
            for (int r = 0; r < 16; ++r) acc[r] = 0.f;
#pragma unroll
            for (int ks = 0; ks < 4; ++ks) { const bf16x8 bfr = *(const LAS bf16x8*)(lds + HG_KT + (32 * kb + cl) * HG_VP + (16 * ks + 8 * hh) * 2); acc = __builtin_amdgcn_mfma_f32_32x32x16_bf16(af[ks], bfr, acc, 0, 0, 0); }
            bf16_t* up = hgU + (size_t)item * 16384 + 32 * kb + cl;
#pragma unroll
            for (int r = 0; r < 16; ++r) { const int v = 32 * vb + (r & 3) + 8 * (r >> 2) + 4 * hh; up[(size_t)v * 128] = (bf16_t)f2bf(acc[r]); } }
    }
}
__device__ __forceinline__ void hgrn_scan(const Params& p) {
    unsigned char* ws = p.ws; bf16_t* hgU = (bf16_t*)(ws + WS_HGU); const float* hgd = (const float*)(ws + TAB_HGD);
    for (int i = blockIdx.x * NTHR + threadIdx.x; i < 32 * 4096; i += gridDim.x * NTHR) {
        const int bh = i >> 12, e4 = i & 4095, k4 = (e4 & 31) * 4;
        float S[4] = {0.f, 0.f, 0.f, 0.f};
        v2u* up = (v2u*)(hgU + (size_t)bh * 32 * 16384 + (size_t)e4 * 4); const float* dp = hgd + (size_t)bh * 32 * 128 + k4;
#pragma unroll 1
        for (int c0 = 0; c0 < 32; c0 += 8) { v2u u[8]; f32x4 d[8];
#pragma unroll
            for (int j = 0; j < 8; ++j) { u[j] = up[(size_t)(c0 + j) * 4096]; d[j] = *(const f32x4*)(dp + (c0 + j) * 128); }
#pragma unroll
            for (int j = 0; j < 8; ++j) { v2u o; o.x = pk2(S[0], S[1]); o.y = pk2(S[2], S[3]); up[(size_t)(c0 + j) * 4096] = o;
                S[0] = d[j][0] * S[0] + bflo(u[j].x); S[1] = d[j][1] * S[1] + bfhi(u[j].x); S[2] = d[j][2] * S[2] + bflo(u[j].y); S[3] = d[j][3] * S[3] + bfhi(u[j].y); } }
    }
}
__device__ __forceinline__ void hgrn_pass3(const Params& p, LAS unsigned char* lds, int wave, int lane) {
    unsigned char* ws = p.ws; const bf16_t* proj = (const bf16_t*)(ws + WS_PROJ);
    const bf16_t* hgS = (const bf16_t*)(ws + WS_HGU); bf16_t* merged = (bf16_t*)(ws + WS_MERGED); const float* og = p.in[9];
    const int tid = threadIdx.x, k = tid & 127, seg = tid >> 7, cl = lane & 31, hh = lane >> 5, vb = wave & 3, tb = wave >> 2, G = gridDim.x;
    HgPre P; if ((int)blockIdx.x < 1024) hg_issue<true>(proj, blockIdx.x, P);
    for (int item = blockIdx.x; item < 1024; item += G) {
        const int bh = item >> 5, c = item & 31, b = bh >> 3, h = bh & 7, t0 = b * SEQ + c * 64;
        bf16x8 sf[8]; v2u gw[4];
        { const bf16_t* sp = hgS + (size_t)item * 16384 + (size_t)(32 * vb + cl) * 128 + 8 * hh;
#pragma unroll
          for (int ks = 0; ks < 8; ++ks) sf[ks] = *(const bf16x8*)(sp + 16 * ks);
          const int t = t0 + 32 * tb + cl;
#pragma unroll
          for (int rq = 0; rq < 4; ++rq) gw[rq] = *(const v2u*)(proj + (size_t)t * INCP + 3072 + h * 128 + 32 * vb + 8 * rq + 4 * hh); }
        HgCol C; hg_stage<true, true>(P, p.in[8], h, lds, C);
        { const LAS unsigned short* qp = (const LAS unsigned short*)(lds + HG_QT + (seg * 16) * HG_P + k * 2);
          LAS unsigned short* a2 = (LAS unsigned short*)(lds + HG_A2 + (seg * 16) * HG_P + k * 2);
          LAS unsigned short* a1 = (LAS unsigned short*)(lds + HG_A1 + (seg * 16) * HG_P + k * 2);
          LAS unsigned short* qb = (LAS unsigned short*)(lds + HG_QB + (seg * 16) * HG_P + k * 2);
          const float em = __expf(-C.bmid), ep = __expf(C.bmid);
#pragma unroll
          for (int i = 0; i < 16; i += 2) { const float q0 = bf2f(qp[i * (HG_P / 2)]), q1 = bf2f(qp[(i + 1) * (HG_P / 2)]);
              const float e0 = __expf(C.b[i]), e1 = __expf(C.b[i + 1]);
              const unsigned wa2 = pk2(C.kv[i] * ep * __builtin_amdgcn_rcpf(e0), C.kv[i + 1] * ep * __builtin_amdgcn_rcpf(e1));
              const unsigned wa1 = pk2(q0 * e0 * em, q1 * e1 * em), wqb = pk2(q0 * e0, q1 * e1);
              a2[i * (HG_P / 2)] = (unsigned short)(wa2 & 0xffff); a2[(i + 1) * (HG_P / 2)] = (unsigned short)(wa2 >> 16);
              a1[i * (HG_P / 2)] = (unsigned short)(wa1 & 0xffff); a1[(i + 1) * (HG_P / 2)] = (unsigned short)(wa1 >> 16);
              qb[i * (HG_P / 2)] = (unsigned short)(wqb & 0xffff); qb[(i + 1) * (HG_P / 2)] = (unsigned short)(wqb >> 16); } }
        __syncthreads();
        if (item + G < 1024) hg_issue<true>(proj, item + G, P);
        f32x16 O;
#pragma unroll
        for (int r = 0; r < 16; ++r) O[r] = 0.f;
#pragma unroll
        for (int ks = 0; ks < 8; ++ks) { const bf16x8 bq = *(const LAS bf16x8*)(lds + HG_QB + (32 * tb + cl) * HG_P + (16 * ks + 8 * hh) * 2); O = __builtin_amdgcn_mfma_f32_32x32x16_bf16(sf[ks], bq, O, 0, 0, 0); }
#pragma unroll
        for (int sb = 0; sb < 2; ++sb) {
            if (sb <= tb) {
                f32x16 X;
#pragma unroll
                for (int r = 0; r < 16; ++r) X[r] = 0.f;
#pragma unroll
                for (int ks = 0; ks < 8; ++ks) { const bf16x8 a = *(const LAS bf16x8*)(lds + HG_A2 + (32 * sb + cl) * HG_P + (16 * ks + 8 * hh) * 2);
                    const bf16x8 bq = *(const LAS bf16x8*)(lds + HG_A1 + (32 * tb + cl) * HG_P + (16 * ks + 8 * hh) * 2); X = __builtin_amdgcn_mfma_f32_32x32x16_bf16(a, bq, X, 0, 0, 0); }
                if (sb == tb) {
#pragma unroll
                    for (int r = 0; r < 16; ++r) { const int s = (r & 3) + 8 * (r >> 2) + 4 * hh; if (s > cl) X[r] = 0.f; } }
#pragma unroll
                for (int s2 = 0; s2 < 2; ++s2) { v4u w; w.x = pk2(X[8 * s2 + 0], X[8 * s2 + 1]); w.y = pk2(X[8 * s2 + 2], X[8 * s2 + 3]); w.z = pk2(X[8 * s2 + 4], X[8 * s2 + 5]); w.w = pk2(X[8 * s2 + 6], X[8 * s2 + 7]);
                    const bf16x8 a = *(const LAS bf16x8*)(lds + HG_VT + (32 * vb + cl) * HG_VP + (((4 * sb + 2 * s2 + hh) ^ ((cl >> 3) & 3) ^ ((vb & 1) << 2)) * 16));
                    O = __builtin_amdgcn_mfma_f32_32x32x16_bf16(a, __builtin_bit_cast(bf16x8, w), O, 0, 0, 0); }
            }
        }
        float ss = 0.f;
#pragma unroll
        for (int r = 0; r < 16; ++r) ss += O[r] * O[r];
        ss += __shfl_xor(ss, 32);
        LAS float* RS = (LAS float*)(lds + HG_RS);
        if (hh == 0) RS[(tb * 4 + vb) * 32 + cl] = ss;
        __syncthreads();
        const float tot = (RS[(tb * 4 + 0) * 32 + cl] + RS[(tb * 4 + 1) * 32 + cl]) + (RS[(tb * 4 + 2) * 32 + cl] + RS[(tb * 4 + 3) * 32 + cl]);
        const float rn = rsqrtf(tot * (1.f / 128.f) + EPS);
        const int t = t0 + 32 * tb + cl;
#pragma unroll
        for (int rq = 0; rq < 4; ++rq) { const int v = 32 * vb + 8 * rq + 4 * hh; const f32x4 gg = *(const f32x4*)(og + v);
            const float g0 = bflo(gw[rq].x), g1 = bfhi(gw[rq].x), g2 = bflo(gw[rq].y), g3 = bfhi(gw[rq].y);
            const float o0 = O[rq * 4 + 0] * rn * gg[0] * (g0 / (1.f + __expf(-g0))), o1 = O[rq * 4 + 1] * rn * gg[1] * (g1 / (1.f + __expf(-g1)));
            const float o2 = O[rq * 4 + 2] * rn * gg[2] * (g2 / (1.f + __expf(-g2))), o3 = O[rq * 4 + 3] * rn * gg[3] * (g3 / (1.f + __expf(-g3)));
            v2u w; w.x = pk2(o0, o1); w.y = pk2(o2, o3); *(v2u*)(merged + (size_t)t * DM + 1024 + h * 128 + v) = w; }
    }
}
typedef float f32x2v __attribute__((ext_vector_type(2)));
constexpr int UPITCH = 2050;
constexpr int LDS_HIST = RING_BYTES + 1024;
__device__ __forceinline__ void phase8(const Params& p, LAS unsigned char* lds, int wave, int lane) {
    unsigned char* ws = p.ws;
    const float* h1 = (const float*)(ws + WS_H1); const float* mod = (const float*)(ws + CTL_MOD);
    unsigned char* u8 = ws + WS_U16;
    const float* wr_ = p.in[18]; const float* rbias = p.in[19];
    int* top_idx = (int*)(ws + TAB_TOPI); float* top_w = (float*)(ws + TAB_TOPW); int* slot = (int*)(ws + TAB_SLOT);
    LAS float* U = (LAS float*)lds;
    LAS int* hist = (LAS int*)(lds + LDS_HIST);
    if (threadIdx.x < 64) hist[threadIdx.x] = 0;
    LAS float* SS = (LAS float*)(lds + RING_BYTES + 5120);
    const int TPB = (NT / 16 + gridDim.x - 1) / gridDim.x;
    int ssb = -1;
    for (int task = blockIdx.x * TPB; task < NT / 16 && task < (int)(blockIdx.x + 1) * TPB; ++task) {
        const int t0 = task * 16;
        if (t0 / SEQ != ssb) { ssb = t0 / SEQ; __syncthreads();
            for (int i4 = threadIdx.x; i4 < DM / 4; i4 += NTHR) { const f32x4 gv = *(const f32x4*)(p.in[6] + i4 * 4), sv = *(const f32x4*)(mod + ssb * MODW + 4 * DM + i4 * 4), hv = *(const f32x4*)(mod + ssb * MODW + 3 * DM + i4 * 4);
                *(LAS f32x4*)(SS + i4 * 4) = gv * (sv + 1.f); *(LAS f32x4*)(SS + DM + i4 * 4) = hv; } }
        __syncthreads();
        { f32x4 v[2][8];
#pragma unroll
          for (int rr = 0; rr < 2; ++rr) { const float* hrow = h1 + (size_t)(t0 + wave * 2 + rr) * DM;
#pragma unroll
              for (int j = 0; j < 8; ++j) v[rr][j] = *(const f32x4*)(hrow + lane * 4 + 256 * j); }
#pragma unroll
          for (int rr = 0; rr < 2; ++rr) {
            const int tl = wave * 2 + rr, t = t0 + tl, b = t / SEQ;
            float s = 0.f;
#pragma unroll
            for (int j = 0; j < 8; ++j) s += (v[rr][j].x * v[rr][j].x + v[rr][j].y * v[rr][j].y) + (v[rr][j].z * v[rr][j].z + v[rr][j].w * v[rr][j].w);
            const float r = rsqrtf(wave_sum(s) * (1.f / DM) + EPS);
#pragma unroll
            for (int j = 0; j < 8; ++j) { const int col = lane * 4 + 256 * j; const f32x4 gs = *(const LAS f32x4*)(SS + col), hv = *(const LAS f32x4*)(SS + DM + col);
                const f32x4 o = v[rr][j] * r * gs + hv; *(unsigned*)(u8 + (size_t)t * DM + col) = pk4_fp8(o.x * 4.f, o.y * 4.f, o.z * 4.f, o.w * 4.f);
                LAS f32x2v* up = (LAS f32x2v*)(U + tl * UPITCH + col); up[0] = (f32x2v){o.x, o.y}; up[1] = (f32x2v){o.z, o.w}; }
          } }
        __syncthreads();
        f32x4 acc[4];
#pragma unroll
        for (int c = 0; c < 4; ++c) acc[c] = (f32x4){0.f, 0.f, 0.f, 0.f};
        { const int kb = wave * 256 + (lane >> 4); const LAS float* ua = U + (lane & 15) * UPITCH + kb; const float* wb = wr_ + (size_t)kb * NE + 4 * (lane & 15);
          f32x4 bv[8], bn[8];
#pragma unroll
          for (int q = 0; q < 8; ++q) bv[q] = *(const f32x4*)(wb + (size_t)q * 4 * NE);
#pragma unroll 1
          for (int k8 = 0; k8 < 64; k8 += 8) {
              if (k8 + 8 < 64) {
#pragma unroll
                  for (int q = 0; q < 8; ++q) bn[q] = *(const f32x4*)(wb + (size_t)(k8 + 8 + q) * 4 * NE); }
#pragma unroll
              for (int q = 0; q < 8; ++q) { const float a = ua[(k8 + q) * 4];
#pragma unroll
                  for (int c = 0; c < 4; ++c) acc[c] = __builtin_amdgcn_mfma_f32_16x16x4f32(a, bv[q][c], acc[c], 0, 0, 0); }
#pragma unroll
              for (int q = 0; q < 8; ++q) bv[q] = bn[q]; } }
        __syncthreads();
        LAS float* P = (LAS float*)lds;
#pragma unroll
        for (int c = 0; c < 4; ++c)
#pragma unroll
            for (int r = 0; r < 4; ++r) P[wave * 1024 + ((lane >> 4) * 4 + r) * 64 + 4 * (lane & 15) + c] = acc[c][r];
        __syncthreads();
        LAS float* LG = (LAS float*)(lds + 32768);
#pragma unroll
        for (int q = 0; q < 2; ++q) { const int i = threadIdx.x + q * NTHR; float s = 0.f;
#pragma unroll
            for (int w = 0; w < 8; ++w) s += P[w * 1024 + i]; LG[i] = s; }
        __syncthreads();
#pragma unroll 1
        for (int rr = 0; rr < 2; ++rr) {
            const int tl = wave * 2 + rr, t = t0 + tl;
            int lanev = lane; asm volatile("" : "+v"(lanev));
            const float sc = 1.f / (1.f + expf(-LG[tl * 64 + lane])); const float sel = sc + rbias[lane];
            float m1 = sel; m1 = fmaxf(m1, __shfl_xor(m1, 1)); m1 = fmaxf(m1, __shfl_xor(m1, 2)); m1 = fmaxf(m1, __shfl_xor(m1, 4));
            const unsigned long long gm = 0xFFull << (lanev & 56);
            const int first = __ffsll((long long)(__ballot(sel == m1) & gm)) - 1;
            float m2 = (lanev == first) ? -INFINITY : sel; m2 = fmaxf(m2, __shfl_xor(m2, 1)); m2 = fmaxf(m2, __shfl_xor(m2, 2)); m2 = fmaxf(m2, __shfl_xor(m2, 4));
            const float gs = m1 + m2; const int g = lanev >> 3; int grank = 0;
#pragma unroll
            for (int gg = 0; gg < 8; ++gg) { const float og = __builtin_bit_cast(float, __builtin_amdgcn_readlane(__builtin_bit_cast(int, gs), gg * 8)); grank += (og > gs || (og == gs && gg < g)) ? 1 : 0; }
            const bool gsel = grank < 4; int rk = 0;
            unsigned kb_ = __builtin_bit_cast(unsigned, sel); kb_ = (kb_ & 0x80000000u) ? ~kb_ : (kb_ | 0x80000000u);
            const unsigned long long key = gsel ? (((unsigned long long)kb_ << 6) | (unsigned long long)(63 - lanev)) : 0ull;
            const int klo = (int)(unsigned)key, khi = (int)(unsigned)(key >> 32);
#pragma unroll
            for (int e = 0; e < 64; ++e) { const unsigned long long o = ((unsigned long long)(unsigned)__builtin_amdgcn_readlane(khi, e) << 32) | (unsigned)__builtin_amdgcn_readlane(klo, e); rk += (o > key) ? 1 : 0; }
            const bool chosen = gsel && rk < 8;
            const unsigned long long cb = __ballot(chosen);
            const float wsum = wave_sum(chosen ? sc : 0.f);
            const int ks = __popcll(cb & ((1ull << lanev) - 1ull));
            if (chosen) { const int lr = __hip_atomic_fetch_add((int*)(hist + lane), 1, __ATOMIC_RELAXED, __HIP_MEMORY_SCOPE_WORKGROUP); top_idx[t * 8 + ks] = lane; top_w[t * 8 + ks] = sc / wsum * 2.5f; slot[t * 8 + ks] = lr; }
        }
        __syncthreads();
    }
    if (threadIdx.x < 64) ((int*)(ws + CTL_HIST))[blockIdx.x * 64 + threadIdx.x] = hist[threadIdx.x];
}

__device__ __forceinline__ void phase9(const Params& p, LAS unsigned char* lds, int wave, int lane) {
    unsigned char* ws = p.ws;
    const int* bh = (const int*)(ws + CTL_HIST);
    int* top_idx = (int*)(ws + TAB_TOPI); int* slot = (int*)(ws + TAB_SLOT); int* row_tok = (int*)(ws + TAB_ROWTOK); int* tile_exp = (int*)(ws + TAB_TILEEXP);
    LAS int* rb = (LAS int*)(lds + LDS_HIST + 256);
    const int G = gridDim.x;
    {
        LAS int* part = (LAS int*)(lds + LDS_HIST + 2048);
        const int e = threadIdx.x & 63, pt = threadIdx.x >> 6, per = (G + 7) / 8, b0 = pt * per, b1 = (b0 + per < G) ? b0 + per : G;
        int cnt = 0, base = 0;
#pragma unroll 8
        for (int b = b0; b < b1; ++b) { const int v = bh[b * 64 + e]; base += (b < (int)blockIdx.x) ? v : 0; cnt += v; }
        part[pt * 64 + e] = cnt; part[512 + pt * 64 + e] = base;
    }
    __syncthreads();
    if (wave == 0) {
        LAS int* part = (LAS int*)(lds + LDS_HIST + 2048);
        int cnt = 0, base = 0;
#pragma unroll
        for (int q = 0; q < 8; ++q) { cnt += part[q * 64 + lane]; base += part[512 + q * 64 + lane]; }
        const int tiles = (cnt + 255) >> 8;
        int incl = tiles;
#pragma unroll
        for (int o = 1; o < 64; o <<= 1) { const int n = __shfl_up(incl, o); if (lane >= o) incl += n; }
        const int toff = incl - tiles;
        rb[lane] = toff * 256 + base;
        if (blockIdx.x == 0) { for (int i = 0; i < tiles; ++i) tile_exp[toff + i] = lane; if (lane == 63) tile_exp[512] = incl; if (lane < 32) tile_exp[320 + lane] = 64; }
        rb[64 + lane] = toff * 256 + cnt; rb[128 + lane] = (toff + tiles) * 256;
    }
    __syncthreads();
    for (int e = blockIdx.x; e < 64; e += G) { const int lo = rb[64 + e], hi = rb[128 + e]; for (int r = lo + (int)threadIdx.x; r < hi; r += NTHR) row_tok[r] = 0; }
    for (int i = blockIdx.x * NTHR + threadIdx.x; i < NT; i += G * NTHR) row_tok[ROUTED_ROWS_MAX + i] = i;
    const int TPB = (NT / 16 + G - 1) / G;
    for (int task = blockIdx.x * TPB; task < NT / 16 && task < (int)(blockIdx.x + 1) * TPB; ++task) {
        const int t = task * 16 + wave * 2 + (lane >> 3), k = lane & 7;
        if (lane < 16) { const int e = top_idx[t * 8 + k]; const int pos = rb[e] + slot[t * 8 + k]; slot[t * 8 + k] = pos; row_tok[pos] = t; }
    }
}

constexpr int LDS_UNITS = RING_BYTES + 8192;
struct MoeOrder {
    LAS int* tab; int n;
    __device__ void init(LAS unsigned char* lds, const int* tile_exp, int nN, int G, int c, long estride, long bstep, int parts) {
        tab = (LAS int*)(lds + LDS_UNITS);
        const int ntr = tile_exp[512], nwg = (ntr + 32) * nN;
        int T = nwg % G, nfull = nwg - T; if (true) { nfull = nwg; T = 0; }
        const int njobs = nfull + parts * T;
        const int i = threadIdx.x; n = 0;
        if (c < njobs) n = (njobs - 1 - c) / G + 1;
        if (i < 32 && i < n) {
            const int L = i * G + c; int wgid, mask = 15;
            if (L < nfull) wgid = L; else { const int j = L - nfull; wgid = nfull + j % T; const int part = j / T; mask = (parts == 2) ? (part ? 12 : 3) : (1 << part); }
            { const int q = nwg / 8, r = nwg % 8, xcd = wgid % 8, off = wgid / 8; wgid = (xcd < r ? xcd * (q + 1) : r * (q + 1) + (xcd - r) * q) + off; }
            const int ti = wgid / nN, pn = wgid % nN; int tile, e; if (ti < ntr) { tile = ti; e = tile_exp[ti]; } else { tile = 320 + (ti - ntr); e = 64; }
            const long boff = (long)e * estride + (long)pn * bstep;
            tab[i * 8 + 0] = tile; tab[i * 8 + 1] = pn; tab[i * 8 + 2] = (int)(boff & 0xffffffffl); tab[i * 8 + 3] = (int)(boff >> 32); tab[i * 8 + 4] = mask;
        }
        __syncthreads();
    }
    __device__ bool next(int i, pg8::Unit& u) const {
        if (i >= n) return false;
        u.pm = tab[i * 8 + 0]; u.pn = tab[i * 8 + 1]; u.boff = (long)(((unsigned long long)(unsigned)tab[i * 8 + 3] << 32) | (unsigned)tab[i * 8 + 2]); u.mask = tab[i * 8 + 4]; u.pad = 0; return true;
    }
};
struct EpiGateUp { static constexpr bool PERM = true, MIDK = false; unsigned char* H;
    __device__ __forceinline__ void operator()(const pg8::f32x4 (&acc)[2][2][4][2], const pg8::Unit& u, int wr, int wc, int fr, int fq) const {
        const int row0 = u.pm * 256 + wr * 64 + fr, col0 = u.pn * 128 + wc * 32 + 8 * fq;
#pragma unroll
        for (int ai = 0; ai < 2; ++ai)
#pragma unroll
            for (int m = 0; m < 4; ++m) { const int row = row0 + ai * 128 + m * 16; float o[8];
#pragma unroll
                for (int n = 0; n < 2; ++n)
#pragma unroll
                    for (int j = 0; j < 4; ++j) { const float gt = acc[ai][0][m][n][j] * (1.f / 256.f), up = acc[ai][1][m][n][j] * (8.f / 256.f); o[n * 4 + j] = gt / (1.f + __expf(-gt)) * up; }
                v2u w; w.x = pk4_fp8(o[0], o[1], o[2], o[3]); w.y = pk4_fp8(o[4], o[5], o[6], o[7]);
                *(v2u*)(H + (size_t)row * DE + col0) = w; }
    }
};
struct EpiDown { static constexpr bool PERM = true, MIDK = false; unsigned char* Y;
    __device__ __forceinline__ void operator()(const pg8::f32x4 (&acc)[2][2][4][2], const pg8::Unit& u, int wr, int wc, int fr, int fq) const {
        const int row0 = u.pm * 256 + wr * 64 + fr, col0 = u.pn * 256 + wc * 32 + 8 * fq; const float s = 16.f / 512.f;
#pragma unroll
        for (int ai = 0; ai < 2; ++ai)
#pragma unroll
            for (int m = 0; m < 4; ++m) { const int row = row0 + ai * 128 + m * 16; unsigned char* rowp = Y + (size_t)row * DM + col0;
#pragma unroll
                for (int bj = 0; bj < 2; ++bj) { const pg8::f32x4 v0 = acc[ai][bj][m][0] * s, v1 = acc[ai][bj][m][1] * s;
                    v2u w; w.x = pk4_fp8(v0[0], v0[1], v0[2], v0[3]); w.y = pk4_fp8(v1[0], v1[1], v1[2], v1[3]); *(v2u*)(rowp + bj * 128) = w; } }
    }
};
__device__ __forceinline__ void phase10(const Params& p, LAS unsigned char* lds) {
    unsigned char* ws = p.ws;
    pg8::Gemm g{(const bf16_t*)(ws + WS_U16), (const bf16_t*)(ws + WS_BT_GU), (const int*)(ws + TAB_ROWTOK), DM, DM, DM, 0};
    MoeOrder S; S.init(lds, (const int*)(ws + TAB_TILEEXP), 4, gridDim.x, blockIdx.x, (long)1024 * DM, (long)256 * DM, 2);
    EpiGateUp E{ws + WS_HID};
    pg8::gemm_phase<EpiGateUp, MoeOrder, 1>((PG8_LAS unsigned char*)lds, g, S, E);
}
__device__ __forceinline__ void phase11(const Params& p, LAS unsigned char* lds) {
    unsigned char* ws = p.ws;
    pg8::Gemm g{(const bf16_t*)(ws + WS_HID), (const bf16_t*)(ws + WS_BT_DN), nullptr, DE, DE, DE, 0};
    MoeOrder S; S.init(lds, (const int*)(ws + TAB_TILEEXP), 8, gridDim.x, blockIdx.x, (long)DM * DE, (long)256 * DE, 4);
    EpiDown E{ws + WS_Y};
    pg8::gemm_phase<EpiDown, MoeOrder, 1>((PG8_LAS unsigned char*)lds, g, S, E);
}
__device__ __forceinline__ void fp8x8_fma(const v2u y, float w, float (&a)[8]) {
#pragma unroll
    for (int q = 0; q < 2; ++q) { const unsigned d = y[q];
        a[q * 4 + 0] += w * __builtin_amdgcn_cvt_f32_fp8((int)d, 0); a[q * 4 + 1] += w * __builtin_amdgcn_cvt_f32_fp8((int)d, 1);
        a[q * 4 + 2] += w * __builtin_amdgcn_cvt_f32_fp8((int)d, 2); a[q * 4 + 3] += w * __builtin_amdgcn_cvt_f32_fp8((int)d, 3); }
}
__device__ __forceinline__ void phase12(const Params& p, int wave, int lane) {
    unsigned char* ws = p.ws;
    const float* h1 = (const float*)(ws + WS_H1); const float* mod = (const float*)(ws + CTL_MOD); const unsigned char* Y = ws + WS_Y;
    const int* slot = (const int*)(ws + TAB_SLOT); const float* top_w = (const float*)(ws + TAB_TOPW);
    const int gw = blockIdx.x * NWAVES + wave, NGW = gridDim.x * NWAVES;
    for (int t = gw; t < NT; t += NGW) {
        const int b = t / SEQ; const float* gt = mod + b * MODW + 5 * DM;
        int sl = 0; float wk = 0.f; if (lane < 8) { sl = slot[t * 8 + lane]; wk = top_w[t * 8 + lane] * (1.f / 16.f); }
#pragma unroll 2
        for (int j = 0; j < 4; ++j) {
            const int col = j * 512 + lane * 4;
            float a[8];
#pragma unroll
            for (int i = 0; i < 8; ++i) a[i] = 0.f;
            v2u yr[9];
            { const unsigned char* yp = Y + (size_t)(ROUTED_ROWS_MAX + t) * DM + col; yr[8].x = __builtin_nontemporal_load((const unsigned*)yp); yr[8].y = __builtin_nontemporal_load((const unsigned*)(yp + 256)); }
#pragma unroll
            for (int k = 0; k < 8; ++k) { const int s = __builtin_amdgcn_readlane(sl, k); const unsigned char* yp = Y + (size_t)s * DM + col;
                yr[k].x = __builtin_nontemporal_load((const unsigned*)yp); yr[k].y = __builtin_nontemporal_load((const unsigned*)(yp + 256)); }
            const f32x4 h0 = *(const f32x4*)(h1 + (size_t)t * DM + col), h4 = *(const f32x4*)(h1 + (size_t)t * DM + col + 256);
            const f32x4 g0 = *(const f32x4*)(gt + col), g4 = *(const f32x4*)(gt + col + 256);
            fp8x8_fma(yr[8], 1.f / 16.f, a);
#pragma unroll
            for (int k = 0; k < 8; ++k) { const float w = __builtin_bit_cast(float, __builtin_amdgcn_readlane(__builtin_bit_cast(int, wk), k)); fp8x8_fma(yr[k], w, a); }
            f32x4 o0, o4; o0.x = h0.x + g0.x * a[0]; o0.y = h0.y + g0.y * a[1]; o0.z = h0.z + g0.z * a[2]; o0.w = h0.w + g0.w * a[3];
            o4.x = h4.x + g4.x * a[4]; o4.y = h4.y + g4.y * a[5]; o4.z = h4.z + g4.z * a[6]; o4.w = h4.w + g4.w * a[7];
            __builtin_nontemporal_store(o0, (f32x4*)(p.out + (size_t)t * DM + col)); __builtin_nontemporal_store(o4, (f32x4*)(p.out + (size_t)t * DM + col + 256));
        }
    }
}

__global__ void __launch_bounds__(NTHR, 2) k_mega(Params p) {
    extern __shared__ __attribute__((aligned(16))) unsigned char lds_raw[];
    LAS unsigned char* lds = (LAS unsigned char*)lds_raw;
    const int tid = threadIdx.x, lane = tid & 63, wave = __builtin_amdgcn_readfirstlane(tid >> 6);
    volatile LAS unsigned* MISC = (volatile LAS unsigned*)(lds + MISC_OFF);
    for (int u = tid; u < (LDS_BYTES - RING_BYTES) / 4; u += NTHR) ((LAS unsigned*)(lds + RING_BYTES))[u] = 0u;
    __syncthreads();
    XcdBarrier bar = xcd_barrier_post((unsigned*)(p.ws + WS_CTL) + CW_BAR, MISC + 8);
    const int lo = p.ph_lo, hi = p.ph_hi;
#ifndef DUP_MASK
#define DUP_MASK 0
#endif
#define IN(k) (lo <= (k) && (k) < hi)
#define DUPK(k, body) do { if (IN(k)) { body; if ((DUP_MASK >> (k)) & 1) { xcd_barrier(bar); body; } } } while (0)
#ifdef SPIN_PHASE
#define STAMP(k) do { if (blockIdx.x == 0 && tid == 0) ((unsigned long long*)(p.ws + 49152))[k] = __builtin_amdgcn_s_memrealtime(); } while (0)
#else
#define STAMP(k) do { } while (0)
#endif
#define SEAM(k) do { if (IN(k) && IN((k) + 1)) { xcd_barrier(bar); STAMP((k) + 1); } } while (0)
    STAMP(0);
    DUPK(0, phase0(p, lds, wave, lane)); SEAM(0);
    DUPK(1, phase1(p, lds, wave, lane)); SEAM(1);
#ifdef EXTRA_BARS
    for (int eb = 0; eb < EXTRA_BARS; ++eb) xcd_barrier(bar);
#endif
    DUPK(2, phase2(p, lds)); SEAM(2);
    DUPK(3, phase3_gemms(p, lds); hgrn_pass1(p, lds, wave, lane)); SEAM(3);
    DUPK(4, hgrn_scan(p); phase4_qk(p, wave, lane); if ((DUP_MASK >> 17) & 1) { xcd_barrier(bar); phase4_qk(p, wave, lane); }); SEAM(4);
    DUPK(5, phase5_attn(p, lds, wave, lane); hgrn_pass3(p, lds, wave, lane); if ((DUP_MASK >> 16) & 1) { xcd_barrier(bar); hgrn_pass3(p, lds, wave, lane); }); if (IN(5) && IN(7)) { xcd_barrier(bar); STAMP(6); STAMP(7); }
    DUPK(7, phase7(p, lds)); SEAM(7);
    DUPK(8, phase8(p, lds, wave, lane)); SEAM(8);
    DUPK(9, phase9(p, lds, wave, lane)); SEAM(9);
    DUPK(10, phase10(p, lds)); SEAM(10);
    DUPK(11, phase11(p, lds)); SEAM(11);
    DUPK(12, phase12(p, wave, lane));
#ifdef SPIN_NTR
    { const int ntr = ((const int*)(p.ws + TAB_TILEEXP))[512]; const unsigned long long d = (unsigned long long)(ntr - 256) * 1000ull;
      const unsigned long long t0 = __builtin_amdgcn_s_memrealtime(); while (__builtin_amdgcn_s_memrealtime() - t0 < d) __builtin_amdgcn_s_sleep(8); }
#endif
#ifdef SPIN_PHASE
    xcd_barrier(bar); STAMP(13);
    xcd_barrier(bar);
    { const unsigned long long* ts = (const unsigned long long*)(p.ws + 49152);
      const unsigned long long d = __hip_atomic_load(ts + SPIN_PHASE + 1, __ATOMIC_RELAXED, __HIP_MEMORY_SCOPE_AGENT) - __hip_atomic_load(ts + SPIN_PHASE, __ATOMIC_RELAXED, __HIP_MEMORY_SCOPE_AGENT);
      const unsigned long long t0 = __builtin_amdgcn_s_memrealtime(); while (__builtin_amdgcn_s_memrealtime() - t0 < 4ull * d) __builtin_amdgcn_s_sleep(8); }
#endif
#undef IN
#undef SEAM
}
extern "C" void kernel_launch(void* const* d_in, const int* in_sizes, int n_in, void* d_out, int out_size, void* d_ws, size_t ws_size, hipStream_t stream) {
    static int grid = 0;
    if (grid == 0) {
        int dev = 0, cus = 0;
        if (hipGetDevice(&dev) != hipSuccess || hipDeviceGetAttribute(&cus, hipDeviceAttributeMultiprocessorCount, dev) != hipSuccess) { grid = -1; return; }
        if (hipFuncSetAttribute((const void*)k_mega, hipFuncAttributeMaxDynamicSharedMemorySize, LDS_BYTES) != hipSuccess) { fprintf(stderr, "kernel_launch: hipFuncSetAttribute failed\n"); grid = -1; return; }
        (void)hipGetLastError();
        grid = cus;
        if (n_in != 26 || ws_size < WS_END) { fprintf(stderr, "kernel_launch: unexpected inputs / workspace (%d, %zu)\n", n_in, ws_size); grid = -1; return; }
    }
    if (grid < 0) return;
    (void)hipMemsetAsync((char*)d_ws + WS_CTL, 0, CTL_ZERO_BYTES, stream);
    Params p{};
    for (int i = 0; i < 26; ++i) p.in[i] = (const float*)d_in[i];
    p.out = (float*)d_out; p.ws = (unsigned char*)d_ws; p.ph_lo = 0; p.ph_hi = 13;
    hipLaunchKernelGGL(k_mega, dim3(grid), dim3(NTHR), LDS_BYTES, stream, p);
}
```

```cpp
#include <hip/hip_runtime.h>
#include <cstdio>
#include <cstdint>
constexpr int NB = 4, SEQ = 2048, DM = 2048, NT = NB * SEQ;
constexpr int INC = 4928, INCP = 5120;
constexpr int MH = 8, QR = 512, KVR = 256, QKD = 192, VD = 128;
constexpr int NE = 64, DE = 512;
constexpr float EPS = 1e-6f;
constexpr int MODW = 6 * DM;
constexpr int NWAVES = 8, NTHR = 512;
constexpr int PROWS = 90112;
constexpr int ROUTED_ROWS_MAX = 81920;

constexpr size_t MiB = 1u << 20;
constexpr size_t WS_CTL = 0, CTL_ZERO_BYTES = 1 * MiB;
constexpr int CW_BAR = 1024;
constexpr size_t CTL_MOD = 64 * 1024;
constexpr size_t WS_MODP = 4 * MiB;
constexpr size_t TAB_SSQ_Q8 = 7 * MiB, TAB_SSQ_KV4 = 7 * MiB + 256 * 1024, TAB_SSQ_O8 = 7 * MiB + 512 * 1024;
constexpr size_t CTL_HIST = 416 * 1024;
constexpr size_t WS_TAB = 1 * MiB;
constexpr size_t TAB_HGD = WS_TAB;
constexpr size_t TAB_TOPI = WS_TAB + 1 * MiB;
constexpr size_t TAB_TOPW = TAB_TOPI + 256 * 1024;
constexpr size_t TAB_SLOT = TAB_TOPW + 256 * 1024;
constexpr size_t TAB_ROWTOK = TAB_SLOT + 256 * 1024;
constexpr size_t TAB_TILEEXP = TAB_ROWTOK + 512 * 1024;
constexpr size_t WS_BT_IN = 8 * MiB, WS_BT_UQ = 28 * MiB, WS_BT_KV = 30 * MiB, WS_BT_OUT = 32 * MiB, WS_BT_GU = 40 * MiB, WS_BT_DN = 300 * MiB;
constexpr size_t WS_U16 = 430 * MiB, WS_H1 = 462 * MiB, WS_HID = 526 * MiB, WS_X = 614 * MiB;
constexpr size_t WS_PROJ = WS_X, WS_QRAW = WS_X + 80 * MiB, WS_KRAW = WS_X + 104 * MiB, WS_VT = WS_X + 120 * MiB, WS_Q16 = WS_X + 136 * MiB, WS_K16 = WS_X + 160 * MiB,
                 WS_HGU = WS_X + 184 * MiB, WS_MERGED = WS_X + 216 * MiB, WS_Y = WS_X, WS_END = 966 * MiB;

constexpr int RING_BYTES = 131072, LDS_BYTES = 163840, MISC_OFF = LDS_BYTES - 256;

#define GAS __attribute__((address_space(1)))
#define LAS __attribute__((address_space(3)))
typedef unsigned short bf16_t;
typedef unsigned v4u __attribute__((ext_vector_type(4)));
typedef unsigned v2u __attribute__((ext_vector_type(2)));
typedef float f32x4 __attribute__((ext_vector_type(4)));
typedef GAS unsigned gu32;
#define RLX_AGENT __ATOMIC_RELAXED, __HIP_MEMORY_SCOPE_AGENT
__device__ __forceinline__ unsigned f2bf(float f) { unsigned u = __builtin_bit_cast(unsigned, f); return (u + 0x7fffu + ((u >> 16) & 1u)) >> 16; }
__device__ __forceinline__ unsigned pk2(float lo, float hi) { unsigned r; asm volatile("v_cvt_pk_bf16_f32 %0, %1, %2" : "=v"(r) : "v"(lo), "v"(hi)); return r; }
__device__ __forceinline__ float bf2f(unsigned short b) { return __builtin_bit_cast(float, ((unsigned)b) << 16); }
__device__ __forceinline__ float bflo(unsigned w) { return __builtin_bit_cast(float, w << 16); }
__device__ __forceinline__ float bfhi(unsigned w) { return __builtin_bit_cast(float, w & 0xffff0000u); }
__device__ __forceinline__ float sigmoidf_(float x) { return 1.f / (1.f + __expf(-x)); }
__device__ __forceinline__ float siluf_(float x) { return x / (1.f + __expf(-x)); }
__device__ __forceinline__ float wave_sum(float v) {
#pragma unroll
    for (int o = 1; o < 64; o <<= 1) v += __shfl_xor(v, o);
    return v;
}

#define XB_TMO      128
#define XB_XCNT(j)  (256  + 64 * (j))
#define XB_XSUB(j)  (1280 + 64 * (j))
#define XB_XGEN(j)  (2304 + 64 * (j))
#define XB_TOP      3328
#define XB_TOPGEN   3392
#define XCD_BAR_WORDS 3456
#define XB_SPIN_CAP (1u << 18)
__device__ __forceinline__ unsigned xb_ld(unsigned* p)              { return __hip_atomic_load(p, __ATOMIC_RELAXED, __HIP_MEMORY_SCOPE_AGENT); }
__device__ __forceinline__ unsigned xb_add(unsigned* p, unsigned v) { return __hip_atomic_fetch_add(p, v, __ATOMIC_RELAXED, __HIP_MEMORY_SCOPE_AGENT); }
__device__ __forceinline__ unsigned xb_xcc_id() { return (unsigned)__builtin_amdgcn_s_getreg((3 << 11) | 20) & 0xFu; }
#define XB_SPIN(cond, bar) do { unsigned _sp = 0; while (cond) { __builtin_amdgcn_s_sleep(1); \
    if ((++_sp & 255u) == 0u) { if (xb_ld(&(bar)[XB_TMO])) break; if (_sp > XB_SPIN_CAP) { atomicAdd(&(bar)[XB_TMO], 1u); break; } } } } while (0)
struct XcdBarrier { unsigned* bar; unsigned x; volatile LAS unsigned* st; };
__device__ __forceinline__ XcdBarrier xcd_barrier_post(unsigned* bar, volatile LAS unsigned* st) {
    XcdBarrier b; b.bar = bar; b.x = xb_xcc_id(); b.st = st;
    if (threadIdx.x == 0) (void)xb_add(&bar[XB_XCNT(b.x)], 1u);
    return b;
}
__device__ __forceinline__ void xcd_barrier_complete(unsigned* bar, unsigned x, unsigned& nloc, unsigned& nx) {
    const unsigned G = gridDim.x * gridDim.y * gridDim.z;
    unsigned sum, cnt, mine, sp = 0u;
    for (;;) {
        sum = 0u; cnt = 0u; mine = 0u;
#pragma unroll
        for (unsigned j = 0; j < 16; ++j) { const unsigned c = xb_ld(&bar[XB_XCNT(j)]); sum += c; cnt += (c > 0u) ? 1u : 0u; mine = (j == x) ? c : mine; }
        if (sum == G) break;
        __builtin_amdgcn_s_sleep(1);
        if ((++sp & 255u) == 0u) { if (xb_ld(&bar[XB_TMO])) break; if (sp > XB_SPIN_CAP) { atomicAdd(&bar[XB_TMO], 1u); break; } }
    }
    nloc = mine > 0u ? mine : 1u; nx = cnt > 0u ? cnt : 1u;
}
__device__ __forceinline__ void xcd_barrier(const XcdBarrier& b) {
    asm volatile("s_waitcnt vmcnt(0)" ::: "memory");
    __syncthreads();
    if (threadIdx.x == 0) {
        unsigned* bar = b.bar;
        __builtin_amdgcn_s_waitcnt(0);
        unsigned nloc = b.st[0], nx = b.st[1];
        if (nloc == 0u) { xcd_barrier_complete(bar, b.x, nloc, nx); b.st[0] = nloc; b.st[1] = nx; }
        const unsigned old = xb_add(&bar[XB_XSUB(b.x)], 1u);
        const unsigned gen = old / nloc;
        if (old + 1u == (gen + 1u) * nloc) {
            __builtin_amdgcn_fence(__ATOMIC_RELEASE, "agent");
            asm volatile("s_waitcnt vmcnt(0)" ::: "memory");
            const unsigned og = xb_add(&bar[XB_TOP], 1u);
            const unsigned tg = og / nx;
            if (og + 1u == (tg + 1u) * nx) xb_add(&bar[XB_TOPGEN], 1u);
            else XB_SPIN(xb_ld(&bar[XB_TOPGEN]) == tg, bar);
            __builtin_amdgcn_fence(__ATOMIC_ACQUIRE, "agent");
            xb_add(&bar[XB_XGEN(b.x)], 1u);
            asm volatile("s_waitcnt vmcnt(0)" ::: "memory");
        } else {
            XB_SPIN(xb_ld(&bar[XB_XGEN(b.x)]) == gen, bar);
            __builtin_amdgcn_fence(__ATOMIC_ACQUIRE, "agent");
            asm volatile("s_waitcnt vmcnt(0)" ::: "memory");
        }
    }
    __syncthreads();
}

struct Params { const float* in[26]; float* out; unsigned char* ws; int ph_lo, ph_hi; };
namespace pg8 {
#define PG8_LAS __attribute__((address_space(3)))
typedef unsigned short bf16_t;
typedef short bf16x8 __attribute__((ext_vector_type(8)));
typedef float f32x4 __attribute__((ext_vector_type(4)));
typedef unsigned u32x4 __attribute__((ext_vector_type(4)));
typedef unsigned u32x2 __attribute__((ext_vector_type(2)));
constexpr int BM = 256, BK = 64, HALF = 128, HTB = HALF * BK * 2, STAGE_BYTES = 8 * HTB, NXCD = 8, WGM = 8;

__host__ __device__ __forceinline__ int lds_byte(int r, int c) { const int st = (r >> 4) * 2 + (c >> 5), rr = r & 15, cc = c & 31, ob = rr * 64 + cc * 2; return st * 1024 + (ob ^ (((ob >> 9) & 1) << 5)); }
__host__ __device__ __forceinline__ void stage_rc(int b, int& R, int& C) { const int st = b / 1024, sb = b % 1024, swz = sb ^ (((sb >> 9) & 1) << 5); R = (st >> 1) * 16 + swz / 64; C = (st & 1) * 32 + (swz % 64) / 2; }
__host__ __device__ __forceinline__ int perm32(int rho) { const int n = rho >> 4, i = rho & 15; return 8 * (i >> 2) + 4 * n + (i & 3); }

struct Unit { int pm, pn; long boff; int mask, pad; };
struct Gemm { const bf16_t* A; const bf16_t* Bt; const int* rowtab; int lda, ldb, K, pad; };

__device__ __forceinline__ unsigned cvt_pk_bf16(float lo, float hi) { unsigned r; asm volatile("v_cvt_pk_bf16_f32 %0, %1, %2" : "=v"(r) : "v"(lo), "v"(hi)); return r; }

struct StaticOrder {
    int nM, nN, nwg, G, c, nfull, T; long bstep;
    __device__ void init(int nM_, int nN_, int G_, int c_, int ldb) { nM = nM_; nN = nN_; nwg = nM * nN; G = G_; c = c_; bstep = (long)BM * ldb * 2;
        T = 0; nfull = nwg; }
    __device__ bool next(int i, Unit& u) const {
        const long L = (long)i * G + c; int wgid, mask = 15;
        if (L < nfull) wgid = (int)L;
        else { const long j = L - nfull; if (j >= 2 * T) return false; wgid = nfull + (int)(j % T); mask = (j / T) ? 12 : 3; }
        { const int q = nwg / NXCD, r = nwg % NXCD, xcd = wgid % NXCD, off = wgid / NXCD; wgid = (xcd < r ? xcd * (q + 1) : r * (q + 1) + (xcd - r) * q) + off; }
        const int nig = WGM * nN, gid = wgid / nig, fm = gid * WGM, gsz = (nM - fm) < WGM ? (nM - fm) : WGM;
        u.pm = fm + ((wgid % nig) % gsz); u.pn = (wgid % nig) / gsz; u.boff = (long)u.pn * bstep; u.mask = mask; u.pad = i; return true;
    }
};

typedef long i64x2 __attribute__((ext_vector_type(2)));
template <class Epi, class Sched, int ES = 2, bool ALIGN_EPI = true>
__device__ __forceinline__ void gemm_phase(PG8_LAS unsigned char* lds, const Gemm g, const Sched& S, const Epi& E) {
    const int tid = threadIdx.x, wid = __builtin_amdgcn_readfirstlane(tid >> 6), lane = tid & 63, wr = wid >> 2, wc = wid & 3, fr = lane & 15, fq = lane >> 4;
    const int K = g.K, nt = K * ES / (BK * 2);
    int Rr[2]; unsigned Cb[2], voffB[2];
#pragma unroll
    for (int i = 0; i < 2; ++i) { int R, C; stage_rc(tid * 16 + i * 8192, R, C); const int Rb = Epi::PERM ? ((R & ~31) + perm32(R & 31)) : R;
        Rr[i] = R; Cb[i] = (unsigned)C * 2u; voffB[i] = (unsigned)(Rb * g.ldb) * (unsigned)ES + (unsigned)C * 2u; }
    const size_t kstep = (size_t)(BK * 2);
    const size_t hstepB = (size_t)HALF * g.ldb * ES;
    const unsigned lda2 = (unsigned)g.lda * (unsigned)ES;
    const unsigned ldsw = (unsigned)wid * 1024u;
    const int aoff = lds_byte(wr * 64 + fr, fq * 8), boff = lds_byte(wc * 32 + fr, fq * 8);
    const char* const Abase = (const char*)g.A; const char* const Bbase = (const char*)g.Bt;
#define PG8_SA(b, h) (((b) * 2 + (h)) * HTB)
#define PG8_SB(b, h) ((4 + (b) * 2 + (h)) * HTB)
#define PG8_STAGE(bufoff, gbase, voff) do { _Pragma("unroll") for (int _i = 0; _i < 2; ++_i) \
        __builtin_amdgcn_global_load_lds((const unsigned*)((const char*)(gbase) + (voff)[_i]), (PG8_LAS unsigned*)(lds + (bufoff) + ldsw + _i * 8192), 16, 0, 0); } while (0)
#define PG8_VOFFA(u, v) do { _Pragma("unroll") for (int _h = 0; _h < 2; ++_h) _Pragma("unroll") for (int _i = 0; _i < 2; ++_i) { const int _gr = (u).pm * BM + _h * HALF + Rr[_i]; \
        const int _src = g.rowtab ? g.rowtab[_gr] : _gr; (v)[_h][_i] = (unsigned)_src * lda2 + Cb[_i]; } } while (0)
#define PG8_LDA(dst, b, h) do { _Pragma("unroll") for (int m = 0; m < 4; ++m) _Pragma("unroll") for (int k = 0; k < 2; ++k) dst[m][k] = *(const PG8_LAS bf16x8*)(lds + PG8_SA(b, h) + aoff + m * 2048 + k * 1024); } while (0)
#define PG8_LDB(dst, b, h) do { _Pragma("unroll") for (int n = 0; n < 2; ++n) _Pragma("unroll") for (int k = 0; k < 2; ++k) dst[n][k] = *(const PG8_LAS bf16x8*)(lds + PG8_SB(b, h) + boff + n * 2048 + k * 1024); } while (0)
#define PG8_MMA(ai, bj, At, Bt) do { __builtin_amdgcn_s_setprio(1); \
        if constexpr (ES == 2) { _Pragma("unroll") for (int m = 0; m < 4; ++m) _Pragma("unroll") for (int n = 0; n < 2; ++n) _Pragma("unroll") for (int k = 0; k < 2; ++k) \
            acc[ai][bj][m][n] = __builtin_amdgcn_mfma_f32_16x16x32_bf16(Bt[n][k], At[m][k], acc[ai][bj][m][n], 0, 0, 0); } \
        else { _Pragma("unroll") for (int m = 0; m < 4; ++m) _Pragma("unroll") for (int n = 0; n < 2; ++n) _Pragma("unroll") for (int k = 0; k < 2; ++k) { \
            const i64x2 _a = __builtin_bit_cast(i64x2, At[m][k]), _b = __builtin_bit_cast(i64x2, Bt[n][k]); \
            acc[ai][bj][m][n] = __builtin_amdgcn_mfma_f32_16x16x32_fp8_fp8(_b.x, _a.x, acc[ai][bj][m][n], 0, 0, 0); \
            acc[ai][bj][m][n] = __builtin_amdgcn_mfma_f32_16x16x32_fp8_fp8(_b.y, _a.y, acc[ai][bj][m][n], 0, 0, 0); } } \
        __builtin_amdgcn_s_setprio(0); } while (0)
#define PG8_WAIT_V(n) asm volatile("s_waitcnt vmcnt(" #n ")" ::: "memory")
#define PG8_WAIT_L(n) asm volatile("s_waitcnt lgkmcnt(" #n ")" ::: "memory")
#define PG8_BAR __builtin_amdgcn_s_barrier()
#define PG8_SCHED __builtin_amdgcn_sched_barrier(0)
    Unit cur, nxt; int ui = 0;
    if (!S.next(0, cur)) return;
    f32x4 acc[2][2][4][2];
#pragma unroll
    for (int a = 0; a < 2; ++a)
#pragma unroll
        for (int b = 0; b < 2; ++b)
#pragma unroll
            for (int m = 0; m < 4; ++m)
#pragma unroll
                for (int n = 0; n < 2; ++n) acc[a][b][m][n] = (f32x4){0.f, 0.f, 0.f, 0.f};
    bf16x8 At[4][2], B0[2][2], B1[2][2];
    unsigned cv[2][2], nv[2][2];
    PG8_VOFFA(cur, cv);
#pragma unroll
    for (int h = 0; h < 2; ++h) { nv[h][0] = cv[h][0]; nv[h][1] = cv[h][1]; }
    const char* cB = Bbase + cur.boff;
    PG8_STAGE(PG8_SB(0, 0), cB, voffB); PG8_STAGE(PG8_SB(0, 1), cB + hstepB, voffB); PG8_STAGE(PG8_SA(0, 0), Abase, cv[0]); PG8_STAGE(PG8_SA(0, 1), Abase, cv[1]);
    if (wr == 1) PG8_BAR;
    PG8_WAIT_V(2); PG8_BAR;
    PG8_STAGE(PG8_SB(1, 0), cB + kstep, voffB); PG8_STAGE(PG8_SA(1, 0), Abase + kstep, cv[0]); PG8_STAGE(PG8_SB(1, 1), cB + hstepB + kstep, voffB);
    PG8_WAIT_V(6); PG8_BAR;
    for (;;) {
        const bool has_next = S.next(ui + 1, nxt);
        const char* nB = has_next ? Bbase + nxt.boff : cB;
#pragma unroll 1
        for (int t = 0; t < nt; t += 2) {
            const bool last = (t == nt - 2);
            if constexpr (Epi::MIDK) { if (t == nt / 2) E.mid(acc, cur, wr, wc, fr, fq); }
            if (last && has_next) { PG8_VOFFA(nxt, nv); }
            const char* a1 = Abase + (size_t)(t + 1) * kstep;
            const char* a2 = Abase + (last ? (size_t)0 : (size_t)(t + 2) * kstep); const char* a3 = a2 + kstep;
            const char* b2 = last ? nB : cB + (size_t)(t + 2) * kstep; const char* b3 = b2 + kstep;
            unsigned x0[2], x1[2];
            x0[0] = last ? nv[0][0] : cv[0][0]; x0[1] = last ? nv[0][1] : cv[0][1]; x1[0] = last ? nv[1][0] : cv[1][0]; x1[1] = last ? nv[1][1] : cv[1][1];
            PG8_LDB(B0, 0, 0); PG8_LDB(B1, 0, 1); PG8_SCHED; PG8_LDA(At, 0, 0); PG8_STAGE(PG8_SA(1, 1), a1, cv[1]);
            PG8_WAIT_V(8); PG8_WAIT_L(0); PG8_BAR; PG8_MMA(0, 0, At, B0); PG8_MMA(0, 1, At, B1); PG8_BAR; PG8_SCHED;
            PG8_LDA(At, 0, 1); PG8_STAGE(PG8_SB(0, 0), b2, voffB); PG8_STAGE(PG8_SB(0, 1), b2 + hstepB, voffB); PG8_STAGE(PG8_SA(0, 0), a2, x0);
            PG8_WAIT_V(8); PG8_WAIT_L(0); PG8_BAR; PG8_MMA(1, 0, At, B0); PG8_MMA(1, 1, At, B1); PG8_BAR; PG8_SCHED;
            PG8_LDB(B0, 1, 0); PG8_LDB(B1, 1, 1); PG8_SCHED; PG8_LDA(At, 1, 0); PG8_STAGE(PG8_SA(0, 1), a2, x1);
            PG8_WAIT_V(8); PG8_WAIT_L(0); PG8_BAR; PG8_MMA(0, 0, At, B0); PG8_MMA(0, 1, At, B1); PG8_BAR; PG8_SCHED;
            PG8_LDA(At, 1, 1); PG8_STAGE(PG8_SB(1, 0), b3, voffB); PG8_STAGE(PG8_SB(1, 1), b3 + hstepB, voffB); PG8_STAGE(PG8_SA(1, 0), a3, x0);
            PG8_WAIT_V(8); PG8_WAIT_L(0); PG8_BAR; PG8_MMA(1, 0, At, B0); PG8_MMA(1, 1, At, B1); PG8_BAR; PG8_SCHED;
        }
        if constexpr (ALIGN_EPI) { if (wr == 0) PG8_BAR; }
        E(acc, cur, wr, wc, fr, fq);
        if (!has_next) break;
#pragma unroll
        for (int a = 0; a < 2; ++a)
#pragma unroll
            for (int b = 0; b < 2; ++b)
#pragma unroll
                for (int m = 0; m < 4; ++m)
#pragma unroll
                    for (int n = 0; n < 2; ++n) acc[a][b][m][n] = (f32x4){0.f, 0.f, 0.f, 0.f};
        cur = nxt; cB = nB; ++ui;
#pragma unroll
        for (int h = 0; h < 2; ++h) { cv[h][0] = nv[h][0]; cv[h][1] = nv[h][1]; }
        if constexpr (ALIGN_EPI) { if (wr == 1) PG8_BAR; }
    }
    PG8_WAIT_V(0);
    if constexpr (!ALIGN_EPI) { if (wr == 0) PG8_BAR; }
    PG8_BAR;
#undef PG8_SA
#undef PG8_SB
#undef PG8_STAGE
#undef PG8_VOFFA
#undef PG8_LDA
#undef PG8_LDB
#undef PG8_MMA
#undef PG8_WAIT_V
#undef PG8_WAIT_L
#undef PG8_BAR
#undef PG8_SCHED
}
}
__device__ __forceinline__ void conv_tile(const float* __restrict__ src, int ldn, int k0, int n0, const float* __restrict__ kscale, int kfrom,
                                          bf16_t* __restrict__ dst, int dld, int drow0, LAS unsigned* T, int lane, int dk0 = -1) {
    if (dk0 < 0) dk0 = k0;
    const int c4 = lane & 15, kq = lane >> 4;
    f32x4 v0[8], v1[8];
#pragma unroll
    for (int j = 0; j < 8; ++j) { const int kp = kq + 4 * j; const float* p = src + (size_t)(k0 + 2 * kp) * ldn + n0 + c4 * 4;
        v0[j] = *(const f32x4*)p; v1[j] = *(const f32x4*)(p + ldn); }
#pragma unroll
    for (int j = 0; j < 8; ++j) { const int kp = kq + 4 * j; const int k = k0 + 2 * kp;
        float s0 = 1.f, s1 = 1.f; if (kscale && k >= kfrom) { s0 = kscale[k - kfrom]; s1 = kscale[k + 1 - kfrom]; }
#pragma unroll
        for (int q = 0; q < 4; ++q) T[(c4 * 4 + q) * 33 + kp] = pk2(v0[j][q] * s0, v1[j][q] * s1); }
    asm volatile("s_waitcnt lgkmcnt(0)" ::: "memory"); __builtin_amdgcn_wave_barrier();
    const int ch = lane & 7, nr = lane >> 3;
#pragma unroll
    for (int ps = 0; ps < 8; ++ps) { const int n = ps * 8 + nr; const LAS unsigned* t = T + n * 33 + ch * 4;
        v4u o; o.x = t[0]; o.y = t[1]; o.z = t[2]; o.w = t[3];
        *(v4u*)(dst + (size_t)(drow0 + n) * dld + dk0 + ch * 8) = o; }
    asm volatile("s_waitcnt lgkmcnt(0)" ::: "memory"); __builtin_amdgcn_wave_barrier();
}

__device__ __forceinline__ void conv_tile128(const float* __restrict__ src, int ldn, int k0, int n0, bf16_t* __restrict__ dst, int dld, int drow0, LAS unsigned* T, int lane) {
    const int c4 = lane & 15, kq = lane >> 4;
    f32x4 v0[16], v1[16];
#pragma unroll
    for (int j = 0; j < 16; ++j) { const int kp = kq + 4 * j; const float* q = src + (size_t)(k0 + 2 * kp) * ldn + n0 + c4 * 4;
        v0[j] = __builtin_nontemporal_load((const f32x4*)q); v1[j] = __builtin_nontemporal_load((const f32x4*)(q + ldn)); }
#pragma unroll
    for (int j = 0; j < 16; ++j) { const int kp = kq + 4 * j;
#pragma unroll
        for (int q = 0; q < 4; ++q) T[(c4 * 4 + q) * 65 + kp] = pk2(v0[j][q], v1[j][q]); }
    asm volatile("s_waitcnt lgkmcnt(0)" ::: "memory"); __builtin_amdgcn_wave_barrier();
    const int ch = lane & 15, nr = lane >> 4;
#pragma unroll
    for (int ps = 0; ps < 16; ++ps) { const int n = ps * 4 + nr; const LAS unsigned* t = T + n * 65 + ch * 4;
        v4u o; o.x = t[0]; o.y = t[1]; o.z = t[2]; o.w = t[3];
        __builtin_nontemporal_store(o, (v4u*)(dst + (size_t)(drow0 + n) * dld + k0 + ch * 8)); }
    asm volatile("s_waitcnt lgkmcnt(0)" ::: "memory"); __builtin_amdgcn_wave_barrier();
}

__device__ __forceinline__ unsigned pk4_fp8(float a, float b, float c, float d) {
    int w = 0; w = __builtin_amdgcn_cvt_pk_fp8_f32(__builtin_amdgcn_fmed3f(a, -448.f, 448.f), __builtin_amdgcn_fmed3f(b, -448.f, 448.f), w, false);
    w = __builtin_amdgcn_cvt_pk_fp8_f32(__builtin_amdgcn_fmed3f(c, -448.f, 448.f), __builtin_amdgcn_fmed3f(d, -448.f, 448.f), w, true); return (unsigned)w; }
__device__ __forceinline__ void conv_tile128_fp8(const float* __restrict__ src, int ldn, int k0, int n0, unsigned char* __restrict__ dst, int dld, int drow0, LAS unsigned* T, int lane) {
    const int c4 = lane & 15, kq = lane >> 4;
#pragma unroll 1
    for (int hf = 0; hf < 2; ++hf) {
        f32x4 v[8][4];
#pragma unroll
        for (int j = 0; j < 8; ++j) { const float* q = src + (size_t)(k0 + hf * 128 + 4 * (kq + 4 * j)) * ldn + n0 + c4 * 4;
#pragma unroll
            for (int r = 0; r < 4; ++r) v[j][r] = __builtin_nontemporal_load((const f32x4*)(q + (size_t)r * ldn)); }
#pragma unroll
        for (int j = 0; j < 8; ++j) { const int kp = hf * 32 + kq + 4 * j;
#pragma unroll
            for (int q = 0; q < 4; ++q) T[(c4 * 4 + q) * 65 + kp] = pk4_fp8(v[j][0][q] * 64.f, v[j][1][q] * 64.f, v[j][2][q] * 64.f, v[j][3][q] * 64.f); }
    }
    asm volatile("s_waitcnt lgkmcnt(0)" ::: "memory"); __builtin_amdgcn_wave_barrier();
    const int ch = lane & 15, nr = lane >> 4;
#pragma unroll
    for (int ps = 0; ps < 16; ++ps) { const int n = ps * 4 + nr; const LAS unsigned* t = T + n * 65 + ch * 4;
        v4u o; o.x = t[0]; o.y = t[1]; o.z = t[2]; o.w = t[3];
        __builtin_nontemporal_store(o, (v4u*)(dst + (size_t)(drow0 + n) * dld + k0 + ch * 16)); }
    asm volatile("s_waitcnt lgkmcnt(0)" ::: "memory"); __builtin_amdgcn_wave_barrier();
}

__device__ __forceinline__ void ada_item(const float* __restrict__ c, const float* __restrict__ w, float* __restrict__ modp, int item, int lane) {
    const int cc = item % 48, ks = item / 48, col = cc * 256 + lane * 4;
    f32x4 acc[4];
#pragma unroll
    for (int b = 0; b < 4; ++b) acc[b] = (f32x4){0.f, 0.f, 0.f, 0.f};
#pragma unroll 1
    for (int half = 0; half < 2; ++half) {
        const int k0 = ks * 128 + half * 64;
        float cd[4];
#pragma unroll
        for (int b = 0; b < 4; ++b) cd[b] = siluf_(c[b * DM + k0 + lane]);
        const float* wp = w + (size_t)k0 * MODW + col;
#pragma unroll 16
        for (int kk = 0; kk < 64; ++kk) { const f32x4 wv = __builtin_nontemporal_load((const f32x4*)(wp + (size_t)kk * MODW));
#pragma unroll
            for (int b = 0; b < 4; ++b) { const float s = __builtin_bit_cast(float, __builtin_amdgcn_readlane(__builtin_bit_cast(int, cd[b]), kk)); acc[b] += wv * s; } }
    }
#pragma unroll
    for (int b = 0; b < 4; ++b) *(f32x4*)(modp + ((size_t)ks * 4 + b) * MODW + col) = acc[b];
}

constexpr int CT_ADA = 48 * 16;
constexpr int CT_IN = 32 * 77, CT_UQ = 8 * 24, CT_KV = 4 * 32, CT_OUT = 32 * 32, CT_G1 = 8 * 8, CT_D1 = 2 * 32;
constexpr int CT_ZERO = 192 * 4;
constexpr int CT_GU = 65 * 2 * CT_G1, CT_DN = 65 * CT_D1;
constexpr int CT_GU_LATE = 0;
constexpr int CT_TOTAL0 = CT_ADA + CT_IN + CT_UQ + CT_KV + CT_OUT + CT_ZERO + (CT_GU - CT_GU_LATE) + CT_DN;
constexpr int CW_QGU = 8192, CW_QDN = 8192 + 512;

__device__ __forceinline__ void conv_gu_tile(const Params& p, int r, LAS unsigned* T, int lane) {
    const int e = r / (2 * CT_G1); int q = r % (2 * CT_G1);
    unsigned char* gu = p.ws + WS_BT_GU + (size_t)e * 1024 * DM;
    const int up = q >= CT_G1; q -= up * CT_G1; const int kb = q / 8, nb = q % 8, n0 = nb * 64;
    const float* src = (e < 64) ? p.in[up ? 21 : 20] + (size_t)e * DM * DE : p.in[up ? 24 : 23];
    conv_tile128_fp8(src, DE, kb * 256, n0, gu, DM, (n0 >> 7) * 256 + up * 128 + (n0 & 127), T, lane);
}
__device__ __forceinline__ void conv_dn_tile(const Params& p, int r, LAS unsigned* T, int lane) {
    const int e = r / CT_D1, q = r % CT_D1, kb = q / 32, nb = q % 32;
    unsigned char* dn = p.ws + WS_BT_DN + (size_t)e * DM * DE;
    const float* src = (e < 64) ? p.in[22] + (size_t)e * DE * DM : p.in[25];
    conv_tile128_fp8(src, DM, kb * 256, nb * 64, dn, DE, nb * 64, T, lane);
}
template <bool DN>
__device__ __forceinline__ void conv_queue(const Params& p, LAS unsigned char* lds, int wave, int lane, int first, int total) {
    LAS unsigned* T = (LAS unsigned*)(lds + wave * 18432);
    unsigned* heads = (unsigned*)(p.ws + WS_CTL) + (DN ? CW_QDN : CW_QGU);
    const int n = total - first, per = (n + 7) / 8, xcd = (int)xb_xcc_id() & 7;
    for (int s = 0; s < 8; ++s) {
        const int sh = (xcd + s) & 7, lo = first + sh * per, hi = (lo + per < total) ? lo + per : total;
        for (;;) {
            unsigned i = 0; if (lane == 0) i = __hip_atomic_fetch_add(heads + 64 * sh, 2u, __ATOMIC_RELAXED, __HIP_MEMORY_SCOPE_AGENT);
            const int r = lo + (int)__builtin_amdgcn_readfirstlane(i);
            if (r >= hi) break;
            if (DN) conv_dn_tile(p, r, T, lane); else conv_gu_tile(p, r, T, lane);
            if (r + 1 < hi) { if (DN) conv_dn_tile(p, r + 1, T, lane); else conv_gu_tile(p, r + 1, T, lane); }
        }
    }
}

struct ETile { const float* src; unsigned char* dst; int ldn, dld; };
__device__ __forceinline__ ETile etile_decode(const Params& p, int r) {
    ETile t;
    if (r < CT_GU) { const int e = r / (2 * CT_G1); int q = r % (2 * CT_G1); const int up = q >= CT_G1; q -= up * CT_G1; const int kb = q / 8, nb = q % 8, n0 = nb * 64;
        t.src = ((e < 64) ? p.in[up ? 21 : 20] + (size_t)e * DM * DE : p.in[up ? 24 : 23]) + (size_t)(kb * 256) * DE + n0; t.ldn = DE;
        t.dst = p.ws + WS_BT_GU + (size_t)e * 1024 * DM + (size_t)((n0 >> 7) * 256 + up * 128 + (n0 & 127)) * DM + kb * 256; t.dld = DM; }
    else { const int rr = r - CT_GU; const int e = rr / CT_D1, q = rr % CT_D1, kb = q / 32, nb = q % 32;
        t.src = ((e < 64) ? p.in[22] + (size_t)e * DE * DM : p.in[25]) + (size_t)(kb * 256) * DM + nb * 64; t.ldn = DM;
        t.dst = p.ws + WS_BT_DN + (size_t)e * DM * DE + (size_t)(nb * 64) * DE + kb * 256; t.dld = DE; }
    return t;
}
constexpr int CT_EXP_LATE2 = 2048, CT_EXP_LATE3 = 512;
__device__ __forceinline__ int p2_first_idle(int G) { const int nunits = (NT / 256) * (INCP / 256), rounds = (nunits + G - 1) / G; return nunits - (rounds - 1) * G; }
__device__ __forceinline__ int exp_late2(int G) { return (p2_first_idle(G) < G && (G - p2_first_idle(G)) * NWAVES * 2 >= CT_EXP_LATE2) ? CT_EXP_LATE2 : 0; }
__device__ __forceinline__ int exp_late3(int G) { return (G == 256) ? CT_EXP_LATE3 : 0; }
__device__ __forceinline__ void expert_stream(const Params& p, LAS unsigned* T, int gw, int NGW, int lane, int NEXP) {
    int r = gw; if (r >= NEXP) return;
    const int c4 = lane & 15, kq = lane >> 4, ch = lane & 15, nr = lane >> 4;
    ETile cur = etile_decode(p, r);
    f32x4 A[16], B[16];
#define ES_LOADQ(R, t, qd) do { _Pragma("unroll") for (int j = 0; j < 4; ++j) { const float* q_ = (t).src + (size_t)((qd) * 64 + 4 * (kq + 4 * j)) * (t).ldn + c4 * 4; \
        _Pragma("unroll") for (int rr = 0; rr < 4; ++rr) R[j * 4 + rr] = __builtin_nontemporal_load((const f32x4*)(q_ + (size_t)rr * (t).ldn)); } } while (0)
#define ES_CONVQ(R, qd) do { _Pragma("unroll") for (int j = 0; j < 4; ++j) { const int kp = (qd) * 16 + kq + 4 * j; \
        _Pragma("unroll") for (int q = 0; q < 4; ++q) T[(c4 * 4 + q) * 65 + kp] = pk4_fp8(R[j * 4 + 0][q] * 64.f, R[j * 4 + 1][q] * 64.f, R[j * 4 + 2][q] * 64.f, R[j * 4 + 3][q] * 64.f); } } while (0)
    ES_LOADQ(A, cur, 0);
    for (;;) {
        const int rn = r + NGW; const bool hn = rn < NEXP; const ETile nxt = hn ? etile_decode(p, rn) : cur;
        ES_LOADQ(B, cur, 1); ES_CONVQ(A, 0);
        ES_LOADQ(A, cur, 2); ES_CONVQ(B, 1);
        ES_LOADQ(B, cur, 3); ES_CONVQ(A, 2);
        if (hn) ES_LOADQ(A, nxt, 0);
        ES_CONVQ(B, 3);
        asm volatile("s_waitcnt lgkmcnt(0)" ::: "memory"); __builtin_amdgcn_wave_barrier();
#pragma unroll
        for (int ps = 0; ps < 16; ++ps) { const int n = ps * 4 + nr; const LAS unsigned* t = T + n * 65 + ch * 4;
            v4u o; o.x = t[0]; o.y = t[1]; o.z = t[2]; o.w = t[3];
            __builtin_nontemporal_store(o, (v4u*)(cur.dst + (size_t)n * cur.dld + ch * 16)); }
        asm volatile("s_waitcnt lgkmcnt(0)" ::: "memory"); __builtin_amdgcn_wave_barrier();
        if (!hn) break;
        cur = nxt; r = rn;
    }
#undef ES_LOADQ
#undef ES_CONVQ
}

constexpr int CT_SMALL = CT_IN + CT_UQ + CT_KV + CT_OUT + CT_ZERO;
__device__ __forceinline__ void phase0(const Params& p, LAS unsigned char* lds, int wave, int lane) {
    LAS unsigned* T = (LAS unsigned*)(lds + wave * 18432);
    unsigned char* ws = p.ws;
    float* modp = (float*)(ws + WS_MODP);
    const int gw = blockIdx.x * NWAVES + wave, NGW = gridDim.x * NWAVES;
    for (int it = gw; it < CT_ADA; it += NGW) ada_item(p.in[1], p.in[3], modp, it, lane);
    expert_stream(p, T, (gw + NGW - (CT_ADA % NGW)) % NGW, NGW, lane, CT_GU + CT_DN - exp_late2(gridDim.x) - exp_late3(gridDim.x));
    for (int it = gw; it < CT_SMALL; it += NGW) {
        int r = it;
        if (r < CT_IN) { const int kb = r / 77, nb = r % 77; conv_tile(p.in[7], INC, kb * 64, nb * 64, nullptr, 0, (bf16_t*)(ws + WS_BT_IN), DM, nb * 64, T, lane); continue; } r -= CT_IN;
        if (r < CT_UQ) { const int kb = r / 24, nb = r % 24; conv_tile(p.in[11], 1536, kb * 64, nb * 64, p.in[10], 0, (bf16_t*)(ws + WS_BT_UQ), QR, nb * 64, T, lane); continue; } r -= CT_UQ;
        if (r < CT_KV) { const int kb = r / 32, nb = r % 32, n0 = nb * 64, h = n0 >> 8, j0 = n0 & 255; const int dr = (j0 < 128) ? h * 128 + j0 : 1024 + h * 128 + (j0 - 128);
                         conv_tile(p.in[13], 2048, kb * 64, n0, p.in[12], 0, (bf16_t*)(ws + WS_BT_KV), KVR, dr, T, lane); continue; } r -= CT_KV;
        if (r < CT_OUT) { const int kb = r / 32, nb = r % 32; conv_tile(p.in[17], DM, kb * 64, nb * 64, p.in[16], 1024, (bf16_t*)(ws + WS_BT_OUT), DM, nb * 64, T, lane, (kb * 64 + 1024) & 2047); continue; } r -= CT_OUT;
        { const int row = INC + (r >> 2), pc = r & 3; v4u z = {0u, 0u, 0u, 0u}; *(v4u*)((bf16_t*)(ws + WS_BT_IN) + (size_t)row * DM + pc * 512 + lane * 8) = z; }
    }
}

__device__ __forceinline__ void norm_mod_row(const float* __restrict__ hrow, const float* __restrict__ g, const float* __restrict__ sc, const float* __restrict__ sh, bf16_t* __restrict__ urow, int lane) {
    f32x4 v[8]; float s = 0.f;
#pragma unroll
    for (int j = 0; j < 8; ++j) { v[j] = *(const f32x4*)(hrow + lane * 4 + 256 * j); s += (v[j].x * v[j].x + v[j].y * v[j].y) + (v[j].z * v[j].z + v[j].w * v[j].w); }
    const float r = rsqrtf(wave_sum(s) * (1.f / DM) + EPS);
#pragma unroll
    for (int j = 0; j < 8; ++j) { const int col = lane * 4 + 256 * j; const f32x4 gv = *(const f32x4*)(g + col), sv = *(const f32x4*)(sc + col), hv = *(const f32x4*)(sh + col);
        const f32x4 o = v[j] * r * gv * (sv + 1.f) + hv; v2u w; w.x = pk2(o.x, o.y); w.y = pk2(o.z, o.w); *(v2u*)(urow + col) = w; }
}
__device__ __forceinline__ f32x4 mod_reduce4(const float* __restrict__ modp, const float* __restrict__ bias, int v) {
    f32x4 t[16];
#pragma unroll
    for (int ks = 0; ks < 16; ++ks) t[ks] = *(const f32x4*)(modp + (size_t)ks * 4 * MODW + v);
    f32x4 s = *(const f32x4*)(bias + v % MODW);
#pragma unroll
    for (int ks = 0; ks < 16; ++ks) s += t[ks];
    return s;
}
__device__ __forceinline__ void phase1(const Params& p, LAS unsigned char* lds, int wave, int lane) {
    const float* modp = (const float*)(p.ws + WS_MODP); float* mod = (float*)(p.ws + CTL_MOD); bf16_t* u16 = (bf16_t*)(p.ws + WS_U16);
    LAS float* sm = (LAS float*)lds;
    const int G = gridDim.x;
    for (int v4 = blockIdx.x * NTHR + threadIdx.x; v4 < NB * MODW / 4; v4 += G * NTHR) *(f32x4*)(mod + v4 * 4) = mod_reduce4(modp, p.in[4], v4 * 4);
    for (int tb = blockIdx.x; tb < NT / 32; tb += G) {
        const int b = (tb * 32) / SEQ;
        f32x4 v[8];
        { const float* hrow = p.in[0] + (size_t)(tb * 32 + wave * 4) * DM;
#pragma unroll
          for (int j = 0; j < 8; ++j) v[j] = __builtin_nontemporal_load((const f32x4*)(hrow + lane * 4 + 256 * j)); }
        __syncthreads();
        for (int i4 = threadIdx.x; i4 < 2 * DM / 4; i4 += NTHR) *(LAS f32x4*)(sm + i4 * 4) = mod_reduce4(modp, p.in[4], b * MODW + i4 * 4);
        __syncthreads();
#pragma unroll 1
        for (int rr = 0; rr < 4; ++rr) { const int t = tb * 32 + wave * 4 + rr; const float* g = p.in[5];
            f32x4 vn[8];
            if (rr < 3) { const float* hrow = p.in[0] + (size_t)(t + 1) * DM;
#pragma unroll
                for (int j = 0; j < 8; ++j) vn[j] = __builtin_nontemporal_load((const f32x4*)(hrow + lane * 4 + 256 * j)); }
            float s = 0.f;
#pragma unroll
            for (int j = 0; j < 8; ++j) s += (v[j].x * v[j].x + v[j].y * v[j].y) + (v[j].z * v[j].z + v[j].w * v[j].w);
            const float r = rsqrtf(wave_sum(s) * (1.f / DM) + EPS);
#pragma unroll
            for (int j = 0; j < 8; ++j) { const int col = lane * 4 + 256 * j; const f32x4 gv = *(const f32x4*)(g + col);
                const f32x4 hv = *(const LAS f32x4*)(sm + col), sv = *(const LAS f32x4*)(sm + DM + col);
                const f32x4 o = v[j] * r * gv * (sv + 1.f) + hv; v2u w; w.x = pk2(o.x, o.y); w.y = pk2(o.z, o.w); *(v2u*)(u16 + (size_t)t * DM + col) = w; }
            if (rr < 3) {
#pragma unroll
                for (int j = 0; j < 8; ++j) v[j] = vn[j]; }
        }
    }
}

struct EpiInProj { static constexpr bool PERM = true, MIDK = false; bf16_t* O; float* ssq_q8; float* ssq_kv4;
    __device__ __forceinline__ void operator()(const pg8::f32x4 (&acc)[2][2][4][2], const pg8::Unit& u, int wr, int wc, int fr, int fq) const {
        const int row0 = u.pm * 256 + wr * 64 + fr, col0 = u.pn * 256 + wc * 32 + 8 * fq;
        const bool sq = (u.pn >= 16 && u.pn <= 18);
#pragma unroll
        for (int ai = 0; ai < 2; ++ai)
#pragma unroll
            for (int m = 0; m < 4; ++m) { if (!(u.mask & (3 << (ai * 2)))) continue; const int row = row0 + ai * 128 + m * 16; bf16_t* rowp = O + (size_t)row * INCP + col0; float ss = 0.f;
#pragma unroll
                for (int bj = 0; bj < 2; ++bj) { const pg8::f32x4 v0 = acc[ai][bj][m][0], v1 = acc[ai][bj][m][1];
                    v4u w; w.x = pk2(v0[0], v0[1]); w.y = pk2(v0[2], v0[3]); w.z = pk2(v1[0], v1[1]); w.w = pk2(v1[2], v1[3]);
                    *(v4u*)(rowp + bj * 128) = w;
                    ss += (v0[0] * v0[0] + v0[1] * v0[1]) + (v0[2] * v0[2] + v0[3] * v0[3]) + (v1[0] * v1[0] + v1[1] * v1[1]) + (v1[2] * v1[2] + v1[3] * v1[3]); }
                if (sq) { ss += __shfl_xor(ss, 16); ss += __shfl_xor(ss, 32);
                    if (fq == 0) { if (u.pn == 18) ssq_kv4[row * 4 + wc] = ss; else ssq_q8[row * 8 + (u.pn - 16) * 4 + wc] = ss; } } }
    }
};
__device__ __forceinline__ void phase2(const Params& p, LAS unsigned char* lds) {
    unsigned char* ws = p.ws;
    pg8::Gemm g{(const bf16_t*)(ws + WS_U16), (const bf16_t*)(ws + WS_BT_IN), nullptr, DM, DM, DM, 0};
    pg8::StaticOrder S; S.init(NT / 256, INCP / 256, gridDim.x, blockIdx.x, DM);
    EpiInProj E{(bf16_t*)(ws + WS_PROJ), (float*)(ws + TAB_SSQ_Q8), (float*)(ws + TAB_SSQ_KV4)};
    pg8::gemm_phase<EpiInProj, pg8::StaticOrder>((PG8_LAS unsigned char*)lds, g, S, E);
    { const int G = gridDim.x, firstidle = p2_first_idle(G), l2 = exp_late2(G);
      if (l2 > 0 && (int)blockIdx.x >= firstidle) { const int wave = __builtin_amdgcn_readfirstlane(threadIdx.x >> 6), j = ((int)blockIdx.x - firstidle) * NWAVES + wave, nw = (G - firstidle) * NWAVES;
          const int base = CT_GU + CT_DN - l2;
          for (int r = base + j; r < CT_GU + CT_DN; r += nw) expert_stream(p, (LAS unsigned*)(lds + wave * 18432), r, 1 << 30, threadIdx.x & 63, CT_GU + CT_DN); } }
}
struct EpiBf16Store { static constexpr bool PERM = true, MIDK = false; bf16_t* O; int ldc, pad;
    __device__ __forceinline__ void operator()(const pg8::f32x4 (&acc)[2][2][4][2], const pg8::Unit& u, int wr, int wc, int fr, int fq) const {
        const int row0 = u.pm * 256 + wr * 64 + fr, col0 = u.pn * 256 + wc * 32 + 8 * fq;
#pragma unroll
        for (int ai = 0; ai < 2; ++ai)
#pragma unroll
            for (int m = 0; m < 4; ++m) { if (!(u.mask & (3 << (ai * 2)))) continue; bf16_t* rowp = O + (size_t)(row0 + ai * 128 + m * 16) * ldc + col0;
#pragma unroll
                for (int bj = 0; bj < 2; ++bj) { const pg8::f32x4 v0 = acc[ai][bj][m][0], v1 = acc[ai][bj][m][1];
                    v4u w; w.x = pk2(v0[0], v0[1]); w.y = pk2(v0[2], v0[3]); w.z = pk2(v1[0], v1[1]); w.w = pk2(v1[2], v1[3]); *(v4u*)(rowp + bj * 128) = w; } }
    }
};
struct EpiVt { static constexpr bool PERM = true, MIDK = false; bf16_t* Vt; const float* ssq_kv4;
    __device__ __forceinline__ void operator()(const pg8::f32x4 (&acc)[2][2][4][2], const pg8::Unit& u, int wr, int wc, int fr, int fq) const {
        const int row0 = u.pm * 256 + wr * 64 + fr, col0 = u.pn * 256 + wc * 32 + 8 * fq;
        const int pb = (col0 & ~15) + 4 * (fq & 1);
#pragma unroll
        for (int bj = 0; bj < 2; ++bj) {
            float rs[8];
#pragma unroll
            for (int j = 0; j < 8; ++j) { const pg8::f32x4 s4 = *(const pg8::f32x4*)(ssq_kv4 + (size_t)(col0 + bj * 128 + j) * 4); rs[j] = rsqrtf(((s4[0] + s4[1]) + (s4[2] + s4[3])) * (1.f / KVR) + EPS); }
#pragma unroll
            for (int ai = 0; ai < 2; ++ai)
#pragma unroll
                for (int m = 0; m < 4; ++m) { if (!(u.mask & (1 << (ai * 2 + bj)))) continue; bf16_t* rowp = Vt + (size_t)(row0 + ai * 128 + m * 16) * NT + pb + bj * 128;
                    const pg8::f32x4 v0 = acc[ai][bj][m][0], v1 = acc[ai][bj][m][1];
                    v2u a, b; a.x = pk2(v0[0] * rs[0], v0[1] * rs[1]); a.y = pk2(v0[2] * rs[2], v0[3] * rs[3]);
                    b.x = pk2(v1[0] * rs[4], v1[1] * rs[5]); b.y = pk2(v1[2] * rs[6], v1[3] * rs[7]);
                    *(v2u*)(rowp) = a; *(v2u*)(rowp + 8) = b; }
        }
    }
};
__device__ __forceinline__ void phase3_gemms(const Params& p, LAS unsigned char* lds) {
    unsigned char* ws = p.ws; const int G = gridDim.x, c = blockIdx.x;
    const bf16_t* proj = (const bf16_t*)(ws + WS_PROJ);
    { pg8::Gemm g{proj + 4096, (const bf16_t*)(ws + WS_BT_UQ), nullptr, INCP, QR, QR, 0};
      pg8::StaticOrder S; S.init(NT / 256, 6, G, c, QR); EpiBf16Store E{(bf16_t*)(ws + WS_QRAW), 1536, 0};
      pg8::gemm_phase<EpiBf16Store, pg8::StaticOrder>((PG8_LAS unsigned char*)lds, g, S, E); }
    { pg8::Gemm g{proj + 4608, (const bf16_t*)(ws + WS_BT_KV), nullptr, INCP, KVR, KVR, 0};
      pg8::StaticOrder S; S.init(NT / 256, 4, G, (c + 64) % G, KVR); EpiBf16Store E{(bf16_t*)(ws + WS_KRAW), 1024, 0};
      pg8::gemm_phase<EpiBf16Store, pg8::StaticOrder>((PG8_LAS unsigned char*)lds, g, S, E); }
    { pg8::Gemm g{(const bf16_t*)(ws + WS_BT_KV) + 1024 * KVR, proj + 4608, nullptr, KVR, INCP, KVR, 0};
      pg8::StaticOrder S; S.init(4, NT / 256, G, (c + 192) % G, INCP); EpiVt E{(bf16_t*)(ws + WS_VT), (const float*)(ws + TAB_SSQ_KV4)};
      pg8::gemm_phase<EpiVt, pg8::StaticOrder>((PG8_LAS unsigned char*)lds, g, S, E); }
    if (exp_late3(G) > 0 && c >= 192) { const int wave = __builtin_amdgcn_readfirstlane(threadIdx.x >> 6), j = (c - 192) * NWAVES + wave, base = CT_GU + CT_DN - exp_late2(G) - exp_late3(G);
        for (int r = base + j; r < base + CT_EXP_LATE3; r += 64 * NWAVES) expert_stream(p, (LAS unsigned*)(lds + wave * 18432), r, 1 << 30, threadIdx.x & 63, CT_GU + CT_DN); }
}

constexpr float QSCALE = 0.07216878364870323f * 1.4426950408889634f;
__device__ __forceinline__ void phase4_qk(const Params& p, int wave, int lane) {
    unsigned char* ws = p.ws;
    const bf16_t* qraw = (const bf16_t*)(ws + WS_QRAW); const bf16_t* kraw = (const bf16_t*)(ws + WS_KRAW); const bf16_t* proj = (const bf16_t*)(ws + WS_PROJ);
    const float* ssq_q8 = (const float*)(ws + TAB_SSQ_Q8); const float* ssq_kv4 = (const float*)(ws + TAB_SSQ_KV4);
    const int* pos = (const int*)p.in[2]; const float* qg = p.in[14]; const float* kg = p.in[15];
    bf16_t* Q16 = (bf16_t*)(ws + WS_Q16); bf16_t* K16 = (bf16_t*)(ws + WS_K16);
    const float g0q = qg[lane], g1q = qg[64 + lane], g2q = qg[128 + lane], g0k = kg[lane], g1k = kg[64 + lane], g2k = kg[128 + lane];
    const int i = lane & 31; const float inv = exp2f(-(float)i * (13.287712379549449f / 32.f));
    const int gw = blockIdx.x * NWAVES + wave, NGW = gridDim.x * NWAVES;
    for (int it0 = gw; it0 < NT * MH; it0 += 2 * NGW) {
        float q0[2], q1[2], q2[2], k0[2], k1[2], k2[2], rq[2], rkv[2], ps[2];
#pragma unroll
        for (int u = 0; u < 2; ++u) { const int it = it0 + u * NGW; const int t = it >> 3, h = it & 7;
            const pg8::f32x4 qa = *(const pg8::f32x4*)(ssq_q8 + (size_t)t * 8), qb = *(const pg8::f32x4*)(ssq_q8 + (size_t)t * 8 + 4), ka = *(const pg8::f32x4*)(ssq_kv4 + (size_t)t * 4);
            rq[u] = rsqrtf((((qa[0] + qa[1]) + (qa[2] + qa[3])) + ((qb[0] + qb[1]) + (qb[2] + qb[3]))) * (1.f / QR) + EPS); rkv[u] = rsqrtf(((ka[0] + ka[1]) + (ka[2] + ka[3])) * (1.f / KVR) + EPS);
            q0[u] = bf2f(qraw[(size_t)t * 1536 + h * 192 + lane]); q1[u] = bf2f(qraw[(size_t)t * 1536 + h * 192 + 64 + lane]); q2[u] = bf2f(qraw[(size_t)t * 1536 + h * 192 + 128 + lane]);
            k0[u] = bf2f(kraw[(size_t)t * 1024 + h * 128 + lane]); k1[u] = bf2f(kraw[(size_t)t * 1024 + h * 128 + 64 + lane]); k2[u] = bf2f(proj[(size_t)t * INCP + 4864 + lane]); ps[u] = (float)pos[t]; }
#pragma unroll
        for (int u = 0; u < 2; ++u) { const int it = it0 + u * NGW; const int t = it >> 3, h = it & 7, b = t / SEQ, s = t % SEQ;
            float a0 = q0[u] * rq[u], a1 = q1[u] * rq[u], a2 = q2[u] * rq[u], c0 = k0[u] * rkv[u], c1 = k1[u] * rkv[u], c2 = k2[u];
            const float sq = wave_sum(a0 * a0 + a1 * a1 + a2 * a2), sk = wave_sum(c0 * c0 + c1 * c1 + c2 * c2);
            const float nq = rsqrtf(sq * (1.f / 192.f) + EPS) * QSCALE, nk = rsqrtf(sk * (1.f / 192.f) + EPS);
            a0 *= nq * g0q; a1 *= nq * g1q; a2 *= nq * g2q; c0 *= nk * g0k; c1 *= nk * g1k; c2 *= nk * g2k;
            const float ang = ps[u] * inv; const float rev = ang * 0.15915494309189535f; const float fr_ = rev - floorf(rev); const float sn = __builtin_amdgcn_sinf(fr_), cs = __builtin_amdgcn_cosf(fr_);
            const float a2o = __shfl_xor(a2, 32), c2o = __shfl_xor(c2, 32);
            const float a2r = lane < 32 ? a2 * cs - a2o * sn : a2 * cs + a2o * sn;
            const float c2r = lane < 32 ? c2 * cs - c2o * sn : c2 * cs + c2o * sn;
            const size_t base = ((size_t)(b * MH + h) * SEQ + s) * QKD;
            Q16[base + lane] = (bf16_t)f2bf(a0); Q16[base + 64 + lane] = (bf16_t)f2bf(a1); Q16[base + 128 + lane] = (bf16_t)f2bf(a2r);
            K16[base + lane] = (bf16_t)f2bf(c0); K16[base + 64 + lane] = (bf16_t)f2bf(c1); K16[base + 128 + lane] = (bf16_t)f2bf(c2r); }
    }
}

typedef short bf16x8 __attribute__((ext_vector_type(8)));
typedef float f32x16 __attribute__((ext_vector_type(16)));
constexpr int AT_KP = 400, AT_VP = 144, AT_KB = 64 * AT_KP, AT_VB = 128 * AT_VP, AT_BUF = AT_KB + AT_VB;
__device__ __forceinline__ void phase5_attn(const Params& p, LAS unsigned char* lds, int wave, int lane) {
    unsigned char* ws = p.ws;
    const bf16_t* Q16 = (const bf16_t*)(ws + WS_Q16); const bf16_t* K16 = (const bf16_t*)(ws + WS_K16); const bf16_t* Vt = (const bf16_t*)(ws + WS_VT);
    bf16_t* merged = (bf16_t*)(ws + WS_MERGED); float* ssq_o8 = (float*)(ws + TAB_SSQ_O8);
    const int tid = threadIdx.x, cl = lane & 31, hh = lane >> 5, qsub = wave & 3, kpar = wave >> 2;
    float mq = 0.f, mk = 0.f;
    for (int i = 0; i < 3; ++i) { mq = fmaxf(mq, fabsf(p.in[14][lane + 64 * i])); mk = fmaxf(mk, fabsf(p.in[15][lane + 64 * i])); }
#pragma unroll
    for (int o = 1; o < 64; o <<= 1) { mq = fmaxf(mq, __shfl_xor(mq, o)); mk = fmaxf(mk, __shfl_xor(mk, o)); }
    const float negc0 = -(13.856406460551018f * 1.4426950408889634f * 1.02f) * mq * mk;
    int kso[3], vso[2]; size_t vgo[2];
#pragma unroll
    for (int i = 0; i < 3; ++i) { const int c = tid + 512 * i; kso[i] = (c / 24) * AT_KP + (c % 24) * 16; }
#pragma unroll
    for (int i = 0; i < 2; ++i) { const int c = tid + 512 * i, dv = c >> 3, ch = c & 7; vso[i] = AT_KB + dv * AT_VP + ch * 16; vgo[i] = (size_t)dv * NT * 2 + ch * 16; }
    for (int item = blockIdx.x; item < 256; item += gridDim.x) {
        const int bh = item >> 3, x = item & 7, b = bh >> 3, h = bh & 7;
        const char* Qg = (const char*)(Q16 + (size_t)bh * SEQ * QKD); const char* Kg = (const char*)(K16 + (size_t)bh * SEQ * QKD);
        const char* Vg = (const char*)(Vt + (size_t)(h * 128) * NT + b * SEQ);
#pragma unroll 1
        for (int pass = 0; pass < 2; ++pass) {
            const int qi = pass == 0 ? 15 - x : x, nsteps = 2 * (qi + 1), qrow0 = qi * 128 + qsub * 32;
            bf16x8 Qf[12];
#pragma unroll
            for (int ks = 0; ks < 12; ++ks) Qf[ks] = *(const bf16x8*)(Qg + ((size_t)(qrow0 + cl) * QKD + ks * 16 + hh * 8) * 2);
            f32x16 O[4];
#pragma unroll
            for (int vb = 0; vb < 4; ++vb)
#pragma unroll
                for (int r = 0; r < 16; ++r) O[vb][r] = 0.f;
            float lsum = 0.f;
            v4u kr[3], vr[2];
#define AT_LOAD(j) do { _Pragma("unroll") for (int i_ = 0; i_ < 3; ++i_) kr[i_] = *(const v4u*)(Kg + (size_t)(j) * 24576 + (size_t)(tid + 512 * i_) * 16); \
                        _Pragma("unroll") for (int i_ = 0; i_ < 2; ++i_) vr[i_] = *(const v4u*)(Vg + vgo[i_] + (size_t)(j) * 128); } while (0)
#define AT_WRITE(bo) do { _Pragma("unroll") for (int i_ = 0; i_ < 3; ++i_) *(LAS v4u*)(lds + (bo) + kso[i_]) = kr[i_]; \
                          _Pragma("unroll") for (int i_ = 0; i_ < 2; ++i_) *(LAS v4u*)(lds + (bo) + vso[i_]) = vr[i_]; } while (0)
            AT_LOAD(0); AT_WRITE(0); __syncthreads();
#pragma unroll 1
            for (int j = 0; j < nsteps; ++j) {
                const int bo = (j & 1) * AT_BUF;
                if (j + 1 < nsteps) AT_LOAD(j + 1);
                const int key0 = 64 * j + 32 * kpar;
                if (key0 <= qrow0 + 31) {
                    f32x16 S;
#pragma unroll
                    for (int r = 0; r < 16; ++r) S[r] = negc0;
                    const LAS unsigned char* kb = lds + bo + (32 * kpar + cl) * AT_KP + hh * 16;
                    __builtin_amdgcn_s_setprio(1);
#pragma unroll
                    for (int ks = 0; ks < 12; ++ks) { const bf16x8 a = *(const LAS bf16x8*)(kb + ks * 32); S = __builtin_amdgcn_mfma_f32_32x32x16_bf16(a, Qf[ks], S, 0, 0, 0); }
                    __builtin_amdgcn_s_setprio(0);
                    const bool diag = key0 + 31 > qrow0;
                    float pr[16];
#pragma unroll
                    for (int r = 0; r < 16; ++r) { float e = __builtin_amdgcn_exp2f(S[r]);
                        if (diag) { const int key = key0 + (r & 3) + 8 * (r >> 2) + 4 * hh; if (key > qrow0 + cl) e = 0.f; }
                        pr[r] = e; lsum += e; }
                    bf16x8 Pf[2];
#pragma unroll
                    for (int s = 0; s < 2; ++s) { v4u w; w.x = pk2(pr[8 * s + 0], pr[8 * s + 1]); w.y = pk2(pr[8 * s + 2], pr[8 * s + 3]); w.z = pk2(pr[8 * s + 4], pr[8 * s + 5]); w.w = pk2(pr[8 * s + 6], pr[8 * s + 7]);
                        Pf[s] = __builtin_bit_cast(bf16x8, w); }
                    const LAS unsigned char* vbp = lds + bo + AT_KB + cl * AT_VP + (32 * kpar + 8 * hh) * 2;
                    __builtin_amdgcn_s_setprio(1);
#pragma unroll
                    for (int vb = 0; vb < 4; ++vb)
#pragma unroll
                        for (int s = 0; s < 2; ++s) { const bf16x8 a = *(const LAS bf16x8*)(vbp + vb * 32 * AT_VP + s * 32); O[vb] = __builtin_amdgcn_mfma_f32_32x32x16_bf16(a, Pf[s], O[vb], 0, 0, 0); }
                    __builtin_amdgcn_s_setprio(0);
                }
                if (j + 1 < nsteps) AT_WRITE(((j + 1) & 1) * AT_BUF);
                __syncthreads();
            }
            LAS float* X = (LAS float*)lds;
            if (kpar == 1) {
#pragma unroll
                for (int vb = 0; vb < 4; ++vb)
#pragma unroll
                    for (int r = 0; r < 16; ++r) X[(qsub * 65 + vb * 16 + r) * 64 + lane] = O[vb][r];
                X[(qsub * 65 + 64) * 64 + lane] = lsum;
            }
            __syncthreads();
            if (kpar == 0) {
                float l = lsum + X[(qsub * 65 + 64) * 64 + lane];
                l += __shfl_xor(l, 32);
                const float il = 1.f / l; float ss = 0.f;
                const int t = b * SEQ + qrow0 + cl;
                bf16_t* op = merged + (size_t)t * DM + h * 128 + 4 * hh;
#pragma unroll
                for (int vb = 0; vb < 4; ++vb)
#pragma unroll
                    for (int rq = 0; rq < 4; ++rq) { float o[4];
#pragma unroll
                        for (int r3 = 0; r3 < 4; ++r3) { const int r = rq * 4 + r3; o[r3] = (O[vb][r] + X[(qsub * 65 + vb * 16 + r) * 64 + lane]) * il; ss += o[r3] * o[r3]; }
                        v2u w; w.x = pk2(o[0], o[1]); w.y = pk2(o[2], o[3]); *(v2u*)(op + vb * 32 + rq * 8) = w; }
                ss += __shfl_xor(ss, 32);
                if (hh == 0) ssq_o8[(size_t)t * 8 + h] = ss;
            }
            __syncthreads();
        }
    }
#undef AT_LOAD
#undef AT_WRITE
}

__device__ __forceinline__ void phase6_scale(const Params& p, int wave, int lane) {
    unsigned char* ws = p.ws; bf16_t* merged = (bf16_t*)(ws + WS_MERGED); const float* ssq_o8 = (const float*)(ws + TAB_SSQ_O8);
    const int gw = blockIdx.x * NWAVES + wave, NGW = gridDim.x * NWAVES;
    for (int t = gw; t < NT; t += NGW) { const pg8::f32x4 oa = *(const pg8::f32x4*)(ssq_o8 + (size_t)t * 8), ob = *(const pg8::f32x4*)(ssq_o8 + (size_t)t * 8 + 4);
        const float r = rsqrtf((((oa[0] + oa[1]) + (oa[2] + oa[3])) + ((ob[0] + ob[1]) + (ob[2] + ob[3]))) * (1.f / 1024.f) + EPS);
#pragma unroll
        for (int j = 0; j < 2; ++j) { v4u* q = (v4u*)(merged + (size_t)t * DM + 1024 + j * 512 + lane * 8); v4u y = *q;
            y.x = pk2(bflo(y.x) * r, bfhi(y.x) * r); y.y = pk2(bflo(y.y) * r, bfhi(y.y) * r); y.z = pk2(bflo(y.z) * r, bfhi(y.z) * r); y.w = pk2(bflo(y.w) * r, bfhi(y.w) * r); *q = y; } }
}

struct EpiResidF32 { static constexpr bool PERM = false, MIDK = true; const float* x; const float* gate; float* out; const LAS float* rs;
    __device__ __forceinline__ void mid(pg8::f32x4 (&acc)[2][2][4][2], const pg8::Unit& u, int wr, int wc, int fr, int fq) const {
        const LAS float* rp = rs + u.pad * 256 + wr * 64 + fr;
#pragma unroll
        for (int ai = 0; ai < 2; ++ai)
#pragma unroll
            for (int m = 0; m < 4; ++m) { const float r = rp[ai * 128 + m * 16];
#pragma unroll
                for (int bj = 0; bj < 2; ++bj)
#pragma unroll
                    for (int n = 0; n < 2; ++n) acc[ai][bj][m][n] = acc[ai][bj][m][n] * r; }
    }
    __device__ __forceinline__ void operator()(const pg8::f32x4 (&acc)[2][2][4][2], const pg8::Unit& u, int wr, int wc, int fr, int fq) const {
        const int row0 = u.pm * 256 + wr * 64 + fr, col0 = u.pn * 256 + wc * 32 + 4 * fq;
        const float* gp = gate + (size_t)((u.pm * 256) / SEQ) * MODW + col0;
        pg8::f32x4 gv[2][2];
#pragma unroll
        for (int bj = 0; bj < 2; ++bj)
#pragma unroll
            for (int n = 0; n < 2; ++n) gv[bj][n] = *(const pg8::f32x4*)(gp + bj * 128 + n * 16);
#pragma unroll
        for (int ai = 0; ai < 2; ++ai)
#pragma unroll
            for (int m = 0; m < 4; ++m) { if (!(u.mask & (3 << (ai * 2)))) continue; const size_t ro = (size_t)(row0 + ai * 128 + m * 16) * DM + col0;
#pragma unroll
                for (int bj = 0; bj < 2; ++bj)
#pragma unroll
                    for (int n = 0; n < 2; ++n) { const pg8::f32x4 xv = *(const pg8::f32x4*)(x + ro + bj * 128 + n * 16); *(pg8::f32x4*)(out + ro + bj * 128 + n * 16) = xv + gv[bj][n] * acc[ai][bj][m][n]; } }
    }
};
__device__ __forceinline__ void phase7(const Params& p, LAS unsigned char* lds) {
    unsigned char* ws = p.ws;
    pg8::Gemm g{(const bf16_t*)(ws + WS_MERGED), (const bf16_t*)(ws + WS_BT_OUT), nullptr, DM, DM, DM, 0};
    pg8::StaticOrder S; S.init(NT / 256, DM / 256, gridDim.x, blockIdx.x, DM);
    LAS float* rs = (LAS float*)(lds + RING_BYTES + 12288);
    { const float* ssq_o8 = (const float*)(ws + TAB_SSQ_O8); pg8::Unit u;
      for (int i = 0; i < 4 && S.next(i, u); ++i) if (threadIdx.x < 256) { const float* sp = ssq_o8 + (size_t)(u.pm * 256 + threadIdx.x) * 8; const pg8::f32x4 oa = *(const pg8::f32x4*)sp, ob = *(const pg8::f32x4*)(sp + 4);
          rs[i * 256 + threadIdx.x] = rsqrtf((((oa[0] + oa[1]) + (oa[2] + oa[3])) + ((ob[0] + ob[1]) + (ob[2] + ob[3]))) * (1.f / 1024.f) + EPS); }
      __syncthreads(); }
    EpiResidF32 E{p.in[0], (const float*)(ws + CTL_MOD) + 2 * DM, (float*)(ws + WS_H1), rs};
    pg8::gemm_phase<EpiResidF32, pg8::StaticOrder>((PG8_LAS unsigned char*)lds, g, S, E);
}
constexpr int HG_P = 272, HG_VP = 144;
constexpr int HG_A2 = 0, HG_A1 = 17408, HG_QB = 34816, HG_VT = 52224, HG_KT = 70656, HG_SEG = 89088, HG_RS = 91136, HG_FL = 92160, HG_QT = 109568;
struct HgPre { v4u fl[2], q[2], v[2]; };
template <bool NEEDQ>
__device__ __forceinline__ void hg_issue(const bf16_t* __restrict__ proj, int item, HgPre& P) {
    const int bh = item >> 5, c = item & 31, b = bh >> 3, h = bh & 7, t0 = b * SEQ + c * 64, tid = threadIdx.x;
#pragma unroll
    for (int i = 0; i < 2; ++i) { const int ch = tid + 512 * i, t = ch >> 4, c16 = ch & 15; const bf16_t* rp = proj + (size_t)(t0 + t) * INCP + h * 128 + c16 * 8;
        P.fl[i] = *(const v4u*)(rp + 1024); P.v[i] = *(const v4u*)(rp + 2048); if (NEEDQ) P.q[i] = *(const v4u*)rp; }
}
struct HgCol { float kv[16]; float b[16]; float blast, bmid; };
template <bool NEEDQ, bool PERM>
__device__ __forceinline__ void hg_stage(const HgPre& P, const float* __restrict__ lbl, int h, LAS unsigned char* lds, HgCol& C) {
    const int tid = threadIdx.x, k = tid & 127, seg = tid >> 7;
    __syncthreads();
#pragma unroll
    for (int i = 0; i < 2; ++i) { const int ch = tid + 512 * i, t = ch >> 4, c16 = ch & 15;
        *(LAS v4u*)(lds + HG_FL + t * HG_P + c16 * 16) = P.fl[i]; if (NEEDQ) *(LAS v4u*)(lds + HG_QT + t * HG_P + c16 * 16) = P.q[i];
        const v4u w = P.v[i]; const int o = t & 15, pos = PERM ? ((t & ~15) + 8 * ((o >> 2) & 1) + 4 * ((o >> 3) & 1) + (o & 3)) : t;
        LAS unsigned short* vp = (LAS unsigned short*)(lds + HG_VT + (c16 * 8) * HG_VP + (((pos >> 3) ^ (c16 & 7)) * 16) + (pos & 7) * 2);
        vp[0 * (HG_VP / 2)] = (unsigned short)(w.x & 0xffff); vp[1 * (HG_VP / 2)] = (unsigned short)(w.x >> 16);
        vp[2 * (HG_VP / 2)] = (unsigned short)(w.y & 0xffff); vp[3 * (HG_VP / 2)] = (unsigned short)(w.y >> 16);
        vp[4 * (HG_VP / 2)] = (unsigned short)(w.z & 0xffff); vp[5 * (HG_VP / 2)] = (unsigned short)(w.z >> 16);
        vp[6 * (HG_VP / 2)] = (unsigned short)(w.w & 0xffff); vp[7 * (HG_VP / 2)] = (unsigned short)(w.w >> 16); }
    const float l0 = lbl[h * 128 + k], l1 = lbl[1024 + h * 128 + k];
    const float lb = 1.f / (1.f + __expf(l1 - l0));
    __syncthreads();
    const LAS unsigned short* fp = (const LAS unsigned short*)(lds + HG_FL + (seg * 16) * HG_P + k * 2);
    float run = 0.f;
#pragma unroll
    for (int i = 0; i < 16; ++i) { const float fl = bf2f(fp[i * (HG_P / 2)]); const float f = lb + (1.f - lb) / (1.f + __expf(-fl)); C.kv[i] = 1.f - f; run += __logf(f); C.b[i] = run; }
    LAS float* SEG = (LAS float*)(lds + HG_SEG);
    SEG[seg * 128 + k] = run;
    __syncthreads();
    const float s0 = SEG[k], s1 = SEG[128 + k], s2 = SEG[256 + k], s3 = SEG[384 + k];
    const float off = (seg > 0 ? s0 : 0.f) + (seg > 1 ? s1 : 0.f) + (seg > 2 ? s2 : 0.f);
#pragma unroll
    for (int i = 0; i < 16; ++i) C.b[i] += off;
    C.bmid = s0 + s1; C.blast = (s0 + s1) + (s2 + s3);
}
__device__ __forceinline__ void hgrn_pass1(const Params& p, LAS unsigned char* lds, int wave, int lane) {
    unsigned char* ws = p.ws; const bf16_t* proj = (const bf16_t*)(ws + WS_PROJ);
    bf16_t* hgU = (bf16_t*)(ws + WS_HGU); float* hgd = (float*)(ws + TAB_HGD);
    const int tid = threadIdx.x, k = tid & 127, seg = tid >> 7, cl = lane & 31, hh = lane >> 5, G = gridDim.x;
    HgPre P; if ((int)blockIdx.x < 1024) hg_issue<false>(proj, blockIdx.x, P);
    for (int item = blockIdx.x; item < 1024; item += G) {
        const int h = (item >> 5) & 7;
        HgCol C; hg_stage<false, false>(P, p.in[8], h, lds, C);
        if (item + G < 1024) hg_issue<false>(proj, item + G, P);
        { unsigned w[8];
#pragma unroll
          for (int i = 0; i < 8; ++i) { const float a0 = C.kv[2 * i] * __expf(C.blast - C.b[2 * i]), a1 = C.kv[2 * i + 1] * __expf(C.blast - C.b[2 * i + 1]); w[i] = pk2(a0, a1); }
          LAS v4u* kp = (LAS v4u*)(lds + HG_KT + k * HG_VP + seg * 32); kp[0] = (v4u){w[0], w[1], w[2], w[3]}; kp[1] = (v4u){w[4], w[5], w[6], w[7]}; }
        if (seg == 0) hgd[item * 128 + k] = __expf(C.blast);
        __syncthreads();
        const int vb = wave >> 1;
        bf16x8 af[4];
#pragma unroll
        for (int ks = 0; ks < 4; ++ks) af[ks] = *(const LAS bf16x8*)(lds + HG_VT + (32 * vb + cl) * HG_VP + (((2 * ks + hh) ^ ((cl >> 3) & 3) ^ ((vb & 1) << 2)) * 16));
#pragma unroll
        for (int q = 0; q < 2; ++q) { const int kb = (wave & 1) * 2 + q; f32x16 acc;
#pragma unroll
            for (int r = 0; r < 16; ++r) acc[r] = 0.f;
#pragma unroll
            for (int ks = 0; ks < 4; ++ks) { const bf16x8 bfr = *(const LAS bf16x8*)(lds + HG_KT + (32 * kb + cl) * HG_VP + (16 * ks + 8 * hh) * 2); acc = __builtin_amdgcn_mfma_f32_32x32x16_bf16(af[ks], bfr, acc, 0, 0, 0); }
            bf16_t* up = hgU + (size_t)item * 16384 + 32 * kb + cl;
#pragma unroll
            for (int r = 0; r < 16; ++r) { const int v = 32 * vb + (r & 3) + 8 * (r >> 2) + 4 * hh; up[(size_t)v * 128] = (bf16_t)f2bf(acc[r]); } }
    }
}
__device__ __forceinline__ void hgrn_scan(const Params& p) {
    unsigned char* ws = p.ws; bf16_t* hgU = (bf16_t*)(ws + WS_HGU); const float* hgd = (const float*)(ws + TAB_HGD);
    for (int i = blockIdx.x * NTHR + threadIdx.x; i < 32 * 4096; i += gridDim.x * NTHR) {
        const int bh = i >> 12, e4 = i & 4095, k4 = (e4 & 31) * 4;
        float S[4] = {0.f, 0.f, 0.f, 0.f};
        v2u* up = (v2u*)(hgU + (size_t)bh * 32 * 16384 + (size_t)e4 * 4); const float* dp = hgd + (size_t)bh * 32 * 128 + k4;
#pragma unroll 1
        for (int c0 = 0; c0 < 32; c0 += 8) { v2u u[8]; f32x4 d[8];
#pragma unroll
            for (int j = 0; j < 8; ++j) { u[j] = up[(size_t)(c0 + j) * 4096]; d[j] = *(const f32x4*)(dp + (c0 + j) * 128); }
#pragma unroll
            for (int j = 0; j < 8; ++j) { v2u o; o.x = pk2(S[0], S[1]); o.y = pk2(S[2], S[3]); up[(size_t)(c0 + j) * 4096] = o;
                S[0] = d[j][0] * S[0] + bflo(u[j].x); S[1] = d[j][1] * S[1] + bfhi(u[j].x); S[2] = d[j][2] * S[2] + bflo(u[j].y); S[3] = d[j][3] * S[3] + bfhi(u[j].y); } }
    }
}
__device__ __forceinline__ void hgrn_pass3(const Params& p, LAS unsigned char* lds, int wave, int lane) {
    unsigned char* ws = p.ws; const bf16_t* proj = (const bf16_t*)(ws + WS_PROJ);
    const bf16_t* hgS = (const bf16_t*)(ws + WS_HGU); bf16_t* merged = (bf16_t*)(ws + WS_MERGED); const float* og = p.in[9];
    const int tid = threadIdx.x, k = tid & 127, seg = tid >> 7, cl = lane & 31, hh = lane >> 5, vb = wave & 3, tb = wave >> 2, G = gridDim.x;
    HgPre P; if ((int)blockIdx.x < 1024) hg_issue<true>(proj, blockIdx.x, P);
    for (int item = blockIdx.x; item < 1024; item += G) {
        const int bh = item >> 5, c = item & 31, b = bh >> 3, h = bh & 7, t0 = b * SEQ + c * 64;
        bf16x8 sf[8]; v2u gw[4];
        { const bf16_t* sp = hgS + (size_t)item * 16384 + (size_t)(32 * vb + cl) * 128 + 8 * hh;
#pragma unroll
          for (int ks = 0; ks < 8; ++ks) sf[ks] = *(const bf16x8*)(sp + 16 * ks);
          const int t = t0 + 32 * tb + cl;
#pragma unroll
          for (int rq = 0; rq < 4; ++rq) gw[rq] = *(const v2u*)(proj + (size_t)t * INCP + 3072 + h * 128 + 32 * vb + 8 * rq + 4 * hh); }
        HgCol C; hg_stage<true, true>(P, p.in[8], h, lds, C);
        { const LAS unsigned short* qp = (const LAS unsigned short*)(lds + HG_QT + (seg * 16) * HG_P + k * 2);
          LAS unsigned short* a2 = (LAS unsigned short*)(lds + HG_A2 + (seg * 16) * HG_P + k * 2);
          LAS unsigned short* a1 = (LAS unsigned short*)(lds + HG_A1 + (seg * 16) * HG_P + k * 2);
          LAS unsigned short* qb = (LAS unsigned short*)(lds + HG_QB + (seg * 16) * HG_P + k * 2);
          const float em = __expf(-C.bmid), ep = __expf(C.bmid);
#pragma unroll
          for (int i = 0; i < 16; i += 2) { const float q0 = bf2f(qp[i * (HG_P / 2)]), q1 = bf2f(qp[(i + 1) * (HG_P / 2)]);
              const float e0 = __expf(C.b[i]), e1 = __expf(C.b[i + 1]);
              const unsigned wa2 = pk2(C.kv[i] * ep * __builtin_amdgcn_rcpf(e0), C.kv[i + 1] * ep * __builtin_amdgcn_rcpf(e1));
              const unsigned wa1 = pk2(q0 * e0 * em, q1 * e1 * em), wqb = pk2(q0 * e0, q1 * e1);
              a2[i * (HG_P / 2)] = (unsigned short)(wa2 & 0xffff); a2[(i + 1) * (HG_P / 2)] = (unsigned short)(wa2 >> 16);
              a1[i * (HG_P / 2)] = (unsigned short)(wa1 & 0xffff); a1[(i + 1) * (HG_P / 2)] = (unsigned short)(wa1 >> 16);
              qb[i * (HG_P / 2)] = (unsigned short)(wqb & 0xffff); qb[(i + 1) * (HG_P / 2)] = (unsigned short)(wqb >> 16); } }
        __syncthreads();
        if (item + G < 1024) hg_issue<true>(proj, item + G, P);
        f32x16 O;
#pragma unroll
        for (int r = 0; r < 16; ++r) O[r] = 0.f;
#pragma unroll
        for (int ks = 0; ks < 8; ++ks) { const bf16x8 bq = *(const LAS bf16x8*)(lds + HG_QB + (32 * tb + cl) * HG_P + (16 * ks + 8 * hh) * 2); O = __builtin_amdgcn_mfma_f32_32x32x16_bf16(sf[ks], bq, O, 0, 0, 0); }
#pragma unroll
        for (int sb = 0; sb < 2; ++sb) {
            if (sb <= tb) {
                f32x16 X;
#pragma unroll
                for (int r = 0; r < 16; ++r) X[r] = 0.f;
#pragma unroll
                for (int ks = 0; ks < 8; ++ks) { const bf16x8 a = *(const LAS bf16x8*)(lds + HG_A2 + (32 * sb + cl) * HG_P + (16 * ks + 8 * hh) * 2);
                    const bf16x8 bq = *(const LAS bf16x8*)(lds + HG_A1 + (32 * tb + cl) * HG_P + (16 * ks + 8 * hh) * 2); X = __builtin_amdgcn_mfma_f32_32x32x16_bf16(a, bq, X, 0, 0, 0); }
                if (sb == tb) {
#pragma unroll
                    for (int r = 0; r < 16; ++r) { const int s = (r & 3) + 8 * (r >> 2) + 4 * hh; if (s > cl) X[r] = 0.f; } }
#pragma unroll
                for (int s2 = 0; s2 < 2; ++s2) { v4u w; w.x = pk2(X[8 * s2 + 0], X[8 * s2 + 1]); w.y = pk2(X[8 * s2 + 2], X[8 * s2 + 3]); w.z = pk2(X[8 * s2 + 4], X[8 * s2 + 5]); w.w = pk2(X[8 * s2 + 6], X[8 * s2 + 7]);
                    const bf16x8 a = *(const LAS bf16x8*)(lds + HG_VT + (32 * vb + cl) * HG_VP + (((4 * sb + 2 * s2 + hh) ^ ((cl >> 3) & 3) ^ ((vb & 1) << 2)) * 16));
                    O = __builtin_amdgcn_mfma_f32_32x32x16_bf16(a, __builtin_bit_cast(bf16x8, w), O, 0, 0, 0); }
            }
        }
        float ss = 0.f;
#pragma unroll
        for (int r = 0; r < 16; ++r) ss += O[r] * O[r];
        ss += __shfl_xor(ss, 32);
        LAS float* RS = (LAS float*)(lds + HG_RS);
        if (hh == 0) RS[(tb * 4 + vb) * 32 + cl] = ss;
        __syncthreads();
        const float tot = (RS[(tb * 4 + 0) * 32 + cl] + RS[(tb * 4 + 1) * 32 + cl]) + (RS[(tb * 4 + 2) * 32 + cl] + RS[(tb * 4 + 3) * 32 + cl]);
        const float rn = rsqrtf(tot * (1.f / 128.f) + EPS);
        const int t = t0 + 32 * tb + cl;
#pragma unroll
        for (int rq = 0; rq < 4; ++rq) { const int v = 32 * vb + 8 * rq + 4 * hh; const f32x4 gg = *(const f32x4*)(og + v);
            const float g0 = bflo(gw[rq].x), g1 = bfhi(gw[rq].x), g2 = bflo(gw[rq].y), g3 = bfhi(gw[rq].y);
            const float o0 = O[rq * 4 + 0] * rn * gg[0] * (g0 / (1.f + __expf(-g0))), o1 = O[rq * 4 + 1] * rn * gg[1] * (g1 / (1.f + __expf(-g1)));
            const float o2 = O[rq * 4 + 2] * rn * gg[2] * (g2 / (1.f + __expf(-g2))), o3 = O[rq * 4 + 3] * rn * gg[3] * (g3 / (1.f + __expf(-g3)));
            v2u w; w.x = pk2(o0, o1); w.y = pk2(o2, o3); *(v2u*)(merged + (size_t)t * DM + 1024 + h * 128 + v) = w; }
    }
}
typedef float f32x2v __attribute__((ext_vector_type(2)));
constexpr int UPITCH = 2050;
constexpr int LDS_HIST = RING_BYTES + 1024;
__device__ __forceinline__ void phase8(const Params& p, LAS unsigned char* lds, int wave, int lane) {
    unsigned char* ws = p.ws;
    const float* h1 = (const float*)(ws + WS_H1); const float* mod = (const float*)(ws + CTL_MOD);
    unsigned char* u8 = ws + WS_U16;
    const float* wr_ = p.in[18]; const float* rbias = p.in[19];
    int* top_idx = (int*)(ws + TAB_TOPI); float* top_w = (float*)(ws + TAB_TOPW); int* slot = (int*)(ws + TAB_SLOT);
    LAS float* U = (LAS float*)lds;
    LAS int* hist = (LAS int*)(lds + LDS_HIST);
    if (threadIdx.x < 64) hist[threadIdx.x] = 0;
    LAS float* SS = (LAS float*)(lds + RING_BYTES + 5120);
    const int TPB = (NT / 16 + gridDim.x - 1) / gridDim.x;
    int ssb = -1;
    for (int task = blockIdx.x * TPB; task < NT / 16 && task < (int)(blockIdx.x + 1) * TPB; ++task) {
        const int t0 = task * 16;
        if (t0 / SEQ != ssb) { ssb = t0 / SEQ; __syncthreads();
            for (int i4 = threadIdx.x; i4 < DM / 4; i4 += NTHR) { const f32x4 gv = *(const f32x4*)(p.in[6] + i4 * 4), sv = *(const f32x4*)(mod + ssb * MODW + 4 * DM + i4 * 4), hv = *(const f32x4*)(mod + ssb * MODW + 3 * DM + i4 * 4);
                *(LAS f32x4*)(SS + i4 * 4) = gv * (sv + 1.f); *(LAS f32x4*)(SS + DM + i4 * 4) = hv; } }
        __syncthreads();
        { f32x4 v[2][8];
#pragma unroll
          for (int rr = 0; rr < 2; ++rr) { const float* hrow = h1 + (size_t)(t0 + wave * 2 + rr) * DM;
#pragma unroll
              for (int j = 0; j < 8; ++j) v[rr][j] = *(const f32x4*)(hrow + lane * 4 + 256 * j); }
#pragma unroll
          for (int rr = 0; rr < 2; ++rr) {
            const int tl = wave * 2 + rr, t = t0 + tl, b = t / SEQ;
            float s = 0.f;
#pragma unroll
            for (int j = 0; j < 8; ++j) s += (v[rr][j].x * v[rr][j].x + v[rr][j].y * v[rr][j].y) + (v[rr][j].z * v[rr][j].z + v[rr][j].w * v[rr][j].w);
            const float r = rsqrtf(wave_sum(s) * (1.f / DM) + EPS);
#pragma unroll
            for (int j = 0; j < 8; ++j) { const int col = lane * 4 + 256 * j; const f32x4 gs = *(const LAS f32x4*)(SS + col), hv = *(const LAS f32x4*)(SS + DM + col);
                const f32x4 o = v[rr][j] * r * gs + hv; *(unsigned*)(u8 + (size_t)t * DM + col) = pk4_fp8(o.x * 4.f, o.y * 4.f, o.z * 4.f, o.w * 4.f);
                LAS f32x2v* up = (LAS f32x2v*)(U + tl * UPITCH + col); up[0] = (f32x2v){o.x, o.y}; up[1] = (f32x2v){o.z, o.w}; }
          } }
        __syncthreads();
        f32x4 acc[4];
#pragma unroll
        for (int c = 0; c < 4; ++c) acc[c] = (f32x4){0.f, 0.f, 0.f, 0.f};
        { const int kb = wave * 256 + (lane >> 4); const LAS float* ua = U + (lane & 15) * UPITCH + kb; const float* wb = wr_ + (size_t)kb * NE + 4 * (lane & 15);
          f32x4 bv[8], bn[8];
#pragma unroll
          for (int q = 0; q < 8; ++q) bv[q] = *(const f32x4*)(wb + (size_t)q * 4 * NE);
#pragma unroll 1
          for (int k8 = 0; k8 < 64; k8 += 8) {
              if (k8 + 8 < 64) {
#pragma unroll
                  for (int q = 0; q < 8; ++q) bn[q] = *(const f32x4*)(wb + (size_t)(k8 + 8 + q) * 4 * NE); }
#pragma unroll
              for (int q = 0; q < 8; ++q) { const float a = ua[(k8 + q) * 4];
#pragma unroll
                  for (int c = 0; c < 4; ++c) acc[c] = __builtin_amdgcn_mfma_f32_16x16x4f32(a, bv[q][c], acc[c], 0, 0, 0); }
#pragma unroll
              for (int q = 0; q < 8; ++q) bv[q] = bn[q]; } }
        __syncthreads();
        LAS float* P = (LAS float*)lds;
#pragma unroll
        for (int c = 0; c < 4; ++c)
#pragma unroll
            for (int r = 0; r < 4; ++r) P[wave * 1024 + ((lane >> 4) * 4 + r) * 64 + 4 * (lane & 15) + c] = acc[c][r];
        __syncthreads();
        LAS float* LG = (LAS float*)(lds + 32768);
#pragma unroll
        for (int q = 0; q < 2; ++q) { const int i = threadIdx.x + q * NTHR; float s = 0.f;
#pragma unroll
            for (int w = 0; w < 8; ++w) s += P[w * 1024 + i]; LG[i] = s; }
        __syncthreads();
#pragma unroll 1
        for (int rr = 0; rr < 2; ++rr) {
            const int tl = wave * 2 + rr, t = t0 + tl;
            int lanev = lane; asm volatile("" : "+v"(lanev));
            const float sc = 1.f / (1.f + expf(-LG[tl * 64 + lane])); const float sel = sc + rbias[lane];
            float m1 = sel; m1 = fmaxf(m1, __shfl_xor(m1, 1)); m1 = fmaxf(m1, __shfl_xor(m1, 2)); m1 = fmaxf(m1, __shfl_xor(m1, 4));
            const unsigned long long gm = 0xFFull << (lanev & 56);
            const int first = __ffsll((long long)(__ballot(sel == m1) & gm)) - 1;
            float m2 = (lanev == first) ? -INFINITY : sel; m2 = fmaxf(m2, __shfl_xor(m2, 1)); m2 = fmaxf(m2, __shfl_xor(m2, 2)); m2 = fmaxf(m2, __shfl_xor(m2, 4));
            const float gs = m1 + m2; const int g = lanev >> 3; int grank = 0;
#pragma unroll
            for (int gg = 0; gg < 8; ++gg) { const float og = __builtin_bit_cast(float, __builtin_amdgcn_readlane(__builtin_bit_cast(int, gs), gg * 8)); grank += (og > gs || (og == gs && gg < g)) ? 1 : 0; }
            const bool gsel = grank < 4; int rk = 0;
            unsigned kb_ = __builtin_bit_cast(unsigned, sel); kb_ = (kb_ & 0x80000000u) ? ~kb_ : (kb_ | 0x80000000u);
            const unsigned long long key = gsel ? (((unsigned long long)kb_ << 6) | (unsigned long long)(63 - lanev)) : 0ull;
            const int klo = (int)(unsigned)key, khi = (int)(unsigned)(key >> 32);
#pragma unroll
            for (int e = 0; e < 64; ++e) { const unsigned long long o = ((unsigned long long)(unsigned)__builtin_amdgcn_readlane(khi, e) << 32) | (unsigned)__builtin_amdgcn_readlane(klo, e); rk += (o > key) ? 1 : 0; }
            const bool chosen = gsel && rk < 8;
            const unsigned long long cb = __ballot(chosen);
            const float wsum = wave_sum(chosen ? sc : 0.f);
            const int ks = __popcll(cb & ((1ull << lanev) - 1ull));
            if (chosen) { const int lr = __hip_atomic_fetch_add((int*)(hist + lane), 1, __ATOMIC_RELAXED, __HIP_MEMORY_SCOPE_WORKGROUP); top_idx[t * 8 + ks] = lane; top_w[t * 8 + ks] = sc / wsum * 2.5f; slot[t * 8 + ks] = lr; }
        }
        __syncthreads();
    }
    if (threadIdx.x < 64) ((int*)(ws + CTL_HIST))[blockIdx.x * 64 + threadIdx.x] = hist[threadIdx.x];
}

__device__ __forceinline__ void phase9(const Params& p, LAS unsigned char* lds, int wave, int lane) {
    unsigned char* ws = p.ws;
    const int* bh = (const int*)(ws + CTL_HIST);
    int* top_idx = (int*)(ws + TAB_TOPI); int* slot = (int*)(ws + TAB_SLOT); int* row_tok = (int*)(ws + TAB_ROWTOK); int* tile_exp = (int*)(ws + TAB_TILEEXP);
    LAS int* rb = (LAS int*)(lds + LDS_HIST + 256);
    const int G = gridDim.x;
    {
        LAS int* part = (LAS int*)(lds + LDS_HIST + 2048);
        const int e = threadIdx.x & 63, pt = threadIdx.x >> 6, per = (G + 7) / 8, b0 = pt * per, b1 = (b0 + per < G) ? b0 + per : G;
        int cnt = 0, base = 0;
#pragma unroll 8
        for (int b = b0; b < b1; ++b) { const int v = bh[b * 64 + e]; base += (b < (int)blockIdx.x) ? v : 0; cnt += v; }
        part[pt * 64 + e] = cnt; part[512 + pt * 64 + e] = base;
    }
    __syncthreads();
    if (wave == 0) {
        LAS int* part = (LAS int*)(lds + LDS_HIST + 2048);
        int cnt = 0, base = 0;
#pragma unroll
        for (int q = 0; q < 8; ++q) { cnt += part[q * 64 + lane]; base += part[512 + q * 64 + lane]; }
        const int tiles = (cnt + 255) >> 8;
        int incl = tiles;
#pragma unroll
        for (int o = 1; o < 64; o <<= 1) { const int n = __shfl_up(incl, o); if (lane >= o) incl += n; }
        const int toff = incl - tiles;
        rb[lane] = toff * 256 + base;
        if (blockIdx.x == 0) { for (int i = 0; i < tiles; ++i) tile_exp[toff + i] = lane; if (lane == 63) tile_exp[512] = incl; if (lane < 32) tile_exp[320 + lane] = 64; }
        rb[64 + lane] = toff * 256 + cnt; rb[128 + lane] = (toff + tiles) * 256;
    }
    __syncthreads();
    for (int e = blockIdx.x; e < 64; e += G) { const int lo = rb[64 + e], hi = rb[128 + e]; for (int r = lo + (int)threadIdx.x; r < hi; r += NTHR) row_tok[r] = 0; }
    for (int i = blockIdx.x * NTHR + threadIdx.x; i < NT; i += G * NTHR) row_tok[ROUTED_ROWS_MAX + i] = i;
    const int TPB = (NT / 16 + G - 1) / G;
    for (int task = blockIdx.x * TPB; task < NT / 16 && task < (int)(blockIdx.x + 1) * TPB; ++task) {
        const int t = task * 16 + wave * 2 + (lane >> 3), k = lane & 7;
        if (lane < 16) { const int e = top_idx[t * 8 + k]; const int pos = rb[e] + slot[t * 8 + k]; slot[t * 8 + k] = pos; row_tok[pos] = t; }
    }
}

constexpr int LDS_UNITS = RING_BYTES + 8192;
struct MoeOrder {
    LAS int* tab; int n;
    __device__ void init(LAS unsigned char* lds, const int* tile_exp, int nN, int G, int c, long estride, long bstep, int parts) {
        tab = (LAS int*)(lds + LDS_UNITS);
        const int ntr = tile_exp[512], nwg = (ntr + 32) * nN;
        int T = nwg % G, nfull = nwg - T; if (true) { nfull = nwg; T = 0; }
        const int njobs = nfull + parts * T;
        const int i = threadIdx.x; n = 0;
        if (c < njobs) n = (njobs - 1 - c) / G + 1;
        if (i < 32 && i < n) {
            const int L = i * G + c; int wgid, mask = 15;
            if (L < nfull) wgid = L; else { const int j = L - nfull; wgid = nfull + j % T; const int part = j / T; mask = (parts == 2) ? (part ? 12 : 3) : (1 << part); }
            { const int q = nwg / 8, r = nwg % 8, xcd = wgid % 8, off = wgid / 8; wgid = (xcd < r ? xcd * (q + 1) : r * (q + 1) + (xcd - r) * q) + off; }
            const int ti = wgid / nN, pn = wgid % nN; int tile, e; if (ti < ntr) { tile = ti; e = tile_exp[ti]; } else { tile = 320 + (ti - ntr); e = 64; }
            const long boff = (long)e * estride + (long)pn * bstep;
            tab[i * 8 + 0] = tile; tab[i * 8 + 1] = pn; tab[i * 8 + 2] = (int)(boff & 0xffffffffl); tab[i * 8 + 3] = (int)(boff >> 32); tab[i * 8 + 4] = mask;
        }
        __syncthreads();
    }
    __device__ bool next(int i, pg8::Unit& u) const {
        if (i >= n) return false;
        u.pm = tab[i * 8 + 0]; u.pn = tab[i * 8 + 1]; u.boff = (long)(((unsigned long long)(unsigned)tab[i * 8 + 3] << 32) | (unsigned)tab[i * 8 + 2]); u.mask = tab[i * 8 + 4]; u.pad = 0; return true;
    }
};
struct EpiGateUp { static constexpr bool PERM = true, MIDK = false; unsigned char* H;
    __device__ __forceinline__ void operator()(const pg8::f32x4 (&acc)[2][2][4][2], const pg8::Unit& u, int wr, int wc, int fr, int fq) const {
        const int row0 = u.pm * 256 + wr * 64 + fr, col0 = u.pn * 128 + wc * 32 + 8 * fq;
#pragma unroll
        for (int ai = 0; ai < 2; ++ai)
#pragma unroll
            for (int m = 0; m < 4; ++m) { const int row = row0 + ai * 128 + m * 16; float o[8];
#pragma unroll
                for (int n = 0; n < 2; ++n)
#pragma unroll
                    for (int j = 0; j < 4; ++j) { const float gt = acc[ai][0][m][n][j] * (1.f / 256.f), up = acc[ai][1][m][n][j] * (8.f / 256.f); o[n * 4 + j] = gt / (1.f + __expf(-gt)) * up; }
                v2u w; w.x = pk4_fp8(o[0], o[1], o[2], o[3]); w.y = pk4_fp8(o[4], o[5], o[6], o[7]);
                *(v2u*)(H + (size_t)row * DE + col0) = w; }
    }
};
struct EpiDown { static constexpr bool PERM = true, MIDK = false; unsigned char* Y;
    __device__ __forceinline__ void operator()(const pg8::f32x4 (&acc)[2][2][4][2], const pg8::Unit& u, int wr, int wc, int fr, int fq) const {
        const int row0 = u.pm * 256 + wr * 64 + fr, col0 = u.pn * 256 + wc * 32 + 8 * fq; const float s = 16.f / 512.f;
#pragma unroll
        for (int ai = 0; ai < 2; ++ai)
#pragma unroll
            for (int m = 0; m < 4; ++m) { const int row = row0 + ai * 128 + m * 16; unsigned char* rowp = Y + (size_t)row * DM + col0;
#pragma unroll
                for (int bj = 0; bj < 2; ++bj) { const pg8::f32x4 v0 = acc[ai][bj][m][0] * s, v1 = acc[ai][bj][m][1] * s;
                    v2u w; w.x = pk4_fp8(v0[0], v0[1], v0[2], v0[3]); w.y = pk4_fp8(v1[0], v1[1], v1[2], v1[3]); *(v2u*)(rowp + bj * 128) = w; } }
    }
};
__device__ __forceinline__ void phase10(const Params& p, LAS unsigned char* lds) {
    unsigned char* ws = p.ws;
    pg8::Gemm g{(const bf16_t*)(ws + WS_U16), (const bf16_t*)(ws + WS_BT_GU), (const int*)(ws + TAB_ROWTOK), DM, DM, DM, 0};
    MoeOrder S; S.init(lds, (const int*)(ws + TAB_TILEEXP), 4, gridDim.x, blockIdx.x, (long)1024 * DM, (long)256 * DM, 2);
    EpiGateUp E{ws + WS_HID};
    pg8::gemm_phase<EpiGateUp, MoeOrder, 1>((PG8_LAS unsigned char*)lds, g, S, E);
}
__device__ __forceinline__ void phase11(const Params& p, LAS unsigned char* lds) {
    unsigned char* ws = p.ws;
    pg8::Gemm g{(const bf16_t*)(ws + WS_HID), (const bf16_t*)(ws + WS_BT_DN), nullptr, DE, DE, DE, 0};
    MoeOrder S; S.init(lds, (const int*)(ws + TAB_TILEEXP), 8, gridDim.x, blockIdx.x, (long)DM * DE, (long)256 * DE, 4);
    EpiDown E{ws + WS_Y};
    pg8::gemm_phase<EpiDown, MoeOrder, 1>((PG8_LAS unsigned char*)lds, g, S, E);
}
__device__ __forceinline__ void fp8x8_fma(const v2u y, float w, float (&a)[8]) {
#pragma unroll
    for (int q = 0; q < 2; ++q) { const unsigned d = y[q];
        a[q * 4 + 0] += w * __builtin_amdgcn_cvt_f32_fp8((int)d, 0); a[q * 4 + 1] += w * __builtin_amdgcn_cvt_f32_fp8((int)d, 1);
        a[q * 4 + 2] += w * __builtin_amdgcn_cvt_f32_fp8((int)d, 2); a[q * 4 + 3] += w * __builtin_amdgcn_cvt_f32_fp8((int)d, 3); }
}
__device__ __forceinline__ void phase12(const Params& p, int wave, int lane) {
    unsigned char* ws = p.ws;
    const float* h1 = (const float*)(ws + WS_H1); const float* mod = (const float*)(ws + CTL_MOD); const unsigned char* Y = ws + WS_Y;
    const int* slot = (const int*)(ws + TAB_SLOT); const float* top_w = (const float*)(ws + TAB_TOPW);
    const int gw = blockIdx.x * NWAVES + wave, NGW = gridDim.x * NWAVES;
    for (int t = gw; t < NT; t += NGW) {
        const int b = t / SEQ; const float* gt = mod + b * MODW + 5 * DM;
        int sl = 0; float wk = 0.f; if (lane < 8) { sl = slot[t * 8 + lane]; wk = top_w[t * 8 + lane] * (1.f / 16.f); }
#pragma unroll 2
        for (int j = 0; j < 4; ++j) {
            const int col = j * 512 + lane * 4;
            float a[8];
#pragma unroll
            for (int i = 0; i < 8; ++i) a[i] = 0.f;
            v2u yr[9];
            { const unsigned char* yp = Y + (size_t)(ROUTED_ROWS_MAX + t) * DM + col; yr[8].x = __builtin_nontemporal_load((const unsigned*)yp); yr[8].y = __builtin_nontemporal_load((const unsigned*)(yp + 256)); }
#pragma unroll
            for (int k = 0; k < 8; ++k) { const int s = __builtin_amdgcn_readlane(sl, k); const unsigned char* yp = Y + (size_t)s * DM + col;
                yr[k].x = __builtin_nontemporal_load((const unsigned*)yp); yr[k].y = __builtin_nontemporal_load((const unsigned*)(yp + 256)); }
            const f32x4 h0 = *(const f32x4*)(h1 + (size_t)t * DM + col), h4 = *(const f32x4*)(h1 + (size_t)t * DM + col + 256);
            const f32x4 g0 = *(const f32x4*)(gt + col), g4 = *(const f32x4*)(gt + col + 256);
            fp8x8_fma(yr[8], 1.f / 16.f, a);
#pragma unroll
            for (int k = 0; k < 8; ++k) { const float w = __builtin_bit_cast(float, __builtin_amdgcn_readlane(__builtin_bit_cast(int, wk), k)); fp8x8_fma(yr[k], w, a); }
            f32x4 o0, o4; o0.x = h0.x + g0.x * a[0]; o0.y = h0.y + g0.y * a[1]; o0.z = h0.z + g0.z * a[2]; o0.w = h0.w + g0.w * a[3];
            o4.x = h4.x + g4.x * a[4]; o4.y = h4.y + g4.y * a[5]; o4.z = h4.z + g4.z * a[6]; o4.w = h4.w + g4.w * a[7];
            __builtin_nontemporal_store(o0, (f32x4*)(p.out + (size_t)t * DM + col)); __builtin_nontemporal_store(o4, (f32x4*)(p.out + (size_t)t * DM + col + 256));
        }
    }
}

__global__ void __launch_bounds__(NTHR, 2) k_mega(Params p) {
    extern __shared__ __attribute__((aligned(16))) unsigned char lds_raw[];
    LAS unsigned char* lds = (LAS unsigned char*)lds_raw;
    const int tid = threadIdx.x, lane = tid & 63, wave = __builtin_amdgcn_readfirstlane(tid >> 6);
    volatile LAS unsigned* MISC = (volatile LAS unsigned*)(lds + MISC_OFF);
    for (int u = tid; u < (LDS_BYTES - RING_BYTES) / 4; u += NTHR) ((LAS unsigned*)(lds + RING_BYTES))[u] = 0u;
    __syncthreads();
    XcdBarrier bar = xcd_barrier_post((unsigned*)(p.ws + WS_CTL) + CW_BAR, MISC + 8);
    const int lo = p.ph_lo, hi = p.ph_hi;
#ifndef DUP_MASK
#define DUP_MASK 0
#endif
#define IN(k) (lo <= (k) && (k) < hi)
#define DUPK(k, body) do { if (IN(k)) { body; if ((DUP_MASK >> (k)) & 1) { xcd_barrier(bar); body; } } } while (0)
#ifdef SPIN_PHASE
#define STAMP(k) do { if (blockIdx.x == 0 && tid == 0) ((unsigned long long*)(p.ws + 49152))[k] = __builtin_amdgcn_s_memrealtime(); } while (0)
#else
#define STAMP(k) do { } while (0)
#endif
#define SEAM(k) do { if (IN(k) && IN((k) + 1)) { xcd_barrier(bar); STAMP((k) + 1); } } while (0)
    STAMP(0);
    DUPK(0, phase0(p, lds, wave, lane)); SEAM(0);
    DUPK(1, phase1(p, lds, wave, lane)); SEAM(1);
#ifdef EXTRA_BARS
    for (int eb = 0; eb < EXTRA_BARS; ++eb) xcd_barrier(bar);
#endif
    DUPK(2, phase2(p, lds)); SEAM(2);
    DUPK(3, phase3_gemms(p, lds); hgrn_pass1(p, lds, wave, lane)); SEAM(3);
    DUPK(4, hgrn_scan(p); phase4_qk(p, wave, lane); if ((DUP_MASK >> 17) & 1) { xcd_barrier(bar); phase4_qk(p, wave, lane); }); SEAM(4);
    DUPK(5, phase5_attn(p, lds, wave, lane); hgrn_pass3(p, lds, wave, lane); if ((DUP_MASK >> 16) & 1) { xcd_barrier(bar); hgrn_pass3(p, lds, wave, lane); }); if (IN(5) && IN(7)) { xcd_barrier(bar); STAMP(6); STAMP(7); }
    DUPK(7, phase7(p, lds)); SEAM(7);
    DUPK(8, phase8(p, lds, wave, lane)); SEAM(8);
    DUPK(9, phase9(p, lds, wave, lane)); SEAM(9);
    DUPK(10, phase10(p, lds)); SEAM(10);
    DUPK(11, phase11(p, lds)); SEAM(11);
    DUPK(12, phase12(p, wave, lane));
#ifdef SPIN_NTR
    { const int ntr = ((const int*)(p.ws + TAB_TILEEXP))[512]; const unsigned long long d = (unsigned long long)(ntr - 256) * 1000ull;
      const unsigned long long t0 = __builtin_amdgcn_s_memrealtime(); while (__builtin_amdgcn_s_memrealtime() - t0 < d) __builtin_amdgcn_s_sleep(8); }
#endif
#ifdef SPIN_PHASE
    xcd_barrier(bar); STAMP(13);
    xcd_barrier(bar);
    { const unsigned long long* ts = (const unsigned long long*)(p.ws + 49152);
      const unsigned long long d = __hip_atomic_load(ts + SPIN_PHASE + 1, __ATOMIC_RELAXED, __HIP_MEMORY_SCOPE_AGENT) - __hip_atomic_load(ts + SPIN_PHASE, __ATOMIC_RELAXED, __HIP_MEMORY_SCOPE_AGENT);
      const unsigned long long t0 = __builtin_amdgcn_s_memrealtime(); while (__builtin_amdgcn_s_memrealtime() - t0 < 4ull * d) __builtin_amdgcn_s_sleep(8); }
#endif
#undef IN
#undef SEAM
}
extern "C" void kernel_launch(void* const* d_in, const int* in_sizes, int n_in, void* d_out, int out_size, void* d_ws, size_t ws_size, hipStream_t stream) {
    static int grid = 0;
    if (grid == 0) {
        int dev = 0, cus = 0;
        if (hipGetDevice(&dev) != hipSuccess || hipDeviceGetAttribute(&cus, hipDeviceAttributeMultiprocessorCount, dev) != hipSuccess) { grid = -1; return; }
        if (hipFuncSetAttribute((const void*)k_mega, hipFuncAttributeMaxDynamicSharedMemorySize, LDS_BYTES) != hipSuccess) { fprintf(stderr, "kernel_launch: hipFuncSetAttribute failed\n"); grid = -1; return; }
        (void)hipGetLastError();
        grid = cus;
        if (n_in != 26 || ws_size < WS_END) { fprintf(stderr, "kernel_launch: unexpected inputs / workspace (%d, %zu)\n", n_in, ws_size); grid = -1; return; }
    }
    if (grid < 0) return;
    (void)hipMemsetAsync((char*)d_ws + WS_CTL, 0, CTL_ZERO_BYTES, stream);
    Params p{};
    for (int i = 0; i < 26; ++i) p.in[i] = (const float*)d_in[i];
    p.out = (float*)d_out; p.ws = (unsigned char*)d_ws; p.ph_lo = 0; p.ph_hi = 13;
    hipLaunchKernelGGL(k_mega, dim3(grid), dim3(NTHR), LDS_BYTES, stream, p);
}
```

```cpp
#include <hip/hip_runtime.h>
#include <cstdio>
#include <cstdint>
constexpr int NB = 4, SEQ = 2048, DM = 2048, NT = NB * SEQ;
constexpr int INC = 4928, INCP = 5120;
constexpr int MH = 8, QR = 512, KVR = 256, QKD = 192, VD = 128;
constexpr int NE = 64, DE = 512;
constexpr float EPS = 1e-6f;
constexpr int MODW = 6 * DM;
constexpr int NWAVES = 8, NTHR = 512;
constexpr int PROWS = 90112;
constexpr int ROUTED_ROWS_MAX = 81920;

constexpr size_t MiB = 1u << 20;
constexpr size_t WS_CTL = 0, CTL_ZERO_BYTES = 1 * MiB;
constexpr int CW_BAR = 1024;
constexpr size_t CTL_MOD = 64 * 1024;
constexpr size_t WS_MODP = 4 * MiB;
constexpr size_t TAB_SSQ_Q8 = 7 * MiB, TAB_SSQ_KV4 = 7 * MiB + 256 * 1024, TAB_SSQ_O8 = 7 * MiB + 512 * 1024;
constexpr size_t CTL_HIST = 416 * 1024;
constexpr size_t WS_TAB = 1 * MiB;
constexpr size_t TAB_HGD = WS_TAB;
constexpr size_t TAB_TOPI = WS_TAB + 1 * MiB;
constexpr size_t TAB_TOPW = TAB_TOPI + 256 * 1024;
constexpr size_t TAB_SLOT = TAB_TOPW + 256 * 1024;
constexpr size_t TAB_ROWTOK = TAB_SLOT + 256 * 1024;
constexpr size_t TAB_TILEEXP = TAB_ROWTOK + 512 * 1024;
constexpr size_t WS_BT_IN = 8 * MiB, WS_BT_UQ = 28 * MiB, WS_BT_KV = 30 * MiB, WS_BT_OUT = 32 * MiB, WS_BT_GU = 40 * MiB, WS_BT_DN = 300 * MiB;
constexpr size_t WS_U16 = 430 * MiB, WS_H1 = 462 * MiB, WS_HID = 526 * MiB, WS_X = 614 * MiB;
constexpr size_t WS_PROJ = WS_X, WS_QRAW = WS_X + 80 * MiB, WS_KRAW = WS_X + 104 * MiB, WS_VT = WS_X + 120 * MiB, WS_Q16 = WS_X + 136 * MiB, WS_K16 = WS_X + 160 * MiB,
                 WS_HGU = WS_X + 184 * MiB, WS_MERGED = WS_X + 216 * MiB, WS_Y = WS_X, WS_END = 966 * MiB;

constexpr int RING_BYTES = 131072, LDS_BYTES = 163840, MISC_OFF = LDS_BYTES - 256;

#define GAS __attribute__((address_space(1)))
#define LAS __attribute__((address_space(3)))
typedef unsigned short bf16_t;
typedef unsigned v4u __attribute__((ext_vector_type(4)));
typedef unsigned v2u __attribute__((ext_vector_type(2)));
typedef float f32x4 __attribute__((ext_vector_type(4)));
typedef GAS unsigned gu32;
#define RLX_AGENT __ATOMIC_RELAXED, __HIP_MEMORY_SCOPE_AGENT
__device__ __forceinline__ unsigned f2bf(float f) { unsigned u = __builtin_bit_cast(unsigned, f); return (u + 0x7fffu + ((u >> 16) & 1u)) >> 16; }
__device__ __forceinline__ unsigned pk2(float lo, float hi) { unsigned r; asm volatile("v_cvt_pk_bf16_f32 %0, %1, %2" : "=v"(r) : "v"(lo), "v"(hi)); return r; }
__device__ __forceinline__ float bf2f(unsigned short b) { return __builtin_bit_cast(float, ((unsigned)b) << 16); }
__device__ __forceinline__ float bflo(unsigned w) { return __builtin_bit_cast(float, w << 16); }
__device__ __forceinline__ float bfhi(unsigned w) { return __builtin_bit_cast(float, w & 0xffff0000u); }
__device__ __forceinline__ float sigmoidf_(float x) { return 1.f / (1.f + __expf(-x)); }
__device__ __forceinline__ float siluf_(float x) { return x / (1.f + __expf(-x)); }
__device__ __forceinline__ float wave_sum(float v) {
#pragma unroll
    for (int o = 1; o < 64; o <<= 1) v += __shfl_xor(v, o);
    return v;
}

#define XB_TMO      128
#define XB_XCNT(j)  (256  + 64 * (j))
#define XB_XSUB(j)  (1280 + 64 * (j))
#define XB_XGEN(j)  (2304 + 64 * (j))
#define XB_TOP      3328
#define XB_TOPGEN   3392
#define XCD_BAR_WORDS 3456
#define XB_SPIN_CAP (1u << 18)
__device__ __forceinline__ unsigned xb_ld(unsigned* p)              { return __hip_atomic_load(p, __ATOMIC_RELAXED, __HIP_MEMORY_SCOPE_AGENT); }
__device__ __forceinline__ unsigned xb_add(unsigned* p, unsigned v) { return __hip_atomic_fetch_add(p, v, __ATOMIC_RELAXED, __HIP_MEMORY_SCOPE_AGENT); }
__device__ __forceinline__ unsigned xb_xcc_id() { return (unsigned)__builtin_amdgcn_s_getreg((3 << 11) | 20) & 0xFu; }
#define XB_SPIN(cond, bar) do { unsigned _sp = 0; while (cond) { __builtin_amdgcn_s_sleep(1); \
    if ((++_sp & 255u) == 0u) { if (xb_ld(&(bar)[XB_TMO])) break; if (_sp > XB_SPIN_CAP) { atomicAdd(&(bar)[XB_TMO], 1u); break; } } } } while (0)
struct XcdBarrier { unsigned* bar; unsigned x; volatile LAS unsigned* st; };
__device__ __forceinline__ XcdBarrier xcd_barrier_post(unsigned* bar, volatile LAS unsigned* st) {
    XcdBarrier b; b.bar = bar; b.x = xb_xcc_id(); b.st = st;
    if (threadIdx.x == 0) (void)xb_add(&bar[XB_XCNT(b.x)], 1u);
    return b;
}
__device__ __forceinline__ void xcd_barrier_complete(unsigned* bar, unsigned x, unsigned& nloc, unsigned& nx) {
    const unsigned G = gridDim.x * gridDim.y * gridDim.z;
    unsigned sum, cnt, mine, sp = 0u;
    for (;;) {
        sum = 0u; cnt = 0u; mine = 0u;
#pragma unroll
        for (unsigned j = 0; j < 16; ++j) { const unsigned c = xb_ld(&bar[XB_XCNT(j)]); sum += c; cnt += (c > 0u) ? 1u : 0u; mine = (j == x) ? c : mine; }
        if (sum == G) break;
        __builtin_amdgcn_s_sleep(1);
        if ((++sp & 255u) == 0u) { if (xb_ld(&bar[XB_TMO])) break; if (sp > XB_SPIN_CAP) { atomicAdd(&bar[XB_TMO], 1u); break; } }
    }
    nloc = mine > 0u ? mine : 1u; nx = cnt > 0u ? cnt : 1u;
}
__device__ __forceinline__ void xcd_barrier(const XcdBarrier& b) {
    asm volatile("s_waitcnt vmcnt(0)" ::: "memory");
    __syncthreads();
    if (threadIdx.x == 0) {
        unsigned* bar = b.bar;
        __builtin_amdgcn_s_waitcnt(0);
        unsigned nloc = b.st[0], nx = b.st[1];
        if (nloc == 0u) { xcd_barrier_complete(bar, b.x, nloc, nx); b.st[0] = nloc; b.st[1] = nx; }
        const unsigned old = xb_add(&bar[XB_XSUB(b.x)], 1u);
        const unsigned gen = old / nloc;
        if (old + 1u == (gen + 1u) * nloc) {
            __builtin_amdgcn_fence(__ATOMIC_RELEASE, "agent");
            asm volatile("s_waitcnt vmcnt(0)" ::: "memory");
            const unsigned og = xb_add(&bar[XB_TOP], 1u);
            const unsigned tg = og / nx;
            if (og + 1u == (tg + 1u) * nx) xb_add(&bar[XB_TOPGEN], 1u);
            else XB_SPIN(xb_ld(&bar[XB_TOPGEN]) == tg, bar);
            __builtin_amdgcn_fence(__ATOMIC_ACQUIRE, "agent");
            xb_add(&bar[XB_XGEN(b.x)], 1u);
            asm volatile("s_waitcnt vmcnt(0)" ::: "memory");
        } else {
            XB_SPIN(xb_ld(&bar[XB_XGEN(b.x)]) == gen, bar);
            __builtin_amdgcn_fence(__ATOMIC_ACQUIRE, "agent");
            asm volatile("s_waitcnt vmcnt(0)" ::: "memory");
        }
    }
    __syncthreads();
}

struct Params { const float* in[26]; float* out; unsigned char* ws; int ph_lo, ph_hi; };
namespace pg8 {
#define PG8_LAS __attribute__((address_space(3)))
typedef unsigned short bf16_t;
typedef short bf16x8 __attribute__((ext_vector_type(8)));
typedef float f32x4 __attribute__((ext_vector_type(4)));
typedef unsigned u32x4 __attribute__((ext_vector_type(4)));
typedef unsigned u32x2 __attribute__((ext_vector_type(2)));
constexpr int BM = 256, BK = 64, HALF = 128, HTB = HALF * BK * 2, STAGE_BYTES = 8 * HTB, NXCD = 8, WGM = 8;

__host__ __device__ __forceinline__ int lds_byte(int r, int c) { const int st = (r >> 4) * 2 + (c >> 5), rr = r & 15, cc = c & 31, ob = rr * 64 + cc * 2; return st * 1024 + (ob ^ (((ob >> 9) & 1) << 5)); }
__host__ __device__ __forceinline__ void stage_rc(int b, int& R, int& C) { const int st = b / 1024, sb = b % 1024, swz = sb ^ (((sb >> 9) & 1) << 5); R = (st >> 1) * 16 + swz / 64; C = (st & 1) * 32 + (swz % 64) / 2; }
__host__ __device__ __forceinline__ int perm32(int rho) { const int n = rho >> 4, i = rho & 15; return 8 * (i >> 2) + 4 * n + (i & 3); }

struct Unit { int pm, pn; long boff; int mask, pad; };
struct Gemm { const bf16_t* A; const bf16_t* Bt; const int* rowtab; int lda, ldb, K, pad; };

__device__ __forceinline__ unsigned cvt_pk_bf16(float lo, float hi) { unsigned r; asm volatile("v_cvt_pk_bf16_f32 %0, %1, %2" : "=v"(r) : "v"(lo), "v"(hi)); return r; }

struct StaticOrder {
    int nM, nN, nwg, G, c, nfull, T; long bstep;
    __device__ void init(int nM_, int nN_, int G_, int c_, int ldb) { nM = nM_; nN = nN_; nwg = nM * nN; G = G_; c = c_; bstep = (long)BM * ldb * 2;
        T = 0; nfull = nwg; }
    __device__ bool next(int i, Unit& u) const {
        const long L = (long)i * G + c; int wgid, mask = 15;
        if (L < nfull) wgid = (int)L;
        else { const long j = L - nfull; if (j >= 2 * T) return false; wgid = nfull + (int)(j % T); mask = (j / T) ? 12 : 3; }
        { const int q = nwg / NXCD, r = nwg % NXCD, xcd = wgid % NXCD, off = wgid / NXCD; wgid = (xcd < r ? xcd * (q + 1) : r * (q + 1) + (xcd - r) * q) + off; }
        const int nig = WGM * nN, gid = wgid / nig, fm = gid * WGM, gsz = (nM - fm) < WGM ? (nM - fm) : WGM;
        u.pm = fm + ((wgid % nig) % gsz); u.pn = (wgid % nig) / gsz; u.boff = (long)u.pn * bstep; u.mask = mask; u.pad = i; return true;
    }
};

typedef long i64x2 __attribute__((ext_vector_type(2)));
template <class Epi, class Sched, int ES = 2, bool ALIGN_EPI = true>
__device__ __forceinline__ void gemm_phase(PG8_LAS unsigned char* lds, const Gemm g, const Sched& S, const Epi& E) {
    const int tid = threadIdx.x, wid = __builtin_amdgcn_readfirstlane(tid >> 6), lane = tid & 63, wr = wid >> 2, wc = wid & 3, fr = lane & 15, fq = lane >> 4;
    const int K = g.K, nt = K * ES / (BK * 2);
    int Rr[2]; unsigned Cb[2], voffB[2];
#pragma unroll
    for (int i = 0; i < 2; ++i) { int R, C; stage_rc(tid * 16 + i * 8192, R, C); const int Rb = Epi::PERM ? ((R & ~31) + perm32(R & 31)) : R;
        Rr[i] = R; Cb[i] = (unsigned)C * 2u; voffB[i] = (unsigned)(Rb * g.ldb) * (unsigned)ES + (unsigned)C * 2u; }
    const size_t kstep = (size_t)(BK * 2);
    const size_t hstepB = (size_t)HALF * g.ldb * ES;
    const unsigned lda2 = (unsigned)g.lda * (unsigned)ES;
    const unsigned ldsw = (unsigned)wid * 1024u;
    const int aoff = lds_byte(wr * 64 + fr, fq * 8), boff = lds_byte(wc * 32 + fr, fq * 8);
    const char* const Abase = (const char*)g.A; const char* const Bbase = (const char*)g.Bt;
#define PG8_SA(b, h) (((b) * 2 + (h)) * HTB)
#define PG8_SB(b, h) ((4 + (b) * 2 + (h)) * HTB)
#define PG8_STAGE(bufoff, gbase, voff) do { _Pragma("unroll") for (int _i = 0; _i < 2; ++_i) \
        __builtin_amdgcn_global_load_lds((const unsigned*)((const char*)(gbase) + (voff)[_i]), (PG8_LAS unsigned*)(lds + (bufoff) + ldsw + _i * 8192), 16, 0, 0); } while (0)
#define PG8_VOFFA(u, v) do { _Pragma("unroll") for (int _h = 0; _h < 2; ++_h) _Pragma("unroll") for (int _i = 0; _i < 2; ++_i) { const int _gr = (u).pm * BM + _h * HALF + Rr[_i]; \
        const int _src = g.rowtab ? g.rowtab[_gr] : _gr; (v)[_h][_i] = (unsigned)_src * lda2 + Cb[_i]; } } while (0)
#define PG8_LDA(dst, b, h) do { _Pragma("unroll") for (int m = 0; m < 4; ++m) _Pragma("unroll") for (int k = 0; k < 2; ++k) dst[m][k] = *(const PG8_LAS bf16x8*)(lds + PG8_SA(b, h) + aoff + m * 2048 + k * 1024); } while (0)
#define PG8_LDB(dst, b, h) do { _Pragma("unroll") for (int n = 0; n < 2; ++n) _Pragma("unroll") for (int k = 0; k < 2; ++k) dst[n][k] = *(const PG8_LAS bf16x8*)(lds + PG8_SB(b, h) + boff + n * 2048 + k * 1024); } while (0)
#define PG8_MMA(ai, bj, At, Bt) do { __builtin_amdgcn_s_setprio(1); \
        if constexpr (ES == 2) { _Pragma("unroll") for (int m = 0; m < 4; ++m) _Pragma("unroll") for (int n = 0; n < 2; ++n) _Pragma("unroll") for (int k = 0; k < 2; ++k) \
            acc[ai][bj][m][n] = __builtin_amdgcn_mfma_f32_16x16x32_bf16(Bt[n][k], At[m][k], acc[ai][bj][m][n], 0, 0, 0); } \
        else { _Pragma("unroll") for (int m = 0; m < 4; ++m) _Pragma("unroll") for (int n = 0; n < 2; ++n) _Pragma("unroll") for (int k = 0; k < 2; ++k) { \
            const i64x2 _a = __builtin_bit_cast(i64x2, At[m][k]), _b = __builtin_bit_cast(i64x2, Bt[n][k]); \
            acc[ai][bj][m][n] = __builtin_amdgcn_mfma_f32_16x16x32_fp8_fp8(_b.x, _a.x, acc[ai][bj][m][n], 0, 0, 0); \
            acc[ai][bj][m][n] = __builtin_amdgcn_mfma_f32_16x16x32_fp8_fp8(_b.y, _a.y, acc[ai][bj][m][n], 0, 0, 0); } } \
        __builtin_amdgcn_s_setprio(0); } while (0)
#define PG8_WAIT_V(n) asm volatile("s_waitcnt vmcnt(" #n ")" ::: "memory")
#define PG8_WAIT_L(n) asm volatile("s_waitcnt lgkmcnt(" #n ")" ::: "memory")
#define PG8_BAR __builtin_amdgcn_s_barrier()
#define PG8_SCHED __builtin_amdgcn_sched_barrier(0)
    Unit cur, nxt; int ui = 0;
    if (!S.next(0, cur)) return;
    f32x4 acc[2][2][4][2];
#pragma unroll
    for (int a = 0; a < 2; ++a)
#pragma unroll
        for (int b = 0; b < 2; ++b)
#pragma unroll
            for (int m = 0; m < 4; ++m)
#pragma unroll
                for (int n = 0; n < 2; ++n) acc[a][b][m][n] = (f32x4){0.f, 0.f, 0.f, 0.f};
    bf16x8 At[4][2], B0[2][2], B1[2][2];
    unsigned cv[2][2], nv[2][2];
    PG8_VOFFA(cur, cv);
#pragma unroll
    for (int h = 0; h < 2; ++h) { nv[h][0] = cv[h][0]; nv[h][1] = cv[h][1]; }
    const char* cB = Bbase + cur.boff;
    PG8_STAGE(PG8_SB(0, 0), cB, voffB); PG8_STAGE(PG8_SB(0, 1), cB + hstepB, voffB); PG8_STAGE(PG8_SA(0, 0), Abase, cv[0]); PG8_STAGE(PG8_SA(0, 1), Abase, cv[1]);
    if (wr == 1) PG8_BAR;
    PG8_WAIT_V(2); PG8_BAR;
    PG8_STAGE(PG8_SB(1, 0), cB + kstep, voffB); PG8_STAGE(PG8_SA(1, 0), Abase + kstep, cv[0]); PG8_STAGE(PG8_SB(1, 1), cB + hstepB + kstep, voffB);
    PG8_WAIT_V(6); PG8_BAR;
    for (;;) {
        const bool has_next = S.next(ui + 1, nxt);
        const char* nB = has_next ? Bbase + nxt.boff : cB;
#pragma unroll 1
        for (int t = 0; t < nt; t += 2) {
            const bool last = (t == nt - 2);
            if constexpr (Epi::MIDK) { if (t == nt / 2) E.mid(acc, cur, wr, wc, fr, fq); }
            if (last && has_next) { PG8_VOFFA(nxt, nv); }
            const char* a1 = Abase + (size_t)(t + 1) * kstep;
            const char* a2 = Abase + (last ? (size_t)0 : (size_t)(t + 2) * kstep); const char* a3 = a2 + kstep;
            const char* b2 = last ? nB : cB + (size_t)(t + 2) * kstep; const char* b3 = b2 + kstep;
            unsigned x0[2], x1[2];
            x0[0] = last ? nv[0][0] : cv[0][0]; x0[1] = last ? nv[0][1] : cv[0][1]; x1[0] = last ? nv[1][0] : cv[1][0]; x1[1] = last ? nv[1][1] : cv[1][1];
            PG8_LDB(B0, 0, 0); PG8_LDB(B1, 0, 1); PG8_SCHED; PG8_LDA(At, 0, 0); PG8_STAGE(PG8_SA(1, 1), a1, cv[1]);
            PG8_WAIT_V(8); PG8_WAIT_L(0); PG8_BAR; PG8_MMA(0, 0, At, B0); PG8_MMA(0, 1, At, B1); PG8_BAR; PG8_SCHED;
            PG8_LDA(At, 0, 1); PG8_STAGE(PG8_SB(0, 0), b2, voffB); PG8_STAGE(PG8_SB(0, 1), b2 + hstepB, voffB); PG8_STAGE(PG8_SA(0, 0), a2, x0);
            PG8_WAIT_V(8); PG8_WAIT_L(0); PG8_BAR; PG8_MMA(1, 0, At, B0); PG8_MMA(1, 1, At, B1); PG8_BAR; PG8_SCHED;
            PG8_LDB(B0, 1, 0); PG8_LDB(B1, 1, 1); PG8_SCHED; PG8_LDA(At, 1, 0); PG8_STAGE(PG8_SA(0, 1), a2, x1);
            PG8_WAIT_V(8); PG8_WAIT_L(0); PG8_BAR; PG8_MMA(0, 0, At, B0); PG8_MMA(0, 1, At, B1); PG8_BAR; PG8_SCHED;
            PG8_LDA(At, 1, 1); PG8_STAGE(PG8_SB(1, 0), b3, voffB); PG8_STAGE(PG8_SB(1, 1), b3 + hstepB, voffB); PG8_STAGE(PG8_SA(1, 0), a3, x0);
            PG8_WAIT_V(8); PG8_WAIT_L(0); PG8_BAR; PG8_MMA(1, 0, At, B0); PG8_MMA(1, 1, At, B1); PG8_BAR; PG8_SCHED;
        }
        if constexpr (ALIGN_EPI) { if (wr == 0) PG8_BAR; }
        E(acc, cur, wr, wc, fr, fq);
        if (!has_next) break;
#pragma unroll
        for (int a = 0; a < 2; ++a)
#pragma unroll
            for (int b = 0; b < 2; ++b)
#pragma unroll
                for (int m = 0; m < 4; ++m)
#pragma unroll
                    for (int n = 0; n < 2; ++n) acc[a][b][m][n] = (f32x4){0.f, 0.f, 0.f, 0.f};
        cur = nxt; cB = nB; ++ui;
#pragma unroll
        for (int h = 0; h < 2; ++h) { cv[h][0] = nv[h][0]; cv[h][1] = nv[h][1]; }
        if constexpr (ALIGN_EPI) { if (wr == 1) PG8_BAR; }
    }
    PG8_WAIT_V(0);
    if constexpr (!ALIGN_EPI) { if (wr == 0) PG8_BAR; }
    PG8_BAR;
#undef PG8_SA
#undef PG8_SB
#undef PG8_STAGE
#undef PG8_VOFFA
#undef PG8_LDA
#undef PG8_LDB
#undef PG8_MMA
#undef PG8_WAIT_V
#undef PG8_WAIT_L
#undef PG8_BAR
#undef PG8_SCHED
}
}
__device__ __forceinline__ void conv_tile(const float* __restrict__ src, int ldn, int k0, int n0, const float* __restrict__ kscale, int kfrom,
                                          bf16_t* __restrict__ dst, int dld, int drow0, LAS unsigned* T, int lane, int dk0 = -1) {
    if (dk0 < 0) dk0 = k0;
    const int c4 = lane & 15, kq = lane >> 4;
    f32x4 v0[8], v1[8];
#pragma unroll
    for (int j = 0; j < 8; ++j) { const int kp = kq + 4 * j; const float* p = src + (size_t)(k0 + 2 * kp) * ldn + n0 + c4 * 4;
        v0[j] = *(const f32x4*)p; v1[j] = *(const f32x4*)(p + ldn); }
#pragma unroll
    for (int j = 0; j < 8; ++j) { const int kp = kq + 4 * j; const int k = k0 + 2 * kp;
        float s0 = 1.f, s1 = 1.f; if (kscale && k >= kfrom) { s0 = kscale[k - kfrom]; s1 = kscale[k + 1 - kfrom]; }
#pragma unroll
        for (int q = 0; q < 4; ++q) T[(c4 * 4 + q) * 33 + kp] = pk2(v0[j][q] * s0, v1[j][q] * s1); }
    asm volatile("s_waitcnt lgkmcnt(0)" ::: "memory"); __builtin_amdgcn_wave_barrier();
    const int ch = lane & 7, nr = lane >> 3;
#pragma unroll
    for (int ps = 0; ps < 8; ++ps) { const int n = ps * 8 + nr; const LAS unsigned* t = T + n * 33 + ch * 4;
        v4u o; o.x = t[0]; o.y = t[1]; o.z = t[2]; o.w = t[3];
        *(v4u*)(dst + (size_t)(drow0 + n) * dld + dk0 + ch * 8) = o; }
    asm volatile("s_waitcnt lgkmcnt(0)" ::: "memory"); __builtin_amdgcn_wave_barrier();
}

__device__ __forceinline__ void conv_tile128(const float* __restrict__ src, int ldn, int k0, int n0, bf16_t* __restrict__ dst, int dld, int drow0, LAS unsigned* T, int lane) {
    const int c4 = lane & 15, kq = lane >> 4;
    f32x4 v0[16], v1[16];
#pragma unroll
    for (int j = 0; j < 16; ++j) { const int kp = kq + 4 * j; const float* q = src + (size_t)(k0 + 2 * kp) * ldn + n0 + c4 * 4;
        v0[j] = __builtin_nontemporal_load((const f32x4*)q); v1[j] = __builtin_nontemporal_load((const f32x4*)(q + ldn)); }
#pragma unroll
    for (int j = 0; j < 16; ++j) { const int kp = kq + 4 * j;
#pragma unroll
        for (int q = 0; q < 4; ++q) T[(c4 * 4 + q) * 65 + kp] = pk2(v0[j][q], v1[j][q]); }
    asm volatile("s_waitcnt lgkmcnt(0)" ::: "memory"); __builtin_amdgcn_wave_barrier();
    const int ch = lane & 15, nr = lane >> 4;
#pragma unroll
    for (int ps = 0; ps < 16; ++ps) { const int n = ps * 4 + nr; const LAS unsigned* t = T + n * 65 + ch * 4;
        v4u o; o.x = t[0]; o.y = t[1]; o.z = t[2]; o.w = t[3];
        __builtin_nontemporal_store(o, (v4u*)(dst + (size_t)(drow0 + n) * dld + k0 + ch * 8)); }
    asm volatile("s_waitcnt lgkmcnt(0)" ::: "memory"); __builtin_amdgcn_wave_barrier();
}

__device__ __forceinline__ unsigned pk4_fp8(float a, float b, float c, float d) {
    int w = 0; w = __builtin_amdgcn_cvt_pk_fp8_f32(__builtin_amdgcn_fmed3f(a, -448.f, 448.f), __builtin_amdgcn_fmed3f(b, -448.f, 448.f), w, false);
    w = __builtin_amdgcn_cvt_pk_fp8_f32(__builtin_amdgcn_fmed3f(c, -448.f, 448.f), __builtin_amdgcn_fmed3f(d, -448.f, 448.f), w, true); return (unsigned)w; }
__device__ __forceinline__ void conv_tile128_fp8(const float* __restrict__ src, int ldn, int k0, int n0, unsigned char* __restrict__ dst, int dld, int drow0, LAS unsigned* T, int lane) {
    const int c4 = lane & 15, kq = lane >> 4;
#pragma unroll 1
    for (int hf = 0; hf < 2; ++hf) {
        f32x4 v[8][4];
#pragma unroll
        for (int j = 0; j < 8; ++j) { const float* q = src + (size_t)(k0 + hf * 128 + 4 * (kq + 4 * j)) * ldn + n0 + c4 * 4;
#pragma unroll
            for (int r = 0; r < 4; ++r) v[j][r] = __builtin_nontemporal_load((const f32x4*)(q + (size_t)r * ldn)); }
#pragma unroll
        for (int j = 0; j < 8; ++j) { const int kp = hf * 32 + kq + 4 * j;
#pragma unroll
            for (int q = 0; q < 4; ++q) T[(c4 * 4 + q) * 65 + kp] = pk4_fp8(v[j][0][q] * 64.f, v[j][1][q] * 64.f, v[j][2][q] * 64.f, v[j][3][q] * 64.f); }
    }
    asm volatile("s_waitcnt lgkmcnt(0)" ::: "memory"); __builtin_amdgcn_wave_barrier();
    const int ch = lane & 15, nr = lane >> 4;
#pragma unroll
    for (int ps = 0; ps < 16; ++ps) { const int n = ps * 4 + nr; const LAS unsigned* t = T + n * 65 + ch * 4;
        v4u o; o.x = t[0]; o.y = t[1]; o.z = t[2]; o.w = t[3];
        __builtin_nontemporal_store(o, (v4u*)(dst + (size_t)(drow0 + n) * dld + k0 + ch * 16)); }
    asm volatile("s_waitcnt lgkmcnt(0)" ::: "memory"); __builtin_amdgcn_wave_barrier();
}

__device__ __forceinline__ void ada_item(const float* __restrict__ c, const float* __restrict__ w, float* __restrict__ modp, int item, int lane) {
    const int cc = item % 48, ks = item / 48, col = cc * 256 + lane * 4;
    f32x4 acc[4];
#pragma unroll
    for (int b = 0; b < 4; ++b) acc[b] = (f32x4){0.f, 0.f, 0.f, 0.f};
#pragma unroll 1
    for (int half = 0; half < 2; ++half) {
        const int k0 = ks * 128 + half * 64;
        float cd[4];
#pragma unroll
        for (int b = 0; b < 4; ++b) cd[b] = siluf_(c[b * DM + k0 + lane]);
        const float* wp = w + (size_t)k0 * MODW + col;
#pragma unroll 16
        for (int kk = 0; kk < 64; ++kk) { const f32x4 wv = __builtin_nontemporal_load((const f32x4*)(wp + (size_t)kk * MODW));
#pragma unroll
            for (int b = 0; b < 4; ++b) { const float s = __builtin_bit_cast(float, __builtin_amdgcn_readlane(__builtin_bit_cast(int, cd[b]), kk)); acc[b] += wv * s; } }
    }
#pragma unroll
    for (int b = 0; b < 4; ++b) *(f32x4*)(modp + ((size_t)ks * 4 + b) * MODW + col) = acc[b];
}

constexpr int CT_ADA = 48 * 16;
constexpr int CT_IN = 32 * 77, CT_UQ = 8 * 24, CT_KV = 4 * 32, CT_OUT = 32 * 32, CT_G1 = 8 * 8, CT_D1 = 2 * 32;
constexpr int CT_ZERO = 192 * 4;
constexpr int CT_GU = 65 * 2 * CT_G1, CT_DN = 65 * CT_D1;
constexpr int CT_GU_LATE = 0;
constexpr int CT_TOTAL0 = CT_ADA + CT_IN + CT_UQ + CT_KV + CT_OUT + CT_ZERO + (CT_GU - CT_GU_LATE) + CT_DN;
constexpr int CW_QGU = 8192, CW_QDN = 8192 + 512;

__device__ __forceinline__ void conv_gu_tile(const Params& p, int r, LAS unsigned* T, int lane) {
    const int e = r / (2 * CT_G1); int q = r % (2 * CT_G1);
    unsigned char* gu = p.ws + WS_BT_GU + (size_t)e * 1024 * DM;
    const int up = q >= CT_G1; q -= up * CT_G1; const int kb = q / 8, nb = q % 8, n0 = nb * 64;
    const float* src = (e < 64) ? p.in[up ? 21 : 20] + (size_t)e * DM * DE : p.in[up ? 24 : 23];
    conv_tile128_fp8(src, DE, kb * 256, n0, gu, DM, (n0 >> 7) * 256 + up * 128 + (n0 & 127), T, lane);
}
__device__ __forceinline__ void conv_dn_tile(const Params& p, int r, LAS unsigned* T, int lane) {
    const int e = r / CT_D1, q = r % CT_D1, kb = q / 32, nb = q % 32;
    unsigned char* dn = p.ws + WS_BT_DN + (size_t)e * DM * DE;
    const float* src = (e < 64) ? p.in[22] + (size_t)e * DE * DM : p.in[25];
    conv_tile128_fp8(src, DM, kb * 256, nb * 64, dn, DE, nb * 64, T, lane);
}
template <bool DN>
__device__ __forceinline__ void conv_queue(const Params& p, LAS unsigned char* lds, int wave, int lane, int first, int total) {
    LAS unsigned* T = (LAS unsigned*)(lds + wave * 18432);
    unsigned* heads = (unsigned*)(p.ws + WS_CTL) + (DN ? CW_QDN : CW_QGU);
    const int n = total - first, per = (n + 7) / 8, xcd = (int)xb_xcc_id() & 7;
    for (int s = 0; s < 8; ++s) {
        const int sh = (xcd + s) & 7, lo = first + sh * per, hi = (lo + per < total) ? lo + per : total;
        for (;;) {
            unsigned i = 0; if (lane == 0) i = __hip_atomic_fetch_add(heads + 64 * sh, 2u, __ATOMIC_RELAXED, __HIP_MEMORY_SCOPE_AGENT);
            const int r = lo + (int)__builtin_amdgcn_readfirstlane(i);
            if (r >= hi) break;
            if (DN) conv_dn_tile(p, r, T, lane); else conv_gu_tile(p, r, T, lane);
            if (r + 1 < hi) { if (DN) conv_dn_tile(p, r + 1, T, lane); else conv_gu_tile(p, r + 1, T, lane); }
        }
    }
}

struct ETile { const float* src; unsigned char* dst; int ldn, dld; };
__device__ __forceinline__ ETile etile_decode(const Params& p, int r) {
    ETile t;
    if (r < CT_GU) { const int e = r / (2 * CT_G1); int q = r % (2 * CT_G1); const int up = q >= CT_G1; q -= up * CT_G1; const int kb = q / 8, nb = q % 8, n0 = nb * 64;
        t.src = ((e < 64) ? p.in[up ? 21 : 20] + (size_t)e * DM * DE : p.in[up ? 24 : 23]) + (size_t)(kb * 256) * DE + n0; t.ldn = DE;
        t.dst = p.ws + WS_BT_GU + (size_t)e * 1024 * DM + (size_t)((n0 >> 7) * 256 + up * 128 + (n0 & 127)) * DM + kb * 256; t.dld = DM; }
    else { const int rr = r - CT_GU; const int e = rr / CT_D1, q = rr % CT_D1, kb = q / 32, nb = q % 32;
        t.src = ((e < 64) ? p.in[22] + (size_t)e * DE * DM : p.in[25]) + (size_t)(kb * 256) * DM + nb * 64; t.ldn = DM;
        t.dst = p.ws + WS_BT_DN + (size_t)e * DM * DE + (size_t)(nb * 64) * DE + kb * 256; t.dld = DE; }
    return t;
}
constexpr int CT_EXP_LATE2 = 2048, CT_EXP_LATE3 = 512;
__device__ __forceinline__ int p2_first_idle(int G) { const int nunits = (NT / 256) * (INCP / 256), rounds = (nunits + G - 1) / G; return nunits - (rounds - 1) * G; }
__device__ __forceinline__ int exp_late2(int G) { return (p2_first_idle(G) < G && (G - p2_first_idle(G)) * NWAVES * 2 >= CT_EXP_LATE2) ? CT_EXP_LATE2 : 0; }
__device__ __forceinline__ int exp_late3(int G) { return (G == 256) ? CT_EXP_LATE3 : 0; }
__device__ __forceinline__ void expert_stream(const Params& p, LAS unsigned* T, int gw, int NGW, int lane, int NEXP) {
    int r = gw; if (r >= NEXP) return;
    const int c4 = lane & 15, kq = lane >> 4, ch = lane & 15, nr = lane >> 4;
    ETile cur = etile_decode(p, r);
    f32x4 A[16], B[16];
#define ES_LOADQ(R, t, qd) do { _Pragma("unroll") for (int j = 0; j < 4; ++j) { const float* q_ = (t).src + (size_t)((qd) * 64 + 4 * (kq + 4 * j)) * (t).ldn + c4 * 4; \
        _Pragma("unroll") for (int rr = 0; rr < 4; ++rr) R[j * 4 + rr] = __builtin_nontemporal_load((const f32x4*)(q_ + (size_t)rr * (t).ldn)); } } while (0)
#define ES_CONVQ(R, qd) do { _Pragma("unroll") for (int j = 0; j < 4; ++j) { const int kp = (qd) * 16 + kq + 4 * j; \
        _Pragma("unroll") for (int q = 0; q < 4; ++q) T[(c4 * 4 + q) * 65 + kp] = pk4_fp8(R[j * 4 + 0][q] * 64.f, R[j * 4 + 1][q] * 64.f, R[j * 4 + 2][q] * 64.f, R[j * 4 + 3][q] * 64.f); } } while (0)
    ES_LOADQ(A, cur, 0);
    for (;;) {
        const int rn = r + NGW; const bool hn = rn < NEXP; const ETile nxt = hn ? etile_decode(p, rn) : cur;
        ES_LOADQ(B, cur, 1); ES_CONVQ(A, 0);
        ES_LOADQ(A, cur, 2); ES_CONVQ(B, 1);
        ES_LOADQ(B, cur, 3); ES_CONVQ(A, 2);
        if (hn) ES_LOADQ(A, nxt, 0);
        ES_CONVQ(B, 3);
        asm volatile("s_waitcnt lgkmcnt(0)" ::: "memory"); __builtin_amdgcn_wave_barrier();
#pragma unroll
        for (int ps = 0; ps < 16; ++ps) { const int n = ps * 4 + nr; const LAS unsigned* t = T + n * 65 + ch * 4;
            v4u o; o.x = t[0]; o.y = t[1]; o.z = t[2]; o.w = t[3];
            __builtin_nontemporal_store(o, (v4u*)(cur.dst + (size_t)n * cur.dld + ch * 16)); }
        asm volatile("s_waitcnt lgkmcnt(0)" ::: "memory"); __builtin_amdgcn_wave_barrier();
        if (!hn) break;
        cur = nxt; r = rn;
    }
#undef ES_LOADQ
#undef ES_CONVQ
}

constexpr int CT_SMALL = CT_IN + CT_UQ + CT_KV + CT_OUT + CT_ZERO;
__device__ __forceinline__ void phase0(const Params& p, LAS unsigned char* lds, int wave, int lane) {
    LAS unsigned* T = (LAS unsigned*)(lds + wave * 18432);
    unsigned char* ws = p.ws;
    float* modp = (float*)(ws + WS_MODP);
    const int gw = blockIdx.x * NWAVES + wave, NGW = gridDim.x * NWAVES;
    for (int it = gw; it < CT_ADA; it += NGW) ada_item(p.in[1], p.in[3], modp, it, lane);
    expert_stream(p, T, (gw + NGW - (CT_ADA % NGW)) % NGW, NGW, lane, CT_GU + CT_DN - exp_late2(gridDim.x) - exp_late3(gridDim.x));
    for (int it = gw; it < CT_SMALL; it += NGW) {
        int r = it;
        if (r < CT_IN) { const int kb = r / 77, nb = r % 77; conv_tile(p.in[7], INC, kb * 64, nb * 64, nullptr, 0, (bf16_t*)(ws + WS_BT_IN), DM, nb * 64, T, lane); continue; } r -= CT_IN;
        if (r < CT_UQ) { const int kb = r / 24, nb = r % 24; conv_tile(p.in[11], 1536, kb * 64, nb * 64, p.in[10], 0, (bf16_t*)(ws + WS_BT_UQ), QR, nb * 64, T, lane); continue; } r -= CT_UQ;
        if (r < CT_KV) { const int kb = r / 32, nb = r % 32, n0 = nb * 64, h = n0 >> 8, j0 = n0 & 255; const int dr = (j0 < 128) ? h * 128 + j0 : 1024 + h * 128 + (j0 - 128);
                         conv_tile(p.in[13], 2048, kb * 64, n0, p.in[12], 0, (bf16_t*)(ws + WS_BT_KV), KVR, dr, T, lane); continue; } r -= CT_KV;
        if (r < CT_OUT) { const int kb = r / 32, nb = r % 32; conv_tile(p.in[17], DM, kb * 64, nb * 64, p.in[16], 1024, (bf16_t*)(ws + WS_BT_OUT), DM, nb * 64, T, lane, (kb * 64 + 1024) & 2047); continue; } r -= CT_OUT;
        { const int row = INC + (r >> 2), pc = r & 3; v4u z = {0u, 0u, 0u, 0u}; *(v4u*)((bf16_t*)(ws + WS_BT_IN) + (size_t)row * DM + pc * 512 + lane * 8) = z; }
    }
}

__device__ __forceinline__ void norm_mod_row(const float* __restrict__ hrow, const float* __restrict__ g, const float* __restrict__ sc, const float* __restrict__ sh, bf16_t* __restrict__ urow, int lane) {
    f32x4 v[8]; float s = 0.f;
#pragma unroll
    for (int j = 0; j < 8; ++j) { v[j] = *(const f32x4*)(hrow + lane * 4 + 256 * j); s += (v[j].x * v[j].x + v[j].y * v[j].y) + (v[j].z * v[j].z + v[j].w * v[j].w); }
    const float r = rsqrtf(wave_sum(s) * (1.f / DM) + EPS);
#pragma unroll
    for (int j = 0; j < 8; ++j) { const int col = lane * 4 + 256 * j; const f32x4 gv = *(const f32x4*)(g + col), sv = *(const f32x4*)(sc + col), hv = *(const f32x4*)(sh + col);
        const f32x4 o = v[j] * r * gv * (sv + 1.f) + hv; v2u w; w.x = pk2(o.x, o.y); w.y = pk2(o.z, o.w); *(v2u*)(urow + col) = w; }
}
__device__ __forceinline__ f32x4 mod_reduce4(const float* __restrict__ modp, const float* __restrict__ bias, int v) {
    f32x4 t[16];
#pragma unroll
    for (int ks = 0; ks < 16; ++ks) t[ks] = *(const f32x4*)(modp + (size_t)ks * 4 * MODW + v);
    f32x4 s = *(const f32x4*)(bias + v % MODW);
#pragma unroll
    for (int ks = 0; ks < 16; ++ks) s += t[ks];
    return s;
}
__device__ __forceinline__ void phase1(const Params& p, LAS unsigned char* lds, int wave, int lane) {
    const float* modp = (const float*)(p.ws + WS_MODP); float* mod = (float*)(p.ws + CTL_MOD); bf16_t* u16 = (bf16_t*)(p.ws + WS_U16);
    LAS float* sm = (LAS float*)lds;
    const int G = gridDim.x;
    for (int v4 = blockIdx.x * NTHR + threadIdx.x; v4 < NB * MODW / 4; v4 += G * NTHR) *(f32x4*)(mod + v4 * 4) = mod_reduce4(modp, p.in[4], v4 * 4);
    for (int tb = blockIdx.x; tb < NT / 32; tb += G) {
        const int b = (tb * 32) / SEQ;
        f32x4 v[8];
        { const float* hrow = p.in[0] + (size_t)(tb * 32 + wave * 4) * DM;
#pragma unroll
          for (int j = 0; j < 8; ++j) v[j] = __builtin_nontemporal_load((const f32x4*)(hrow + lane * 4 + 256 * j)); }
        __syncthreads();
        for (int i4 = threadIdx.x; i4 < 2 * DM / 4; i4 += NTHR) *(LAS f32x4*)(sm + i4 * 4) = mod_reduce4(modp, p.in[4], b * MODW + i4 * 4);
        __syncthreads();
#pragma unroll 1
        for (int rr = 0; rr < 4; ++rr) { const int t = tb * 32 + wave * 4 + rr; const float* g = p.in[5];
            f32x4 vn[8];
            if (rr < 3) { const float* hrow = p.in[0] + (size_t)(t + 1) * DM;
#pragma unroll
                for (int j = 0; j < 8; ++j) vn[j] = __builtin_nontemporal_load((const f32x4*)(hrow + lane * 4 + 256 * j)); }
            float s = 0.f;
#pragma unroll
            for (int j = 0; j < 8; ++j) s += (v[j].x * v[j].x + v[j].y * v[j].y) + (v[j].z * v[j].z + v[j].w * v[j].w);
            const float r = rsqrtf(wave_sum(s) * (1.f / DM) + EPS);
#pragma unroll
            for (int j = 0; j < 8; ++j) { const int col = lane * 4 + 256 * j; const f32x4 gv = *(const f32x4*)(g + col);
                const f32x4 hv = *(const LAS f32x4*)(sm + col), sv = *(const LAS f32x4*)(sm + DM + col);
                const f32x4 o = v[j] * r * gv * (sv + 1.f) + hv; v2u w; w.x = pk2(o.x, o.y); w.y = pk2(o.z, o.w); *(v2u*)(u16 + (size_t)t * DM + col) = w; }
            if (rr < 3) {
#pragma unroll
                for (int j = 0; j < 8; ++j) v[j] = vn[j]; }
        }
    }
}

struct EpiInProj { static constexpr bool PERM = true, MIDK = false; bf16_t* O; float* ssq_q8; float* ssq_kv4;
    __device__ __forceinline__ void operator()(const pg8::f32x4 (&acc)[2][2][4][2], const pg8::Unit& u, int wr, int wc, int fr, int fq) const {
        const int row0 = u.pm * 256 + wr * 64 + fr, col0 = u.pn * 256 + wc * 32 + 8 * fq;
        const bool sq = (u.pn >= 16 && u.pn <= 18);
#pragma unroll
        for (int ai = 0; ai < 2; ++ai)
#pragma unroll
            for (int m = 0; m < 4; ++m) { if (!(u.mask & (3 << (ai * 2)))) continue; const int row = row0 + ai * 128 + m * 16; bf16_t* rowp = O + (size_t)row * INCP + col0; float ss = 0.f;
#pragma unroll
                for (int bj = 0; bj < 2; ++bj) { const pg8::f32x4 v0 = acc[ai][bj][m][0], v1 = acc[ai][bj][m][1];
                    v4u w; w.x = pk2(v0[0], v0[1]); w.y = pk2(v0[2], v0[3]); w.z = pk2(v1[0], v1[1]); w.w = pk2(v1[2], v1[3]);
                    *(v4u*)(rowp + bj * 128) = w;
                    ss += (v0[0] * v0[0] + v0[1] * v0[1]) + (v0[2] * v0[2] + v0[3] * v0[3]) + (v1[0] * v1[0] + v1[1] * v1[1]) + (v1[2] * v1[2] + v1[3] * v1[3]); }
                if (sq) { ss += __shfl_xor(ss, 16); ss += __shfl_xor(ss, 32);
                    if (fq == 0) { if (u.pn == 18) ssq_kv4[row * 4 + wc] = ss; else ssq_q8[row * 8 + (u.pn - 16) * 4 + wc] = ss; } } }
    }
};
__device__ __forceinline__ void phase2(const Params& p, LAS unsigned char* lds) {
    unsigned char* ws = p.ws;
    pg8::Gemm g{(const bf16_t*)(ws + WS_U16), (const bf16_t*)(ws + WS_BT_IN), nullptr, DM, DM, DM, 0};
    pg8::StaticOrder S; S.init(NT / 256, INCP / 256, gridDim.x, blockIdx.x, DM);
    EpiInProj E{(bf16_t*)(ws + WS_PROJ), (float*)(ws + TAB_SSQ_Q8), (float*)(ws + TAB_SSQ_KV4)};
    pg8::gemm_phase<EpiInProj, pg8::StaticOrder>((PG8_LAS unsigned char*)lds, g, S, E);
    { const int G = gridDim.x, firstidle = p2_first_idle(G), l2 = exp_late2(G);
      if (l2 > 0 && (int)blockIdx.x >= firstidle) { const int wave = __builtin_amdgcn_readfirstlane(threadIdx.x >> 6), j = ((int)blockIdx.x - firstidle) * NWAVES + wave, nw = (G - firstidle) * NWAVES;
          const int base = CT_GU + CT_DN - l2;
          for (int r = base + j; r < CT_GU + CT_DN; r += nw) expert_stream(p, (LAS unsigned*)(lds + wave * 18432), r, 1 << 30, threadIdx.x & 63, CT_GU + CT_DN); } }
}
struct EpiBf16Store { static constexpr bool PERM = true, MIDK = false; bf16_t* O; int ldc, pad;
    __device__ __forceinline__ void operator()(const pg8::f32x4 (&acc)[2][2][4][2], const pg8::Unit& u, int wr, int wc, int fr, int fq) const {
        const int row0 = u.pm * 256 + wr * 64 + fr, col0 = u.pn * 256 + wc * 32 + 8 * fq;
#pragma unroll
        for (int ai = 0; ai < 2; ++ai)
#pragma unroll
            for (int m = 0; m < 4; ++m) { if (!(u.mask & (3 << (ai * 2)))) continue; bf16_t* rowp = O + (size_t)(row0 + ai * 128 + m * 16) * ldc + col0;
#pragma unroll
                for (int bj = 0; bj < 2; ++bj) { const pg8::f32x4 v0 = acc[ai][bj][m][0], v1 = acc[ai][bj][m][1];
                    v4u w; w.x = pk2(v0[0], v0[1]); w.y = pk2(v0[2], v0[3]); w.z = pk2(v1[0], v1[1]); w.w = pk2(v1[2], v1[3]); *(v4u*)(rowp + bj * 128) = w; } }
    }
};
struct EpiVt { static constexpr bool PERM = true, MIDK = false; bf16_t* Vt; const float* ssq_kv4;
    __device__ __forceinline__ void operator()(const pg8::f32x4 (&acc)[2][2][4][2], const pg8::Unit& u, int wr, int wc, int fr, int fq) const {
        const int row0 = u.pm * 256 + wr * 64 + fr, col0 = u.pn * 256 + wc * 32 + 8 * fq;
        const int pb = (col0 & ~15) + 4 * (fq & 1);
#pragma unroll
        for (int bj = 0; bj < 2; ++bj) {
            float rs[8];
#pragma unroll
            for (int j = 0; j < 8; ++j) { const pg8::f32x4 s4 = *(const pg8::f32x4*)(ssq_kv4 + (size_t)(col0 + bj * 128 + j) * 4); rs[j] = rsqrtf(((s4[0] + s4[1]) + (s4[2] + s4[3])) * (1.f / KVR) + EPS); }
#pragma unroll
            for (int ai = 0; ai < 2; ++ai)
#pragma unroll
                for (int m = 0; m < 4; ++m) { if (!(u.mask & (1 << (ai * 2 + bj)))) continue; bf16_t* rowp = Vt + (size_t)(row0 + ai * 128 + m * 16) * NT + pb + bj * 128;
                    const pg8::f32x4 v0 = acc[ai][bj][m][0], v1 = acc[ai][bj][m][1];
                    v2u a, b; a.x = pk2(v0[0] * rs[0], v0[1] * rs[1]); a.y = pk2(v0[2] * rs[2], v0[3] * rs[3]);
                    b.x = pk2(v1[0] * rs[4], v1[1] * rs[5]); b.y = pk2(v1[2] * rs[6], v1[3] * rs[7]);
                    *(v2u*)(rowp) = a; *(v2u*)(rowp + 8) = b; }
        }
    }
};
__device__ __forceinline__ void phase3_gemms(const Params& p, LAS unsigned char* lds) {
    unsigned char* ws = p.ws; const int G = gridDim.x, c = blockIdx.x;
    const bf16_t* proj = (const bf16_t*)(ws + WS_PROJ);
    { pg8::Gemm g{proj + 4096, (const bf16_t*)(ws + WS_BT_UQ), nullptr, INCP, QR, QR, 0};
      pg8::StaticOrder S; S.init(NT / 256, 6, G, c, QR); EpiBf16Store E{(bf16_t*)(ws + WS_QRAW), 1536, 0};
      pg8::gemm_phase<EpiBf16Store, pg8::StaticOrder>((PG8_LAS unsigned char*)lds, g, S, E); }
    { pg8::Gemm g{proj + 4608, (const bf16_t*)(ws + WS_BT_KV), nullptr, INCP, KVR, KVR, 0};
      pg8::StaticOrder S; S.init(NT / 256, 4, G, (c + 64) % G, KVR); EpiBf16Store E{(bf16_t*)(ws + WS_KRAW), 1024, 0};
      pg8::gemm_phase<EpiBf16Store, pg8::StaticOrder>((PG8_LAS unsigned char*)lds, g, S, E); }
    { pg8::Gemm g{(const bf16_t*)(ws + WS_BT_KV) + 1024 * KVR, proj + 4608, nullptr, KVR, INCP, KVR, 0};
      pg8::StaticOrder S; S.init(4, NT / 256, G, (c + 192) % G, INCP); EpiVt E{(bf16_t*)(ws + WS_VT), (const float*)(ws + TAB_SSQ_KV4)};
      pg8::gemm_phase<EpiVt, pg8::StaticOrder>((PG8_LAS unsigned char*)lds, g, S, E); }
    if (exp_late3(G) > 0 && c >= 192) { const int wave = __builtin_amdgcn_readfirstlane(threadIdx.x >> 6), j = (c - 192) * NWAVES + wave, base = CT_GU + CT_DN - exp_late2(G) - exp_late3(G);
        for (int r = base + j; r < base + CT_EXP_LATE3; r += 64 * NWAVES) expert_stream(p, (LAS unsigned*)(lds + wave * 18432), r, 1 << 30, threadIdx.x & 63, CT_GU + CT_DN); }
}

constexpr float QSCALE = 0.07216878364870323f * 1.4426950408889634f;
__device__ __forceinline__ void phase4_qk(const Params& p, int wave, int lane) {
    unsigned char* ws = p.ws;
    const bf16_t* qraw = (const bf16_t*)(ws + WS_QRAW); const bf16_t* kraw = (const bf16_t*)(ws + WS_KRAW); const bf16_t* proj = (const bf16_t*)(ws + WS_PROJ);
    const float* ssq_q8 = (const float*)(ws + TAB_SSQ_Q8); const float* ssq_kv4 = (const float*)(ws + TAB_SSQ_KV4);
    const int* pos = (const int*)p.in[2]; const float* qg = p.in[14]; const float* kg = p.in[15];
    bf16_t* Q16 = (bf16_t*)(ws + WS_Q16); bf16_t* K16 = (bf16_t*)(ws + WS_K16);
    const float g0q = qg[lane], g1q = qg[64 + lane], g2q = qg[128 + lane], g0k = kg[lane], g1k = kg[64 + lane], g2k = kg[128 + lane];
    const int i = lane & 31; const float inv = exp2f(-(float)i * (13.287712379549449f / 32.f));
    const int gw = blockIdx.x * NWAVES + wave, NGW = gridDim.x * NWAVES;
    for (int it0 = gw; it0 < NT * MH; it0 += 2 * NGW) {
        float q0[2], q1[2], q2[2], k0[2], k1[2], k2[2], rq[2], rkv[2], ps[2];
#pragma unroll
        for (int u = 0; u < 2; ++u) { const int it = it0 + u * NGW; const int t = it >> 3, h = it & 7;
            const pg8::f32x4 qa = *(const pg8::f32x4*)(ssq_q8 + (size_t)t * 8), qb = *(const pg8::f32x4*)(ssq_q8 + (size_t)t * 8 + 4), ka = *(const pg8::f32x4*)(ssq_kv4 + (size_t)t * 4);
            rq[u] = rsqrtf((((qa[0] + qa[1]) + (qa[2] + qa[3])) + ((qb[0] + qb[1]) + (qb[2] + qb[3]))) * (1.f / QR) + EPS); rkv[u] = rsqrtf(((ka[0] + ka[1]) + (ka[2] + ka[3])) * (1.f / KVR) + EPS);
            q0[u] = bf2f(qraw[(size_t)t * 1536 + h * 192 + lane]); q1[u] = bf2f(qraw[(size_t)t * 1536 + h * 192 + 64 + lane]); q2[u] = bf2f(qraw[(size_t)t * 1536 + h * 192 + 128 + lane]);
            k0[u] = bf2f(kraw[(size_t)t * 1024 + h * 128 + lane]); k1[u] = bf2f(kraw[(size_t)t * 1024 + h * 128 + 64 + lane]); k2[u] = bf2f(proj[(size_t)t * INCP + 4864 + lane]); ps[u] = (float)pos[t]; }
#pragma unroll
        for (int u = 0; u < 2; ++u) { const int it = it0 + u * NGW; const int t = it >> 3, h = it & 7, b = t / SEQ, s = t % SEQ;
            float a0 = q0[u] * rq[u], a1 = q1[u] * rq[u], a2 = q2[u] * rq[u], c0 = k0[u] * rkv[u], c1 = k1[u] * rkv[u], c2 = k2[u];
            const float sq = wave_sum(a0 * a0 + a1 * a1 + a2 * a2), sk = wave_sum(c0 * c0 + c1 * c1 + c2 * c2);
            const float nq = rsqrtf(sq * (1.f / 192.f) + EPS) * QSCALE, nk = rsqrtf(sk * (1.f / 192.f) + EPS);
            a0 *= nq * g0q; a1 *= nq * g1q; a2 *= nq * g2q; c0 *= nk * g0k; c1 *= nk * g1k; c2 *= nk * g2k;
            const float ang = ps[u] * inv; const float rev = ang * 0.15915494309189535f; const float fr_ = rev - floorf(rev); const float sn = __builtin_amdgcn_sinf(fr_), cs = __builtin_amdgcn_cosf(fr_);
            const float a2o = __shfl_xor(a2, 32), c2o = __shfl_xor(c2, 32);
            const float a2r = lane < 32 ? a2 * cs - a2o * sn : a2 * cs + a2o * sn;
            const float c2r = lane < 32 ? c2 * cs - c2o * sn : c2 * cs + c2o * sn;
            const size_t base = ((size_t)(b * MH + h) * SEQ + s) * QKD;
            Q16[base + lane] = (bf16_t)f2bf(a0); Q16[base + 64 + lane] = (bf16_t)f2bf(a1); Q16[base + 128 + lane] = (bf16_t)f2bf(a2r);
            K16[base + lane] = (bf16_t)f2bf(c0); K16[base + 64 + lane] = (bf16_t)f2bf(c1); K16[base + 128 + lane] = (bf16_t)f2bf(c2r); }
    }
}

typedef short bf16x8 __attribute__((ext_vector_type(8)));
typedef float f32x16 __attribute__((ext_vector_type(16)));
constexpr int AT_KP = 400, AT_VP = 144, AT_KB = 64 * AT_KP, AT_VB = 128 * AT_VP, AT_BUF = AT_KB + AT_VB;
__device__ __forceinline__ void phase5_attn(const Params& p, LAS unsigned char* lds, int wave, int lane) {
    unsigned char* ws = p.ws;
    const bf16_t* Q16 = (const bf16_t*)(ws + WS_Q16); const bf16_t* K16 = (const bf16_t*)(ws + WS_K16); const bf16_t* Vt = (const bf16_t*)(ws + WS_VT);
    bf16_t* merged = (bf16_t*)(ws + WS_MERGED); float* ssq_o8 = (float*)(ws + TAB_SSQ_O8);
    const int tid = threadIdx.x, cl = lane & 31, hh = lane >> 5, qsub = wave & 3, kpar = wave >> 2;
    float mq = 0.f, mk = 0.f;
    for (int i = 0; i < 3; ++i) { mq = fmaxf(mq, fabsf(p.in[14][lane + 64 * i])); mk = fmaxf(mk, fabsf(p.in[15][lane + 64 * i])); }
#pragma unroll
    for (int o = 1; o < 64; o <<= 1) { mq = fmaxf(mq, __shfl_xor(mq, o)); mk = fmaxf(mk, __shfl_xor(mk, o)); }
    const float negc0 = -(13.856406460551018f * 1.4426950408889634f * 1.02f) * mq * mk;
    int kso[3], vso[2]; size_t vgo[2];
#pragma unroll
    for (int i = 0; i < 3; ++i) { const int c = tid + 512 * i; kso[i] = (c / 24) * AT_KP + (c % 24) * 16; }
#pragma unroll
    for (int i = 0; i < 2; ++i) { const int c = tid + 512 * i, dv = c >> 3, ch = c & 7; vso[i] = AT_KB + dv * AT_VP + ch * 16; vgo[i] = (size_t)dv * NT * 2 + ch * 16; }
    for (int item = blockIdx.x; item < 256; item += gridDim.x) {
        const int bh = item >> 3, x = item & 7, b = bh >> 3, h = bh & 7;
        const char* Qg = (const char*)(Q16 + (size_t)bh * SEQ * QKD); const char* Kg = (const char*)(K16 + (size_t)bh * SEQ * QKD);
        const char* Vg = (const char*)(Vt + (size_t)(h * 128) * NT + b * SEQ);
#pragma unroll 1
        for (int pass = 0; pass < 2; ++pass) {
            const int qi = pass == 0 ? 15 - x : x, nsteps = 2 * (qi + 1), qrow0 = qi * 128 + qsub * 32;
            bf16x8 Qf[12];
#pragma unroll
            for (int ks = 0; ks < 12; ++ks) Qf[ks] = *(const bf16x8*)(Qg + ((size_t)(qrow0 + cl) * QKD + ks * 16 + hh * 8) * 2);
            f32x16 O[4];
#pragma unroll
            for (int vb = 0; vb < 4; ++vb)
#pragma unroll
                for (int r = 0; r < 16; ++r) O[vb][r] = 0.f;
            float lsum = 0.f;
            v4u kr[3], vr[2];
#define AT_LOAD(j) do { _Pragma("unroll") for (int i_ = 0; i_ < 3; ++i_) kr[i_] = *(const v4u*)(Kg + (size_t)(j) * 24576 + (size_t)(tid + 512 * i_) * 16); \
                        _Pragma("unroll") for (int i_ = 0; i_ < 2; ++i_) vr[i_] = *(const v4u*)(Vg + vgo[i_] + (size_t)(j) * 128); } while (0)
#define AT_WRITE(bo) do { _Pragma("unroll") for (int i_ = 0; i_ < 3; ++i_) *(LAS v4u*)(lds + (bo) + kso[i_]) = kr[i_]; \
                          _Pragma("unroll") for (int i_ = 0; i_ < 2; ++i_) *(LAS v4u*)(lds + (bo) + vso[i_]) = vr[i_]; } while (0)
            AT_LOAD(0); AT_WRITE(0); __syncthreads();
#pragma unroll 1
            for (int j = 0; j < nsteps; ++j) {
                const int bo = (j & 1) * AT_BUF;
                if (j + 1 < nsteps) AT_LOAD(j + 1);
                const int key0 = 64 * j + 32 * kpar;
                if (key0 <= qrow0 + 31) {
                    f32x16 S;
#pragma unroll
                    for (int r = 0; r < 16; ++r) S[r] = negc0;
                    const LAS unsigned char* kb = lds + bo + (32 * kpar + cl) * AT_KP + hh * 16;
                    __builtin_amdgcn_s_setprio(1);
#pragma unroll
                    for (int ks = 0; ks < 12; ++ks) { const bf16x8 a = *(const LAS bf16x8*)(kb + ks * 32); S = __builtin_amdgcn_mfma_f32_32x32x16_bf16(a, Qf[ks], S, 0, 0, 0); }
                    __builtin_amdgcn_s_setprio(0);
                    const bool diag = key0 + 31 > qrow0;
                    float pr[16];
#pragma unroll
                    for (int r = 0; r < 16; ++r) { float e = __builtin_amdgcn_exp2f(S[r]);
                        if (diag) { const int key = key0 + (r & 3) + 8 * (r >> 2) + 4 * hh; if (key > qrow0 + cl) e = 0.f; }
                        pr[r] = e; lsum += e; }
                    bf16x8 Pf[2];
#pragma unroll
                    for (int s = 0; s < 2; ++s) { v4u w; w.x = pk2(pr[8 * s + 0], pr[8 * s + 1]); w.y = pk2(pr[8 * s + 2], pr[8 * s + 3]); w.z = pk2(pr[8 * s + 4], pr[8 * s + 5]); w.w = pk2(pr[8 * s + 6], pr[8 * s + 7]);
                        Pf[s] = __builtin_bit_cast(bf16x8, w); }
                    const LAS unsigned char* vbp = lds + bo + AT_KB + cl * AT_VP + (32 * kpar + 8 * hh) * 2;
                    __builtin_amdgcn_s_setprio(1);
#pragma unroll
                    for (int vb = 0; vb < 4; ++vb)
#pragma unroll
                        for (int s = 0; s < 2; ++s) { const bf16x8 a = *(const LAS bf16x8*)(vbp + vb * 32 * AT_VP + s * 32); O[vb] = __builtin_amdgcn_mfma_f32_32x32x16_bf16(a, Pf[s], O[vb], 0, 0, 0); }
                    __builtin_amdgcn_s_setprio(0);
                }
                if (j + 1 < nsteps) AT_WRITE(((j + 1) & 1) * AT_BUF);
                __syncthreads();
            }
            LAS float* X = (LAS float*)lds;
            if (kpar == 1) {
#pragma unroll
                for (int vb = 0; vb < 4; ++vb)
#pragma unroll
                    for (int r = 0; r < 16; ++r) X[(qsub * 65 + vb * 16 + r) * 64 + lane] = O[vb][r];
                X[(qsub * 65 + 64) * 64 + lane] = lsum;
            }
            __syncthreads();
            if (kpar == 0) {
                float l = lsum + X[(qsub * 65 + 64) * 64 + lane];
                l += __shfl_xor(l, 32);
                const float il = 1.f / l; float ss = 0.f;
                const int t = b * SEQ + qrow0 + cl;
                bf16_t* op = merged + (size_t)t * DM + h * 128 + 4 * hh;
#pragma unroll
                for (int vb = 0; vb < 4; ++vb)
#pragma unroll
                    for (int rq = 0; rq < 4; ++rq) { float o[4];
#pragma unroll
                        for (int r3 = 0; r3 < 4; ++r3) { const int r = rq * 4 + r3; o[r3] = (O[vb][r] + X[(qsub * 65 + vb * 16 + r) * 64 + lane]) * il; ss += o[r3] * o[r3]; }
                        v2u w; w.x = pk2(o[0], o[1]); w.y = pk2(o[2], o[3]); *(v2u*)(op + vb * 32 + rq * 8) = w; }
                ss += __shfl_xor(ss, 32);
                if (hh == 0) ssq_o8[(size_t)t * 8 + h] = ss;
            }
            __syncthreads();
        }
    }
#undef AT_LOAD
#undef AT_WRITE
}

__device__ __forceinline__ void phase6_scale(const Params& p, int wave, int lane) {
    unsigned char* ws = p.ws; bf16_t* merged = (bf16_t*)(ws + WS_MERGED); const float* ssq_o8 = (const float*)(ws + TAB_SSQ_O8);
    const int gw = blockIdx.x * NWAVES + wave, NGW = gridDim.x * NWAVES;
    for (int t = gw; t < NT; t += NGW) { const pg8::f32x4 oa = *(const pg8::f32x4*)(ssq_o8 + (size_t)t * 8), ob = *(const pg8::f32x4*)(ssq_o8 + (size_t)t * 8 + 4);
        const float r = rsqrtf((((oa[0] + oa[1]) + (oa[2] + oa[3])) + ((ob[0] + ob[1]) + (ob[2] + ob[3]))) * (1.f / 1024.f) + EPS);
#pragma unroll
        for (int j = 0; j < 2; ++j) { v4u* q = (v4u*)(merged + (size_t)t * DM + 1024 + j * 512 + lane * 8); v4u y = *q;
            y.x = pk2(bflo(y.x) * r, bfhi(y.x) * r); y.y = pk2(bflo(y.y) * r, bfhi(y.y) * r); y.z = pk2(bflo(y.z) * r, bfhi(y.z) * r); y.w = pk2(bflo(y.w) * r, bfhi(y.w) * r); *q = y; } }
}

struct EpiResidF32 { static constexpr bool PERM = false, MIDK = true; const float* x; const float* gate; float* out; const LAS float* rs;
    __device__ __forceinline__ void mid(pg8::f32x4 (&acc)[2][2][4][2], const pg8::Unit& u, int wr, int wc, int fr, int fq) const {
        const LAS float* rp = rs + u.pad * 256 + wr * 64 + fr;
#pragma unroll
        for (int ai = 0; ai < 2; ++ai)
#pragma unroll
            for (int m = 0; m < 4; ++m) { const float r = rp[ai * 128 + m * 16];
#pragma unroll
                for (int bj = 0; bj < 2; ++bj)
#pragma unroll
                    for (int n = 0; n < 2; ++n) acc[ai][bj][m][n] = acc[ai][bj][m][n] * r; }
    }
    __device__ __forceinline__ void operator()(const pg8::f32x4 (&acc)[2][2][4][2], const pg8::Unit& u, int wr, int wc, int fr, int fq) const {
        const int row0 = u.pm * 256 + wr * 64 + fr, col0 = u.pn * 256 + wc * 32 + 4 * fq;
        const float* gp = gate + (size_t)((u.pm * 256) / SEQ) * MODW + col0;
        pg8::f32x4 gv[2][2];
#pragma unroll
        for (int bj = 0; bj < 2; ++bj)
#pragma unroll
            for (int n = 0; n < 2; ++n) gv[bj][n] = *(const pg8::f32x4*)(gp + bj * 128 + n * 16);
#pragma unroll
        for (int ai = 0; ai < 2; ++ai)
#pragma unroll
            for (int m = 0; m < 4; ++m) { if (!(u.mask & (3 << (ai * 2)))) continue; const size_t ro = (size_t)(row0 + ai * 128 + m * 16) * DM + col0;
#pragma unroll
                for (int bj = 0; bj < 2; ++bj)
#pragma unroll
                    for (int n = 0; n < 2; ++n) { const pg8::f32x4 xv = *(const pg8::f32x4*)(x + ro + bj * 128 + n * 16); *(pg8::f32x4*)(out + ro + bj * 128 + n * 16) = xv + gv[bj][n] * acc[ai][bj][m][n]; } }
    }
};
__device__ __forceinline__ void phase7(const Params& p, LAS unsigned char* lds) {
    unsigned char* ws = p.ws;
    pg8::Gemm g{(const bf16_t*)(ws + WS_MERGED), (const bf16_t*)(ws + WS_BT_OUT), nullptr, DM, DM, DM, 0};
    pg8::StaticOrder S; S.init(NT / 256, DM / 256, gridDim.x, blockIdx.x, DM);
    LAS float* rs = (LAS float*)(lds + RING_BYTES + 12288);
    { const float* ssq_o8 = (const float*)(ws + TAB_SSQ_O8); pg8::Unit u;
      for (int i = 0; i < 4 && S.next(i, u); ++i) if (threadIdx.x < 256) { const float* sp = ssq_o8 + (size_t)(u.pm * 256 + threadIdx.x) * 8; const pg8::f32x4 oa = *(const pg8::f32x4*)sp, ob = *(const pg8::f32x4*)(sp + 4);
          rs[i * 256 + threadIdx.x] = rsqrtf((((oa[0] + oa[1]) + (oa[2] + oa[3])) + ((ob[0] + ob[1]) + (ob[2] + ob[3]))) * (1.f / 1024.f) + EPS); }
      __syncthreads(); }
    EpiResidF32 E{p.in[0], (const float*)(ws + CTL_MOD) + 2 * DM, (float*)(ws + WS_H1), rs};
    pg8::gemm_phase<EpiResidF32, pg8::StaticOrder>((PG8_LAS unsigned char*)lds, g, S, E);
}
constexpr int HG_P = 272, HG_VP = 144;
constexpr int HG_A2 = 0, HG_A1 = 17408, HG_QB = 34816, HG_VT = 52224, HG_KT = 70656, HG_SEG = 89088, HG_RS = 91136, HG_FL = 92160, HG_QT = 109568;
struct HgPre { v4u fl[2], q[2], v[2]; };
template <bool NEEDQ>
__device__ __forceinline__ void hg_issue(const bf16_t* __restrict__ proj, int item, HgPre& P) {
    const int bh = item >> 5, c = item & 31, b = bh >> 3, h = bh & 7, t0 = b * SEQ + c * 64, tid = threadIdx.x;
#pragma unroll
    for (int i = 0; i < 2; ++i) { const int ch = tid + 512 * i, t = ch >> 4, c16 = ch & 15; const bf16_t* rp = proj + (size_t)(t0 + t) * INCP + h * 128 + c16 * 8;
        P.fl[i] = *(const v4u*)(rp + 1024); P.v[i] = *(const v4u*)(rp + 2048); if (NEEDQ) P.q[i] = *(const v4u*)rp; }
}
struct HgCol { float kv[16]; float b[16]; float blast, bmid; };
template <bool NEEDQ, bool PERM>
__device__ __forceinline__ void hg_stage(const HgPre& P, const float* __restrict__ lbl, int h, LAS unsigned char* lds, HgCol& C) {
    const int tid = threadIdx.x, k = tid & 127, seg = tid >> 7;
    __syncthreads();
#pragma unroll
    for (int i = 0; i < 2; ++i) { const int ch = tid + 512 * i, t = ch >> 4, c16 = ch & 15;
        *(LAS v4u*)(lds + HG_FL + t * HG_P + c16 * 16) = P.fl[i]; if (NEEDQ) *(LAS v4u*)(lds + HG_QT + t * HG_P + c16 * 16) = P.q[i];
        const v4u w = P.v[i]; const int o = t & 15, pos = PERM ? ((t & ~15) + 8 * ((o >> 2) & 1) + 4 * ((o >> 3) & 1) + (o & 3)) : t;
        LAS unsigned short* vp = (LAS unsigned short*)(lds + HG_VT + (c16 * 8) * HG_VP + (((pos >> 3) ^ (c16 & 7)) * 16) + (pos & 7) * 2);
        vp[0 * (HG_VP / 2)] = (unsigned short)(w.x & 0xffff); vp[1 * (HG_VP / 2)] = (unsigned short)(w.x >> 16);
        vp[2 * (HG_VP / 2)] = (unsigned short)(w.y & 0xffff); vp[3 * (HG_VP / 2)] = (unsigned short)(w.y >> 16);
        vp[4 * (HG_VP / 2)] = (unsigned short)(w.z & 0xffff); vp[5 * (HG_VP / 2)] = (unsigned short)(w.z >> 16);
        vp[6 * (HG_VP / 2)] = (unsigned short)(w.w & 0xffff); vp[7 * (HG_VP / 2)] = (unsigned short)(w.w >> 16); }
    const float l0 = lbl[h * 128 + k], l1 = lbl[1024 + h * 128 + k];
    const float lb = 1.f / (1.f + __expf(l1 - l0));
    __syncthreads();
    const LAS unsigned short* fp = (const LAS unsigned short*)(lds + HG_FL + (seg * 16) * HG_P + k * 2);
    float run = 0.f;
#pragma unroll
    for (int i = 0; i < 16; ++i) { const float fl = bf2f(fp[i * (HG_P / 2)]); const float f = lb + (1.f - lb) / (1.f + __expf(-fl)); C.kv[i] = 1.f - f; run += __logf(f); C.b[i] = run; }
    LAS float* SEG = (LAS float*)(lds + HG_SEG);
    SEG[seg * 128 + k] = run;
    __syncthreads();
    const float s0 = SEG[k], s1 = SEG[128 + k], s2 = SEG[256 + k], s3 = SEG[384 + k];
    const float off = (seg > 0 ? s0 : 0.f) + (seg > 1 ? s1 : 0.f) + (seg > 2 ? s2 : 0.f);
#pragma unroll
    for (int i = 0; i < 16; ++i) C.b[i] += off;
    C.bmid = s0 + s1; C.blast = (s0 + s1) + (s2 + s3);
}
__device__ __forceinline__ void hgrn_pass1(const Params& p, LAS unsigned char* lds, int wave, int lane) {
    unsigned char* ws = p.ws; const bf16_t* proj = (const bf16_t*)(ws + WS_PROJ);
    bf16_t* hgU = (bf16_t*)(ws + WS_HGU); float* hgd = (float*)(ws + TAB_HGD);
    const int tid = threadIdx.x, k = tid & 127, seg = tid >> 7, cl = lane & 31, hh = lane >> 5, G = gridDim.x;
    HgPre P; if ((int)blockIdx.x < 1024) hg_issue<false>(proj, blockIdx.x, P);
    for (int item = blockIdx.x; item < 1024; item += G) {
        const int h = (item >> 5) & 7;
        HgCol C; hg_stage<false, false>(P, p.in[8], h, lds, C);
        if (item + G < 1024) hg_issue<false>(proj, item + G, P);
        { unsigned w[8];
#pragma unroll
          for (int i = 0; i < 8; ++i) { const float a0 = C.kv[2 * i] * __expf(C.blast - C.b[2 * i]), a1 = C.kv[2 * i + 1] * __expf(C.blast - C.b[2 * i + 1]); w[i] = pk2(a0, a1); }
          LAS v4u* kp = (LAS v4u*)(lds + HG_KT + k * HG_VP + seg * 32); kp[0] = (v4u){w[0], w[1], w[2], w[3]}; kp[1] = (v4u){w[4], w[5], w[6], w[7]}; }
        if (seg == 0) hgd[item * 128 + k] = __expf(C.blast);
        __syncthreads();
        const int vb = wave >> 1;
        bf16x8 af[4];
#pragma unroll
        for (int ks = 0; ks < 4; ++ks) af[ks] = *(const LAS bf16x8*)(lds + HG_VT + (32 * vb + cl) * HG_VP + (((2 * ks + hh) ^ ((cl >> 3) & 3) ^ ((vb & 1) << 2)) * 16));
#pragma unroll
        for (int q = 0; q < 2; ++q) { const int kb = (wave & 1) * 2 + q; f32x16 acc;
#pragma unroll
            for (int r = 0; r < 16; ++r) acc[r] = 0.f;
#pragma unroll
            for (int ks = 0; ks < 4; ++ks) { const bf16x8 bfr = *(const LAS bf16x8*)(lds + HG_KT + (32 * kb + cl) * HG_VP + (16 * ks + 8 * hh) * 2); acc = __builtin_amdgcn_mfma_f32_32x32x16_bf16(af[ks], bfr, acc, 0, 0, 0); }
            bf16_t* up = hgU + (size_t)item * 16384 + 32 * kb + cl;
#pragma unroll
            for (int r = 0; r < 16; ++r) { const int v = 32 * vb + (r & 3) + 8 * (r >> 2) + 4 * hh; up[(size_t)v * 128] = (bf16_t)f2bf(acc[r]); } }
    }
}
__device__ __forceinline__ void hgrn_scan(const Params& p) {
    unsigned char* ws = p.ws; bf16_t* hgU = (bf16_t*)(ws + WS_HGU); const float* hgd = (const float*)(ws + TAB_HGD);
    for (int i = blockIdx.x * NTHR + threadIdx.x; i < 32 * 4096; i += gridDim.x * NTHR) {
        const int bh = i >> 12, e4 = i & 4095, k4 = (e4 & 31) * 4;
        float S[4] = {0.f, 0.f, 0.f, 0.f};
        v2u* up = (v2u*)(hgU + (size_t)bh * 32 * 16384 + (size_t)e4 * 4); const float* dp = hgd + (size_t)bh * 32 * 128 + k4;
#pragma unroll 1
        for (int c0 = 0; c0 < 32; c0 += 16) { v2u u[16]; f32x4 d[16];
#pragma unroll
            for (int j = 0; j < 16; ++j) { u[j] = up[(size_t)(c0 + j) * 4096]; d[j] = *(const f32x4*)(dp + (c0 + j) * 128); }
#pragma unroll
            for (int j = 0; j < 16; ++j) { v2u o; o.x = pk2(S[0], S[1]); o.y = pk2(S[2], S[3]); up[(size_t)(c0 + j) * 4096] = o;
                S[0] = d[j][0] * S[0] + bflo(u[j].x); S[1] = d[j][1] * S[1] + bfhi(u[j].x); S[2] = d[j][2] * S[2] + bflo(u[j].y); S[3] = d[j][3] * S[3] + bfhi(u[j].y); } }
    }
}
__device__ __forceinline__ void hgrn_pass3(const Params& p, LAS unsigned char* lds, int wave, int lane) {
    unsigned char* ws = p.ws; const bf16_t* proj = (const bf16_t*)(ws + WS_PROJ);
    const bf16_t* hgS = (const bf16_t*)(ws + WS_HGU); bf16_t* merged = (bf16_t*)(ws + WS_MERGED); const float* og = p.in[9];
    const int tid = threadIdx.x, k = tid & 127, seg = tid >> 7, cl = lane & 31, hh = lane >> 5, vb = wave & 3, tb = wave >> 2, G = gridDim.x;
    HgPre P; if ((int)blockIdx.x < 1024) hg_issue<true>(proj, blockIdx.x, P);
    for (int item = blockIdx.x; item < 1024; item += G) {
        const int bh = item >> 5, c = item & 31, b = bh >> 3, h = bh & 7, t0 = b * SEQ + c * 64;
        bf16x8 sf[8]; v2u gw[4];
        { const bf16_t* sp = hgS + (size_t)item * 16384 + (size_t)(32 * vb + cl) * 128 + 8 * hh;
#pragma unroll
          for (int ks = 0; ks < 8; ++ks) sf[ks] = *(const bf16x8*)(sp + 16 * ks);
          const int t = t0 + 32 * tb + cl;
#pragma unroll
          for (int rq = 0; rq < 4; ++rq) gw[rq] = *(const v2u*)(proj + (size_t)t * INCP + 3072 + h * 128 + 32 * vb + 8 * rq + 4 * hh); }
        HgCol C; hg_stage<true, true>(P, p.in[8], h, lds, C);
        { const LAS unsigned short* qp = (const LAS unsigned short*)(lds + HG_QT + (seg * 16) * HG_P + k * 2);
          LAS unsigned short* a2 = (LAS unsigned short*)(lds + HG_A2 + (seg * 16) * HG_P + k * 2);
          LAS unsigned short* a1 = (LAS unsigned short*)(lds + HG_A1 + (seg * 16) * HG_P + k * 2);
          LAS unsigned short* qb = (LAS unsigned short*)(lds + HG_QB + (seg * 16) * HG_P + k * 2);
          const float em = __expf(-C.bmid), ep = __expf(C.bmid);
#pragma unroll
          for (int i = 0; i < 16; i += 2) { const float q0 = bf2f(qp[i * (HG_P / 2)]), q1 = bf2f(qp[(i + 1) * (HG_P / 2)]);
              const float e0 = __expf(C.b[i]), e1 = __expf(C.b[i + 1]);
              const unsigned wa2 = pk2(C.kv[i] * ep * __builtin_amdgcn_rcpf(e0), C.kv[i + 1] * ep * __builtin_amdgcn_rcpf(e1));
              const unsigned wa1 = pk2(q0 * e0 * em, q1 * e1 * em), wqb = pk2(q0 * e0, q1 * e1);
              a2[i * (HG_P / 2)] = (unsigned short)(wa2 & 0xffff); a2[(i + 1) * (HG_P / 2)] = (unsigned short)(wa2 >> 16);
              a1[i * (HG_P / 2)] = (unsigned short)(wa1 & 0xffff); a1[(i + 1) * (HG_P / 2)] = (unsigned short)(wa1 >> 16);
              qb[i * (HG_P / 2)] = (unsigned short)(wqb & 0xffff); qb[(i + 1) * (HG_P / 2)] = (unsigned short)(wqb >> 16); } }
        __syncthreads();
        if (item + G < 1024) hg_issue<true>(proj, item + G, P);
        f32x16 O;
#pragma unroll
        for (int r = 0; r < 16; ++r) O[r] = 0.f;
#pragma unroll
        for (int ks = 0; ks < 8; ++ks) { const bf16x8 bq = *(const LAS bf16x8*)(lds + HG_QB + (32 * tb + cl) * HG_P + (16 * ks + 8 * hh) * 2); O = __builtin_amdgcn_mfma_f32_32x32x16_bf16(sf[ks], bq, O, 0, 0, 0); }
#pragma unroll
        for (int sb = 0; sb < 2; ++sb) {
            if (sb <= tb) {
                f32x16 X;
#pragma unroll
                for (int r = 0; r < 16; ++r) X[r] = 0.f;
#pragma unroll
                for (int ks = 0; ks < 8; ++ks) { const bf16x8 a = *(const LAS bf16x8*)(lds + HG_A2 + (32 * sb + cl) * HG_P + (16 * ks + 8 * hh) * 2);
                    const bf16x8 bq = *(const LAS bf16x8*)(lds + HG_A1 + (32 * tb + cl) * HG_P + (16 * ks + 8 * hh) * 2); X = __builtin_amdgcn_mfma_f32_32x32x16_bf16(a, bq, X, 0, 0, 0); }
                if (sb == tb) {
#pragma unroll
                    for (int r = 0; r < 16; ++r) { const int s = (r & 3) + 8 * (r >> 2) + 4 * hh; if (s > cl) X[r] = 0.f; } }
#pragma unroll
                for (int s2 = 0; s2 < 2; ++s2) { v4u w; w.x = pk2(X[8 * s2 + 0], X[8 * s2 + 1]); w.y = pk2(X[8 * s2 + 2], X[8 * s2 + 3]); w.z = pk2(X[8 * s2 + 4], X[8 * s2 + 5]); w.w = pk2(X[8 * s2 + 6], X[8 * s2 + 7]);
                    const bf16x8 a = *(const LAS bf16x8*)(lds + HG_VT + (32 * vb + cl) * HG_VP + (((4 * sb + 2 * s2 + hh) ^ ((cl >> 3) & 3) ^ ((vb & 1) << 2)) * 16));
                    O = __builtin_amdgcn_mfma_f32_32x32x16_bf16(a, __builtin_bit_cast(bf16x8, w), O, 0, 0, 0); }
            }
        }
        float ss = 0.f;
#pragma unroll
        for (int r = 0; r < 16; ++r) ss += O[r] * O[r];
        ss += __shfl_xor(ss, 32);
        LAS float* RS = (LAS float*)(lds + HG_RS);
        if (hh == 0) RS[(tb * 4 + vb) * 32 + cl] = ss;
        __syncthreads();
        const float tot = (RS[(tb * 4 + 0) * 32 + cl] + RS[(tb * 4 + 1) * 32 + cl]) + (RS[(tb * 4 + 2) * 32 + cl] + RS[(tb * 4 + 3) * 32 + cl]);
        const float rn = rsqrtf(tot * (1.f / 128.f) + EPS);
        const int t = t0 + 32 * tb + cl;
#pragma unroll
        for (int rq = 0; rq < 4; ++rq) { const int v = 32 * vb + 8 * rq + 4 * hh; const f32x4 gg = *(const f32x4*)(og + v);
            const float g0 = bflo(gw[rq].x), g1 = bfhi(gw[rq].x), g2 = bflo(gw[rq].y), g3 = bfhi(gw[rq].y);
            const float o0 = O[rq * 4 + 0] * rn * gg[0] * (g0 / (1.f + __expf(-g0))), o1 = O[rq * 4 + 1] * rn * gg[1] * (g1 / (1.f + __expf(-g1)));
            const float o2 = O[rq * 4 + 2] * rn * gg[2] * (g2 / (1.f + __expf(-g2))), o3 = O[rq * 4 + 3] * rn * gg[3] * (g3 / (1.f + __expf(-g3)));
            v2u w; w.x = pk2(o0, o1); w.y = pk2(o2, o3); *(v2u*)(merged + (size_t)t * DM + 1024 + h * 128 + v) = w; }
    }
}
typedef float f32x2v __attribute__((ext_vector_type(2)));
constexpr int UPITCH = 2050;
constexpr int LDS_HIST = RING_BYTES + 1024;
__device__ __forceinline__ void phase8(const Params& p, LAS unsigned char* lds, int wave, int lane) {
    unsigned char* ws = p.ws;
    const float* h1 = (const float*)(ws + WS_H1); const float* mod = (const float*)(ws + CTL_MOD);
    unsigned char* u8 = ws + WS_U16;
    const float* wr_ = p.in[18]; const float* rbias = p.in[19];
    int* top_idx = (int*)(ws + TAB_TOPI); float* top_w = (float*)(ws + TAB_TOPW); int* slot = (int*)(ws + TAB_SLOT);
    LAS float* U = (LAS float*)lds;
    LAS int* hist = (LAS int*)(lds + LDS_HIST);
    if (threadIdx.x < 64) hist[threadIdx.x] = 0;
    LAS float* SS = (LAS float*)(lds + RING_BYTES + 5120);
    const int TPB = (NT / 16 + gridDim.x - 1) / gridDim.x;
    int ssb = -1;
    for (int task = blockIdx.x * TPB; task < NT / 16 && task < (int)(blockIdx.x + 1) * TPB; ++task) {
        const int t0 = task * 16;
        if (t0 / SEQ != ssb) { ssb = t0 / SEQ; __syncthreads();
            for (int i4 = threadIdx.x; i4 < DM / 4; i4 += NTHR) { const f32x4 gv = *(const f32x4*)(p.in[6] + i4 * 4), sv = *(const f32x4*)(mod + ssb * MODW + 4 * DM + i4 * 4), hv = *(const f32x4*)(mod + ssb * MODW + 3 * DM + i4 * 4);
                *(LAS f32x4*)(SS + i4 * 4) = gv * (sv + 1.f); *(LAS f32x4*)(SS + DM + i4 * 4) = hv; } }
        __syncthreads();
        { f32x4 v[2][8];
#pragma unroll
          for (int rr = 0; rr < 2; ++rr) { const float* hrow = h1 + (size_t)(t0 + wave * 2 + rr) * DM;
#pragma unroll
              for (int j = 0; j < 8; ++j) v[rr][j] = *(const f32x4*)(hrow + lane * 4 + 256 * j); }
#pragma unroll
          for (int rr = 0; rr < 2; ++rr) {
            const int tl = wave * 2 + rr, t = t0 + tl, b = t / SEQ;
            float s = 0.f;
#pragma unroll
            for (int j = 0; j < 8; ++j) s += (v[rr][j].x * v[rr][j].x + v[rr][j].y * v[rr][j].y) + (v[rr][j].z * v[rr][j].z + v[rr][j].w * v[rr][j].w);
            const float r = rsqrtf(wave_sum(s) * (1.f / DM) + EPS);
#pragma unroll
            for (int j = 0; j < 8; ++j) { const int col = lane * 4 + 256 * j; const f32x4 gs = *(const LAS f32x4*)(SS + col), hv = *(const LAS f32x4*)(SS + DM + col);
                const f32x4 o = v[rr][j] * r * gs + hv; *(unsigned*)(u8 + (size_t)t * DM + col) = pk4_fp8(o.x * 4.f, o.y * 4.f, o.z * 4.f, o.w * 4.f);
                LAS f32x2v* up = (LAS f32x2v*)(U + tl * UPITCH + col); up[0] = (f32x2v){o.x, o.y}; up[1] = (f32x2v){o.z, o.w}; }
          } }
        __syncthreads();
        f32x4 acc[4];
#pragma unroll
        for (int c = 0; c < 4; ++c) acc[c] = (f32x4){0.f, 0.f, 0.f, 0.f};
        { const int kb = wave * 256 + (lane >> 4); const LAS float* ua = U + (lane & 15) * UPITCH + kb; const float* wb = wr_ + (size_t)kb * NE + 4 * (lane & 15);
          f32x4 bv[8], bn[8];
#pragma unroll
          for (int q = 0; q < 8; ++q) bv[q] = *(const f32x4*)(wb + (size_t)q * 4 * NE);
#pragma unroll 1
          for (int k8 = 0; k8 < 64; k8 += 8) {
              if (k8 + 8 < 64) {
#pragma unroll
                  for (int q = 0; q < 8; ++q) bn[q] = *(const f32x4*)(wb + (size_t)(k8 + 8 + q) * 4 * NE); }
#pragma unroll
              for (int q = 0; q < 8; ++q) { const float a = ua[(k8 + q) * 4];
#pragma unroll
                  for (int c = 0; c < 4; ++c) acc[c] = __builtin_amdgcn_mfma_f32_16x16x4f32(a, bv[q][c], acc[c], 0, 0, 0); }
#pragma unroll
              for (int q = 0; q < 8; ++q) bv[q] = bn[q]; } }
        __syncthreads();
        LAS float* P = (LAS float*)lds;
#pragma unroll
        for (int c = 0; c < 4; ++c)
#pragma unroll
            for (int r = 0; r < 4; ++r) P[wave * 1024 + ((lane >> 4) * 4 + r) * 64 + 4 * (lane & 15) + c] = acc[c][r];
        __syncthreads();
        LAS float* LG = (LAS float*)(lds + 32768);
#pragma unroll
        for (int q = 0; q < 2; ++q) { const int i = threadIdx.x + q * NTHR; float s = 0.f;
#pragma unroll
            for (int w = 0; w < 8; ++w) s += P[w * 1024 + i]; LG[i] = s; }
        __syncthreads();
#pragma unroll 1
        for (int rr = 0; rr < 2; ++rr) {
            const int tl = wave * 2 + rr, t = t0 + tl;
            int lanev = lane; asm volatile("" : "+v"(lanev));
            const float sc = 1.f / (1.f + expf(-LG[tl * 64 + lane])); const float sel = sc + rbias[lane];
            float m1 = sel; m1 = fmaxf(m1, __shfl_xor(m1, 1)); m1 = fmaxf(m1, __shfl_xor(m1, 2)); m1 = fmaxf(m1, __shfl_xor(m1, 4));
            const unsigned long long gm = 0xFFull << (lanev & 56);
            const int first = __ffsll((long long)(__ballot(sel == m1) & gm)) - 1;
            float m2 = (lanev == first) ? -INFINITY : sel; m2 = fmaxf(m2, __shfl_xor(m2, 1)); m2 = fmaxf(m2, __shfl_xor(m2, 2)); m2 = fmaxf(m2, __shfl_xor(m2, 4));
            const float gs = m1 + m2; const int g = lanev >> 3; int grank = 0;
#pragma unroll
            for (int gg = 0; gg < 8; ++gg) { const float og = __builtin_bit_cast(float, __builtin_amdgcn_readlane(__builtin_bit_cast(int, gs), gg * 8)); grank += (og > gs || (og == gs && gg < g)) ? 1 : 0; }
            const bool gsel = grank < 4; int rk = 0;
            unsigned kb_ = __builtin_bit_cast(unsigned, sel); kb_ = (kb_ & 0x80000000u) ? ~kb_ : (kb_ | 0x80000000u);
            const unsigned long long key = gsel ? (((unsigned long long)kb_ << 6) | (unsigned long long)(63 - lanev)) : 0ull;
            const int klo = (int)(unsigned)key, khi = (int)(unsigned)(key >> 32);
#pragma unroll
            for (int e = 0; e < 64; ++e) { const unsigned long long o = ((unsigned long long)(unsigned)__builtin_amdgcn_readlane(khi, e) << 32) | (unsigned)__builtin_amdgcn_readlane(klo, e); rk += (o > key) ? 1 : 0; }
            const bool chosen = gsel && rk < 8;
            const unsigned long long cb = __ballot(chosen);
            const float wsum = wave_sum(chosen ? sc : 0.f);
            const int ks = __popcll(cb & ((1ull << lanev) - 1ull));
            if (chosen) { const int lr = __hip_atomic_fetch_add((int*)(hist + lane), 1, __ATOMIC_RELAXED, __HIP_MEMORY_SCOPE_WORKGROUP); top_idx[t * 8 + ks] = lane; top_w[t * 8 + ks] = sc / wsum * 2.5f; slot[t * 8 + ks] = lr; }
        }
        __syncthreads();
    }
    if (threadIdx.x < 64) ((int*)(ws + CTL_HIST))[blockIdx.x * 64 + threadIdx.x] = hist[threadIdx.x];
}

__device__ __forceinline__ void phase9(const Params& p, LAS unsigned char* lds, int wave, int lane) {
    unsigned char* ws = p.ws;
    const int* bh = (const int*)(ws + CTL_HIST);
    int* top_idx = (int*)(ws + TAB_TOPI); int* slot = (int*)(ws + TAB_SLOT); int* row_tok = (int*)(ws + TAB_ROWTOK); int* tile_exp = (int*)(ws + TAB_TILEEXP);
    LAS int* rb = (LAS int*)(lds + LDS_HIST + 256);
    const int G = gridDim.x;
    {
        LAS int* part = (LAS int*)(lds + LDS_HIST + 2048);
        const int e = threadIdx.x & 63, pt = threadIdx.x >> 6, per = (G + 7) / 8, b0 = pt * per, b1 = (b0 + per < G) ? b0 + per : G;
        int cnt = 0, base = 0;
#pragma unroll 8
        for (int b = b0; b < b1; ++b) { const int v = bh[b * 64 + e]; base += (b < (int)blockIdx.x) ? v : 0; cnt += v; }
        part[pt * 64 + e] = cnt; part[512 + pt * 64 + e] = base;
    }
    __syncthreads();
    if (wave == 0) {
        LAS int* part = (LAS int*)(lds + LDS_HIST + 2048);
        int cnt = 0, base = 0;
#pragma unroll
        for (int q = 0; q < 8; ++q) { cnt += part[q * 64 + lane]; base += part[512 + q * 64 + lane]; }
        const int tiles = (cnt + 255) >> 8;
        int incl = tiles;
#pragma unroll
        for (int o = 1; o < 64; o <<= 1) { const int n = __shfl_up(incl, o); if (lane >= o) incl += n; }
        const int toff = incl - tiles;
        rb[lane] = toff * 256 + base;
        if (blockIdx.x == 0) { for (int i = 0; i < tiles; ++i) tile_exp[toff + i] = lane; if (lane == 63) tile_exp[512] = incl; if (lane < 32) tile_exp[320 + lane] = 64; }
        rb[64 + lane] = toff * 256 + cnt; rb[128 + lane] = (toff + tiles) * 256;
    }
    __syncthreads();
    for (int e = blockIdx.x; e < 64; e += G) { const int lo = rb[64 + e], hi = rb[128 + e]; for (int r = lo + (int)threadIdx.x; r < hi; r += NTHR) row_tok[r] = 0; }
    for (int i = blockIdx.x * NTHR + threadIdx.x; i < NT; i += G * NTHR) row_tok[ROUTED_ROWS_MAX + i] = i;
    const int TPB = (NT / 16 + G - 1) / G;
    for (int task = blockIdx.x * TPB; task < NT / 16 && task < (int)(blockIdx.x + 1) * TPB; ++task) {
        const int t = task * 16 + wave * 2 + (lane >> 3), k = lane & 7;
        if (lane < 16) { const int e = top_idx[t * 8 + k]; const int pos = rb[e] + slot[t * 8 + k]; slot[t * 8 + k] = pos; row_tok[pos] = t; }
    }
}

constexpr int LDS_UNITS = RING_BYTES + 8192;
struct MoeOrder {
    LAS int* tab; int n;
    __device__ void init(LAS unsigned char* lds, const int* tile_exp, int nN, int G, int c, long estride, long bstep, int parts) {
        tab = (LAS int*)(lds + LDS_UNITS);
        const int ntr = tile_exp[512], nwg = (ntr + 32) * nN;
        int T = nwg % G, nfull = nwg - T; if (true) { nfull = nwg; T = 0; }
        const int njobs = nfull + parts * T;
        const int i = threadIdx.x; n = 0;
        if (c < njobs) n = (njobs - 1 - c) / G + 1;
        if (i < 32 && i < n) {
            const int L = i * G + c; int wgid, mask = 15;
            if (L < nfull) wgid = L; else { const int j = L - nfull; wgid = nfull + j % T; const int part = j / T; mask = (parts == 2) ? (part ? 12 : 3) : (1 << part); }
            { const int q = nwg / 8, r = nwg % 8, xcd = wgid % 8, off = wgid / 8; wgid = (xcd < r ? xcd * (q + 1) : r * (q + 1) + (xcd - r) * q) + off; }
            const int ti = wgid / nN, pn = wgid % nN; int tile, e; if (ti < ntr) { tile = ti; e = tile_exp[ti]; } else { tile = 320 + (ti - ntr); e = 64; }
            const long boff = (long)e * estride + (long)pn * bstep;
            tab[i * 8 + 0] = tile; tab[i * 8 + 1] = pn; tab[i * 8 + 2] = (int)(boff & 0xffffffffl); tab[i * 8 + 3] = (int)(boff >> 32); tab[i * 8 + 4] = mask;
        }
        __syncthreads();
    }
    __device__ bool next(int i, pg8::Unit& u) const {
        if (i >= n) return false;
        u.pm = tab[i * 8 + 0]; u.pn = tab[i * 8 + 1]; u.boff = (long)(((unsigned long long)(unsigned)tab[i * 8 + 3] << 32) | (unsigned)tab[i * 8 + 2]); u.mask = tab[i * 8 + 4]; u.pad = 0; return true;
    }
};
struct EpiGateUp { static constexpr bool PERM = true, MIDK = false; unsigned char* H;
    __device__ __forceinline__ void operator()(const pg8::f32x4 (&acc)[2][2][4][2], const pg8::Unit& u, int wr, int wc, int fr, int fq) const {
        const int row0 = u.pm * 256 + wr * 64 + fr, col0 = u.pn * 128 + wc * 32 + 8 * fq;
#pragma unroll
        for (int ai = 0; ai < 2; ++ai)
#pragma unroll
            for (int m = 0; m < 4; ++m) { const int row = row0 + ai * 128 + m * 16; float o[8];
#pragma unroll
                for (int n = 0; n < 2; ++n)
#pragma unroll
                    for (int j = 0; j < 4; ++j) { const float gt = acc[ai][0][m][n][j] * (1.f / 256.f), up = acc[ai][1][m][n][j] * (8.f / 256.f); o[n * 4 + j] = gt / (1.f + __expf(-gt)) * up; }
                v2u w; w.x = pk4_fp8(o[0], o[1], o[2], o[3]); w.y = pk4_fp8(o[4], o[5], o[6], o[7]);
                *(v2u*)(H + (size_t)row * DE + col0) = w; }
    }
};
struct EpiDown { static constexpr bool PERM = true, MIDK = false; unsigned char* Y;
    __device__ __forceinline__ void operator()(const pg8::f32x4 (&acc)[2][2][4][2], const pg8::Unit& u, int wr, int wc, int fr, int fq) const {
        const int row0 = u.pm * 256 + wr * 64 + fr, col0 = u.pn * 256 + wc * 32 + 8 * fq; const float s = 16.f / 512.f;
#pragma unroll
        for (int ai = 0; ai < 2; ++ai)
#pragma unroll
            for (int m = 0; m < 4; ++m) { const int row = row0 + ai * 128 + m * 16; unsigned char* rowp = Y + (size_t)row * DM + col0;
#pragma unroll
                for (int bj = 0; bj < 2; ++bj) { const pg8::f32x4 v0 = acc[ai][bj][m][0] * s, v1 = acc[ai][bj][m][1] * s;
                    v2u w; w.x = pk4_fp8(v0[0], v0[1], v0[2], v0[3]); w.y = pk4_fp8(v1[0], v1[1], v1[2], v1[3]); *(v2u*)(rowp + bj * 128) = w; } }
    }
};
__device__ __forceinline__ void phase10(const Params& p, LAS unsigned char* lds) {
    unsigned char* ws = p.ws;
    pg8::Gemm g{(const bf16_t*)(ws + WS_U16), (const bf16_t*)(ws + WS_BT_GU), (const int*)(ws + TAB_ROWTOK), DM, DM, DM, 0};
    MoeOrder S; S.init(lds, (const int*)(ws + TAB_TILEEXP), 4, gridDim.x, blockIdx.x, (long)1024 * DM, (long)256 * DM, 2);
    EpiGateUp E{ws + WS_HID};
    pg8::gemm_phase<EpiGateUp, MoeOrder, 1>((PG8_LAS unsigned char*)lds, g, S, E);
}
__device__ __forceinline__ void phase11(const Params& p, LAS unsigned char* lds) {
    unsigned char* ws = p.ws;
    pg8::Gemm g{(const bf16_t*)(ws + WS_HID), (const bf16_t*)(ws + WS_BT_DN), nullptr, DE, DE, DE, 0};
    MoeOrder S; S.init(lds, (const int*)(ws + TAB_TILEEXP), 8, gridDim.x, blockIdx.x, (long)DM * DE, (long)256 * DE, 4);
    EpiDown E{ws + WS_Y};
    pg8::gemm_phase<EpiDown, MoeOrder, 1>((PG8_LAS unsigned char*)lds, g, S, E);
}
__device__ __forceinline__ void fp8x8_fma(const v2u y, float w, float (&a)[8]) {
#pragma unroll
    for (int q = 0; q < 2; ++q) { const unsigned d = y[q];
        a[q * 4 + 0] += w * __builtin_amdgcn_cvt_f32_fp8((int)d, 0); a[q * 4 + 1] += w * __builtin_amdgcn_cvt_f32_fp8((int)d, 1);
        a[q * 4 + 2] += w * __builtin_amdgcn_cvt_f32_fp8((int)d, 2); a[q * 4 + 3] += w * __builtin_amdgcn_cvt_f32_fp8((int)d, 3); }
}
__device__ __forceinline__ void phase12(const Params& p, int wave, int lane) {
    unsigned char* ws = p.ws;
    const float* h1 = (const float*)(ws + WS_H1); const float* mod = (const float*)(ws + CTL_MOD); const unsigned char* Y = ws + WS_Y;
    const int* slot = (const int*)(ws + TAB_SLOT); const float* top_w = (const float*)(ws + TAB_TOPW);
    const int gw = blockIdx.x * NWAVES + wave, NGW = gridDim.x * NWAVES;
    for (int t = gw; t < NT; t += NGW) {
        const int b = t / SEQ; const float* gt = mod + b * MODW + 5 * DM;
        int sl = 0; float wk = 0.f; if (lane < 8) { sl = slot[t * 8 + lane]; wk = top_w[t * 8 + lane] * (1.f / 16.f); }
#pragma unroll 2
        for (int j = 0; j < 4; ++j) {
            const int col = j * 512 + lane * 4;
            float a[8];
#pragma unroll
            for (int i = 0; i < 8; ++i) a[i] = 0.f;
            v2u yr[9];
            { const unsigned char* yp = Y + (size_t)(ROUTED_ROWS_MAX + t) * DM + col; yr[8].x = __builtin_nontemporal_load((const unsigned*)yp); yr[8].y = __builtin_nontemporal_load((const unsigned*)(yp + 256)); }
#pragma unroll
            for (int k = 0; k < 8; ++k) { const int s = __builtin_amdgcn_readlane(sl, k); const unsigned char* yp = Y + (size_t)s * DM + col;
                yr[k].x = __builtin_nontemporal_load((const unsigned*)yp); yr[k].y = __builtin_nontemporal_load((const unsigned*)(yp + 256)); }
            const f32x4 h0 = *(const f32x4*)(h1 + (size_t)t * DM + col), h4 = *(const f32x4*)(h1 + (size_t)t * DM + col + 256);
            const f32x4 g0 = *(const f32x4*)(gt + col), g4 = *(const f32x4*)(gt + col + 256);
            fp8x8_fma(yr[8], 1.f / 16.f, a);
#pragma unroll
            for (int k = 0; k < 8; ++k) { const float w = __builtin_bit_cast(float, __builtin_amdgcn_readlane(__builtin_bit_cast(int, wk), k)); fp8x8_fma(yr[k], w, a); }
            f32x4 o0, o4; o0.x = h0.x + g0.x * a[0]; o0.y = h0.y + g0.y * a[1]; o0.z = h0.z + g0.z * a[2]; o0.w = h0.w + g0.w * a[3];
            o4.x = h4.x + g4.x * a[4]; o4.y = h4.y + g4.y * a[5]; o4.z = h4.z + g4.z * a[6]; o4.w = h4.w + g4.w * a[7];
            __builtin_nontemporal_store(o0, (f32x4*)(p.out + (size_t)t * DM + col)); __builtin_nontemporal_store(o4, (f32x4*)(p.out + (size_t)t * DM + col + 256));
        }
    }
}

__global__ void __launch_bounds__(NTHR, 2) k_mega(Params p) {
    extern __shared__ __attribute__((aligned(16))) unsigned char lds_raw[];
    LAS unsigned char* lds = (LAS unsigned char*)lds_raw;
    const int tid = threadIdx.x, lane = tid & 63, wave = __builtin_amdgcn_readfirstlane(tid >> 6);
    volatile LAS unsigned* MISC = (volatile LAS unsigned*)(lds + MISC_OFF);
    for (int u = tid; u < (LDS_BYTES - RING_BYTES) / 4; u += NTHR) ((LAS unsigned*)(lds + RING_BYTES))[u] = 0u;
    __syncthreads();
    XcdBarrier bar = xcd_barrier_post((unsigned*)(p.ws + WS_CTL) + CW_BAR, MISC + 8);
    const int lo = p.ph_lo, hi = p.ph_hi;
#ifndef DUP_MASK
#define DUP_MASK 0
#endif
#define IN(k) (lo <= (k) && (k) < hi)
#define DUPK(k, body) do { if (IN(k)) { body; if ((DUP_MASK >> (k)) & 1) { xcd_barrier(bar); body; } } } while (0)
#ifdef SPIN_PHASE
#define STAMP(k) do { if (blockIdx.x == 0 && tid == 0) ((unsigned long long*)(p.ws + 49152))[k] = __builtin_amdgcn_s_memrealtime(); } while (0)
#else
#define STAMP(k) do { } while (0)
#endif
#define SEAM(k) do { if (IN(k) && IN((k) + 1)) { xcd_barrier(bar); STAMP((k) + 1); } } while (0)
    STAMP(0);
    DUPK(0, phase0(p, lds, wave, lane)); SEAM(0);
    DUPK(1, phase1(p, lds, wave, lane)); SEAM(1);
#ifdef EXTRA_BARS
    for (int eb = 0; eb < EXTRA_BARS; ++eb) xcd_barrier(bar);
#endif
    DUPK(2, phase2(p, lds)); SEAM(2);
    DUPK(3, phase3_gemms(p, lds); hgrn_pass1(p, lds, wave, lane)); SEAM(3);
    DUPK(4, hgrn_scan(p); phase4_qk(p, wave, lane); if ((DUP_MASK >> 17) & 1) { xcd_barrier(bar); phase4_qk(p, wave, lane); }); SEAM(4);
    DUPK(5, phase5_attn(p, lds, wave, lane); hgrn_pass3(p, lds, wave, lane); if ((DUP_MASK >> 16) & 1) { xcd_barrier(bar); hgrn_pass3(p, lds, wave, lane); }); if (IN(5) && IN(7)) { xcd_barrier(bar); STAMP(6); STAMP(7); }
    DUPK(7, phase7(p, lds)); SEAM(7);
    DUPK(8, phase8(p, lds, wave, lane)); SEAM(8);
    DUPK(9, phase9(p, lds, wave, lane)); SEAM(9);
    DUPK(10, phase10(p, lds)); SEAM(10);
    DUPK(11, phase11(p, lds)); SEAM(11);
    DUPK(12, phase12(p, wave, lane));
#ifdef SPIN_NTR
    { const int ntr = ((const int*)(p.ws + TAB_TILEEXP))[512]; const unsigned long long d = (unsigned long long)(ntr - 256) * 1000ull;
      const unsigned long long t0 = __builtin_amdgcn_s_memrealtime(); while (__builtin_amdgcn_s_memrealtime() - t0 < d) __builtin_amdgcn_s_sleep(8); }
#endif
#ifdef SPIN_PHASE
    xcd_barrier(bar); STAMP(13);
    xcd_barrier(bar);
    { const unsigned long long* ts = (const unsigned long long*)(p.ws + 49152);
      const unsigned long long d = __hip_atomic_load(ts + SPIN_PHASE + 1, __ATOMIC_RELAXED, __HIP_MEMORY_SCOPE_AGENT) - __hip_atomic_load(ts + SPIN_PHASE, __ATOMIC_RELAXED, __HIP_MEMORY_SCOPE_AGENT);
      const unsigned long long t0 = __builtin_amdgcn_s_memrealtime(); while (__builtin_amdgcn_s_memrealtime() - t0 < 4ull * d) __builtin_amdgcn_s_sleep(8); }
#endif
#undef IN
#undef SEAM
}
extern "C" void kernel_launch(void* const* d_in, const int* in_sizes, int n_in, void* d_out, int out_size, void* d_ws, size_t ws_size, hipStream_t stream) {
    static int grid = 0;
    if (grid == 0) {
        int dev = 0, cus = 0;
        if (hipGetDevice(&dev) != hipSuccess || hipDeviceGetAttribute(&cus, hipDeviceAttributeMultiprocessorCount, dev) != hipSuccess) { grid = -1; return; }
        if (hipFuncSetAttribute((const void*)k_mega, hipFuncAttributeMaxDynamicSharedMemorySize, LDS_BYTES) != hipSuccess) { fprintf(stderr, "kernel_launch: hipFuncSetAttribute failed\n"); grid = -1; return; }
        (void)hipGetLastError();
        grid = cus;
        if (n_in != 26 || ws_size < WS_END) { fprintf(stderr, "kernel_launch: unexpected inputs / workspace (%d, %zu)\n", n_in, ws_size); grid = -1; return; }
    }
    if (grid < 0) return;
    (void)hipMemsetAsync((char*)d_ws + WS_CTL, 0, CTL_ZERO_BYTES, stream);
    Params p{};
    for (int i = 0; i < 26; ++i) p.in[i] = (const float*)d_in[i];
    p.out = (float*)d_out; p.ws = (unsigned char*)d_ws; p.ph_lo = 0; p.ph_hi = 13;
    hipLaunchKernelGGL(k_mega, dim3(grid), dim3(NTHR), LDS_BYTES, stream, p);
}
```

```cpp
#include <hip/hip_runtime.h>
#include <cstdio>
#include <cstdint>
constexpr int NB = 4, SEQ = 2048, DM = 2048, NT = NB * SEQ;
constexpr int INC = 4928, INCP = 5120;
constexpr int MH = 8, QR = 512, KVR = 256, QKD = 192, VD = 128;
constexpr int NE = 64, DE = 512;
constexpr float EPS = 1e-6f;
constexpr int MODW = 6 * DM;
constexpr int NWAVES = 8, NTHR = 512;
constexpr int PROWS = 90112;
constexpr int ROUTED_ROWS_MAX = 81920;

constexpr size_t MiB = 1u << 20;
constexpr size_t WS_CTL = 0, CTL_ZERO_BYTES = 1 * MiB;
constexpr int CW_BAR = 1024;
constexpr size_t CTL_MOD = 64 * 1024;
constexpr size_t WS_MODP = 4 * MiB;
constexpr size_t TAB_SSQ_Q8 = 7 * MiB, TAB_SSQ_KV4 = 7 * MiB + 256 * 1024, TAB_SSQ_O8 = 7 * MiB + 512 * 1024;
constexpr size_t CTL_HIST = 416 * 1024;
constexpr size_t WS_TAB = 1 * MiB;
constexpr size_t TAB_HGD = WS_TAB;
constexpr size_t TAB_TOPI = WS_TAB + 1 * MiB;
constexpr size_t TAB_TOPW = TAB_TOPI + 256 * 1024;
constexpr size_t TAB_SLOT = TAB_TOPW + 256 * 1024;
constexpr size_t TAB_ROWTOK = TAB_SLOT + 256 * 1024;
constexpr size_t TAB_TILEEXP = TAB_ROWTOK + 512 * 1024;
constexpr size_t WS_BT_IN = 8 * MiB, WS_BT_UQ = 28 * MiB, WS_BT_KV = 30 * MiB, WS_BT_OUT = 32 * MiB, WS_BT_GU = 40 * MiB, WS_BT_DN = 300 * MiB;
constexpr size_t WS_WRH = 31 * MiB, WS_WRL = 31 * MiB + 256 * 1024;
constexpr size_t WS_U16 = 430 * MiB, WS_H1 = 462 * MiB, WS_HID = 526 * MiB, WS_X = 614 * MiB;
constexpr size_t WS_PROJ = WS_X, WS_QRAW = WS_X + 80 * MiB, WS_KRAW = WS_X + 104 * MiB, WS_VT = WS_X + 120 * MiB, WS_Q16 = WS_X + 136 * MiB, WS_K16 = WS_X + 160 * MiB,
                 WS_HGU = WS_X + 184 * MiB, WS_MERGED = WS_X + 216 * MiB, WS_Y = WS_X, WS_END = 966 * MiB;

constexpr int RING_BYTES = 131072, LDS_BYTES = 163840, MISC_OFF = LDS_BYTES - 256;

#define GAS __attribute__((address_space(1)))
#define LAS __attribute__((address_space(3)))
typedef unsigned short bf16_t;
typedef unsigned v4u __attribute__((ext_vector_type(4)));
typedef unsigned v2u __attribute__((ext_vector_type(2)));
typedef float f32x4 __attribute__((ext_vector_type(4)));
typedef GAS unsigned gu32;
#define RLX_AGENT __ATOMIC_RELAXED, __HIP_MEMORY_SCOPE_AGENT
__device__ __forceinline__ unsigned f2bf(float f) { unsigned u = __builtin_bit_cast(unsigned, f); return (u + 0x7fffu + ((u >> 16) & 1u)) >> 16; }
__device__ __forceinline__ unsigned pk2(float lo, float hi) { unsigned r; asm volatile("v_cvt_pk_bf16_f32 %0, %1, %2" : "=v"(r) : "v"(lo), "v"(hi)); return r; }
__device__ __forceinline__ float bf2f(unsigned short b) { return __builtin_bit_cast(float, ((unsigned)b) << 16); }
__device__ __forceinline__ float bflo(unsigned w) { return __builtin_bit_cast(float, w << 16); }
__device__ __forceinline__ float bfhi(unsigned w) { return __builtin_bit_cast(float, w & 0xffff0000u); }
__device__ __forceinline__ float sigmoidf_(float x) { return 1.f / (1.f + __expf(-x)); }
__device__ __forceinline__ float siluf_(float x) { return x / (1.f + __expf(-x)); }
template <int CTRL, int RM> __device__ __forceinline__ float dppf(float x) { return __builtin_bit_cast(float, __builtin_amdgcn_update_dpp(0, __builtin_bit_cast(int, x), CTRL, RM, 0xF, false)); }
__device__ __forceinline__ float wave_sum(float v) {
    v += dppf<0xB1, 0xF>(v); v += dppf<0x4E, 0xF>(v); v += dppf<0x141, 0xF>(v); v += dppf<0x140, 0xF>(v);
    v += dppf<0x142, 0xA>(v); v += dppf<0x143, 0xC>(v);
    return __builtin_bit_cast(float, __builtin_amdgcn_readlane(__builtin_bit_cast(int, v), 63));
}
__device__ __forceinline__ float max8(float m) {
    m = fmaxf(m, dppf<0xB1, 0xF>(m)); m = fmaxf(m, dppf<0x4E, 0xF>(m)); m = fmaxf(m, dppf<0x141, 0xF>(m)); return m;
}

#define XB_TMO      128
#define XB_XCNT(j)  (256  + 64 * (j))
#define XB_XSUB(j)  (1280 + 64 * (j))
#define XB_XGEN(j)  (2304 + 64 * (j))
#define XB_TOP      3328
#define XB_TOPGEN   3392
#define XCD_BAR_WORDS 3456
#define XB_SPIN_CAP (1u << 18)
__device__ __forceinline__ unsigned xb_ld(unsigned* p)              { return __hip_atomic_load(p, __ATOMIC_RELAXED, __HIP_MEMORY_SCOPE_AGENT); }
__device__ __forceinline__ unsigned xb_add(unsigned* p, unsigned v) { return __hip_atomic_fetch_add(p, v, __ATOMIC_RELAXED, __HIP_MEMORY_SCOPE_AGENT); }
__device__ __forceinline__ unsigned xb_xcc_id() { return (unsigned)__builtin_amdgcn_s_getreg((3 << 11) | 20) & 0xFu; }
#define XB_SPIN(cond, bar) do { unsigned _sp = 0; while (cond) { __builtin_amdgcn_s_sleep(1); \
    if ((++_sp & 255u) == 0u) { if (xb_ld(&(bar)[XB_TMO])) break; if (_sp > XB_SPIN_CAP) { atomicAdd(&(bar)[XB_TMO], 1u); break; } } } } while (0)
struct XcdBarrier { unsigned* bar; unsigned x; volatile LAS unsigned* st; };
__device__ __forceinline__ XcdBarrier xcd_barrier_post(unsigned* bar, volatile LAS unsigned* st) {
    XcdBarrier b; b.bar = bar; b.x = xb_xcc_id(); b.st = st;
    if (threadIdx.x == 0) (void)xb_add(&bar[XB_XCNT(b.x)], 1u);
    return b;
}
__device__ __forceinline__ void xcd_barrier_complete(unsigned* bar, unsigned x, unsigned& nloc, unsigned& nx) {
    const unsigned G = gridDim.x * gridDim.y * gridDim.z;
    unsigned sum, cnt, mine, sp = 0u;
    for (;;) {
        sum = 0u; cnt = 0u; mine = 0u;
#pragma unroll
        for (unsigned j = 0; j < 16; ++j) { const unsigned c = xb_ld(&bar[XB_XCNT(j)]); sum += c; cnt += (c > 0u) ? 1u : 0u; mine = (j == x) ? c : mine; }
        if (sum == G) break;
        __builtin_amdgcn_s_sleep(1);
        if ((++sp & 255u) == 0u) { if (xb_ld(&bar[XB_TMO])) break; if (sp > XB_SPIN_CAP) { atomicAdd(&bar[XB_TMO], 1u); break; } }
    }
    nloc = mine > 0u ? mine : 1u; nx = cnt > 0u ? cnt : 1u;
}
__device__ __forceinline__ void xcd_barrier(const XcdBarrier& b) {
    asm volatile("s_waitcnt vmcnt(0)" ::: "memory");
    __syncthreads();
    if (threadIdx.x == 0) {
        unsigned* bar = b.bar;
        __builtin_amdgcn_s_waitcnt(0);
        unsigned nloc = b.st[0], nx = b.st[1];
        if (nloc == 0u) { xcd_barrier_complete(bar, b.x, nloc, nx); b.st[0] = nloc; b.st[1] = nx; }
        const unsigned old = xb_add(&bar[XB_XSUB(b.x)], 1u);
        const unsigned gen = old / nloc;
        if (old + 1u == (gen + 1u) * nloc) {
            __builtin_amdgcn_fence(__ATOMIC_RELEASE, "agent");
            asm volatile("s_waitcnt vmcnt(0)" ::: "memory");
            const unsigned og = xb_add(&bar[XB_TOP], 1u);
            const unsigned tg = og / nx;
            if (og + 1u == (tg + 1u) * nx) xb_add(&bar[XB_TOPGEN], 1u);
            else XB_SPIN(xb_ld(&bar[XB_TOPGEN]) == tg, bar);
            __builtin_amdgcn_fence(__ATOMIC_ACQUIRE, "agent");
            xb_add(&bar[XB_XGEN(b.x)], 1u);
            asm volatile("s_waitcnt vmcnt(0)" ::: "memory");
        } else {
            XB_SPIN(xb_ld(&bar[XB_XGEN(b.x)]) == gen, bar);
            __builtin_amdgcn_fence(__ATOMIC_ACQUIRE, "agent");
            asm volatile("s_waitcnt vmcnt(0)" ::: "memory");
        }
    }
    __syncthreads();
}

struct Params { const float* in[26]; float* out; unsigned char* ws; int ph_lo, ph_hi; };
namespace pg8 {
#define PG8_LAS __attribute__((address_space(3)))
typedef unsigned short bf16_t;
typedef short bf16x8 __attribute__((ext_vector_type(8)));
typedef float f32x4 __attribute__((ext_vector_type(4)));
typedef unsigned u32x4 __attribute__((ext_vector_type(4)));
typedef unsigned u32x2 __attribute__((ext_vector_type(2)));
constexpr int BM = 256, BK = 64, HALF = 128, HTB = HALF * BK * 2, STAGE_BYTES = 8 * HTB, NXCD = 8, WGM = 8;

__host__ __device__ __forceinline__ int lds_byte(int r, int c) { const int st = (r >> 4) * 2 + (c >> 5), rr = r & 15, cc = c & 31, ob = rr * 64 + cc * 2; return st * 1024 + (ob ^ (((ob >> 9) & 1) << 5)); }
__host__ __device__ __forceinline__ void stage_rc(int b, int& R, int& C) { const int st = b / 1024, sb = b % 1024, swz = sb ^ (((sb >> 9) & 1) << 5); R = (st >> 1) * 16 + swz / 64; C = (st & 1) * 32 + (swz % 64) / 2; }
__host__ __device__ __forceinline__ int perm32(int rho) { const int n = rho >> 4, i = rho & 15; return 8 * (i >> 2) + 4 * n + (i & 3); }

struct Unit { int pm, pn; long boff; int mask, pad; };
struct Gemm { const bf16_t* A; const bf16_t* Bt; const int* rowtab; int lda, ldb, K, pad; };

__device__ __forceinline__ unsigned cvt_pk_bf16(float lo, float hi) { unsigned r; asm volatile("v_cvt_pk_bf16_f32 %0, %1, %2" : "=v"(r) : "v"(lo), "v"(hi)); return r; }

struct StaticOrder {
    int nM, nN, nwg, G, c, nfull, T; long bstep;
    __device__ void init(int nM_, int nN_, int G_, int c_, int ldb) { nM = nM_; nN = nN_; nwg = nM * nN; G = G_; c = c_; bstep = (long)BM * ldb * 2;
        T = 0; nfull = nwg; }
    __device__ bool next(int i, Unit& u) const {
        const long L = (long)i * G + c; int wgid, mask = 15;
        if (L < nfull) wgid = (int)L;
        else { const long j = L - nfull; if (j >= 2 * T) return false; wgid = nfull + (int)(j % T); mask = (j / T) ? 12 : 3; }
        { const int q = nwg / NXCD, r = nwg % NXCD, xcd = wgid % NXCD, off = wgid / NXCD; wgid = (xcd < r ? xcd * (q + 1) : r * (q + 1) + (xcd - r) * q) + off; }
        const int nig = WGM * nN, gid = wgid / nig, fm = gid * WGM, gsz = (nM - fm) < WGM ? (nM - fm) : WGM;
        u.pm = fm + ((wgid % nig) % gsz); u.pn = (wgid % nig) / gsz; u.boff = (long)u.pn * bstep; u.mask = mask; u.pad = i; return true;
    }
};

typedef long i64x2 __attribute__((ext_vector_type(2)));
typedef int i32x4 __attribute__((ext_vector_type(4)));
typedef int i32x8 __attribute__((ext_vector_type(8)));
template <class Epi, class Sched, int ES = 2, bool ALIGN_EPI = true, bool BT = false>
__device__ __forceinline__ void gemm_phase(PG8_LAS unsigned char* lds, const Gemm g, const Sched& S, const Epi& E) {
    const int tid = threadIdx.x, wid = __builtin_amdgcn_readfirstlane(tid >> 6), lane = tid & 63, wr = wid >> 2, wc = wid & 3, fr = lane & 15, fq = lane >> 4;
    const int K = g.K, nt = K * ES / (BK * 2);
    int Rr[2]; unsigned Cb[2], voffB[2];
#pragma unroll
    for (int i = 0; i < 2; ++i) { int R, C; stage_rc(tid * 16 + i * 8192, R, C); const int Rb = Epi::PERM ? ((R & ~31) + perm32(R & 31)) : R;
        Rr[i] = R; Cb[i] = (unsigned)C * 2u; voffB[i] = (BT ? (unsigned)Rb * 128u : (unsigned)(Rb * g.ldb) * (unsigned)ES) + (unsigned)C * 2u; }
    const size_t kstep = (size_t)(BK * 2), kstepB = BT ? (size_t)(BM * BK * 2) : kstep;
    const size_t hstepB = BT ? (size_t)(HALF * BK * 2) : (size_t)HALF * g.ldb * ES;
    const unsigned lda2 = (unsigned)g.lda * (unsigned)ES;
    const unsigned ldsw = (unsigned)wid * 1024u;
    const int aoff = lds_byte(wr * 64 + fr, fq * 8), boff = lds_byte(wc * 32 + fr, fq * 8);
    const char* const Abase = (const char*)g.A; const char* const Bbase = (const char*)g.Bt;
#define PG8_SA(b, h) (((b) * 2 + (h)) * HTB)
#define PG8_SB(b, h) ((4 + (b) * 2 + (h)) * HTB)
#define PG8_STAGE(bufoff, gbase, voff) do { const char* _gb = (const char*)(gbase); asm volatile("" : "+s"(_gb));     \
        _Pragma("unroll") for (int _i = 0; _i < 2; ++_i) { unsigned _vo = (voff)[_i]; asm volatile("" : "+v"(_vo)); \
        __builtin_amdgcn_global_load_lds((const unsigned*)(_gb + _vo), (PG8_LAS unsigned*)(lds + (bufoff) + ldsw + _i * 8192), 16, 0, 0); } } while (0)
#define PG8_VOFFA(u, v) do { _Pragma("unroll") for (int _h = 0; _h < 2; ++_h) _Pragma("unroll") for (int _i = 0; _i < 2; ++_i) { const int _gr = (u).pm * BM + _h * HALF + Rr[_i]; \
        const int _src = g.rowtab ? g.rowtab[_gr] : _gr; (v)[_h][_i] = (unsigned)_src * lda2 + Cb[_i]; } } while (0)
#define PG8_LDA(dst, b, h) do { if constexpr (ES == 2) { _Pragma("unroll") for (int m = 0; m < 4; ++m) _Pragma("unroll") for (int k = 0; k < 2; ++k) dst[m][k] = *(const PG8_LAS bf16x8*)(lds + PG8_SA(b, h) + aoff + m * 2048 + k * 1024); } \
        else { _Pragma("unroll") for (int m = 0; m < 4; ++m) { const i32x4 _lo = *(const PG8_LAS i32x4*)(lds + PG8_SA(b, h) + aoff + m * 2048), _hi = *(const PG8_LAS i32x4*)(lds + PG8_SA(b, h) + aoff + m * 2048 + 1024); \
            dst##8[m] = __builtin_shufflevector(_lo, _hi, 0, 1, 2, 3, 4, 5, 6, 7); } } } while (0)
#define PG8_LDB(dst, b, h) do { if constexpr (ES == 2) { _Pragma("unroll") for (int n = 0; n < 2; ++n) _Pragma("unroll") for (int k = 0; k < 2; ++k) dst[n][k] = *(const PG8_LAS bf16x8*)(lds + PG8_SB(b, h) + boff + n * 2048 + k * 1024); } \
        else { _Pragma("unroll") for (int n = 0; n < 2; ++n) { const i32x4 _lo = *(const PG8_LAS i32x4*)(lds + PG8_SB(b, h) + boff + n * 2048), _hi = *(const PG8_LAS i32x4*)(lds + PG8_SB(b, h) + boff + n * 2048 + 1024); \
            dst##8[n] = __builtin_shufflevector(_lo, _hi, 0, 1, 2, 3, 4, 5, 6, 7); } } } while (0)
#define PG8_MMA(ai, bj, At, Bt) do { __builtin_amdgcn_s_setprio(1); \
        if constexpr (ES == 2) { _Pragma("unroll") for (int m = 0; m < 4; ++m) _Pragma("unroll") for (int n = 0; n < 2; ++n) _Pragma("unroll") for (int k = 0; k < 2; ++k) \
            acc[ai][bj][m][n] = __builtin_amdgcn_mfma_f32_16x16x32_bf16(Bt[n][k], At[m][k], acc[ai][bj][m][n], 0, 0, 0); } \
        else { _Pragma("unroll") for (int m = 0; m < 4; ++m) _Pragma("unroll") for (int n = 0; n < 2; ++n)     \
            asm volatile("v_mfma_scale_f32_16x16x128_f8f6f4 %0, %1, %2, %0, %3, %3 op_sel_hi:[0,0,0]" : "+v"(acc[ai][bj][m][n]) : "v"(Bt##8[n]), "v"(At##8[m]), "v"(mxone)); } \
        __builtin_amdgcn_s_setprio(0); } while (0)
#define PG8_WAIT_V(n) asm volatile("s_waitcnt vmcnt(" #n ")" ::: "memory")
#define PG8_WAIT_V8R(rel) do { if constexpr (Epi::NST == 8) { if (rel) asm volatile("s_waitcnt vmcnt(16)" ::: "memory"); else asm volatile("s_waitcnt vmcnt(8)" ::: "memory"); } \
        else if constexpr (Epi::NST == 16) { if (rel) asm volatile("s_waitcnt vmcnt(24)" ::: "memory"); else asm volatile("s_waitcnt vmcnt(8)" ::: "memory"); } \
        else asm volatile("s_waitcnt vmcnt(8)" ::: "memory"); } while (0)
#define PG8_WAIT_L(n) asm volatile("s_waitcnt lgkmcnt(" #n ")" ::: "memory")
#define PG8_BAR __builtin_amdgcn_s_barrier()
#define PG8_SCHED __builtin_amdgcn_sched_barrier(0)
    Unit cur, nxt; int ui = 0, pmask = 0;
    if (!S.next(0, cur)) return;
    f32x4 acc[2][2][4][2];
#pragma unroll
    for (int a = 0; a < 2; ++a)
#pragma unroll
        for (int b = 0; b < 2; ++b)
#pragma unroll
            for (int m = 0; m < 4; ++m)
#pragma unroll
                for (int n = 0; n < 2; ++n) acc[a][b][m][n] = (f32x4){0.f, 0.f, 0.f, 0.f};
    bf16x8 At[4][2], B0[2][2], B1[2][2];
    i32x8 At8[4], B08[2], B18[2];
    int mxone = 0x7f7f7f7f; asm volatile("" : "+v"(mxone));
    unsigned cv[2][2], nv[2][2];
    PG8_VOFFA(cur, cv);
#pragma unroll
    for (int h = 0; h < 2; ++h) { nv[h][0] = cv[h][0]; nv[h][1] = cv[h][1]; }
    const char* cB = Bbase + cur.boff;
    PG8_STAGE(PG8_SB(0, 0), cB, voffB); PG8_STAGE(PG8_SB(0, 1), cB + hstepB, voffB); PG8_STAGE(PG8_SA(0, 0), Abase, cv[0]); PG8_STAGE(PG8_SA(0, 1), Abase, cv[1]);
    if (wr == 1) PG8_BAR;
    PG8_WAIT_V(2); PG8_BAR;
    PG8_STAGE(PG8_SB(1, 0), cB + kstepB, voffB); PG8_STAGE(PG8_SA(1, 0), Abase + kstep, cv[0]); PG8_STAGE(PG8_SB(1, 1), cB + hstepB + kstepB, voffB);
    PG8_WAIT_V(6); PG8_BAR;
    for (;;) {
        const bool has_next = S.next(ui + 1, nxt);
        const char* nB = has_next ? Bbase + nxt.boff : cB;
#pragma unroll 1
        for (int t = 0; t < nt; t += 2) {
            const bool last = (t == nt - 2);
            const bool relax = (t == 0) && (ui > 0) && (pmask == 15);
            if constexpr (Epi::MIDK) { if (t == nt / 2) E.mid(acc, cur, wr, wc, fr, fq); }
            if (t == 0 && has_next) { PG8_VOFFA(nxt, nv); }
            const char* a1 = Abase + (size_t)(t + 1) * kstep;
            const char* a2 = Abase + (last ? (size_t)0 : (size_t)(t + 2) * kstep); const char* a3 = a2 + kstep;
            const char* b2 = last ? nB : cB + (size_t)(t + 2) * kstepB; const char* b3 = b2 + kstepB;
            unsigned x0[2], x1[2];
            x0[0] = last ? nv[0][0] : cv[0][0]; x0[1] = last ? nv[0][1] : cv[0][1]; x1[0] = last ? nv[1][0] : cv[1][0]; x1[1] = last ? nv[1][1] : cv[1][1];
            PG8_LDB(B0, 0, 0); PG8_LDB(B1, 0, 1); PG8_SCHED; PG8_LDA(At, 0, 0); PG8_STAGE(PG8_SA(1, 1), a1, cv[1]);
            PG8_WAIT_V8R(relax); PG8_WAIT_L(0); PG8_BAR; PG8_MMA(0, 0, At, B0); PG8_MMA(0, 1, At, B1); PG8_BAR; PG8_SCHED;
            PG8_LDA(At, 0, 1); PG8_STAGE(PG8_SB(0, 0), b2, voffB); PG8_STAGE(PG8_SB(0, 1), b2 + hstepB, voffB); PG8_STAGE(PG8_SA(0, 0), a2, x0);
            PG8_WAIT_V8R(relax); PG8_WAIT_L(0); PG8_BAR; PG8_MMA(1, 0, At, B0); PG8_MMA(1, 1, At, B1); PG8_BAR; PG8_SCHED;
            PG8_LDB(B0, 1, 0); PG8_LDB(B1, 1, 1); PG8_SCHED; PG8_LDA(At, 1, 0); PG8_STAGE(PG8_SA(0, 1), a2, x1);
            PG8_WAIT_V(8); PG8_WAIT_L(0); PG8_BAR; PG8_MMA(0, 0, At, B0); PG8_MMA(0, 1, At, B1); PG8_BAR; PG8_SCHED;
            PG8_LDA(At, 1, 1); PG8_STAGE(PG8_SB(1, 0), b3, voffB); PG8_STAGE(PG8_SB(1, 1), b3 + hstepB, voffB); PG8_STAGE(PG8_SA(1, 0), a3, x0);
            PG8_WAIT_V(8); PG8_WAIT_L(0); PG8_BAR; PG8_MMA(1, 0, At, B0); PG8_MMA(1, 1, At, B1); PG8_BAR; PG8_SCHED;
        }
        asm volatile("s_nop 7\n\ts_nop 7\n\ts_nop 7" ::: "memory");
        if constexpr (ALIGN_EPI) { if (wr == 0) PG8_BAR; }
        E(acc, cur, wr, wc, fr, fq);
        if (!has_next) break;
#pragma unroll
        for (int a = 0; a < 2; ++a)
#pragma unroll
            for (int b = 0; b < 2; ++b)
#pragma unroll
                for (int m = 0; m < 4; ++m)
#pragma unroll
                    for (int n = 0; n < 2; ++n) acc[a][b][m][n] = (f32x4){0.f, 0.f, 0.f, 0.f};
        pmask = cur.mask; cur = nxt; cB = nB; ++ui;
#pragma unroll
        for (int h = 0; h < 2; ++h) { cv[h][0] = nv[h][0]; cv[h][1] = nv[h][1]; }
        if constexpr (ALIGN_EPI) { if (wr == 1) PG8_BAR; }
    }
    PG8_WAIT_V(0);
    if constexpr (!ALIGN_EPI) { if (wr == 0) PG8_BAR; }
    PG8_BAR;
#undef PG8_SA
#undef PG8_SB
#undef PG8_STAGE
#undef PG8_VOFFA
#undef PG8_LDA
#undef PG8_LDB
#undef PG8_MMA
#undef PG8_WAIT_V
#undef PG8_WAIT_V8R
#undef PG8_WAIT_L
#undef PG8_BAR
#undef PG8_SCHED
}
}
__device__ __forceinline__ void conv_tile(const float* __restrict__ src, int ldn, int k0, int n0, const float* __restrict__ kscale, int kfrom,
                                          bf16_t* __restrict__ dst, int dld, int drow0, LAS unsigned* T, int lane, int dk0 = -1) {
    if (dk0 < 0) dk0 = k0;
    const int c4 = lane & 15, kq = lane >> 4;
    f32x4 v0[8], v1[8];
#pragma unroll
    for (int j = 0; j < 8; ++j) { const int kp = kq + 4 * j; const float* p = src + (size_t)(k0 + 2 * kp) * ldn + n0 + c4 * 4;
        v0[j] = __builtin_nontemporal_load((const f32x4*)p); v1[j] = __builtin_nontemporal_load((const f32x4*)(p + ldn)); }
#pragma unroll
    for (int j = 0; j < 8; ++j) { const int kp = kq + 4 * j; const int k = k0 + 2 * kp;
        float s0 = 1.f, s1 = 1.f; if (kscale && k >= kfrom) { s0 = kscale[k - kfrom]; s1 = kscale[k + 1 - kfrom]; }
#pragma unroll
        for (int q = 0; q < 4; ++q) T[(c4 * 4 + q) * 33 + kp] = pk2(v0[j][q] * s0, v1[j][q] * s1); }
    asm volatile("s_waitcnt lgkmcnt(0)" ::: "memory"); __builtin_amdgcn_wave_barrier();
    const int ch = lane & 7, nr = lane >> 3;
#pragma unroll
    for (int ps = 0; ps < 8; ++ps) { const int n = ps * 8 + nr; const LAS unsigned* t = T + n * 33 + ch * 4;
        v4u o; o.x = t[0]; o.y = t[1]; o.z = t[2]; o.w = t[3];
        *(v4u*)(dst + (size_t)(drow0 + n) * dld + dk0 + ch * 8) = o; }
    asm volatile("s_waitcnt lgkmcnt(0)" ::: "memory"); __builtin_amdgcn_wave_barrier();
}

__device__ __forceinline__ unsigned pk4_fp8(float a, float b, float c, float d) {
    int w = 0; w = __builtin_amdgcn_cvt_pk_fp8_f32(__builtin_amdgcn_fmed3f(a, -448.f, 448.f), __builtin_amdgcn_fmed3f(b, -448.f, 448.f), w, false);
    w = __builtin_amdgcn_cvt_pk_fp8_f32(__builtin_amdgcn_fmed3f(c, -448.f, 448.f), __builtin_amdgcn_fmed3f(d, -448.f, 448.f), w, true); return (unsigned)w; }
__device__ __forceinline__ void ada_item(const float* __restrict__ c, const float* __restrict__ w, float* __restrict__ modp, int item, int lane) {
    const int cc = item % 48, ks = item / 48, col = cc * 256 + lane * 4;
    f32x4 acc[4];
#pragma unroll
    for (int b = 0; b < 4; ++b) acc[b] = (f32x4){0.f, 0.f, 0.f, 0.f};
#pragma unroll 1
    for (int half = 0; half < 2; ++half) {
        const int k0 = ks * 128 + half * 64;
        float cd[4];
#pragma unroll
        for (int b = 0; b < 4; ++b) cd[b] = siluf_(c[b * DM + k0 + lane]);
        const float* wp = w + (size_t)k0 * MODW + col;
#pragma unroll
        for (int k0_ = 0; k0_ < 64; k0_ += 16) { f32x4 wv[16];
#pragma unroll
            for (int j = 0; j < 16; ++j) wv[j] = __builtin_nontemporal_load((const f32x4*)(wp + (size_t)(k0_ + j) * MODW));
#pragma unroll
            for (int j = 0; j < 16; ++j)
#pragma unroll
                for (int b = 0; b < 4; ++b) { const float s = __builtin_bit_cast(float, __builtin_amdgcn_readlane(__builtin_bit_cast(int, cd[b]), k0_ + j)); acc[b] += wv[j] * s; } }
    }
#pragma unroll
    for (int b = 0; b < 4; ++b) *(f32x4*)(modp + ((size_t)ks * 4 + b) * MODW + col) = acc[b];
}

constexpr int CT_ADA = 48 * 16;
constexpr int CT_IN = 32 * 77, CT_UQ = 8 * 24, CT_KV = 4 * 32, CT_OUT = 32 * 32, CT_G1 = 8 * 8, CT_D1 = 2 * 32;
constexpr int CT_ZERO = 192 * 4;
constexpr int CT_GU = 65 * 2 * CT_G1, CT_DN = 65 * CT_D1;
constexpr int CT_GU_LATE = 0;
constexpr int CT_TOTAL0 = CT_ADA + CT_IN + CT_UQ + CT_KV + CT_OUT + CT_ZERO + (CT_GU - CT_GU_LATE) + CT_DN;
constexpr int CW_QGU = 8192, CW_QDN = 8192 + 512;

struct ETile { const float* src; unsigned char* dst; int ldn, pad; };
__device__ __forceinline__ ETile etile_decode(const Params& p, int r) {
    ETile t; t.pad = 0;
    if (r < CT_GU) { const int e = r / (2 * CT_G1); int q = r % (2 * CT_G1); const int up = q >= CT_G1; q -= up * CT_G1; const int kb = q / 8, nb = q % 8, n0 = nb * 64;
        t.src = ((e < 64) ? p.in[up ? 21 : 20] + (size_t)e * DM * DE : p.in[up ? 24 : 23]) + (size_t)(kb * 256) * DE + n0; t.ldn = DE;
        const int dr = (n0 >> 7) * 256 + up * 128 + (n0 & 127);
        t.dst = p.ws + WS_BT_GU + (size_t)e * 1024 * DM + ((size_t)((dr >> 8) * (DM / 128) + 2 * kb) * 256 + (dr & 255)) * 128; }
    else { const int rr = r - CT_GU; const int e = rr / CT_D1, q = rr % CT_D1, kb = q / 32, nb = q % 32;
        t.src = ((e < 64) ? p.in[22] + (size_t)e * DE * DM : p.in[25]) + (size_t)(kb * 256) * DM + nb * 64; t.ldn = DM;
        const int dr = nb * 64;
        t.dst = p.ws + WS_BT_DN + (size_t)e * DM * DE + ((size_t)((dr >> 8) * (DE / 128) + 2 * kb) * 256 + (dr & 255)) * 128; }
    return t;
}
constexpr int CT_EXP_LATE2 = 2048, CT_EXP_LATE3 = 512, CT_EXP_LATE5 = 5120;
__device__ __forceinline__ int p2_first_idle(int G) { const int nunits = (NT / 256) * (INCP / 256), rounds = (nunits + G - 1) / G; return nunits - (rounds - 1) * G; }
__device__ __forceinline__ int exp_late2(int G) { return (p2_first_idle(G) < G && (G - p2_first_idle(G)) * NWAVES * 2 >= CT_EXP_LATE2) ? CT_EXP_LATE2 : 0; }
__device__ __forceinline__ int exp_late5(int G) { return (G == 256) ? CT_EXP_LATE5 : 0; }
__device__ __forceinline__ int exp_late3(int G) { return (G == 256) ? CT_EXP_LATE3 : 0; }
__device__ __forceinline__ void expert_stream(const Params& p, LAS unsigned* T, int gw, int NGW, int lane, int NEXP) {
    int r = gw; if (r >= NEXP) return;
    const int c4 = lane & 15, kq = lane >> 4, ch = lane & 15, nr = lane >> 4;
    ETile cur = etile_decode(p, r);
    f32x4 A[16], B[16];
#define ES_LOADQ(R, t, qd) do { _Pragma("unroll") for (int j = 0; j < 4; ++j) { const float* q_ = (t).src + (size_t)((qd) * 64 + 4 * (kq + 4 * j)) * (t).ldn + c4 * 4; \
        _Pragma("unroll") for (int rr = 0; rr < 4; ++rr) R[j * 4 + rr] = __builtin_nontemporal_load((const f32x4*)(q_ + (size_t)rr * (t).ldn)); } } while (0)
#define ES_CONVQ(R, qd) do { _Pragma("unroll") for (int j = 0; j < 4; ++j) { const int kp = (qd) * 16 + kq + 4 * j; \
        _Pragma("unroll") for (int q = 0; q < 4; ++q) T[(c4 * 4 + q) * 65 + kp] = pk4_fp8(R[j * 4 + 0][q] * 64.f, R[j * 4 + 1][q] * 64.f, R[j * 4 + 2][q] * 64.f, R[j * 4 + 3][q] * 64.f); } } while (0)
    ES_LOADQ(A, cur, 0);
    for (;;) {
        const int rn = r + NGW; const bool hn = rn < NEXP; const ETile nxt = hn ? etile_decode(p, rn) : cur;
        ES_LOADQ(B, cur, 1); ES_CONVQ(A, 0);
        ES_LOADQ(A, cur, 2); ES_CONVQ(B, 1);
        ES_LOADQ(B, cur, 3); ES_CONVQ(A, 2);
        if (hn) ES_LOADQ(A, nxt, 0);
        ES_CONVQ(B, 3);
        asm volatile("s_waitcnt lgkmcnt(0)" ::: "memory"); __builtin_amdgcn_wave_barrier();
#pragma unroll
        for (int ps = 0; ps < 16; ++ps) { const int n = ps * 4 + nr; const LAS unsigned* t = T + n * 65 + ch * 4;
            v4u o; o.x = t[0]; o.y = t[1]; o.z = t[2]; o.w = t[3];
            __builtin_nontemporal_store(o, (v4u*)(cur.dst + n * 128 + (ch >> 3) * 32768 + (ch & 7) * 16)); }
        asm volatile("s_waitcnt lgkmcnt(0)" ::: "memory"); __builtin_amdgcn_wave_barrier();
        if (!hn) break;
        cur = nxt; r = rn;
    }
#undef ES_LOADQ
#undef ES_CONVQ
}

__device__ __forceinline__ void router_split(const Params& p, int tix, int nthr) {
    unsigned char* ws = p.ws;
    for (int it = tix; it < NE * (DM / 8); it += nthr) { const int e = it & (NE - 1), k8 = it >> 6; const float* wp = p.in[18] + (size_t)(k8 * 8) * NE + e;
        float x[8], l[8]; v4u hv, lv;
#pragma unroll
        for (int i = 0; i < 8; ++i) x[i] = wp[(size_t)i * NE];
        hv.x = pk2(x[0], x[1]); hv.y = pk2(x[2], x[3]); hv.z = pk2(x[4], x[5]); hv.w = pk2(x[6], x[7]);
        l[0] = x[0] - bflo(hv.x); l[1] = x[1] - bfhi(hv.x); l[2] = x[2] - bflo(hv.y); l[3] = x[3] - bfhi(hv.y); l[4] = x[4] - bflo(hv.z); l[5] = x[5] - bfhi(hv.z); l[6] = x[6] - bflo(hv.w); l[7] = x[7] - bfhi(hv.w);
        lv.x = pk2(l[0], l[1]); lv.y = pk2(l[2], l[3]); lv.z = pk2(l[4], l[5]); lv.w = pk2(l[6], l[7]);
        const size_t off = ((size_t)((((k8 >> 5) * 8 + ((k8 >> 2) & 7)) * 4 + (e >> 4)) * 64 + (k8 & 3) * 16 + (e & 15))) * 16;
        *(v4u*)(ws + WS_WRH + off) = hv; *(v4u*)(ws + WS_WRL + off) = lv; }
}
constexpr int CT_SMALL = CT_IN + CT_UQ + CT_KV + CT_OUT + CT_ZERO;
__device__ __forceinline__ void phase0(const Params& p, LAS unsigned char* lds, int wave, int lane) {
    LAS unsigned* T = (LAS unsigned*)(lds + wave * 18432);
    unsigned char* ws = p.ws;
    float* modp = (float*)(ws + WS_MODP);
    const int gw = blockIdx.x * NWAVES + wave, NGW = gridDim.x * NWAVES;
    for (int it = gw; it < CT_ADA; it += NGW) ada_item(p.in[1], p.in[3], modp, it, lane);
    expert_stream(p, T, (gw + NGW - (CT_ADA % NGW)) % NGW, NGW, lane, CT_GU + CT_DN - exp_late2(gridDim.x) - exp_late3(gridDim.x) - exp_late5(gridDim.x));
    for (int it = gw; it < CT_SMALL; it += NGW) {
        int r = it;
        if (r < CT_IN) { const int kb = r / 77, nb = r % 77; conv_tile(p.in[7], INC, kb * 64, nb * 64, nullptr, 0, (bf16_t*)(ws + WS_BT_IN), DM, nb * 64, T, lane); continue; } r -= CT_IN;
        if (r < CT_UQ) { const int kb = r / 24, nb = r % 24; conv_tile(p.in[11], 1536, kb * 64, nb * 64, p.in[10], 0, (bf16_t*)(ws + WS_BT_UQ), QR, nb * 64, T, lane); continue; } r -= CT_UQ;
        if (r < CT_KV) { const int kb = r / 32, nb = r % 32, n0 = nb * 64, h = n0 >> 8, j0 = n0 & 255; const int dr = (j0 < 128) ? h * 128 + j0 : 1024 + h * 128 + (j0 - 128);
                         conv_tile(p.in[13], 2048, kb * 64, n0, p.in[12], 0, (bf16_t*)(ws + WS_BT_KV), KVR, dr, T, lane); continue; } r -= CT_KV;
        if (r < CT_OUT) { const int kb = r / 32, nb = r % 32; conv_tile(p.in[17], DM, kb * 64, nb * 64, p.in[16], 1024, (bf16_t*)(ws + WS_BT_OUT), DM, nb * 64, T, lane, (kb * 64 + 1024) & 2047); continue; } r -= CT_OUT;
        { const int row = INC + (r >> 2), pc = r & 3; v4u z = {0u, 0u, 0u, 0u}; *(v4u*)((bf16_t*)(ws + WS_BT_IN) + (size_t)row * DM + pc * 512 + lane * 8) = z; }
    }
}

__device__ __forceinline__ void norm_mod_row(const float* __restrict__ hrow, const float* __restrict__ g, const float* __restrict__ sc, const float* __restrict__ sh, bf16_t* __restrict__ urow, int lane) {
    f32x4 v[8]; float s = 0.f;
#pragma unroll
    for (int j = 0; j < 8; ++j) { v[j] = *(const f32x4*)(hrow + lane * 4 + 256 * j); s += (v[j].x * v[j].x + v[j].y * v[j].y) + (v[j].z * v[j].z + v[j].w * v[j].w); }
    const float r = rsqrtf(wave_sum(s) * (1.f / DM) + EPS);
#pragma unroll
    for (int j = 0; j < 8; ++j) { const int col = lane * 4 + 256 * j; const f32x4 gv = *(const f32x4*)(g + col), sv = *(const f32x4*)(sc + col), hv = *(const f32x4*)(sh + col);
        const f32x4 o = v[j] * r * gv * (sv + 1.f) + hv; v2u w; w.x = pk2(o.x, o.y); w.y = pk2(o.z, o.w); *(v2u*)(urow + col) = w; }
}
__device__ __forceinline__ f32x4 mod_reduce4(const float* __restrict__ modp, const float* __restrict__ bias, int v) {
    f32x4 t[16];
#pragma unroll
    for (int ks = 0; ks < 16; ++ks) t[ks] = *(const f32x4*)(modp + (size_t)ks * 4 * MODW + v);
    f32x4 s = *(const f32x4*)(bias + v % MODW);
#pragma unroll
    for (int ks = 0; ks < 16; ++ks) s += t[ks];
    return s;
}
__device__ __forceinline__ void phase1(const Params& p, LAS unsigned char* lds, int wave, int lane) {
    const float* modp = (const float*)(p.ws + WS_MODP); float* mod = (float*)(p.ws + CTL_MOD); bf16_t* u16 = (bf16_t*)(p.ws + WS_U16);
    LAS float* sm = (LAS float*)lds;
    const int G = gridDim.x;
    for (int v4 = blockIdx.x * NTHR + threadIdx.x; v4 < NB * MODW / 4; v4 += G * NTHR) *(f32x4*)(mod + v4 * 4) = mod_reduce4(modp, p.in[4], v4 * 4);
    for (int tb = blockIdx.x; tb < NT / 32; tb += G) {
        const int b = (tb * 32) / SEQ;
        f32x4 v[8];
        { const float* hrow = p.in[0] + (size_t)(tb * 32 + wave * 4) * DM;
#pragma unroll
          for (int j = 0; j < 8; ++j) v[j] = __builtin_nontemporal_load((const f32x4*)(hrow + lane * 4 + 256 * j)); }
        __syncthreads();
        for (int i4 = threadIdx.x; i4 < 2 * DM / 4; i4 += NTHR) *(LAS f32x4*)(sm + i4 * 4) = mod_reduce4(modp, p.in[4], b * MODW + i4 * 4);
        __syncthreads();
        f32x4 gv8[8];
#pragma unroll
        for (int j = 0; j < 8; ++j) gv8[j] = *(const f32x4*)(p.in[5] + lane * 4 + 256 * j);
#pragma unroll 1
        for (int rr = 0; rr < 4; ++rr) { const int t = tb * 32 + wave * 4 + rr;
            f32x4 vn[8];
            if (rr < 3) { const float* hrow = p.in[0] + (size_t)(t + 1) * DM;
#pragma unroll
                for (int j = 0; j < 8; ++j) vn[j] = __builtin_nontemporal_load((const f32x4*)(hrow + lane * 4 + 256 * j)); }
            float s = 0.f;
#pragma unroll
            for (int j = 0; j < 8; ++j) s += (v[j].x * v[j].x + v[j].y * v[j].y) + (v[j].z * v[j].z + v[j].w * v[j].w);
            const float r = rsqrtf(wave_sum(s) * (1.f / DM) + EPS);
#pragma unroll
            for (int j = 0; j < 8; ++j) { const int col = lane * 4 + 256 * j; const f32x4 gv = gv8[j];
                const f32x4 hv = *(const LAS f32x4*)(sm + col), sv = *(const LAS f32x4*)(sm + DM + col);
                const f32x4 o = v[j] * r * gv * (sv + 1.f) + hv; v2u w; w.x = pk2(o.x, o.y); w.y = pk2(o.z, o.w); *(v2u*)(u16 + (size_t)t * DM + col) = w; }
            if (rr < 3) {
#pragma unroll
                for (int j = 0; j < 8; ++j) v[j] = vn[j]; }
        }
    }
}

struct EpiInProj { static constexpr bool PERM = true, MIDK = false; static constexpr int NST = 16;         bf16_t* O; float* ssq_q8; float* ssq_kv4;
    __device__ __forceinline__ void operator()(const pg8::f32x4 (&acc)[2][2][4][2], const pg8::Unit& u, int wr, int wc, int fr, int fq) const {
        const int row0 = u.pm * 256 + wr * 64 + fr, col0 = u.pn * 256 + wc * 32 + 8 * fq;
        const bool sq = (u.pn >= 16 && u.pn <= 18);
#pragma unroll
        for (int ai = 0; ai < 2; ++ai)
#pragma unroll
            for (int m = 0; m < 4; ++m) { if (!(u.mask & (3 << (ai * 2)))) continue; const int row = row0 + ai * 128 + m * 16; bf16_t* rowp = O + (size_t)row * INCP + col0; float ss = 0.f;
#pragma unroll
                for (int bj = 0; bj < 2; ++bj) { const pg8::f32x4 v0 = acc[ai][bj][m][0], v1 = acc[ai][bj][m][1];
                    v4u w; w.x = pk2(v0[0], v0[1]); w.y = pk2(v0[2], v0[3]); w.z = pk2(v1[0], v1[1]); w.w = pk2(v1[2], v1[3]);
                    *(v4u*)(rowp + bj * 128) = w;
                    ss += (v0[0] * v0[0] + v0[1] * v0[1]) + (v0[2] * v0[2] + v0[3] * v0[3]) + (v1[0] * v1[0] + v1[1] * v1[1]) + (v1[2] * v1[2] + v1[3] * v1[3]); }
                if (sq) { ss += __shfl_xor(ss, 16); ss += __shfl_xor(ss, 32);
                    if (fq == 0) { if (u.pn == 18) ssq_kv4[row * 4 + wc] = ss; else ssq_q8[row * 8 + (u.pn - 16) * 4 + wc] = ss; } } }
    }
};
__device__ __forceinline__ void phase2(const Params& p, LAS unsigned char* lds) {
    unsigned char* ws = p.ws;
    pg8::Gemm g{(const bf16_t*)(ws + WS_U16), (const bf16_t*)(ws + WS_BT_IN), nullptr, DM, DM, DM, 0};
    pg8::StaticOrder S; S.init(NT / 256, INCP / 256, gridDim.x, blockIdx.x, DM);
    EpiInProj E{(bf16_t*)(ws + WS_PROJ), (float*)(ws + TAB_SSQ_Q8), (float*)(ws + TAB_SSQ_KV4)};
    pg8::gemm_phase<EpiInProj, pg8::StaticOrder>((PG8_LAS unsigned char*)lds, g, S, E);
    { const int G = gridDim.x, firstidle = p2_first_idle(G), l2 = exp_late2(G);
      if (l2 > 0 && (int)blockIdx.x >= firstidle) { const int wave = __builtin_amdgcn_readfirstlane(threadIdx.x >> 6), j = ((int)blockIdx.x - firstidle) * NWAVES + wave, nw = (G - firstidle) * NWAVES;
          const int base = CT_GU + CT_DN - l2;
          for (int r = base + j; r < CT_GU + CT_DN; r += nw) expert_stream(p, (LAS unsigned*)(lds + wave * 18432), r, 1 << 30, threadIdx.x & 63, CT_GU + CT_DN); }
      if (firstidle < G) { if ((int)blockIdx.x >= firstidle) router_split(p, ((int)blockIdx.x - firstidle) * NTHR + (int)threadIdx.x, (G - firstidle) * NTHR); }
      else router_split(p, (int)blockIdx.x * NTHR + (int)threadIdx.x, G * NTHR); }
}
struct EpiBf16Store { static constexpr bool PERM = true, MIDK = false; static constexpr int NST = 16;      bf16_t* O; int ldc, pad;
    __device__ __forceinline__ void operator()(const pg8::f32x4 (&acc)[2][2][4][2], const pg8::Unit& u, int wr, int wc, int fr, int fq) const {
        const int row0 = u.pm * 256 + wr * 64 + fr, col0 = u.pn * 256 + wc * 32 + 8 * fq;
#pragma unroll
        for (int ai = 0; ai < 2; ++ai)
#pragma unroll
            for (int m = 0; m < 4; ++m) { if (!(u.mask & (3 << (ai * 2)))) continue; bf16_t* rowp = O + (size_t)(row0 + ai * 128 + m * 16) * ldc + col0;
#pragma unroll
                for (int bj = 0; bj < 2; ++bj) { const pg8::f32x4 v0 = acc[ai][bj][m][0], v1 = acc[ai][bj][m][1];
                    v4u w; w.x = pk2(v0[0], v0[1]); w.y = pk2(v0[2], v0[3]); w.z = pk2(v1[0], v1[1]); w.w = pk2(v1[2], v1[3]); *(v4u*)(rowp + bj * 128) = w; } }
    }
};
struct EpiVt { static constexpr bool PERM = true, MIDK = false; static constexpr int NST = 0; bf16_t* Vt; const float* ssq_kv4;
    __device__ __forceinline__ void operator()(const pg8::f32x4 (&acc)[2][2][4][2], const pg8::Unit& u, int wr, int wc, int fr, int fq) const {
        const int row0 = u.pm * 256 + wr * 64 + fr, col0 = u.pn * 256 + wc * 32 + 8 * fq;
        const int pb = (col0 & ~15) + 4 * (fq & 1);
#pragma unroll
        for (int bj = 0; bj < 2; ++bj) {
            float rs[8];
#pragma unroll
            for (int j = 0; j < 8; ++j) { const pg8::f32x4 s4 = *(const pg8::f32x4*)(ssq_kv4 + (size_t)(col0 + bj * 128 + j) * 4); rs[j] = rsqrtf(((s4[0] + s4[1]) + (s4[2] + s4[3])) * (1.f / KVR) + EPS); }
#pragma unroll
            for (int ai = 0; ai < 2; ++ai)
#pragma unroll
                for (int m = 0; m < 4; ++m) { if (!(u.mask & (1 << (ai * 2 + bj)))) continue; bf16_t* rowp = Vt + (size_t)(row0 + ai * 128 + m * 16) * NT + pb + bj * 128;
                    const pg8::f32x4 v0 = acc[ai][bj][m][0], v1 = acc[ai][bj][m][1];
                    v2u a, b; a.x = pk2(v0[0] * rs[0], v0[1] * rs[1]); a.y = pk2(v0[2] * rs[2], v0[3] * rs[3]);
                    b.x = pk2(v1[0] * rs[4], v1[1] * rs[5]); b.y = pk2(v1[2] * rs[6], v1[3] * rs[7]);
                    *(v2u*)(rowp) = a; *(v2u*)(rowp + 8) = b; }
        }
    }
};
__device__ __forceinline__ void phase3_gemms(const Params& p, LAS unsigned char* lds) {
    unsigned char* ws = p.ws; const int G = gridDim.x, c = blockIdx.x;
    const bf16_t* proj = (const bf16_t*)(ws + WS_PROJ);
    { pg8::Gemm g{proj + 4096, (const bf16_t*)(ws + WS_BT_UQ), nullptr, INCP, QR, QR, 0};
      pg8::StaticOrder S; S.init(NT / 256, 6, G, c, QR); EpiBf16Store E{(bf16_t*)(ws + WS_QRAW), 1536, 0};
      pg8::gemm_phase<EpiBf16Store, pg8::StaticOrder>((PG8_LAS unsigned char*)lds, g, S, E); }
    { pg8::Gemm g{proj + 4608, (const bf16_t*)(ws + WS_BT_KV), nullptr, INCP, KVR, KVR, 0};
      pg8::StaticOrder S; S.init(NT / 256, 4, G, (c + 64) % G, KVR); EpiBf16Store E{(bf16_t*)(ws + WS_KRAW), 1024, 0};
      pg8::gemm_phase<EpiBf16Store, pg8::StaticOrder>((PG8_LAS unsigned char*)lds, g, S, E); }
    { pg8::Gemm g{(const bf16_t*)(ws + WS_BT_KV) + 1024 * KVR, proj + 4608, nullptr, KVR, INCP, KVR, 0};
      pg8::StaticOrder S; S.init(4, NT / 256, G, (c + 192) % G, INCP); EpiVt E{(bf16_t*)(ws + WS_VT), (const float*)(ws + TAB_SSQ_KV4)};
      pg8::gemm_phase<EpiVt, pg8::StaticOrder>((PG8_LAS unsigned char*)lds, g, S, E); }
    if (exp_late3(G) > 0 && c >= 192) { const int wave = __builtin_amdgcn_readfirstlane(threadIdx.x >> 6), j = (c - 192) * NWAVES + wave, base = CT_GU + CT_DN - exp_late2(G) - exp_late3(G);
        for (int r = base + j; r < base + CT_EXP_LATE3; r += 64 * NWAVES) expert_stream(p, (LAS unsigned*)(lds + wave * 18432), r, 1 << 30, threadIdx.x & 63, CT_GU + CT_DN); }
}

constexpr float QSCALE = 0.07216878364870323f * 1.4426950408889634f;
__device__ __forceinline__ float sum8(float v) { v += dppf<0xB1, 0xF>(v); v += dppf<0x4E, 0xF>(v); v += dppf<0x141, 0xF>(v); return v; }
struct QkTok { v4u qa, qb, ka, kb; v2u q1, q2, k1, k2; float rq, rkv, ps; };
__device__ __forceinline__ void qk_load(QkTok& L, int t, int h, int l8, const bf16_t* qraw, const bf16_t* kraw, const bf16_t* proj, const float* ssq_q8, const float* ssq_kv4, const int* pos) {
    const bf16_t* qp = qraw + (size_t)t * 1536 + h * 192; const bf16_t* kp = kraw + (size_t)t * 1024 + h * 128; const bf16_t* rp = proj + (size_t)t * INCP + 4864;
    L.qa = __builtin_nontemporal_load((const v4u*)(qp + l8 * 16)); L.qb = __builtin_nontemporal_load((const v4u*)(qp + l8 * 16 + 8)); L.q1 = __builtin_nontemporal_load((const v2u*)(qp + 128 + l8 * 4)); L.q2 = __builtin_nontemporal_load((const v2u*)(qp + 160 + l8 * 4));
    L.ka = __builtin_nontemporal_load((const v4u*)(kp + l8 * 16)); L.kb = __builtin_nontemporal_load((const v4u*)(kp + l8 * 16 + 8)); L.k1 = *(const v2u*)(rp + l8 * 4); L.k2 = *(const v2u*)(rp + 32 + l8 * 4);
    const pg8::f32x4 qa = *(const pg8::f32x4*)(ssq_q8 + (size_t)t * 8), qb = *(const pg8::f32x4*)(ssq_q8 + (size_t)t * 8 + 4), ka = *(const pg8::f32x4*)(ssq_kv4 + (size_t)t * 4);
    L.rq = rsqrtf((((qa[0] + qa[1]) + (qa[2] + qa[3])) + ((qb[0] + qb[1]) + (qb[2] + qb[3]))) * (1.f / QR) + EPS); L.rkv = rsqrtf(((ka[0] + ka[1]) + (ka[2] + ka[3])) * (1.f / KVR) + EPS);
    L.ps = (float)pos[t];
}
__device__ __forceinline__ void qk_finish(float (&a)[24], float r_nope, float r_rope, float nscale, const float (&g)[24], const float (&sn)[4], const float (&cs)[4], bf16_t* dst, int l8) {
#pragma unroll
    for (int j = 0; j < 16; ++j) a[j] *= r_nope;
#pragma unroll
    for (int j = 16; j < 24; ++j) a[j] *= r_rope;
    float ss = 0.f;
#pragma unroll
    for (int j = 0; j < 24; ++j) ss += a[j] * a[j];
    ss = sum8(ss);
    const float nn = rsqrtf(ss * (1.f / 192.f) + EPS) * nscale;
#pragma unroll
    for (int j = 0; j < 24; ++j) a[j] *= nn * g[j];
#pragma unroll
    for (int j = 0; j < 4; ++j) { const float x1 = a[16 + j], x2 = a[20 + j]; a[16 + j] = x1 * cs[j] - x2 * sn[j]; a[20 + j] = x2 * cs[j] + x1 * sn[j]; }
    v4u o0, o1; v2u r1, r2;
    o0.x = pk2(a[0], a[1]); o0.y = pk2(a[2], a[3]); o0.z = pk2(a[4], a[5]); o0.w = pk2(a[6], a[7]); o1.x = pk2(a[8], a[9]); o1.y = pk2(a[10], a[11]); o1.z = pk2(a[12], a[13]); o1.w = pk2(a[14], a[15]);
    r1.x = pk2(a[16], a[17]); r1.y = pk2(a[18], a[19]); r2.x = pk2(a[20], a[21]); r2.y = pk2(a[22], a[23]);
    *(v4u*)(dst + l8 * 16) = o0; *(v4u*)(dst + l8 * 16 + 8) = o1; *(v2u*)(dst + 128 + l8 * 4) = r1; *(v2u*)(dst + 160 + l8 * 4) = r2;
}
__device__ __forceinline__ void unpack8(const v4u w, float* a) { a[0] = bflo(w.x); a[1] = bfhi(w.x); a[2] = bflo(w.y); a[3] = bfhi(w.y); a[4] = bflo(w.z); a[5] = bfhi(w.z); a[6] = bflo(w.w); a[7] = bfhi(w.w); }
__device__ __forceinline__ void unpack4(const v2u w, float* a) { a[0] = bflo(w.x); a[1] = bfhi(w.x); a[2] = bflo(w.y); a[3] = bfhi(w.y); }
__device__ __forceinline__ void phase4_qk(const Params& p, int wave, int lane, int nwaves) {
    unsigned char* ws = p.ws;
    const bf16_t* qraw = (const bf16_t*)(ws + WS_QRAW); const bf16_t* kraw = (const bf16_t*)(ws + WS_KRAW); const bf16_t* proj = (const bf16_t*)(ws + WS_PROJ);
    const float* ssq_q8 = (const float*)(ws + TAB_SSQ_Q8); const float* ssq_kv4 = (const float*)(ws + TAB_SSQ_KV4);
    const int* pos = (const int*)p.in[2]; const float* qg = p.in[14]; const float* kg = p.in[15];
    bf16_t* Q16 = (bf16_t*)(ws + WS_Q16); bf16_t* K16 = (bf16_t*)(ws + WS_K16);
    const int h = lane >> 3, l8 = lane & 7;
    float gq[24], gk[24], inv[4];
#pragma unroll
    for (int j = 0; j < 16; ++j) { gq[j] = qg[l8 * 16 + j]; gk[j] = kg[l8 * 16 + j]; }
#pragma unroll
    for (int j = 0; j < 4; ++j) { gq[16 + j] = qg[128 + l8 * 4 + j]; gq[20 + j] = qg[160 + l8 * 4 + j]; gk[16 + j] = kg[128 + l8 * 4 + j]; gk[20 + j] = kg[160 + l8 * 4 + j];
        inv[j] = exp2f(-(float)(l8 * 4 + j) * (13.287712379549449f / 32.f)); }
    const int gw = blockIdx.x * nwaves + wave, NGW = gridDim.x * nwaves;
    for (int t0 = gw; t0 < NT; t0 += 2 * NGW) {
        const int t1 = t0 + NGW; const bool two = t1 < NT;
        QkTok L0, L1; qk_load(L0, t0, h, l8, qraw, kraw, proj, ssq_q8, ssq_kv4, pos); qk_load(L1, two ? t1 : t0, h, l8, qraw, kraw, proj, ssq_q8, ssq_kv4, pos);
#pragma unroll
        for (int u = 0; u < 2; ++u) { if (u == 1 && !two) break; const QkTok& L = u ? L1 : L0; const int t = u ? t1 : t0, b = t / SEQ, s = t % SEQ;
            float sn[4], cs[4];
#pragma unroll
            for (int j = 0; j < 4; ++j) { const float rev = L.ps * inv[j] * 0.15915494309189535f; const float fr_ = rev - floorf(rev); sn[j] = __builtin_amdgcn_sinf(fr_); cs[j] = __builtin_amdgcn_cosf(fr_); }
            const size_t base = ((size_t)(b * MH + h) * SEQ + s) * QKD;
            float a[24];
            unpack8(L.qa, a); unpack8(L.qb, a + 8); unpack4(L.q1, a + 16); unpack4(L.q2, a + 20);
            qk_finish(a, L.rq, L.rq, QSCALE, gq, sn, cs, Q16 + base, l8);
            unpack8(L.ka, a); unpack8(L.kb, a + 8); unpack4(L.k1, a + 16); unpack4(L.k2, a + 20);
            qk_finish(a, L.rkv, 1.f, 1.f, gk, sn, cs, K16 + base, l8); }
    }
}

typedef short bf16x8 __attribute__((ext_vector_type(8)));
typedef float f32x16 __attribute__((ext_vector_type(16)));
constexpr int AT_KP = 400, AT_VP = 144, AT_KB = 64 * AT_KP, AT_VB = 128 * AT_VP, AT_BUF = AT_KB + AT_VB, AT_Q = 2 * AT_BUF;
__device__ __forceinline__ void phase5_attn(const Params& p, LAS unsigned char* lds, int wave, int lane) {
    unsigned char* ws = p.ws;
    const bf16_t* Q16 = (const bf16_t*)(ws + WS_Q16); const bf16_t* K16 = (const bf16_t*)(ws + WS_K16); const bf16_t* Vt = (const bf16_t*)(ws + WS_VT);
    bf16_t* merged = (bf16_t*)(ws + WS_MERGED); float* ssq_o8 = (float*)(ws + TAB_SSQ_O8);
    const int tid = threadIdx.x, cl = lane & 31, hh = lane >> 5, qsub = wave & 3, kpar = wave >> 2;
    float mq = 0.f, mk = 0.f;
    for (int i = 0; i < 3; ++i) { mq = fmaxf(mq, fabsf(p.in[14][lane + 64 * i])); mk = fmaxf(mk, fabsf(p.in[15][lane + 64 * i])); }
#pragma unroll
    for (int o = 1; o < 64; o <<= 1) { mq = fmaxf(mq, __shfl_xor(mq, o)); mk = fmaxf(mk, __shfl_xor(mk, o)); }
    const float negc0 = -(13.856406460551018f * 1.4426950408889634f * 1.02f) * mq * mk;
    int kso[3], vso[2]; size_t vgo[2];
#pragma unroll
    for (int i = 0; i < 3; ++i) { const int c = tid + 512 * i; kso[i] = (c / 24) * AT_KP + (c % 24) * 16; }
#pragma unroll
    for (int i = 0; i < 2; ++i) { const int c = tid + 512 * i, dv = c >> 3, ch = c & 7; vso[i] = AT_KB + dv * AT_VP + ch * 16; vgo[i] = (size_t)dv * NT * 2 + ch * 16; }
    const bool part = (gridDim.x == 256);
    const int it0 = part ? (int)(blockIdx.x >> 3) : (int)blockIdx.x, itn = part ? 32 : 256, its = part ? 24 : (int)gridDim.x;
    for (int it_ = it0; it_ < itn; it_ += its) {
        const int item = part ? ((((int)blockIdx.x & 7) * 4 + (it_ >> 3)) * 8 + (it_ & 7)) : it_;
        const int bh = item >> 3, x = item & 7, b = bh >> 3, h = bh & 7;
        const char* Qg = (const char*)(Q16 + (size_t)bh * SEQ * QKD); const char* Kg = (const char*)(K16 + (size_t)bh * SEQ * QKD);
        const char* Vg = (const char*)(Vt + (size_t)(h * 128) * NT + b * SEQ);
#pragma unroll 1
        for (int pass = 0; pass < 2; ++pass) {
            const int qi = pass == 0 ? 15 - x : x, nsteps = 2 * (qi + 1), qrow0 = qi * 128 + qsub * 32;
#pragma unroll
            for (int i = 0; i < 6; ++i) { const int c = tid + 512 * i; *(LAS v4u*)(lds + AT_Q + (c / 24) * AT_KP + (c % 24) * 16) = __builtin_nontemporal_load((const v4u*)(Qg + (size_t)(qi * 128) * QKD * 2 + (size_t)c * 16)); }
            const LAS unsigned char* qb = lds + AT_Q + (qsub * 32 + cl) * AT_KP + hh * 16;
            f32x16 O[4];
#pragma unroll
            for (int vb = 0; vb < 4; ++vb)
#pragma unroll
                for (int r = 0; r < 16; ++r) O[vb][r] = 0.f;
            float lsum = 0.f;
            v4u krA[3], vrA[2], krB[3], vrB[2];
#define AT_LOAD(KR, VR, j) do { _Pragma("unroll") for (int i_ = 0; i_ < 3; ++i_) KR[i_] = *(const v4u*)(Kg + (size_t)(j) * 24576 + (size_t)(tid + 512 * i_) * 16); \
                        _Pragma("unroll") for (int i_ = 0; i_ < 2; ++i_) VR[i_] = *(const v4u*)(Vg + vgo[i_] + (size_t)(j) * 128); } while (0)
#define AT_WRITE(KR, VR, bo) do { _Pragma("unroll") for (int i_ = 0; i_ < 3; ++i_) *(LAS v4u*)(lds + (bo) + kso[i_]) = KR[i_]; \
                          _Pragma("unroll") for (int i_ = 0; i_ < 2; ++i_) *(LAS v4u*)(lds + (bo) + vso[i_]) = VR[i_]; } while (0)
#define AT_STEP(j, bo) do { const int key0 = 64 * (j) + 32 * kpar; \
                if (key0 <= qrow0 + 31) { \
                    f32x16 S; \
                    _Pragma("unroll") for (int r = 0; r < 16; ++r) S[r] = negc0; \
                    const LAS unsigned char* kb = lds + (bo) + (32 * kpar + cl) * AT_KP + hh * 16; \
                    __builtin_amdgcn_s_setprio(1); \
                    _Pragma("unroll") for (int ks = 0; ks < 12; ++ks) { const bf16x8 a = *(const LAS bf16x8*)(kb + ks * 32); const bf16x8 qf = *(const LAS bf16x8*)(qb + ks * 32); S = __builtin_amdgcn_mfma_f32_32x32x16_bf16(a, qf, S, 0, 0, 0); } \
                    __builtin_amdgcn_s_setprio(0); \
                    const bool diag = key0 + 31 > qrow0; \
                    float pr[16]; \
                    _Pragma("unroll") for (int r = 0; r < 16; ++r) { float e = __builtin_amdgcn_exp2f(S[r]); \
                        if (diag) { const int key = key0 + (r & 3) + 8 * (r >> 2) + 4 * hh; if (key > qrow0 + cl) e = 0.f; } \
                        pr[r] = e; lsum += e; } \
                    bf16x8 Pf[2]; \
                    _Pragma("unroll") for (int s = 0; s < 2; ++s) { v4u w; w.x = pk2(pr[8 * s + 0], pr[8 * s + 1]); w.y = pk2(pr[8 * s + 2], pr[8 * s + 3]); w.z = pk2(pr[8 * s + 4], pr[8 * s + 5]); w.w = pk2(pr[8 * s + 6], pr[8 * s + 7]); \
                        Pf[s] = __builtin_bit_cast(bf16x8, w); } \
                    const LAS unsigned char* vbp = lds + (bo) + AT_KB + cl * AT_VP + (32 * kpar + 8 * hh) * 2; \
                    __builtin_amdgcn_s_setprio(1); \
                    _Pragma("unroll") for (int vb = 0; vb < 4; ++vb) _Pragma("unroll") for (int s = 0; s < 2; ++s) { const bf16x8 a = *(const LAS bf16x8*)(vbp + vb * 32 * AT_VP + s * 32); O[vb] = __builtin_amdgcn_mfma_f32_32x32x16_bf16(a, Pf[s], O[vb], 0, 0, 0); } \
                    __builtin_amdgcn_s_setprio(0); \
                } } while (0)
            AT_LOAD(krA, vrA, 0); AT_WRITE(krA, vrA, 0); __syncthreads();
            AT_LOAD(krA, vrA, 1);
#pragma unroll 1
            for (int j = 0; j < nsteps; j += 2) {
                { const int jb = (j + 2 < nsteps) ? j + 2 : nsteps - 1; AT_LOAD(krB, vrB, jb); }
                AT_STEP(j, 0);
                AT_WRITE(krA, vrA, AT_BUF);
                __syncthreads();
                { const int ja = (j + 3 < nsteps) ? j + 3 : nsteps - 1; AT_LOAD(krA, vrA, ja); }
                AT_STEP(j + 1, AT_BUF);
                AT_WRITE(krB, vrB, 0);
                __syncthreads();
            }
            LAS float* X = (LAS float*)lds;
            if (kpar == 1) {
#pragma unroll
                for (int vb = 0; vb < 4; ++vb)
#pragma unroll
                    for (int r = 0; r < 16; ++r) X[(qsub * 65 + vb * 16 + r) * 64 + lane] = O[vb][r];
                X[(qsub * 65 + 64) * 64 + lane] = lsum;
            }
            __syncthreads();
            if (kpar == 0) {
                float l = lsum + X[(qsub * 65 + 64) * 64 + lane];
                l += __shfl_xor(l, 32);
                const float il = 1.f / l; float ss = 0.f;
                const int t = b * SEQ + qrow0 + cl;
                bf16_t* op = merged + (size_t)t * DM + h * 128 + 4 * hh;
#pragma unroll
                for (int vb = 0; vb < 4; ++vb)
#pragma unroll
                    for (int rq = 0; rq < 4; ++rq) { float o[4];
#pragma unroll
                        for (int r3 = 0; r3 < 4; ++r3) { const int r = rq * 4 + r3; o[r3] = (O[vb][r] + X[(qsub * 65 + vb * 16 + r) * 64 + lane]) * il; ss += o[r3] * o[r3]; }
                        v2u w; w.x = pk2(o[0], o[1]); w.y = pk2(o[2], o[3]); *(v2u*)(op + vb * 32 + rq * 8) = w; }
                ss += __shfl_xor(ss, 32);
                if (hh == 0) ssq_o8[(size_t)t * 8 + h] = ss;
            }
            __syncthreads();
        }
    }
#undef AT_LOAD
#undef AT_WRITE
#undef AT_STEP
}

__device__ __forceinline__ void phase6_scale(const Params& p, int wave, int lane) {
    unsigned char* ws = p.ws; bf16_t* merged = (bf16_t*)(ws + WS_MERGED); const float* ssq_o8 = (const float*)(ws + TAB_SSQ_O8);
    const int gw = blockIdx.x * NWAVES + wave, NGW = gridDim.x * NWAVES;
    for (int t = gw; t < NT; t += NGW) { const pg8::f32x4 oa = *(const pg8::f32x4*)(ssq_o8 + (size_t)t * 8), ob = *(const pg8::f32x4*)(ssq_o8 + (size_t)t * 8 + 4);
        const float r = rsqrtf((((oa[0] + oa[1]) + (oa[2] + oa[3])) + ((ob[0] + ob[1]) + (ob[2] + ob[3]))) * (1.f / 1024.f) + EPS);
#pragma unroll
        for (int j = 0; j < 2; ++j) { v4u* q = (v4u*)(merged + (size_t)t * DM + 1024 + j * 512 + lane * 8); v4u y = *q;
            y.x = pk2(bflo(y.x) * r, bfhi(y.x) * r); y.y = pk2(bflo(y.y) * r, bfhi(y.y) * r); y.z = pk2(bflo(y.z) * r, bfhi(y.z) * r); y.w = pk2(bflo(y.w) * r, bfhi(y.w) * r); *q = y; } }
}

struct EpiResidF32 { static constexpr bool PERM = false, MIDK = true; static constexpr int NST = 0; const float* x; const float* gate; float* out; const LAS float* rs;
    __device__ __forceinline__ void mid(pg8::f32x4 (&acc)[2][2][4][2], const pg8::Unit& u, int wr, int wc, int fr, int fq) const {
        const LAS float* rp = rs + u.pad * 256 + wr * 64 + fr;
#pragma unroll
        for (int ai = 0; ai < 2; ++ai)
#pragma unroll
            for (int m = 0; m < 4; ++m) { const float r = rp[ai * 128 + m * 16];
#pragma unroll
                for (int bj = 0; bj < 2; ++bj)
#pragma unroll
                    for (int n = 0; n < 2; ++n) acc[ai][bj][m][n] = acc[ai][bj][m][n] * r; }
    }
    __device__ __forceinline__ void operator()(const pg8::f32x4 (&acc)[2][2][4][2], const pg8::Unit& u, int wr, int wc, int fr, int fq) const {
        const int row0 = u.pm * 256 + wr * 64 + fr, col0 = u.pn * 256 + wc * 32 + 4 * fq;
        const float* gp = gate + (size_t)((u.pm * 256) / SEQ) * MODW + col0;
        pg8::f32x4 gv[2][2];
#pragma unroll
        for (int bj = 0; bj < 2; ++bj)
#pragma unroll
            for (int n = 0; n < 2; ++n) gv[bj][n] = *(const pg8::f32x4*)(gp + bj * 128 + n * 16);
#pragma unroll
        for (int ai = 0; ai < 2; ++ai) { if (!(u.mask & (3 << (ai * 2)))) continue;
            pg8::f32x4 xv[4][2][2];
#pragma unroll
            for (int m = 0; m < 4; ++m) { const size_t ro = (size_t)(row0 + ai * 128 + m * 16) * DM + col0;
#pragma unroll
                for (int bj = 0; bj < 2; ++bj)
#pragma unroll
                    for (int n = 0; n < 2; ++n) xv[m][bj][n] = *(const pg8::f32x4*)(x + ro + bj * 128 + n * 16); }
#pragma unroll
            for (int m = 0; m < 4; ++m) { const size_t ro = (size_t)(row0 + ai * 128 + m * 16) * DM + col0;
#pragma unroll
                for (int bj = 0; bj < 2; ++bj)
#pragma unroll
                    for (int n = 0; n < 2; ++n) *(pg8::f32x4*)(out + ro + bj * 128 + n * 16) = xv[m][bj][n] + gv[bj][n] * acc[ai][bj][m][n]; } }
    }
};
__device__ __forceinline__ void phase7(const Params& p, LAS unsigned char* lds) {
    unsigned char* ws = p.ws;
    pg8::Gemm g{(const bf16_t*)(ws + WS_MERGED), (const bf16_t*)(ws + WS_BT_OUT), nullptr, DM, DM, DM, 0};
    pg8::StaticOrder S; S.init(NT / 256, DM / 256, gridDim.x, blockIdx.x, DM);
    LAS float* rs = (LAS float*)(lds + RING_BYTES + 12288);
    { const float* ssq_o8 = (const float*)(ws + TAB_SSQ_O8); pg8::Unit u;
      for (int i = 0; i < 4 && S.next(i, u); ++i) if (threadIdx.x < 256) { const float* sp = ssq_o8 + (size_t)(u.pm * 256 + threadIdx.x) * 8; const pg8::f32x4 oa = *(const pg8::f32x4*)sp, ob = *(const pg8::f32x4*)(sp + 4);
          rs[i * 256 + threadIdx.x] = rsqrtf((((oa[0] + oa[1]) + (oa[2] + oa[3])) + ((ob[0] + ob[1]) + (ob[2] + ob[3]))) * (1.f / 1024.f) + EPS); }
      __syncthreads(); }
    EpiResidF32 E{p.in[0], (const float*)(ws + CTL_MOD) + 2 * DM, (float*)(ws + WS_H1), rs};
    pg8::gemm_phase<EpiResidF32, pg8::StaticOrder>((PG8_LAS unsigned char*)lds, g, S, E);
}
constexpr int HG_P = 272, HG_VP = 144;
constexpr int HG_A2 = 0, HG_A1 = 17408, HG_QB = 34816, HG_VT = 52224, HG_KT = 70656, HG_SEG = 89088, HG_RS = 91136, HG_FL = 92160, HG_QT = 109568;
struct HgPre { v4u fl[2], q[2], v[2]; };
template <bool NEEDQ>
__device__ __forceinline__ void hg_issue(const bf16_t* __restrict__ proj, int item, HgPre& P) {
    const int bh = item >> 5, c = item & 31, b = bh >> 3, h = bh & 7, t0 = b * SEQ + c * 64, tid = threadIdx.x;
#pragma unroll
    for (int i = 0; i < 2; ++i) { const int ch = tid + 512 * i, t = ch >> 4, c16 = ch & 15; const bf16_t* rp = proj + (size_t)(t0 + t) * INCP + h * 128 + c16 * 8;
        P.fl[i] = *(const v4u*)(rp + 1024); P.v[i] = *(const v4u*)(rp + 2048); if (NEEDQ) P.q[i] = *(const v4u*)rp; }
}
struct HgCol { float kv[16]; float b[16]; float blast, bmid; };
template <bool NEEDQ, bool PERM>
__device__ __forceinline__ void hg_stage(const HgPre& P, const float* __restrict__ lbl, int h, LAS unsigned char* lds, HgCol& C) {
    const int tid = threadIdx.x, k = tid & 127, seg = tid >> 7;
    __syncthreads();
#pragma unroll
    for (int i = 0; i < 2; ++i) { const int ch = tid + 512 * i, t = ch >> 4, c16 = ch & 15;
        *(LAS v4u*)(lds + HG_FL + t * HG_P + c16 * 16) = P.fl[i]; if (NEEDQ) *(LAS v4u*)(lds + HG_QT + t * HG_P + c16 * 16) = P.q[i];
        const v4u w = P.v[i]; const int o = t & 15, pos = PERM ? ((t & ~15) + 8 * ((o >> 2) & 1) + 4 * ((o >> 3) & 1) + (o & 3)) : t;
        LAS unsigned short* vp = (LAS unsigned short*)(lds + HG_VT + (c16 * 8) * HG_VP + (((pos >> 3) ^ (c16 & 7)) * 16) + (pos & 7) * 2);
        vp[0 * (HG_VP / 2)] = (unsigned short)(w.x & 0xffff); vp[1 * (HG_VP / 2)] = (unsigned short)(w.x >> 16);
        vp[2 * (HG_VP / 2)] = (unsigned short)(w.y & 0xffff); vp[3 * (HG_VP / 2)] = (unsigned short)(w.y >> 16);
        vp[4 * (HG_VP / 2)] = (unsigned short)(w.z & 0xffff); vp[5 * (HG_VP / 2)] = (unsigned short)(w.z >> 16);
        vp[6 * (HG_VP / 2)] = (unsigned short)(w.w & 0xffff); vp[7 * (HG_VP / 2)] = (unsigned short)(w.w >> 16); }
    const float l0 = lbl[h * 128 + k], l1 = lbl[1024 + h * 128 + k];
    const float lb = 1.f / (1.f + __expf(l1 - l0));
    __syncthreads();
    const LAS unsigned short* fp = (const LAS unsigned short*)(lds + HG_FL + (seg * 16) * HG_P + k * 2);
    float run = 0.f;
#pragma unroll
    for (int i = 0; i < 16; ++i) { const float fl = bf2f(fp[i * (HG_P / 2)]); const float f = lb + (1.f - lb) / (1.f + __expf(-fl)); C.kv[i] = 1.f - f; run += __logf(f); C.b[i] = run; }
    LAS float* SEG = (LAS float*)(lds + HG_SEG);
    SEG[seg * 128 + k] = run;
    __syncthreads();
    const float s0 = SEG[k], s1 = SEG[128 + k], s2 = SEG[256 + k], s3 = SEG[384 + k];
    const float off = (seg > 0 ? s0 : 0.f) + (seg > 1 ? s1 : 0.f) + (seg > 2 ? s2 : 0.f);
#pragma unroll
    for (int i = 0; i < 16; ++i) C.b[i] += off;
    C.bmid = s0 + s1; C.blast = (s0 + s1) + (s2 + s3);
}
__device__ __forceinline__ void hgrn_pass1(const Params& p, LAS unsigned char* lds, int wave, int lane) {
    unsigned char* ws = p.ws; const bf16_t* proj = (const bf16_t*)(ws + WS_PROJ);
    bf16_t* hgU = (bf16_t*)(ws + WS_HGU); float* hgd = (float*)(ws + TAB_HGD);
    const int tid = threadIdx.x, k = tid & 127, seg = tid >> 7, cl = lane & 31, hh = lane >> 5, G = gridDim.x;
    HgPre P; if ((int)blockIdx.x < 1024) hg_issue<false>(proj, blockIdx.x, P);
    for (int item = blockIdx.x; item < 1024; item += G) {
        const int h = (item >> 5) & 7;
        HgCol C; hg_stage<false, false>(P, p.in[8], h, lds, C);
        if (item + G < 1024) hg_issue<false>(proj, item + G, P);
        { unsigned w[8];
#pragma unroll
          for (int i = 0; i < 8; ++i) { const float a0 = C.kv[2 * i] * __expf(C.blast - C.b[2 * i]), a1 = C.kv[2 * i + 1] * __expf(C.blast - C.b[2 * i + 1]); w[i] = pk2(a0, a1); }
          LAS v4u* kp = (LAS v4u*)(lds + HG_KT + k * HG_VP + seg * 32); kp[0] = (v4u){w[0], w[1], w[2], w[3]}; kp[1] = (v4u){w[4], w[5], w[6], w[7]}; }
        if (seg == 0) hgd[item * 128 + k] = __expf(C.blast);
        __syncthreads();
        const int vb = wave >> 1;
        bf16x8 af[4];
#pragma unroll
        for (int ks = 0; ks < 4; ++ks) af[ks] = *(const LAS bf16x8*)(lds + HG_VT + (32 * vb + cl) * HG_VP + (((2 * ks + hh) ^ ((cl >> 3) & 3) ^ ((vb & 1) << 2)) * 16));
#pragma unroll
        for (int q = 0; q < 2; ++q) { const int kb = (wave & 1) * 2 + q; f32x16 acc;
#pragma unroll
            for (int r = 0; r < 16; ++r) acc[r] = 0.f;
#pragma unroll
            for (int ks = 0; ks < 4; ++ks) { const bf16x8 bfr = *(const LAS bf16x8*)(lds + HG_KT + (32 * kb + cl) * HG_VP + (16 * ks + 8 * hh) * 2); acc = __builtin_amdgcn_mfma_f32_32x32x16_bf16(af[ks], bfr, acc, 0, 0, 0); }
            bf16_t* up = hgU + (size_t)item * 16384 + 32 * kb + cl;
#pragma unroll
            for (int r = 0; r < 16; ++r) { const int v = 32 * vb + (r & 3) + 8 * (r >> 2) + 4 * hh; up[(size_t)v * 128] = (bf16_t)f2bf(acc[r]); } }
    }
}
__device__ __forceinline__ void hgrn_scan(const Params& p, int tid, int nthr) {
    unsigned char* ws = p.ws; bf16_t* hgU = (bf16_t*)(ws + WS_HGU); const float* hgd = (const float*)(ws + TAB_HGD);
    for (int i = blockIdx.x * nthr + tid; i < 32 * 2048; i += gridDim.x * nthr) {
        const int bh = i >> 11, e8 = i & 2047, k8 = (e8 & 15) * 8;
        float S[8] = {0.f, 0.f, 0.f, 0.f, 0.f, 0.f, 0.f, 0.f};
        v4u* up = (v4u*)(hgU + (size_t)bh * 32 * 16384 + (size_t)e8 * 8); const float* dp = hgd + (size_t)bh * 32 * 128 + k8;
#pragma unroll 1
        for (int c0 = 0; c0 < 32; c0 += 8) { v4u u[8]; f32x4 d0[8], d1[8];
#pragma unroll
            for (int j = 0; j < 8; ++j) { u[j] = up[(size_t)(c0 + j) * 2048]; d0[j] = *(const f32x4*)(dp + (c0 + j) * 128); d1[j] = *(const f32x4*)(dp + (c0 + j) * 128 + 4); }
#pragma unroll
            for (int j = 0; j < 8; ++j) { v4u o; o.x = pk2(S[0], S[1]); o.y = pk2(S[2], S[3]); o.z = pk2(S[4], S[5]); o.w = pk2(S[6], S[7]); up[(size_t)(c0 + j) * 2048] = o;
                S[0] = d0[j][0] * S[0] + bflo(u[j].x); S[1] = d0[j][1] * S[1] + bfhi(u[j].x); S[2] = d0[j][2] * S[2] + bflo(u[j].y); S[3] = d0[j][3] * S[3] + bfhi(u[j].y);
                S[4] = d1[j][0] * S[4] + bflo(u[j].z); S[5] = d1[j][1] * S[5] + bfhi(u[j].z); S[6] = d1[j][2] * S[6] + bflo(u[j].w); S[7] = d1[j][3] * S[7] + bfhi(u[j].w); } }
    }
}
__device__ __forceinline__ void hgrn_pass3(const Params& p, LAS unsigned char* lds, int wave, int lane, int first, int stride, int limit = 1024) {
    unsigned char* ws = p.ws; const bf16_t* proj = (const bf16_t*)(ws + WS_PROJ);
    const bf16_t* hgS = (const bf16_t*)(ws + WS_HGU); bf16_t* merged = (bf16_t*)(ws + WS_MERGED); const float* og = p.in[9];
    const int tid = threadIdx.x, k = tid & 127, seg = tid >> 7, cl = lane & 31, hh = lane >> 5, vb = wave & 3, tb = wave >> 2, G = gridDim.x;
    HgPre P; if (first < limit) hg_issue<true>(proj, first, P);
    for (int item = first; item < limit; item += stride) {
        const int bh = item >> 5, c = item & 31, b = bh >> 3, h = bh & 7, t0 = b * SEQ + c * 64;
        bf16x8 sf[8]; v2u gw[4];
        { const bf16_t* sp = hgS + (size_t)item * 16384 + (size_t)(32 * vb + cl) * 128 + 8 * hh;
#pragma unroll
          for (int ks = 0; ks < 8; ++ks) sf[ks] = __builtin_nontemporal_load((const bf16x8*)(sp + 16 * ks));
          const int t = t0 + 32 * tb + cl;
#pragma unroll
          for (int rq = 0; rq < 4; ++rq) gw[rq] = *(const v2u*)(proj + (size_t)t * INCP + 3072 + h * 128 + 32 * vb + 8 * rq + 4 * hh); }
        HgCol C; hg_stage<true, true>(P, p.in[8], h, lds, C);
        { const LAS unsigned short* qp = (const LAS unsigned short*)(lds + HG_QT + (seg * 16) * HG_P + k * 2);
          LAS unsigned short* a2 = (LAS unsigned short*)(lds + HG_A2 + (seg * 16) * HG_P + k * 2);
          LAS unsigned short* a1 = (LAS unsigned short*)(lds + HG_A1 + (seg * 16) * HG_P + k * 2);
          LAS unsigned short* qb = (LAS unsigned short*)(lds + HG_QB + (seg * 16) * HG_P + k * 2);
          const float em = __expf(-C.bmid), ep = __expf(C.bmid);
#pragma unroll
          for (int i = 0; i < 16; i += 2) { const float q0 = bf2f(qp[i * (HG_P / 2)]), q1 = bf2f(qp[(i + 1) * (HG_P / 2)]);
              const float e0 = __expf(C.b[i]), e1 = __expf(C.b[i + 1]);
              const unsigned wa2 = pk2(C.kv[i] * ep * __builtin_amdgcn_rcpf(e0), C.kv[i + 1] * ep * __builtin_amdgcn_rcpf(e1));
              const unsigned wa1 = pk2(q0 * e0 * em, q1 * e1 * em), wqb = pk2(q0 * e0, q1 * e1);
              a2[i * (HG_P / 2)] = (unsigned short)(wa2 & 0xffff); a2[(i + 1) * (HG_P / 2)] = (unsigned short)(wa2 >> 16);
              a1[i * (HG_P / 2)] = (unsigned short)(wa1 & 0xffff); a1[(i + 1) * (HG_P / 2)] = (unsigned short)(wa1 >> 16);
              qb[i * (HG_P / 2)] = (unsigned short)(wqb & 0xffff); qb[(i + 1) * (HG_P / 2)] = (unsigned short)(wqb >> 16); } }
        __syncthreads();
        if (item + stride < limit) hg_issue<true>(proj, item + stride, P);
        f32x16 O;
#pragma unroll
        for (int r = 0; r < 16; ++r) O[r] = 0.f;
#pragma unroll
        for (int ks = 0; ks < 8; ++ks) { const bf16x8 bq = *(const LAS bf16x8*)(lds + HG_QB + (32 * tb + cl) * HG_P + (16 * ks + 8 * hh) * 2); O = __builtin_amdgcn_mfma_f32_32x32x16_bf16(sf[ks], bq, O, 0, 0, 0); }
#pragma unroll
        for (int sb = 0; sb < 2; ++sb) {
            if (sb <= tb) {
                f32x16 X;
#pragma unroll
                for (int r = 0; r < 16; ++r) X[r] = 0.f;
#pragma unroll
                for (int ks = 0; ks < 8; ++ks) { const bf16x8 a = *(const LAS bf16x8*)(lds + HG_A2 + (32 * sb + cl) * HG_P + (16 * ks + 8 * hh) * 2);
                    const bf16x8 bq = *(const LAS bf16x8*)(lds + HG_A1 + (32 * tb + cl) * HG_P + (16 * ks + 8 * hh) * 2); X = __builtin_amdgcn_mfma_f32_32x32x16_bf16(a, bq, X, 0, 0, 0); }
                asm volatile("s_nop 7\n\ts_nop 7\n\ts_nop 7" ::: "memory");
                if (sb == tb) {
#pragma unroll
                    for (int r = 0; r < 16; ++r) { const int s = (r & 3) + 8 * (r >> 2) + 4 * hh; if (s > cl) X[r] = 0.f; } }
#pragma unroll
                for (int s2 = 0; s2 < 2; ++s2) { v4u w; w.x = pk2(X[8 * s2 + 0], X[8 * s2 + 1]); w.y = pk2(X[8 * s2 + 2], X[8 * s2 + 3]); w.z = pk2(X[8 * s2 + 4], X[8 * s2 + 5]); w.w = pk2(X[8 * s2 + 6], X[8 * s2 + 7]);
                    const bf16x8 a = *(const LAS bf16x8*)(lds + HG_VT + (32 * vb + cl) * HG_VP + (((4 * sb + 2 * s2 + hh) ^ ((cl >> 3) & 3) ^ ((vb & 1) << 2)) * 16));
                    O = __builtin_amdgcn_mfma_f32_32x32x16_bf16(a, __builtin_bit_cast(bf16x8, w), O, 0, 0, 0); }
            }
        }
        float ss = 0.f;
#pragma unroll
        for (int r = 0; r < 16; ++r) ss += O[r] * O[r];
        ss += __shfl_xor(ss, 32);
        LAS float* RS = (LAS float*)(lds + HG_RS);
        if (hh == 0) RS[(tb * 4 + vb) * 32 + cl] = ss;
        __syncthreads();
        const float tot = (RS[(tb * 4 + 0) * 32 + cl] + RS[(tb * 4 + 1) * 32 + cl]) + (RS[(tb * 4 + 2) * 32 + cl] + RS[(tb * 4 + 3) * 32 + cl]);
        const float rn = rsqrtf(tot * (1.f / 128.f) + EPS);
        const int t = t0 + 32 * tb + cl;
#pragma unroll
        for (int rq = 0; rq < 4; ++rq) { const int v = 32 * vb + 8 * rq + 4 * hh; const f32x4 gg = *(const f32x4*)(og + v);
            const float g0 = bflo(gw[rq].x), g1 = bfhi(gw[rq].x), g2 = bflo(gw[rq].y), g3 = bfhi(gw[rq].y);
            const float o0 = O[rq * 4 + 0] * rn * gg[0] * (g0 / (1.f + __expf(-g0))), o1 = O[rq * 4 + 1] * rn * gg[1] * (g1 / (1.f + __expf(-g1)));
            const float o2 = O[rq * 4 + 2] * rn * gg[2] * (g2 / (1.f + __expf(-g2))), o3 = O[rq * 4 + 3] * rn * gg[3] * (g3 / (1.f + __expf(-g3)));
            v2u w; w.x = pk2(o0, o1); w.y = pk2(o2, o3); *(v2u*)(merged + (size_t)t * DM + 1024 + h * 128 + v) = w; }
    }
}
typedef float f32x2v __attribute__((ext_vector_type(2)));
constexpr int UPITCH = 2056;
constexpr int LDS_HIST = RING_BYTES + 1024;
__device__ __forceinline__ void phase8(const Params& p, LAS unsigned char* lds, int wave, int lane) {
    unsigned char* ws = p.ws;
    const float* h1 = (const float*)(ws + WS_H1); const float* mod = (const float*)(ws + CTL_MOD);
    unsigned char* u8 = ws + WS_U16;
    const float* wr_ = p.in[18]; const float* rbias = p.in[19];
    int* top_idx = (int*)(ws + TAB_TOPI); float* top_w = (float*)(ws + TAB_TOPW); int* slot = (int*)(ws + TAB_SLOT);
    LAS unsigned short* UH = (LAS unsigned short*)lds; LAS unsigned short* UL = UH + 16 * UPITCH;
    const unsigned short* wrh = (const unsigned short*)(ws + WS_WRH); const unsigned short* wrl = (const unsigned short*)(ws + WS_WRL);
    LAS int* hist = (LAS int*)(lds + LDS_HIST);
    if (threadIdx.x < 64) hist[threadIdx.x] = 0;
    LAS float* SS = (LAS float*)(lds + RING_BYTES + 5120);
    const int TPB = (NT / 16 + gridDim.x - 1) / gridDim.x;
    int ssb = -1;
    for (int task = blockIdx.x * TPB; task < NT / 16 && task < (int)(blockIdx.x + 1) * TPB; ++task) {
        const int t0 = task * 16;
        if (t0 / SEQ != ssb) { ssb = t0 / SEQ; __syncthreads();
            for (int i4 = threadIdx.x; i4 < DM / 4; i4 += NTHR) { const f32x4 gv = *(const f32x4*)(p.in[6] + i4 * 4), sv = *(const f32x4*)(mod + ssb * MODW + 4 * DM + i4 * 4), hv = *(const f32x4*)(mod + ssb * MODW + 3 * DM + i4 * 4);
                *(LAS f32x4*)(SS + i4 * 4) = gv * (sv + 1.f); *(LAS f32x4*)(SS + DM + i4 * 4) = hv; } }
        __syncthreads();
        { f32x4 v[2][8];
#pragma unroll
          for (int rr = 0; rr < 2; ++rr) { const float* hrow = h1 + (size_t)(t0 + wave * 2 + rr) * DM;
#pragma unroll
              for (int j = 0; j < 8; ++j) v[rr][j] = __builtin_nontemporal_load((const f32x4*)(hrow + lane * 4 + 256 * j)); }
#pragma unroll
          for (int rr = 0; rr < 2; ++rr) {
            const int tl = wave * 2 + rr, t = t0 + tl, b = t / SEQ;
            float s = 0.f;
#pragma unroll
            for (int j = 0; j < 8; ++j) s += (v[rr][j].x * v[rr][j].x + v[rr][j].y * v[rr][j].y) + (v[rr][j].z * v[rr][j].z + v[rr][j].w * v[rr][j].w);
            const float r = rsqrtf(wave_sum(s) * (1.f / DM) + EPS);
#pragma unroll
            for (int j = 0; j < 8; ++j) { const int col = lane * 4 + 256 * j; const f32x4 gs = *(const LAS f32x4*)(SS + col), hv = *(const LAS f32x4*)(SS + DM + col);
                const f32x4 o = v[rr][j] * r * gs + hv; *(unsigned*)(u8 + (size_t)t * DM + col) = pk4_fp8(o.x * 4.f, o.y * 4.f, o.z * 4.f, o.w * 4.f);
                v2u uhv, ulv; uhv.x = pk2(o.x, o.y); uhv.y = pk2(o.z, o.w); ulv.x = pk2(o.x - bflo(uhv.x), o.y - bfhi(uhv.x)); ulv.y = pk2(o.z - bflo(uhv.y), o.w - bfhi(uhv.y));
                *(LAS v2u*)(UH + tl * UPITCH + col) = uhv; *(LAS v2u*)(UL + tl * UPITCH + col) = ulv; }
          } }
        __syncthreads();
        f32x4 acc[4];
#pragma unroll
        for (int c = 0; c < 4; ++c) acc[c] = (f32x4){0.f, 0.f, 0.f, 0.f};
        { const int kb = wave * 256 + (lane >> 4) * 8, jr = lane & 15;
          const LAS unsigned short* uh = UH + jr * UPITCH + kb; const LAS unsigned short* ul = UL + jr * UPITCH + kb;
          const unsigned short* bh_ = wrh + ((size_t)(wave * 32) * 64 + lane) * 8; const unsigned short* bl_ = wrl + ((size_t)(wave * 32) * 64 + lane) * 8;
          pg8::bf16x8 bh[4], bl[4], nh[4], nl[4];
#pragma unroll
          for (int c = 0; c < 4; ++c) { bh[c] = *(const pg8::bf16x8*)(bh_ + c * 512); bl[c] = *(const pg8::bf16x8*)(bl_ + c * 512); }
#pragma unroll 1
          for (int s = 0; s < 8; ++s) {
              if (s + 1 < 8) {
#pragma unroll
                  for (int c = 0; c < 4; ++c) { nh[c] = *(const pg8::bf16x8*)(bh_ + (4 * (s + 1) + c) * 512); nl[c] = *(const pg8::bf16x8*)(bl_ + (4 * (s + 1) + c) * 512); } }
              const pg8::bf16x8 ah = *(const LAS pg8::bf16x8*)(uh + s * 32), al = *(const LAS pg8::bf16x8*)(ul + s * 32);
#pragma unroll
              for (int c = 0; c < 4; ++c) { acc[c] = __builtin_amdgcn_mfma_f32_16x16x32_bf16(ah, bh[c], acc[c], 0, 0, 0);
                  acc[c] = __builtin_amdgcn_mfma_f32_16x16x32_bf16(ah, bl[c], acc[c], 0, 0, 0); acc[c] = __builtin_amdgcn_mfma_f32_16x16x32_bf16(al, bh[c], acc[c], 0, 0, 0); }
#pragma unroll
              for (int c = 0; c < 4; ++c) { bh[c] = nh[c]; bl[c] = nl[c]; } } }
        __syncthreads();
        LAS float* P = (LAS float*)lds;
#pragma unroll
        for (int c = 0; c < 4; ++c)
#pragma unroll
            for (int r = 0; r < 4; ++r) P[wave * 1024 + ((lane >> 4) * 4 + r) * 64 + 16 * c + (lane & 15)] = acc[c][r];
        __syncthreads();
        LAS float* LG = (LAS float*)(lds + 32768);
#pragma unroll
        for (int q = 0; q < 2; ++q) { const int i = threadIdx.x + q * NTHR; float s = 0.f;
#pragma unroll
            for (int w = 0; w < 8; ++w) s += P[w * 1024 + i]; LG[i] = s; }
        __syncthreads();
#pragma unroll 1
        for (int rr = 0; rr < 2; ++rr) {
            const int tl = wave * 2 + rr, t = t0 + tl;
            int lanev = lane; asm volatile("" : "+v"(lanev));
            const float sc = 1.f / (1.f + expf(-LG[tl * 64 + lane])); const float sel = sc + rbias[lane];
            const float m1 = max8(sel);
            const unsigned long long gm = 0xFFull << (lanev & 56);
            const int first = __ffsll((long long)(__ballot(sel == m1) & gm)) - 1;
            const float m2 = max8((lanev == first) ? -INFINITY : sel);
            const float gs = m1 + m2; const int g = lanev >> 3; int grank = 0;
#pragma unroll
            for (int gg = 0; gg < 8; ++gg) { const float og = __builtin_bit_cast(float, __builtin_amdgcn_readlane(__builtin_bit_cast(int, gs), gg * 8)); grank += (og > gs || (og == gs && gg < g)) ? 1 : 0; }
            const bool gsel = grank < 4; int rk = 0;
            unsigned kb_ = __builtin_bit_cast(unsigned, sel); kb_ = (kb_ & 0x80000000u) ? ~kb_ : (kb_ | 0x80000000u);
            const unsigned long long key = gsel ? (((unsigned long long)kb_ << 6) | (unsigned long long)(63 - lanev)) : 0ull;
            const int klo = (int)(unsigned)key, khi = (int)(unsigned)(key >> 32);
#pragma unroll
            for (int e = 0; e < 64; ++e) { const unsigned long long o = ((unsigned long long)(unsigned)__builtin_amdgcn_readlane(khi, e) << 32) | (unsigned)__builtin_amdgcn_readlane(klo, e); rk += (o > key) ? 1 : 0; }
            const bool chosen = gsel && rk < 8;
            const unsigned long long cb = __ballot(chosen);
            const float wsum = wave_sum(chosen ? sc : 0.f);
            const int ks = __popcll(cb & ((1ull << lanev) - 1ull));
            if (chosen) { const int lr = __hip_atomic_fetch_add((int*)(hist + lane), 1, __ATOMIC_RELAXED, __HIP_MEMORY_SCOPE_WORKGROUP); top_idx[t * 8 + ks] = lane; top_w[t * 8 + ks] = sc / wsum * 2.5f; slot[t * 8 + ks] = lr; }
        }
        __syncthreads();
    }
    if (threadIdx.x < 64) ((int*)(ws + CTL_HIST))[blockIdx.x * 64 + threadIdx.x] = hist[threadIdx.x];
}

__device__ __forceinline__ void phase9(const Params& p, LAS unsigned char* lds, int wave, int lane) {
    unsigned char* ws = p.ws;
    const int* bh = (const int*)(ws + CTL_HIST);
    int* top_idx = (int*)(ws + TAB_TOPI); int* slot = (int*)(ws + TAB_SLOT); int* row_tok = (int*)(ws + TAB_ROWTOK); int* tile_exp = (int*)(ws + TAB_TILEEXP);
    LAS int* rb = (LAS int*)(lds + LDS_HIST + 256);
    const int G = gridDim.x;
    {
        LAS int* part = (LAS int*)(lds + LDS_HIST + 2048);
        const int e = threadIdx.x & 63, pt = threadIdx.x >> 6, per = (G + 7) / 8, b0 = pt * per, b1 = (b0 + per < G) ? b0 + per : G;
        int cnt = 0, base = 0;
#pragma unroll 8
        for (int b = b0; b < b1; ++b) { const int v = bh[b * 64 + e]; base += (b < (int)blockIdx.x) ? v : 0; cnt += v; }
        part[pt * 64 + e] = cnt; part[512 + pt * 64 + e] = base;
    }
    __syncthreads();
    if (wave == 0) {
        LAS int* part = (LAS int*)(lds + LDS_HIST + 2048);
        int cnt = 0, base = 0;
#pragma unroll
        for (int q = 0; q < 8; ++q) { cnt += part[q * 64 + lane]; base += part[512 + q * 64 + lane]; }
        const int tiles = (cnt + 255) >> 8;
        int incl = tiles;
#pragma unroll
        for (int o = 1; o < 64; o <<= 1) { const int n = __shfl_up(incl, o); if (lane >= o) incl += n; }
        const int toff = incl - tiles;
        rb[lane] = toff * 256 + base;
        if (blockIdx.x == 0) { for (int i = 0; i < tiles; ++i) tile_exp[toff + i] = lane; if (lane == 63) tile_exp[512] = incl; if (lane < 32) tile_exp[320 + lane] = 64; }
        rb[64 + lane] = toff * 256 + cnt; rb[128 + lane] = (toff + tiles) * 256;
    }
    __syncthreads();
    for (int e = blockIdx.x; e < 64; e += G) { const int lo = rb[64 + e], hi = rb[128 + e]; for (int r = lo + (int)threadIdx.x; r < hi; r += NTHR) row_tok[r] = 0; }
    for (int i = blockIdx.x * NTHR + threadIdx.x; i < NT; i += G * NTHR) row_tok[ROUTED_ROWS_MAX + i] = i;
    const int TPB = (NT / 16 + G - 1) / G;
    for (int task = blockIdx.x * TPB; task < NT / 16 && task < (int)(blockIdx.x + 1) * TPB; ++task) {
        const int t = task * 16 + wave * 2 + (lane >> 3), k = lane & 7;
        if (lane < 16) { const int e = top_idx[t * 8 + k]; const int pos = rb[e] + slot[t * 8 + k]; slot[t * 8 + k] = pos; row_tok[pos] = t; }
    }
}

constexpr int LDS_UNITS = RING_BYTES + 8192;
struct MoeOrder {
    LAS int* tab; int n;
    __device__ void init(LAS unsigned char* lds, const int* tile_exp, int nN, int G, int c, long estride, long bstep, int parts) {
        tab = (LAS int*)(lds + LDS_UNITS);
        const int ntr = tile_exp[512], nwg = (ntr + 32) * nN;
        int T = nwg % G, nfull = nwg - T; if (true) { nfull = nwg; T = 0; }
        const int njobs = nfull + parts * T;
        const int i = threadIdx.x; n = 0;
        if (c < njobs) n = (njobs - 1 - c) / G + 1;
        if (i < 32 && i < n) {
            const int L = i * G + c; int wgid, mask = 15;
            if (L < nfull) wgid = L; else { const int j = L - nfull; wgid = nfull + j % T; const int part = j / T; mask = (parts == 2) ? (part ? 12 : 3) : (1 << part); }
            { const int q = nwg / 8, r = nwg % 8, xcd = wgid % 8, off = wgid / 8; wgid = (xcd < r ? xcd * (q + 1) : r * (q + 1) + (xcd - r) * q) + off; }
            const int ti = wgid / nN, pn = wgid % nN; int tile, e; if (ti < ntr) { tile = ti; e = tile_exp[ti]; } else { tile = 320 + (ti - ntr); e = 64; }
            const long boff = (long)e * estride + (long)pn * bstep;
            tab[i * 8 + 0] = tile; tab[i * 8 + 1] = pn; tab[i * 8 + 2] = (int)(boff & 0xffffffffl); tab[i * 8 + 3] = (int)(boff >> 32); tab[i * 8 + 4] = mask;
        }
        __syncthreads();
    }
    __device__ bool next(int i, pg8::Unit& u) const {
        if (i >= n) return false;
        u.pm = tab[i * 8 + 0]; u.pn = tab[i * 8 + 1]; u.boff = (long)(((unsigned long long)(unsigned)tab[i * 8 + 3] << 32) | (unsigned)tab[i * 8 + 2]); u.mask = tab[i * 8 + 4]; u.pad = 0; return true;
    }
};
struct EpiGateUp { static constexpr bool PERM = true, MIDK = false; static constexpr int NST = 8;       unsigned char* H;
    __device__ __forceinline__ void operator()(const pg8::f32x4 (&acc)[2][2][4][2], const pg8::Unit& u, int wr, int wc, int fr, int fq) const {
        const int row0 = u.pm * 256 + wr * 64 + fr, col0 = u.pn * 128 + wc * 32 + 8 * fq;
#pragma unroll
        for (int ai = 0; ai < 2; ++ai)
#pragma unroll
            for (int m = 0; m < 4; ++m) { const int row = row0 + ai * 128 + m * 16; float o[8];
#pragma unroll
                for (int n = 0; n < 2; ++n)
#pragma unroll
                    for (int j = 0; j < 4; ++j) { const float gt = acc[ai][0][m][n][j] * (1.f / 256.f), up = acc[ai][1][m][n][j] * (8.f / 256.f); o[n * 4 + j] = gt / (1.f + __expf(-gt)) * up; }
                v2u w; w.x = pk4_fp8(o[0], o[1], o[2], o[3]); w.y = pk4_fp8(o[4], o[5], o[6], o[7]);
                *(v2u*)(H + (size_t)row * DE + col0) = w; }
    }
};
constexpr int EPI_STG = RING_BYTES + 10240, EPI_STG_P = 272;
struct EpiDown { static constexpr bool PERM = true, MIDK = false; static constexpr int NST = 8;        unsigned char* Y; LAS unsigned char* lds;
    __device__ __forceinline__ void operator()(const pg8::f32x4 (&acc)[2][2][4][2], const pg8::Unit& u, int wr, int wc, int fr, int fq) const {
        const float s = 16.f / 512.f; const int tid = threadIdx.x;
        LAS unsigned char* wp = lds + EPI_STG + (wr * 32 + fr) * EPI_STG_P + wc * 32 + 8 * fq;
        const int rrow = tid >> 4, rch = tid & 15;
        const LAS unsigned char* rp = lds + EPI_STG + rrow * EPI_STG_P + rch * 16;
#pragma unroll
        for (int ai = 0; ai < 2; ++ai)
#pragma unroll
            for (int mh = 0; mh < 2; ++mh) {
#pragma unroll
                for (int mm = 0; mm < 2; ++mm)
#pragma unroll
                    for (int bj = 0; bj < 2; ++bj) { const int m = mh * 2 + mm; const pg8::f32x4 v0 = acc[ai][bj][m][0] * s, v1 = acc[ai][bj][m][1] * s;
                        v2u w; w.x = pk4_fp8(v0[0], v0[1], v0[2], v0[3]); w.y = pk4_fp8(v1[0], v1[1], v1[2], v1[3]); *(LAS v2u*)(wp + mm * 16 * EPI_STG_P + bj * 128) = w; }
                asm volatile("s_waitcnt lgkmcnt(0)" ::: "memory"); __builtin_amdgcn_s_barrier();
#pragma unroll
                for (int q = 0; q < 2; ++q) { const int sr = rrow + 32 * q;
                    const v4u w = *(const LAS v4u*)(rp + q * 32 * EPI_STG_P);
                    const int rt = ai * 128 + (sr >> 5) * 64 + mh * 32 + (sr & 31);
                    __builtin_nontemporal_store(w, (v4u*)(Y + ((size_t)(u.pm * 8 + u.pn) * 256 + rt) * 256 + rch * 16)); }

                asm volatile("s_waitcnt lgkmcnt(0)" ::: "memory"); __builtin_amdgcn_s_barrier(); }
    }
};
__device__ __forceinline__ void phase10(const Params& p, LAS unsigned char* lds) {
    unsigned char* ws = p.ws;
    pg8::Gemm g{(const bf16_t*)(ws + WS_U16), (const bf16_t*)(ws + WS_BT_GU), (const int*)(ws + TAB_ROWTOK), DM, DM, DM, 0};
    MoeOrder S; S.init(lds, (const int*)(ws + TAB_TILEEXP), 4, gridDim.x, blockIdx.x, (long)1024 * DM, (long)256 * DM, 2);
    EpiGateUp E{ws + WS_HID};
    pg8::gemm_phase<EpiGateUp, MoeOrder, 1, true, true>((PG8_LAS unsigned char*)lds, g, S, E);
}
__device__ __forceinline__ void phase11(const Params& p, LAS unsigned char* lds) {
    unsigned char* ws = p.ws;
    pg8::Gemm g{(const bf16_t*)(ws + WS_HID), (const bf16_t*)(ws + WS_BT_DN), nullptr, DE, DE, DE, 0};
    MoeOrder S; S.init(lds, (const int*)(ws + TAB_TILEEXP), 8, gridDim.x, blockIdx.x, (long)DM * DE, (long)256 * DE, 4);
    EpiDown E{ws + WS_Y, lds};
    pg8::gemm_phase<EpiDown, MoeOrder, 1, true, true>((PG8_LAS unsigned char*)lds, g, S, E);
}
__device__ __forceinline__ void fp8x8_fma(const v2u y, float w, float (&a)[8]) {
#pragma unroll
    for (int q = 0; q < 2; ++q) { const unsigned d = y[q];
        a[q * 4 + 0] += w * __builtin_amdgcn_cvt_f32_fp8((int)d, 0); a[q * 4 + 1] += w * __builtin_amdgcn_cvt_f32_fp8((int)d, 1);
        a[q * 4 + 2] += w * __builtin_amdgcn_cvt_f32_fp8((int)d, 2); a[q * 4 + 3] += w * __builtin_amdgcn_cvt_f32_fp8((int)d, 3); }
}
__device__ __forceinline__ void phase12(const Params& p, int wave, int lane) {
    unsigned char* ws = p.ws;
    const float* h1 = (const float*)(ws + WS_H1); const float* mod = (const float*)(ws + CTL_MOD); const unsigned char* Y = ws + WS_Y;
    const int* slot = (const int*)(ws + TAB_SLOT); const float* top_w = (const float*)(ws + TAB_TOPW);
    const int gw = blockIdx.x * NWAVES + wave, NGW = gridDim.x * NWAVES;
    for (int t = gw; t < NT; t += NGW) {
        const int b = t / SEQ; const float* gt = mod + b * MODW + 5 * DM;
        int sl = 0; float wk = 0.f; if (lane < 8) { sl = slot[t * 8 + lane]; wk = top_w[t * 8 + lane] * (1.f / 16.f); }
#pragma unroll 2
        for (int j = 0; j < 4; ++j) {
            const int col = j * 512 + lane * 4;
            float a[8];
#pragma unroll
            for (int i = 0; i < 8; ++i) a[i] = 0.f;
            v2u yr[9];
            { const int s = ROUTED_ROWS_MAX + t; const unsigned char* yp = Y + ((size_t)((s >> 8) * 8 + 2 * j) * 256 + (s & 255)) * 256 + lane * 4; yr[8].x = __builtin_nontemporal_load((const unsigned*)yp); yr[8].y = __builtin_nontemporal_load((const unsigned*)(yp + 65536)); }
#pragma unroll
            for (int k = 0; k < 8; ++k) { const int s = __builtin_amdgcn_readlane(sl, k); const unsigned char* yp = Y + ((size_t)((s >> 8) * 8 + 2 * j) * 256 + (s & 255)) * 256 + lane * 4;
                yr[k].x = __builtin_nontemporal_load((const unsigned*)yp); yr[k].y = __builtin_nontemporal_load((const unsigned*)(yp + 65536)); }
            const f32x4 h0 = *(const f32x4*)(h1 + (size_t)t * DM + col), h4 = *(const f32x4*)(h1 + (size_t)t * DM + col + 256);
            const f32x4 g0 = *(const f32x4*)(gt + col), g4 = *(const f32x4*)(gt + col + 256);
            fp8x8_fma(yr[8], 1.f / 16.f, a);
#pragma unroll
            for (int k = 0; k < 8; ++k) { const float w = __builtin_bit_cast(float, __builtin_amdgcn_readlane(__builtin_bit_cast(int, wk), k)); fp8x8_fma(yr[k], w, a); }
            f32x4 o0, o4; o0.x = h0.x + g0.x * a[0]; o0.y = h0.y + g0.y * a[1]; o0.z = h0.z + g0.z * a[2]; o0.w = h0.w + g0.w * a[3];
            o4.x = h4.x + g4.x * a[4]; o4.y = h4.y + g4.y * a[5]; o4.z = h4.z + g4.z * a[6]; o4.w = h4.w + g4.w * a[7];
            __builtin_nontemporal_store(o0, (f32x4*)(p.out + (size_t)t * DM + col)); __builtin_nontemporal_store(o4, (f32x4*)(p.out + (size_t)t * DM + col + 256));
        }
    }
}

__global__ void __launch_bounds__(NTHR, 2) k_mega(Params p) {
    extern __shared__ __attribute__((aligned(16))) unsigned char lds_raw[];
    LAS unsigned char* lds = (LAS unsigned char*)lds_raw;
    const int tid = threadIdx.x, lane = tid & 63, wave = __builtin_amdgcn_readfirstlane(tid >> 6);
    volatile LAS unsigned* MISC = (volatile LAS unsigned*)(lds + MISC_OFF);
    for (int u = tid; u < (LDS_BYTES - RING_BYTES) / 4; u += NTHR) ((LAS unsigned*)(lds + RING_BYTES))[u] = 0u;
    __syncthreads();
    XcdBarrier bar = xcd_barrier_post((unsigned*)(p.ws + WS_CTL) + CW_BAR, MISC + 8);
    const int lo = p.ph_lo, hi = p.ph_hi;
#ifndef DUP_MASK
#define DUP_MASK 0
#endif
#define IN(k) (lo <= (k) && (k) < hi)
#define DUPK(k, body) do { if (IN(k)) { body; if ((DUP_MASK >> (k)) & 1) { xcd_barrier(bar); body; } } } while (0)
#ifdef SPIN_PHASE
#define STAMP(k) do { if (blockIdx.x == 0 && tid == 0) ((unsigned long long*)(p.ws + 49152))[k] = __builtin_amdgcn_s_memrealtime(); } while (0)
#else
#define STAMP(k) do { } while (0)
#endif
#define SEAM(k) do { if (IN(k) && IN((k) + 1)) { xcd_barrier(bar); STAMP((k) + 1); } } while (0)
    STAMP(0);
    DUPK(0, phase0(p, lds, wave, lane)); SEAM(0);
    DUPK(1, phase1(p, lds, wave, lane)); SEAM(1);
#ifdef EXTRA_BARS
    for (int eb = 0; eb < EXTRA_BARS; ++eb) xcd_barrier(bar);
#endif
    DUPK(2, phase2(p, lds)); SEAM(2);
    DUPK(3, phase3_gemms(p, lds); hgrn_pass1(p, lds, wave, lane)); SEAM(3);
    DUPK(4, if (wave < 4) hgrn_scan(p, threadIdx.x, 256); else phase4_qk(p, wave - 4, lane, 4)); SEAM(4);
    DUPK(5, if (gridDim.x != 256) { phase5_attn(p, lds, wave, lane); hgrn_pass3(p, lds, wave, lane, blockIdx.x, gridDim.x); }
            else if (blockIdx.x < 192) { const int li = (int)(blockIdx.x >> 3); const int r3 = li >= 8 ? (li - 8) * 8 + (int)(blockIdx.x & 7) : 1024;
                   if (li >= 8 && li < 16) { hgrn_pass3(p, lds, wave, lane, r3, 128, 896); __syncthreads(); phase5_attn(p, lds, wave, lane); }
                   else if (li >= 16) { phase5_attn(p, lds, wave, lane); hgrn_pass3(p, lds, wave, lane, r3, 128, 896); }
                   else { phase5_attn(p, lds, wave, lane); hgrn_pass3(p, lds, wave, lane, 896 + li * 8 + (int)(blockIdx.x & 7), 64, 1024); } }
            else { const int base = CT_GU + CT_DN - exp_late2(256) - exp_late3(256) - CT_EXP_LATE5;
                   expert_stream(p, (LAS unsigned*)(lds + wave * 18432), base + ((int)blockIdx.x - 192) * NWAVES + wave, 64 * NWAVES, lane, base + CT_EXP_LATE5); }); if (IN(5) && IN(7)) { xcd_barrier(bar); STAMP(6); STAMP(7); }
    DUPK(7, phase7(p, lds)); SEAM(7);
    DUPK(8, phase8(p, lds, wave, lane)); SEAM(8);
    DUPK(9, phase9(p, lds, wave, lane)); SEAM(9);
    DUPK(10, phase10(p, lds)); SEAM(10);
    DUPK(11, phase11(p, lds)); SEAM(11);
    DUPK(12, phase12(p, wave, lane));
#ifdef SPIN_NTR
    { const int ntr = ((const int*)(p.ws + TAB_TILEEXP))[512]; const unsigned long long d = (unsigned long long)(ntr - 256) * 1000ull;
      const unsigned long long t0 = __builtin_amdgcn_s_memrealtime(); while (__builtin_amdgcn_s_memrealtime() - t0 < d) __builtin_amdgcn_s_sleep(8); }
#endif
#ifdef SPIN_PHASE
    xcd_barrier(bar); STAMP(13);
    xcd_barrier(bar);
    { const unsigned long long* ts = (const unsigned long long*)(p.ws + 49152);
      const unsigned long long d = __hip_atomic_load(ts + SPIN_PHASE + 1, __ATOMIC_RELAXED, __HIP_MEMORY_SCOPE_AGENT) - __hip_atomic_load(ts + SPIN_PHASE, __ATOMIC_RELAXED, __HIP_MEMORY_SCOPE_AGENT);
      const unsigned long long t0 = __builtin_amdgcn_s_memrealtime(); while (__builtin_amdgcn_s_memrealtime() - t0 < 4ull * d) __builtin_amdgcn_s_sleep(8); }
#endif
#undef IN
#undef SEAM
}
extern "C" void kernel_launch(void* const* d_in, const int* in_sizes, int n_in, void* d_out, int out_size, void* d_ws, size_t ws_size, hipStream_t stream) {
    static int grid = 0;
    if (grid == 0) {
        int dev = 0, cus = 0;
        if (hipGetDevice(&dev) != hipSuccess || hipDeviceGetAttribute(&cus, hipDeviceAttributeMultiprocessorCount, dev) != hipSuccess) { grid = -1; return; }
        if (hipFuncSetAttribute((const void*)k_mega, hipFuncAttributeMaxDynamicSharedMemorySize, LDS_BYTES) != hipSuccess) { fprintf(stderr, "kernel_launch: hipFuncSetAttribute failed\n"); grid = -1; return; }
        (void)hipGetLastError();
        grid = cus;
        if (n_in != 26 || ws_size < WS_END) { fprintf(stderr, "kernel_launch: unexpected inputs / workspace (%d, %zu)\n", n_in, ws_size); grid = -1; return; }
    }
    if (grid < 0) return;
    (void)hipMemsetAsync((char*)d_ws + WS_CTL, 0, CTL_ZERO_BYTES, stream);
    Params p{};
    for (int i = 0; i < 26; ++i) p.in[i] = (const float*)d_in[i];
    p.out = (float*)d_out; p.ws = (unsigned char*)d_ws; p.ph_lo = 0; p.ph_hi = 13;
    hipLaunchKernelGGL(k_mega, dim3(grid), dim3(NTHR), LDS_BYTES, stream, p);
}
```
